# Optimizing an MI355X kernel written in HIP

```python
import jax
import jax.numpy as jnp
from jax import lax
import numpy as np

D_MODEL = 1024
BATCH = 1
SEQ = 16384
DEPTH = 2

N_MIXERS = 4
GROUP_W = D_MODEL // N_MIXERS
D_MIX = N_MIXERS * GROUP_W
NORM_EPS = 1e-6
POOL_WINDOWS = (2, 4, 8, 16)
POOL_CG = GROUP_W // 4
HEAD_DIM = 64
ATT_HEADS = GROUP_W // HEAD_DIM
ATT_KV_HEADS = 2
ATT_WINDOW = 128
ATT_BLOCK = 128
CONV_W = 3
RWKV_HEAD = 64
RWKV_HEADS = GROUP_W // RWKV_HEAD
LORA_W = 32
LORA_A = 32
LORA_V = 32
LORA_G = 64
RWKV_GN_EPS = 64e-5
N_A = GROUP_W
N_B = (ATT_HEADS + 2 * ATT_KV_HEADS) * HEAD_DIM
N_C = 3 * GROUP_W
N_D = 3 * GROUP_W + LORA_W + LORA_A + LORA_G
N_IN = N_A + N_B + N_C + N_D
N_GROUPS = 4
EXP_PER_GROUP = 8
N_EXPERTS = N_GROUPS * EXP_PER_GROUP
TOP_K_IN_GROUP = 2
D_EXPERT = 128

kernel_name = 'hybrid_parallel_heads_hmoe'


def rms_norm(x, g):
    xf = x.astype(jnp.float32)
    y = xf * lax.rsqrt(jnp.mean(xf * xf, axis=-1, keepdims=True) + NORM_EPS)
    return (y * g.astype(jnp.float32)).astype(x.dtype)


def pool_mixer(u, w_pool, scale):
    B, T, _ = u.shape
    uf = u.astype(jnp.float32).reshape(B, T, len(POOL_WINDOWS), POOL_CG)
    cs = jnp.cumsum(uf, axis=1)
    count = jnp.arange(1, T + 1, dtype=jnp.float32)[None, :, None]
    diffs = []
    for j, w in enumerate(POOL_WINDOWS):
        cj = cs[:, :, j]
        prev = jnp.pad(cj, ((0, 0), (w, 0), (0, 0)))[:, :T]
        diffs.append((cj - prev) / jnp.minimum(count, w) - uf[:, :, j])
    d = jnp.stack(diffs, axis=2)
    y = jnp.einsum('btgc,gce->btge', d, w_pool.astype(jnp.float32)).reshape(B, T, GROUP_W)
    return (y * scale.astype(jnp.float32)).astype(u.dtype)


def swa_sink_attention(q, k, v, sinks):
    B, T, H, hd = q.shape
    KVH = k.shape[2]
    G = H // KVH
    nb = T // ATT_BLOCK
    f32 = jnp.float32
    qb = q.astype(f32).reshape(B, nb, ATT_BLOCK, KVH, G, hd) * (hd ** -0.5)

    def band(z):
        zp = jnp.pad(z.astype(f32), ((0, 0), (ATT_BLOCK, 0), (0, 0), (0, 0)))
        zp = zp.reshape(B, nb + 1, ATT_BLOCK, KVH, hd)
        return jnp.concatenate([zp[:, :-1], zp[:, 1:]], axis=2)

    kb, vb = band(k), band(v)
    s = jnp.einsum('bnqhgd,bnkhd->bnhgqk', qb, kb)
    qi = jnp.arange(ATT_BLOCK)[:, None]
    ki = jnp.arange(2 * ATT_BLOCK)[None, :]
    dist = qi + ATT_BLOCK - ki
    kpos = (jnp.arange(nb)[:, None, None] - 1) * ATT_BLOCK + ki
    valid = (dist >= 0) & (dist < ATT_WINDOW) & (kpos >= 0)
    slopes = (2.0 ** (-8.0 * jnp.arange(1, H + 1, dtype=f32) / H)).reshape(KVH, G)
    s = s - slopes[:, :, None, None] * dist.astype(f32)
    s = jnp.where(valid[None, :, None, None], s, -jnp.inf)
    sink = sinks.astype(f32).reshape(KVH, G)[None, None, :, :, None, None]
    m = jnp.maximum(jnp.max(s, axis=-1, keepdims=True), sink)
    p = jnp.exp(s - m)
    p = p / (jnp.sum(p, axis=-1, keepdims=True) + jnp.exp(sink - m))
    o = jnp.einsum('bnhgqk,bnkhd->bnqhgd', p, vb)
    return o.reshape(B, T, H * hd).astype(q.dtype)


def short_gated_conv(bg, cg, xin, conv_w):
    z = cg * xin
    y = lax.conv_general_dilated(z, conv_w[:, None, :], window_strides=(1,),
                                 padding=[(CONV_W - 1, 0)],
                                 dimension_numbers=('NWC', 'WIO', 'NWC'),
                                 feature_group_count=GROUP_W)
    return bg * y


def rwkv7_time_mix(p, v_first, mu, w0, w2, a0, a2, g2, k_k, k_a, r_k, ln_g, ln_b, v_res):
    f32 = jnp.float32
    B, T, _ = p.shape
    H, N = RWKV_HEADS, RWKV_HEAD
    p = p.astype(f32)
    prev = jnp.pad(p, ((0, 0), (1, 0), (0, 0)))[:, :-1]
    z = p + (prev - p) * mu.astype(f32)
    cuts = [GROUP_W, 2 * GROUP_W, 3 * GROUP_W, 3 * GROUP_W + LORA_W, 3 * GROUP_W + LORA_W + LORA_A]
    r, k, v, wd, ad, gd = jnp.split(z, cuts, axis=-1)
    w = -jax.nn.softplus(-(w0.astype(f32) + jnp.tanh(wd) @ w2.astype(f32))) - 0.5
    decay = jnp.exp(-jnp.exp(w))
    a = jax.nn.sigmoid(a0.astype(f32) + ad @ a2.astype(f32))
    g = jax.nn.sigmoid(gd) @ g2.astype(f32)
    if v_res is None:
        v_first = v
    else:
        v0, v1, v2 = v_res
        v = v + (v_first - v) * jax.nn.sigmoid(v0.astype(f32) + (v @ v1.astype(f32)) @ v2.astype(f32))

    def heads(t):
        return t.reshape(B, T, H, N)

    kk = heads(k * k_k.astype(f32))
    kk = kk / jnp.maximum(jnp.sqrt(jnp.sum(kk * kk, axis=-1, keepdims=True)), 1e-12)
    k = k * (1.0 + (a - 1.0) * k_a.astype(f32))

    def step(S, inp):
        r_t, w_t, k_t, v_t, kk_t, a_t = inp
        sa = jnp.einsum('bhij,bhj->bhi', S, -kk_t)
        S = (S * w_t[:, :, None, :] + sa[..., :, None] * (kk_t * a_t)[:, :, None, :]
             + v_t[..., :, None] * k_t[..., None, :])
        return S, jnp.einsum('bhij,bhj->bhi', S, r_t)

    def tm(t):
        return jnp.moveaxis(heads(t), 1, 0)

    S0 = jnp.zeros((B, H, N, N), f32)
    _, y = lax.scan(step, S0, (tm(r), tm(decay), tm(k), tm(v), jnp.moveaxis(kk, 1, 0), tm(a)))
    y = jnp.moveaxis(y, 0, 1)
    mean = jnp.mean(y, axis=-1, keepdims=True)
    var = jnp.mean(jnp.square(y - mean), axis=-1, keepdims=True)
    y = ((y - mean) * lax.rsqrt(var + RWKV_GN_EPS)).reshape(B, T, GROUP_W)
    y = y * ln_g.astype(f32) + ln_b.astype(f32)
    bonus = (jnp.sum(heads(r * k * r_k.astype(f32)), axis=-1, keepdims=True) * heads(v)).reshape(B, T, GROUP_W)
    return (y + bonus) * g, v_first


def hier_moe(h, w_grp, b_grp, w_exp, b_exp, w_gate, w_up, w_down):
    B, T, D = h.shape
    f32 = jnp.float32
    hf = h.reshape(B * T, D)
    grp_prob = jax.nn.softmax((hf @ w_grp).astype(f32) + b_grp.astype(f32), axis=-1)
    gp, gi = lax.top_k(grp_prob, 1)
    exp_logits = ((hf @ w_exp).astype(f32) + b_exp.astype(f32)).reshape(-1, N_GROUPS, EXP_PER_GROUP)
    in_grp = jnp.take_along_axis(exp_logits, gi[:, :, None], axis=1)[:, 0]
    ev, ei = lax.top_k(in_grp, TOP_K_IN_GROUP)
    wts = jax.nn.softmax(ev, axis=-1) * gp
    eidx = gi * EXP_PER_GROUP + ei
    gates = jnp.einsum('nk,nke->ne', wts, jax.nn.one_hot(eidx, N_EXPERTS, dtype=f32))
    hg = jnp.einsum('nd,edf->nef', hf, w_gate)
    hu = jnp.einsum('nd,edf->nef', hf, w_up)
    act = jax.nn.silu(hg) * hu * gates[:, :, None].astype(h.dtype)
    y = jnp.einsum('nef,efd->nd', act, w_down)
    return y.reshape(B, T, D)


def setup_inputs(seed: int = 0) -> dict:
    key = jax.random.key(seed)
    keys = jax.random.split(key, 48)
    counter = [0]
    f32 = jnp.float32
    L, D = DEPTH, D_MODEL

    def nxt():
        kk = keys[counter[0]]
        counter[0] += 1
        return kk

    def nrm(shape, scale):
        return jax.random.normal(nxt(), shape, f32) * scale

    def unif(shape, lo, hi):
        return jax.random.uniform(nxt(), shape, f32, lo, hi)

    return {
        'x': nrm((BATCH, SEQ, D), 1.0),
        'c': nrm((BATCH, D), 1.0),
        'w_ada': nrm((L, D, 6 * D), 0.5 * D ** -0.5),
        'b_ada': nrm((L, 6 * D), 0.02),
        'norm1_g': 1.0 + nrm((L, D), 0.05),
        'norm2_g': 1.0 + nrm((L, D), 0.05),
        'w_in': nrm((L, D, N_IN), D ** -0.5),
        'w_out': nrm((L, D_MIX, D), D_MIX ** -0.5),
        'pool_w': nrm((L, len(POOL_WINDOWS), POOL_CG, POOL_CG), POOL_CG ** -0.5),
        'pool_scale': unif((L, GROUP_W), 0.5, 1.5),
        'attn_sinks': nrm((L, ATT_HEADS), 0.5),
        'conv_w': nrm((L, CONV_W, GROUP_W), CONV_W ** -0.5),
        'rwkv_mu': unif((L, N_D), 0.0, 1.0),
        'rwkv_w0': unif((L, GROUP_W), -6.0, -0.5),
        'rwkv_w2': nrm((L, LORA_W, GROUP_W), 0.5 * LORA_W ** -0.5),
        'rwkv_a0': nrm((L, GROUP_W), 0.1),
        'rwkv_a2': nrm((L, LORA_A, GROUP_W), 0.5 * LORA_A ** -0.5),
        'rwkv_g2': nrm((L, LORA_G, GROUP_W), LORA_G ** -0.5),
        'rwkv_k_k': 0.85 + nrm((L, GROUP_W), 0.05),
        'rwkv_k_a': 1.0 + nrm((L, GROUP_W), 0.05),
        'rwkv_r_k': nrm((L, GROUP_W), 0.1),
        'rwkv_ln_g': 1.0 + nrm((L, GROUP_W), 0.05),
        'rwkv_ln_b': nrm((L, GROUP_W), 0.02),
        'rwkv_v0': nrm((L - 1, GROUP_W), 0.1),
        'rwkv_v1': nrm((L - 1, GROUP_W, LORA_V), GROUP_W ** -0.5),
        'rwkv_v2': nrm((L - 1, LORA_V, GROUP_W), 0.5 * LORA_V ** -0.5),
        'moe_w_grp': nrm((L, D, N_GROUPS), D ** -0.5),
        'moe_b_grp': nrm((L, N_GROUPS), 0.01),
        'moe_w_exp': nrm((L, D, N_EXPERTS), D ** -0.5),
        'moe_b_exp': nrm((L, N_EXPERTS), 0.01),
        'moe_w_gate': nrm((L, N_EXPERTS, D, D_EXPERT), D ** -0.5),
        'moe_w_up': nrm((L, N_EXPERTS, D, D_EXPERT), D ** -0.5),
        'moe_w_down': nrm((L, N_EXPERTS, D_EXPERT, D), D_EXPERT ** -0.5),
        'final_g': 1.0 + nrm((D,), 0.05),
    }


def reference(x, c, w_ada, b_ada, norm1_g, norm2_g, w_in, w_out, pool_w, pool_scale, attn_sinks,
              conv_w, rwkv_mu, rwkv_w0, rwkv_w2, rwkv_a0, rwkv_a2, rwkv_g2, rwkv_k_k, rwkv_k_a,
              rwkv_r_k, rwkv_ln_g, rwkv_ln_b, rwkv_v0, rwkv_v1, rwkv_v2, moe_w_grp, moe_b_grp,
              moe_w_exp, moe_b_exp, moe_w_gate, moe_w_up, moe_w_down, final_g):
    B, T, _ = x.shape
    cond = jax.nn.silu(c)
    v_first = None
    for l in range(DEPTH):
        mod = cond @ w_ada[l] + b_ada[l]
        sh1, sc1, gt1, sh2, sc2, gt2 = [m[:, None, :] for m in jnp.split(mod, 6, axis=-1)]
        h = rms_norm(x, norm1_g[l]) * (1.0 + sc1) + sh1
        p = h @ w_in[l]
        pa, pb, pc, pd = jnp.split(p, [N_A, N_A + N_B, N_A + N_B + N_C], axis=-1)
        ya = pool_mixer(pa, pool_w[l], pool_scale[l])
        q, k, v = jnp.split(pb, [ATT_HEADS * HEAD_DIM, (ATT_HEADS + ATT_KV_HEADS) * HEAD_DIM], axis=-1)
        yb = swa_sink_attention(q.reshape(B, T, ATT_HEADS, HEAD_DIM),
                                k.reshape(B, T, ATT_KV_HEADS, HEAD_DIM),
                                v.reshape(B, T, ATT_KV_HEADS, HEAD_DIM), attn_sinks[l])
        bg, cg, xin = jnp.split(pc, 3, axis=-1)
        yc = short_gated_conv(bg, cg, xin, conv_w[l])
        v_res = None if l == 0 else (rwkv_v0[l - 1], rwkv_v1[l - 1], rwkv_v2[l - 1])
        yd, v_first = rwkv7_time_mix(pd, v_first, rwkv_mu[l], rwkv_w0[l], rwkv_w2[l], rwkv_a0[l],
                                     rwkv_a2[l], rwkv_g2[l], rwkv_k_k[l], rwkv_k_a[l], rwkv_r_k[l],
                                     rwkv_ln_g[l], rwkv_ln_b[l], v_res)
        y = jnp.concatenate([ya, yb, yc, yd.astype(x.dtype)], axis=-1) @ w_out[l]
        x = x + gt1 * y
        h2 = rms_norm(x, norm2_g[l]) * (1.0 + sc2) + sh2
        x = x + gt2 * hier_moe(h2, moe_w_grp[l], moe_b_grp[l], moe_w_exp[l], moe_b_exp[l],
                               moe_w_gate[l], moe_w_up[l], moe_w_down[l])
    return rms_norm(x, final_g)
```

```cpp
#include <hip/hip_runtime.h>
#include <hip/hip_cooperative_groups.h>
#include <cstdio>
#include <cstdint>
namespace cg = cooperative_groups;

#define LAS __attribute__((address_space(3)))
typedef unsigned short bf16_t;
typedef short bf16x8 __attribute__((ext_vector_type(8)));
typedef float f32x4 __attribute__((ext_vector_type(4)));
typedef float f32x2 __attribute__((ext_vector_type(2)));
typedef unsigned u32x4 __attribute__((ext_vector_type(4)));
typedef unsigned u32x2 __attribute__((ext_vector_type(2)));
typedef LAS unsigned char* ldsp;

namespace pg8 {
#define PG8_LAS __attribute__((address_space(3)))
constexpr int BM = 256, BK = 64, HALF = 128, HTB = HALF * BK * 2, STAGE_BYTES = 8 * HTB, NXCD = 8, WGM = 8;
__host__ __device__ __forceinline__ int lds_byte(int r, int c) { const int st = (r >> 4) * 2 + (c >> 5), rr = r & 15, cc = c & 31, ob = rr * 64 + cc * 2; return st * 1024 + (ob ^ (((ob >> 9) & 1) << 5)); }
__host__ __device__ __forceinline__ void stage_rc(int b, int& R, int& C) { const int st = b / 1024, sb = b % 1024, swz = sb ^ (((sb >> 9) & 1) << 5); R = (st >> 1) * 16 + swz / 64; C = (st & 1) * 32 + (swz % 64) / 2; }
__host__ __device__ __forceinline__ int perm32(int rho) { const int n = rho >> 4, i = rho & 15; return 8 * (i >> 2) + 4 * n + (i & 3); }
struct Unit { int pm, pn; };
struct Gemm { const bf16_t* A; const bf16_t* Bt; int M, N, K, lda, ldb; };
struct StaticOrder {
    int nM, nN, nwg, G, c;
    __host__ __device__ void init(int M, int N, int G_, int c_) { nM = M / BM; nN = N / BM; nwg = nM * nN; G = G_; c = c_; }
    __host__ __device__ bool next(int i, Unit& u) const {
        const long L = (long)i * G + c; if (L >= nwg) return false;
        int wgid = (int)L; { const int q = nwg / NXCD, r = nwg % NXCD, xcd = wgid % NXCD, off = wgid / NXCD; wgid = (xcd < r ? xcd * (q + 1) : r * (q + 1) + (xcd - r) * q) + off; }
        const int nig = WGM * nN, gid = wgid / nig, fm = gid * WGM, gsz = (nM - fm) < WGM ? (nM - fm) : WGM;
        u.pm = fm + ((wgid % nig) % gsz); u.pn = (wgid % nig) / gsz; return true;
    }
    __device__ __forceinline__ void a_ready(const Unit&) const {}
    __device__ __forceinline__ void done(const Unit&) const {}
};
__device__ __forceinline__ unsigned cvt_pk_bf16(float lo, float hi) { unsigned r; asm volatile("v_cvt_pk_bf16_f32 %0, %1, %2" : "=v"(r) : "v"(lo), "v"(hi)); return r; }
struct EpiBf16Bias {
    static constexpr bool PERM = true, AFTER_DRAIN = false;
    bf16_t* O; int ldc; const float* bias;
    __device__ __forceinline__ void operator()(const f32x4 (&acc)[2][2][4][2], const Unit& u, int wr, int wc, int fr, int fq) const {
        const int row0 = u.pm * BM + wr * 64 + fr; const int col0 = u.pn * BM + wc * 32 + 8 * fq;
        f32x4 bv[2][2];
#pragma unroll
        for (int bj = 0; bj < 2; ++bj)
#pragma unroll
            for (int n = 0; n < 2; ++n) bv[bj][n] = *(const f32x4*)(bias + col0 + bj * HALF + 4 * n);
#pragma unroll
        for (int ai = 0; ai < 2; ++ai)
#pragma unroll
            for (int m = 0; m < 4; ++m) { bf16_t* rowp = O + (size_t)(row0 + ai * HALF + m * 16) * ldc + col0;
#pragma unroll
                for (int bj = 0; bj < 2; ++bj) { f32x4 v0 = acc[ai][bj][m][0] + bv[bj][0], v1 = acc[ai][bj][m][1] + bv[bj][1];
                    u32x4 w; w.x = cvt_pk_bf16(v0[0], v0[1]); w.y = cvt_pk_bf16(v0[2], v0[3]); w.z = cvt_pk_bf16(v1[0], v1[1]); w.w = cvt_pk_bf16(v1[2], v1[3]);
                    *(u32x4*)(rowp + bj * HALF) = w; } }
    }
};
struct EpiResF32 {
    static constexpr bool PERM = false, AFTER_DRAIN = false;
    const float* base; float* out; bf16_t* ob; int ldc;
    __device__ __forceinline__ void operator()(const f32x4 (&acc)[2][2][4][2], const Unit& u, int wr, int wc, int fr, int fq) const {
        const int row0 = u.pm * BM + wr * 64 + fr, col0 = u.pn * BM + wc * 32 + 4 * fq;
#pragma unroll
        for (int ai = 0; ai < 2; ++ai)
#pragma unroll
            for (int m = 0; m < 4; ++m) { const size_t off = (size_t)(row0 + ai * HALF + m * 16) * ldc + col0;
#pragma unroll
                for (int bj = 0; bj < 2; ++bj)
#pragma unroll
                    for (int n = 0; n < 2; ++n) { const f32x4 bs = *(const f32x4*)(base + off + bj * HALF + n * 16); const f32x4 o = bs + acc[ai][bj][m][n];
                        *(f32x4*)(out + off + bj * HALF + n * 16) = o;
                        u32x2 w; w.x = cvt_pk_bf16(o[0], o[1]); w.y = cvt_pk_bf16(o[2], o[3]); *(u32x2*)(ob + off + bj * HALF + n * 16) = w; }
                asm volatile("" ::: "memory"); }
    }
};
template <class Epi, class Sched, bool ALIGN_EPI = false, bool SP2 = false>
__device__ __forceinline__ void gemm_phase(PG8_LAS unsigned char* lds, const Gemm g, const Sched& S, const Epi& E) {
    const int tid = threadIdx.x, wid = __builtin_amdgcn_readfirstlane(tid >> 6), lane = tid & 63, wr = wid >> 2, wc = wid & 3, fr = lane & 15, fq = lane >> 4;
    const int K = g.K, nt = K / BK;
    unsigned voffA[2], voffB[2];
#pragma unroll
    for (int i = 0; i < 2; ++i) { int R, C; stage_rc(tid * 16 + i * 8192, R, C); const int Rb = Epi::PERM ? ((R & ~31) + perm32(R & 31)) : R;
        voffA[i] = (unsigned)(R * g.lda + C) * 2u; voffB[i] = (unsigned)(Rb * g.ldb + C) * 2u; }
    const size_t kstep = (size_t)(BK * 2);
    const size_t hstepA = (size_t)HALF * g.lda * 2, hstepB = (size_t)HALF * g.ldb * 2;
    const size_t tstepA = 2 * hstepA, tstepB = 2 * hstepB;
    const unsigned ldsw = (unsigned)wid * 1024u;
    const int aoff = lds_byte(wr * 64 + fr, fq * 8), boff = lds_byte(wc * 32 + fr, fq * 8);
#define PG8_SA(b, h) (((b) * 2 + (h)) * HTB)
#define PG8_SB(b, h) ((4 + (b) * 2 + (h)) * HTB)
#define PG8_STAGE(bufoff, gbase, voff) do { _Pragma("unroll") for (int _i = 0; _i < 2; ++_i) \
        __builtin_amdgcn_global_load_lds((const unsigned*)((const char*)(gbase) + (voff)[_i]), (PG8_LAS unsigned*)(lds + (bufoff) + ldsw + _i * 8192), 16, 0, 0); } while (0)
#define PG8_LDA(dst, b, h) do { _Pragma("unroll") for (int m = 0; m < 4; ++m) _Pragma("unroll") for (int k = 0; k < 2; ++k) dst[m][k] = *(const PG8_LAS bf16x8*)(lds + PG8_SA(b, h) + aoff + m * 2048 + k * 1024); } while (0)
#define PG8_LDB(dst, b, h) do { _Pragma("unroll") for (int n = 0; n < 2; ++n) _Pragma("unroll") for (int k = 0; k < 2; ++k) dst[n][k] = *(const PG8_LAS bf16x8*)(lds + PG8_SB(b, h) + boff + n * 2048 + k * 1024); } while (0)
#define PG8_MMA(ai, bj, At, Bt) do { __builtin_amdgcn_s_setprio(1); _Pragma("unroll") for (int m = 0; m < 4; ++m) _Pragma("unroll") for (int n = 0; n < 2; ++n) _Pragma("unroll") for (int k = 0; k < 2; ++k) \
        acc[ai][bj][m][n] = __builtin_amdgcn_mfma_f32_16x16x32_bf16(Bt[n][k], At[m][k], acc[ai][bj][m][n], 0, 0, 0); __builtin_amdgcn_s_setprio(0); } while (0)
#define PG8_WAIT_V(n) asm volatile("s_waitcnt vmcnt(" #n ")" ::: "memory")
#define PG8_WAIT_L(n) asm volatile("s_waitcnt lgkmcnt(" #n ")" ::: "memory")
#define PG8_BAR __builtin_amdgcn_s_barrier()
#define PG8_SCHED __builtin_amdgcn_sched_barrier(0)
    Unit cur, nxt; int ui = 0;
    if (!S.next(0, cur)) return;
    f32x4 acc[2][2][4][2];
#pragma unroll
    for (int a = 0; a < 2; ++a)
#pragma unroll
        for (int b = 0; b < 2; ++b)
#pragma unroll
            for (int m = 0; m < 4; ++m)
#pragma unroll
                for (int n = 0; n < 2; ++n) acc[a][b][m][n] = (f32x4){0.f, 0.f, 0.f, 0.f};
    bf16x8 At[4][2], B0[2][2], B1[2][2];
    const char* cA = (const char*)g.A + (size_t)cur.pm * tstepA; const char* cB = (const char*)g.Bt + (size_t)cur.pn * tstepB;
    S.a_ready(cur);
    if constexpr (SP2) {
        PG8_STAGE(PG8_SB(0, 0), cB, voffB); PG8_STAGE(PG8_SB(0, 1), cB + hstepB, voffB); PG8_STAGE(PG8_SA(0, 0), cA, voffA); PG8_STAGE(PG8_SA(0, 1), cA + hstepA, voffA);
        if (wr == 1) PG8_BAR;
        PG8_WAIT_V(2); PG8_BAR;
        PG8_STAGE(PG8_SB(1, 0), cB + kstep, voffB); PG8_STAGE(PG8_SA(1, 0), cA + kstep, voffA); PG8_STAGE(PG8_SB(1, 1), cB + hstepB + kstep, voffB);
        PG8_WAIT_V(6); PG8_BAR;
    } else {
        PG8_STAGE(PG8_SB(0, 0), cB, voffB); PG8_STAGE(PG8_SA(0, 0), cA, voffA); PG8_STAGE(PG8_SB(0, 1), cB + hstepB, voffB); PG8_STAGE(PG8_SA(0, 1), cA + hstepA, voffA);
        if (wr == 1) PG8_BAR;
        PG8_WAIT_V(4); PG8_BAR;
        PG8_STAGE(PG8_SB(1, 0), cB + kstep, voffB); PG8_STAGE(PG8_SA(1, 0), cA + kstep, voffA); PG8_STAGE(PG8_SB(1, 1), cB + hstepB + kstep, voffB);
        PG8_WAIT_V(6); PG8_BAR;
    }
    for (;;) {
        const bool has_next = S.next(ui + 1, nxt);
        const char* nA = has_next ? (const char*)g.A + (size_t)nxt.pm * tstepA : cA; const char* nB = has_next ? (const char*)g.Bt + (size_t)nxt.pn * tstepB : cB;
        for (int t = 0; t < nt; t += 2) {
            const bool last = (t == nt - 2);
            const char* a1 = cA + (size_t)(t + 1) * kstep;
            const char* a2 = last ? nA : cA + (size_t)(t + 2) * kstep; const char* b2 = last ? nB : cB + (size_t)(t + 2) * kstep;
            const char* a3 = a2 + kstep; const char* b3 = b2 + kstep;
            if (last && has_next) S.a_ready(nxt);
            if constexpr (SP2) {
            PG8_LDB(B0, 0, 0); PG8_LDB(B1, 0, 1); PG8_SCHED; PG8_LDA(At, 0, 0); PG8_STAGE(PG8_SA(1, 1), a1 + hstepA, voffA);
            PG8_WAIT_V(8); PG8_WAIT_L(0); PG8_BAR; PG8_MMA(0, 0, At, B0); PG8_MMA(0, 1, At, B1); PG8_BAR; PG8_SCHED;
            PG8_LDA(At, 0, 1); PG8_STAGE(PG8_SB(0, 0), b2, voffB); PG8_STAGE(PG8_SB(0, 1), b2 + hstepB, voffB); PG8_STAGE(PG8_SA(0, 0), a2, voffA);
            PG8_WAIT_V(8); PG8_WAIT_L(0); PG8_BAR; PG8_MMA(1, 0, At, B0); PG8_MMA(1, 1, At, B1); PG8_BAR; PG8_SCHED;
            PG8_LDB(B0, 1, 0); PG8_LDB(B1, 1, 1); PG8_SCHED; PG8_LDA(At, 1, 0); PG8_STAGE(PG8_SA(0, 1), a2 + hstepA, voffA);
            PG8_WAIT_V(8); PG8_WAIT_L(0); PG8_BAR; PG8_MMA(0, 0, At, B0); PG8_MMA(0, 1, At, B1); PG8_BAR; PG8_SCHED;
            PG8_LDA(At, 1, 1); PG8_STAGE(PG8_SB(1, 0), b3, voffB); PG8_STAGE(PG8_SB(1, 1), b3 + hstepB, voffB); PG8_STAGE(PG8_SA(1, 0), a3, voffA);
            PG8_WAIT_V(8); PG8_WAIT_L(0); PG8_BAR; PG8_MMA(1, 0, At, B0); PG8_MMA(1, 1, At, B1); PG8_BAR; PG8_SCHED;
            } else {
            PG8_LDB(B0, 0, 0); PG8_SCHED; PG8_LDA(At, 0, 0); PG8_STAGE(PG8_SA(1, 1), a1 + hstepA, voffA);
            PG8_WAIT_L(8); PG8_BAR; PG8_WAIT_L(0); PG8_MMA(0, 0, At, B0); PG8_BAR; PG8_SCHED;
            PG8_LDB(B1, 0, 1); PG8_STAGE(PG8_SB(0, 0), b2, voffB);
            PG8_BAR; PG8_WAIT_L(0); PG8_MMA(0, 1, At, B1); PG8_BAR;
            PG8_LDA(At, 0, 1); PG8_STAGE(PG8_SA(0, 0), a2, voffA);
            PG8_BAR; PG8_WAIT_L(0); PG8_MMA(1, 0, At, B0); PG8_BAR; PG8_SCHED;
            PG8_STAGE(PG8_SB(0, 1), b2 + hstepB, voffB);
            PG8_WAIT_V(6); PG8_BAR; PG8_MMA(1, 1, At, B1); PG8_BAR;
            PG8_LDB(B0, 1, 0); PG8_SCHED; PG8_LDA(At, 1, 0); PG8_STAGE(PG8_SA(0, 1), a2 + hstepA, voffA);
            PG8_WAIT_L(8); PG8_BAR; PG8_WAIT_L(0); PG8_MMA(0, 0, At, B0); PG8_BAR; PG8_SCHED;
            PG8_LDB(B1, 1, 1); PG8_STAGE(PG8_SB(1, 0), b3, voffB);
            PG8_BAR; PG8_WAIT_L(0); PG8_MMA(0, 1, At, B1); PG8_BAR;
            PG8_LDA(At, 1, 1); PG8_STAGE(PG8_SA(1, 0), a3, voffA);
            PG8_BAR; PG8_WAIT_L(0); PG8_MMA(1, 0, At, B0); PG8_BAR; PG8_SCHED;
            PG8_STAGE(PG8_SB(1, 1), b3 + hstepB, voffB);
            PG8_WAIT_V(6); PG8_BAR; PG8_MMA(1, 1, At, B1); PG8_BAR;
            }
        }
        if constexpr (ALIGN_EPI) { if (wr == 0) PG8_BAR; }
        if constexpr (!Epi::AFTER_DRAIN) { E(acc, cur, wr, wc, fr, fq); S.done(cur); }
        if (!has_next) break;
#pragma unroll
        for (int a = 0; a < 2; ++a)
#pragma unroll
            for (int b = 0; b < 2; ++b)
#pragma unroll
                for (int m = 0; m < 4; ++m)
#pragma unroll
                    for (int n = 0; n < 2; ++n) acc[a][b][m][n] = (f32x4){0.f, 0.f, 0.f, 0.f};
        cur = nxt; cA = nA; cB = nB; ++ui;
        if constexpr (ALIGN_EPI) { if (wr == 1) PG8_BAR; }
    }
    PG8_WAIT_V(0);
    if constexpr (!ALIGN_EPI) { if (wr == 0) PG8_BAR; }
    PG8_BAR;
    if constexpr (Epi::AFTER_DRAIN) { E.fused(acc, cur, wr, wc, fr, fq, lds, wid, lane); S.done(cur); }
#undef PG8_SA
#undef PG8_SB
#undef PG8_STAGE
#undef PG8_LDA
#undef PG8_LDB
#undef PG8_MMA
#undef PG8_WAIT_V
#undef PG8_WAIT_L
#undef PG8_BAR
#undef PG8_SCHED
}
}

constexpr int T_ = 16384, DM = 1024, NIN = 2432, NINP = 2560;
constexpr int C_Q = 256, C_K = 512, C_V = 640, C_BG = 768, C_CG = 1024, C_XIN = 1280, C_D = 1536;
constexpr int NWAVES = 8, NTHR = 512;
constexpr int LDS_BYTES = 147456;
constexpr size_t MiB = 1u << 20;
constexpr size_t WS_CTL = 0;
constexpr size_t CTL_BYTES = 65536;
constexpr size_t WS_MOD = 1 * MiB;
constexpr size_t WS_BIN = WS_MOD + 65536;
constexpr size_t WS_BGU = WS_BIN + 16384;
constexpr size_t WS_BR  = WS_BGU + 32768;
constexpr size_t WS_WRH = WS_BR + 1024;
constexpr size_t WS_WRL = WS_WRH + 98304;
constexpr size_t WS_W2T = WS_WRL + 98304;
constexpr size_t WS_A2T = WS_W2T + 16384;
constexpr size_t WS_G2T = WS_A2T + 16384;
constexpr size_t WS_V1T = WS_G2T + 32768;
constexpr size_t WS_V2T = WS_V1T + 16384;
constexpr size_t WS_PWT = WS_V2T + 16384;
constexpr size_t WS_RINV2 = WS_PWT + 32768;
static_assert(WS_RINV2 + 65536 <= 2 * MiB, "small region");
constexpr size_t WS_WIN = 2 * MiB;
constexpr size_t WS_WOUT = 7 * MiB;
constexpr size_t WS_WGU = 9 * MiB;
constexpr size_t WS_WD = 25 * MiB;
constexpr size_t WS_LIST = 33 * MiB;
constexpr size_t WS_WLIST = 35 * MiB;
constexpr size_t WS_VFIRST = 37 * MiB;
constexpr size_t WS_ACT = 45 * MiB;
constexpr size_t WS_P = 77 * MiB;
constexpr size_t WS_RW = 157 * MiB;
constexpr size_t RW_R = WS_RW, RW_K = WS_RW + 8 * MiB, RW_V = WS_RW + 16 * MiB, RW_KAP = WS_RW + 24 * MiB, RW_B = WS_RW + 32 * MiB, RW_G = WS_RW + 40 * MiB;
constexpr size_t RW_LD = WS_RW + 48 * MiB;
constexpr size_t RW_Y = WS_RW + 64 * MiB;
constexpr size_t RW_BONUS = WS_RW + 80 * MiB;
constexpr size_t WS_END = WS_RW + 81 * MiB;
static_assert(WS_END <= 256 * MiB, "workspace");

struct Args { const float* in[34]; float* out; unsigned char* ws; int ph_lo, ph_hi; };

__device__ __forceinline__ unsigned f2bf(float f) { unsigned u = __builtin_bit_cast(unsigned, f); return (u + 0x7fffu + ((u >> 16) & 1u)) >> 16; }
__device__ __forceinline__ float bf2f(unsigned h) { return __builtin_bit_cast(float, h << 16); }
__device__ __forceinline__ unsigned pk2(float lo, float hi) { return f2bf(lo) | (f2bf(hi) << 16); }
__device__ __forceinline__ float bflo(unsigned w) { return __builtin_bit_cast(float, w << 16); }
__device__ __forceinline__ float bfhi(unsigned w) { return __builtin_bit_cast(float, w & 0xffff0000u); }
__device__ __forceinline__ float sigmoidf_(float x) { return 1.f / (1.f + __expf(-x)); }
__device__ __forceinline__ float wave_sum(float v) {
#pragma unroll
    for (int o = 1; o < 64; o <<= 1) v += __shfl_xor(v, o);
    return v;
}
#define LDS_WAIT() asm volatile("s_waitcnt lgkmcnt(0)" ::: "memory")
__device__ __forceinline__ int swz128(int r, int c) { return r * 128 + ((c ^ ((r >> 1) & 7)) << 4); }
__device__ __forceinline__ int swz256(int r, int c) { return r * 256 + ((c ^ (r & 15)) << 4); }
__device__ __forceinline__ int swz512(int r, int c) { return r * 512 + ((c ^ (r & 15)) << 4); }
__device__ __forceinline__ f32x4 mfma16(bf16x8 a, bf16x8 b, f32x4 c) { return __builtin_amdgcn_mfma_f32_16x16x32_bf16(a, b, c, 0, 0, 0); }

struct Frame {
    ldsp lds; int tid, lane, wave, G, bid;
    const float* const* in; float* out; unsigned char* ws;
};

__device__ __forceinline__ void phase_mod(Frame& F) {
    const float* c = F.in[1]; const float* w_ada = F.in[2]; const float* b_ada = F.in[3];
    float* mod = (float*)(F.ws + WS_MOD);
    LAS float* red = (LAS float*)F.lds;
    for (int it = F.bid; it < 192; it += F.G) {
        const int l = it / 96, n0 = (it % 96) * 64;
        const float* W = w_ada + (size_t)l * DM * 6144 + n0 + F.lane;
        const int k0 = F.wave * 128;
        float acc = 0.f;
#pragma unroll 8
        for (int k = 0; k < 128; ++k) { const float cv = c[k0 + k]; const float s = cv / (1.f + __expf(-cv)); acc += s * W[(size_t)(k0 + k) * 6144]; }
        red[F.wave * 64 + F.lane] = acc;
        __syncthreads();
        if (F.wave == 0) { float s = b_ada[l * 6144 + n0 + F.lane];
#pragma unroll
            for (int w = 0; w < 8; ++w) s += red[w * 64 + F.lane];
            mod[l * 6144 + n0 + F.lane] = s; }
        __syncthreads();
    }
}

__device__ __forceinline__ void transpose_strip(const float* W, int N, int K, int n0, const float* rs_a, const float* rs_b, const float* cs, const float* sh, float* bias_out,
                                                bf16_t* dst, int dst_row0, LAS float* scr, int lane) {
    const int col = lane & 31, kp = lane >> 5;
    const float csv = cs ? cs[n0 + col] : 1.f;
    float bacc = 0.f;
    for (int k0 = 0; k0 < K; k0 += 64) {
#pragma unroll 8
        for (int i = 0; i < 32; ++i) { const int kk = 2 * i + kp; const float wv = W[(size_t)(k0 + kk) * N + n0 + col];
            if (sh) bacc += sh[k0 + kk] * wv;
            float v = wv * csv; if (rs_a) v *= rs_a[k0 + kk] * (1.f + rs_b[k0 + kk]);
            scr[kk * 33 + col] = v; }
        LDS_WAIT();
        const int c = lane & 7;
#pragma unroll
        for (int j = 0; j < 4; ++j) { const int n = (lane >> 3) + 8 * j; const LAS float* s = scr + (8 * c) * 33 + n;
            u32x4 o; o.x = pk2(s[0 * 33], s[1 * 33]); o.y = pk2(s[2 * 33], s[3 * 33]); o.z = pk2(s[4 * 33], s[5 * 33]); o.w = pk2(s[6 * 33], s[7 * 33]);
            *(u32x4*)(dst + (size_t)(dst_row0 + n) * K + k0 + 8 * c) = o; }
        LDS_WAIT();
    }
    if (sh) { bacc += __shfl_xor(bacc, 32); if (lane < 32) bias_out[col] = bacc; }
}
__device__ __forceinline__ void phase_prep(Frame& F, int l) {
    LAS float* scr = (LAS float*)(F.lds + F.wave * 16384);
    const float* mod = (const float*)(F.ws + WS_MOD) + l * 6144;
    const float *sh1 = mod, *sc1 = mod + 1024, *gt1 = mod + 2048, *sh2 = mod + 3072, *sc2 = mod + 4096, *gt2 = mod + 5120;
    const float* n1g = F.in[4] + l * DM; const float* n2g = F.in[5] + l * DM;
    const float* w_in = F.in[6] + (size_t)l * DM * NIN; const float* w_out = F.in[7] + (size_t)l * DM * DM;
    const float* wg = F.in[30] + (size_t)l * 32 * DM * 128; const float* wu = F.in[31] + (size_t)l * 32 * DM * 128; const float* wd = F.in[32] + (size_t)l * 32 * 128 * DM;
    bf16_t* WIN = (bf16_t*)(F.ws + WS_WIN); bf16_t* WOUT = (bf16_t*)(F.ws + WS_WOUT); bf16_t* WGU = (bf16_t*)(F.ws + WS_WGU); bf16_t* WD = (bf16_t*)(F.ws + WS_WD);
    float* bias_in = (float*)(F.ws + WS_BIN); float* bias_gu = (float*)(F.ws + WS_BGU); float* bias_r = (float*)(F.ws + WS_BR);
    const int gw = F.bid * NWAVES + F.wave, NGW = F.G * NWAVES;
    constexpr int nA = 80, nB = 32, nC = 128, nD = 128, nE = 1024, nF = 48, nG = 6;
    constexpr int NIT = nA + nB + nC + nD + nE + nF + nG;
    for (int it = gw; it < NIT; it += NGW) {
        int r = it;
        if (r < nA) {
            if (r < 76) transpose_strip(w_in, NIN, DM, r * 32, n1g, sc1, nullptr, sh1, bias_in + r * 32, WIN, r * 32, scr, F.lane);
            else { for (int i = F.lane; i < 32 * 128; i += 64) { const int n = i >> 7, c = i & 127; *(u32x4*)(WIN + (size_t)(r * 32 + n) * DM + c * 8) = (u32x4){0u, 0u, 0u, 0u}; }
                   if (F.lane < 32) bias_in[r * 32 + F.lane] = 0.f; }
            continue; } r -= nA;
        if (r < nB) { transpose_strip(w_out, DM, DM, r * 32, nullptr, nullptr, gt1, nullptr, nullptr, WOUT, r * 32, scr, F.lane); continue; } r -= nB;
        if (r < nC) { const int e = r >> 2, s = r & 3; transpose_strip(wg + (size_t)e * DM * 128, 128, DM, s * 32, n2g, sc2, nullptr, sh2, bias_gu + e * 256 + s * 32, WGU + (size_t)e * 256 * DM, s * 32, scr, F.lane); continue; } r -= nC;
        if (r < nD) { const int e = r >> 2, s = r & 3; transpose_strip(wu + (size_t)e * DM * 128, 128, DM, s * 32, n2g, sc2, nullptr, sh2, bias_gu + e * 256 + 128 + s * 32, WGU + (size_t)e * 256 * DM, 128 + s * 32, scr, F.lane); continue; } r -= nD;
        if (r < nE) { const int e = r >> 5, s = r & 31; transpose_strip(wd + (size_t)e * 128 * DM, DM, 128, s * 32, nullptr, nullptr, gt2, nullptr, nullptr, WD + (size_t)e * DM * 128, s * 32, scr, F.lane); continue; } r -= nE;
        if (r < nF) {
            bf16_t* wh = (bf16_t*)(F.ws + WS_WRH) + r * DM; bf16_t* wl = (bf16_t*)(F.ws + WS_WRL) + r * DM;
            float bacc = 0.f;
            for (int k = F.lane; k < DM; k += 64) {
                float wv = 0.f;
                if (r < 4) wv = F.in[26][(size_t)l * DM * 4 + k * 4 + r]; else if (r < 36) wv = F.in[28][(size_t)l * DM * 32 + k * 32 + (r - 4)];
                bacc += sh2[k] * wv;
                const float v = wv * n2g[k] * (1.f + sc2[k]);
                const unsigned h = f2bf(v); const unsigned lo = f2bf(v - bf2f(h));
                wh[k] = (bf16_t)h; wl[k] = (bf16_t)lo; }
            bacc = wave_sum(bacc);
            if (F.lane == 0) { float b = 0.f; if (r < 4) b = F.in[27][l * 4 + r]; else if (r < 36) b = F.in[29][l * 32 + r - 4]; bias_r[r] = bacc + b; }
            continue; } r -= nF;
        if (r == 0) { const float* s = F.in[14] + l * 32 * 256; bf16_t* d = (bf16_t*)(F.ws + WS_W2T); for (int i = F.lane; i < 8192; i += 64) { const int n = i >> 5, k = i & 31; d[i] = (bf16_t)f2bf(s[k * 256 + n]); } }
        else if (r == 1) { const float* s = F.in[16] + l * 32 * 256; bf16_t* d = (bf16_t*)(F.ws + WS_A2T); for (int i = F.lane; i < 8192; i += 64) { const int n = i >> 5, k = i & 31; d[i] = (bf16_t)f2bf(s[k * 256 + n]); } }
        else if (r == 2) { const float* s = F.in[17] + l * 64 * 256; bf16_t* d = (bf16_t*)(F.ws + WS_G2T); for (int i = F.lane; i < 16384; i += 64) { const int n = i >> 6, k = i & 63; d[i] = (bf16_t)f2bf(s[k * 256 + n]); } }
        else if (r == 3) { if (l > 0) { const float* s = F.in[24] + (l - 1) * 256 * 32; bf16_t* d = (bf16_t*)(F.ws + WS_V1T); for (int i = F.lane; i < 8192; i += 64) { const int n = i >> 8, k = i & 255; d[i] = (bf16_t)f2bf(s[k * 32 + n]); } } }
        else if (r == 4) { if (l > 0) { const float* s = F.in[25] + (l - 1) * 32 * 256; bf16_t* d = (bf16_t*)(F.ws + WS_V2T); for (int i = F.lane; i < 8192; i += 64) { const int n = i >> 5, k = i & 31; d[i] = (bf16_t)f2bf(s[k * 256 + n]); } } }
        else { const float* s = F.in[8] + l * 4 * 64 * 64; bf16_t* d = (bf16_t*)(F.ws + WS_PWT); for (int i = F.lane; i < 16384; i += 64) { const int j = i >> 12, e = (i >> 6) & 63, c = i & 63; d[i] = (bf16_t)f2bf(s[(j * 64 + c) * 64 + e]); } }
    }
}

__device__ __forceinline__ void phase_rownorm(Frame& F, int mode) {
    const float* xin = (mode == 0) ? F.in[0] : F.out;
    const bf16_t* ys0 = (const bf16_t*)(F.ws + WS_P); const bf16_t* ys1 = ys0 + (size_t)T_ * DM;
    bf16_t* xn = (bf16_t*)(F.ws + WS_ACT);
    const float* fg = F.in[33];
    const int gw = F.bid * NWAVES + F.wave, NGW = F.G * NWAVES;
    for (int m = gw; m < T_; m += NGW) {
        const f32x4* xr = (const f32x4*)(xin + (size_t)m * DM) + F.lane;
        f32x4 v[4]; float s = 0.f;
#pragma unroll
        for (int j = 0; j < 4; ++j) v[j] = xr[64 * j];
        if (mode != 0) {
            const u32x2* a = (const u32x2*)(ys0 + (size_t)m * DM) + F.lane; const u32x2* b = (const u32x2*)(ys1 + (size_t)m * DM) + F.lane;
#pragma unroll
            for (int j = 0; j < 4; ++j) { const u32x2 ua = a[64 * j], ub = b[64 * j];
                v[j][0] += bflo(ua.x) + bflo(ub.x); v[j][1] += bfhi(ua.x) + bfhi(ub.x); v[j][2] += bflo(ua.y) + bflo(ub.y); v[j][3] += bfhi(ua.y) + bfhi(ub.y); }
        }
#pragma unroll
        for (int j = 0; j < 4; ++j) s += (v[j][0] * v[j][0] + v[j][1] * v[j][1]) + (v[j][2] * v[j][2] + v[j][3] * v[j][3]);
        const float rinv = 1.f / sqrtf(wave_sum(s) * (1.f / DM) + 1e-6f);
        if (mode == 2) {
            f32x4* o = (f32x4*)(F.out + (size_t)m * DM) + F.lane;
#pragma unroll
            for (int j = 0; j < 4; ++j) { const f32x4 g = *((const f32x4*)fg + F.lane + 64 * j); o[64 * j] = v[j] * rinv * g; }
        } else {
            if (mode == 1) { f32x4* o = (f32x4*)(F.out + (size_t)m * DM) + F.lane;
#pragma unroll
                for (int j = 0; j < 4; ++j) o[64 * j] = v[j]; }
            u32x2* o8 = (u32x2*)(xn + (size_t)m * DM) + F.lane;
#pragma unroll
            for (int j = 0; j < 4; ++j) { u32x2 w; w.x = pk2(v[j][0] * rinv, v[j][1] * rinv); w.y = pk2(v[j][2] * rinv, v[j][3] * rinv); o8[64 * j] = w; }
        }
    }
}

__device__ __forceinline__ void attn_item(Frame& F, int l, int item) {
    const int t0 = item * 128;
    const bf16_t* P = (const bf16_t*)(F.ws + WS_P);
    bf16_t* ycat = (bf16_t*)(F.ws + WS_ACT);
    ldsp Ks = F.lds, Vt = F.lds + 65536;
    for (int i = F.tid; i < 4096; i += NTHR) {
        const int ko = i >> 4, kvh = (i >> 3) & 1, c = i & 7; const int s = t0 - 128 + ko;
        u32x4 kv = (u32x4){0u, 0u, 0u, 0u}, vv = (u32x4){0u, 0u, 0u, 0u};
        if (s >= 0) { kv = *(const u32x4*)(P + (size_t)s * NINP + C_K + kvh * 64 + c * 8); vv = *(const u32x4*)(P + (size_t)s * NINP + C_V + kvh * 64 + c * 8); }
        *(LAS u32x4*)(Ks + kvh * 32768 + swz128(ko, c)) = kv;
        const int k32 = ko & 31, sg = ko >> 5, g = (k32 >> 2) & 3, j = ((k32 >> 4) << 2) | (k32 & 3), chunk = sg * 4 + g;
        const unsigned vw[4] = {vv.x, vv.y, vv.z, vv.w};
#pragma unroll
        for (int e = 0; e < 8; ++e) { const int d = c * 8 + e; const unsigned short val = (unsigned short)((e & 1) ? (vw[e >> 1] >> 16) : (vw[e >> 1] & 0xffffu));
            *(LAS unsigned short*)(Vt + kvh * 32768 + swz512(d, chunk) + j * 2) = val; }
    }
    __syncthreads();
    const int h = F.wave >> 1, half = F.wave & 1, kvh = h >> 1, fr = F.lane & 15, g = F.lane >> 4;
    const float slope = exp2f(-2.f * (float)(h + 1));
    const float sink = F.in[10][l * 4 + h];
    ldsp Kh = Ks + kvh * 32768, Vh = Vt + kvh * 32768;
#pragma unroll 1
    for (int qt = 0; qt < 4; ++qt) {
        const int q_lo = 64 * half + 16 * qt, qo = q_lo + fr, tile0 = (q_lo >> 5) << 1;
        bf16x8 qf[2];
#pragma unroll
        for (int ks = 0; ks < 2; ++ks) qf[ks] = *(const bf16x8*)(P + (size_t)(t0 + qo) * NINP + C_Q + h * 64 + ks * 32 + g * 8);
        f32x4 s[10];
#pragma unroll
        for (int kt = 0; kt < 10; ++kt) { s[kt] = (f32x4){0.f, 0.f, 0.f, 0.f};
#pragma unroll
            for (int ks = 0; ks < 2; ++ks) { const bf16x8 a = *(const LAS bf16x8*)(Kh + swz128((tile0 + kt) * 16 + fr, ks * 4 + g)); s[kt] = mfma16(a, qf[ks], s[kt]); } }
        float m = sink;
#pragma unroll
        for (int kt = 0; kt < 10; ++kt)
#pragma unroll
            for (int j = 0; j < 4; ++j) { const int ko = 16 * (tile0 + kt) + 4 * g + j; const int dist = qo + 128 - ko;
                const bool valid = (dist >= 0) && (dist < 128) && (t0 - 128 + ko >= 0);
                const float v = valid ? s[kt][j] * 0.125f - slope * (float)dist : -INFINITY; s[kt][j] = v; m = fmaxf(m, v); }
        m = fmaxf(m, __shfl_xor(m, 16)); m = fmaxf(m, __shfl_xor(m, 32));
        float sum = 0.f;
#pragma unroll
        for (int kt = 0; kt < 10; ++kt)
#pragma unroll
            for (int j = 0; j < 4; ++j) { const float p = __expf(s[kt][j] - m); s[kt][j] = p; sum += p; }
        sum += __shfl_xor(sum, 16); sum += __shfl_xor(sum, 32);
        const float inv = 1.f / (sum + __expf(sink - m));
        f32x4 o[4];
#pragma unroll
        for (int dt = 0; dt < 4; ++dt) o[dt] = (f32x4){0.f, 0.f, 0.f, 0.f};
#pragma unroll
        for (int ss = 0; ss < 5; ++ss) {
            u32x4 pw; pw.x = pk2(s[2 * ss][0], s[2 * ss][1]); pw.y = pk2(s[2 * ss][2], s[2 * ss][3]); pw.z = pk2(s[2 * ss + 1][0], s[2 * ss + 1][1]); pw.w = pk2(s[2 * ss + 1][2], s[2 * ss + 1][3]);
            const bf16x8 pb = __builtin_bit_cast(bf16x8, pw);
#pragma unroll
            for (int dt = 0; dt < 4; ++dt) { const bf16x8 a = *(const LAS bf16x8*)(Vh + swz512(dt * 16 + fr, ((tile0 >> 1) + ss) * 4 + g)); o[dt] = mfma16(a, pb, o[dt]); }
        }
#pragma unroll
        for (int dt = 0; dt < 4; ++dt) { u32x2 w; w.x = pk2(o[dt][0] * inv, o[dt][1] * inv); w.y = pk2(o[dt][2] * inv, o[dt][3] * inv);
            *(u32x2*)(ycat + (size_t)(t0 + qo) * DM + 256 + h * 64 + dt * 16 + 4 * g) = w; }
    }
    __syncthreads();
}

__device__ __forceinline__ void poolconv_item(Frame& F, int l, int item) {
    const int t0 = item * 128;
    const bf16_t* P = (const bf16_t*)(F.ws + WS_P);
    bf16_t* ycat = (bf16_t*)(F.ws + WS_ACT);
    ldsp U = F.lds;
    ldsp Dt = F.lds + 73728;
    for (int i = F.tid; i < 144 * 32; i += NTHR) { const int r = i >> 5, c = i & 31; const int s = t0 - 16 + r;
        u32x4 v = (u32x4){0u, 0u, 0u, 0u}; if (s >= 0) v = *(const u32x4*)(P + (size_t)s * NINP + c * 8);
        *(LAS u32x4*)(U + r * 512 + c * 16) = v; }
    __syncthreads();
    for (int i = F.tid; i < 128 * 32; i += NTHR) { const int tok = i >> 5, c8 = i & 31, j = c8 >> 3, w = 2 << j; const int t = t0 + tok;
        float acc[8];
#pragma unroll
        for (int e = 0; e < 8; ++e) acc[e] = 0.f;
        u32x4 cur = (u32x4){0u, 0u, 0u, 0u};
        for (int q = 0; q < w; ++q) { const u32x4 v = *(const LAS u32x4*)(U + (tok + 16 - q) * 512 + c8 * 16); if (q == 0) cur = v;
            acc[0] += bflo(v.x); acc[1] += bfhi(v.x); acc[2] += bflo(v.y); acc[3] += bfhi(v.y); acc[4] += bflo(v.z); acc[5] += bfhi(v.z); acc[6] += bflo(v.w); acc[7] += bfhi(v.w); }
        const float ic = 1.f / (float)((t + 1) < w ? (t + 1) : w);
        u32x4 o; o.x = pk2(acc[0] * ic - bflo(cur.x), acc[1] * ic - bfhi(cur.x)); o.y = pk2(acc[2] * ic - bflo(cur.y), acc[3] * ic - bfhi(cur.y));
        o.z = pk2(acc[4] * ic - bflo(cur.z), acc[5] * ic - bfhi(cur.z)); o.w = pk2(acc[6] * ic - bflo(cur.w), acc[7] * ic - bfhi(cur.w));
        *(LAS u32x4*)(Dt + j * 16384 + swz128(tok, c8 & 7)) = o; }
    __syncthreads();
    {
        const int j = F.wave >> 1, half = F.wave & 1, fr = F.lane & 15, g = F.lane >> 4;
        const bf16_t* pwt = (const bf16_t*)(F.ws + WS_PWT) + j * 4096;
        const float* psc = F.in[9] + l * 256 + j * 64;
        bf16x8 bfr[4][2];
#pragma unroll
        for (int n = 0; n < 4; ++n)
#pragma unroll
            for (int ks = 0; ks < 2; ++ks) bfr[n][ks] = *(const bf16x8*)(pwt + (16 * n + fr) * 64 + ks * 32 + g * 8);
#pragma unroll
        for (int m = 0; m < 4; ++m) {
            bf16x8 af[2];
#pragma unroll
            for (int ks = 0; ks < 2; ++ks) af[ks] = *(const LAS bf16x8*)(Dt + j * 16384 + swz128(64 * half + 16 * m + fr, ks * 4 + g));
#pragma unroll
            for (int n = 0; n < 4; ++n) { f32x4 acc = (f32x4){0.f, 0.f, 0.f, 0.f};
#pragma unroll
                for (int ks = 0; ks < 2; ++ks) acc = mfma16(bfr[n][ks], af[ks], acc);
                const f32x4 sc = *(const f32x4*)(psc + 16 * n + 4 * g);
                u32x2 w; w.x = pk2(acc[0] * sc[0], acc[1] * sc[1]); w.y = pk2(acc[2] * sc[2], acc[3] * sc[3]);
                *(u32x2*)(ycat + (size_t)(t0 + 64 * half + 16 * m + fr) * DM + j * 64 + 16 * n + 4 * g) = w; }
        }
    }
    const float* cw = F.in[11] + l * 3 * 256;
    for (int i = F.tid; i < 128 * 32; i += NTHR) { const int tok = i >> 5, c8 = i & 31; const int t = t0 + tok;
        float acc[8];
#pragma unroll
        for (int e = 0; e < 8; ++e) acc[e] = 0.f;
#pragma unroll
        for (int q = 0; q < 3; ++q) { const int s = t - 2 + q; if (s >= 0) {
                const u32x4 a = *(const u32x4*)(P + (size_t)s * NINP + C_CG + c8 * 8), b = *(const u32x4*)(P + (size_t)s * NINP + C_XIN + c8 * 8);
                const float* wq = cw + q * 256 + c8 * 8;
                acc[0] += wq[0] * bflo(a.x) * bflo(b.x); acc[1] += wq[1] * bfhi(a.x) * bfhi(b.x); acc[2] += wq[2] * bflo(a.y) * bflo(b.y); acc[3] += wq[3] * bfhi(a.y) * bfhi(b.y);
                acc[4] += wq[4] * bflo(a.z) * bflo(b.z); acc[5] += wq[5] * bfhi(a.z) * bfhi(b.z); acc[6] += wq[6] * bflo(a.w) * bflo(b.w); acc[7] += wq[7] * bfhi(a.w) * bfhi(b.w); } }
        const u32x4 bg = *(const u32x4*)(P + (size_t)t * NINP + C_BG + c8 * 8);
        u32x4 o; o.x = pk2(acc[0] * bflo(bg.x), acc[1] * bfhi(bg.x)); o.y = pk2(acc[2] * bflo(bg.y), acc[3] * bfhi(bg.y));
        o.z = pk2(acc[4] * bflo(bg.z), acc[5] * bfhi(bg.z)); o.w = pk2(acc[6] * bflo(bg.w), acc[7] * bfhi(bg.w));
        *(u32x4*)(ycat + (size_t)t * DM + 512 + c8 * 8) = o; }
    __syncthreads();
}

__device__ __forceinline__ u32x4 lerp8(u32x4 cur, u32x4 prv, const float* mu, int act) {
    const unsigned cw[4] = {cur.x, cur.y, cur.z, cur.w}, pw[4] = {prv.x, prv.y, prv.z, prv.w}; float z[8];
#pragma unroll
    for (int e = 0; e < 8; ++e) { const float c = (e & 1) ? bfhi(cw[e >> 1]) : bflo(cw[e >> 1]), p = (e & 1) ? bfhi(pw[e >> 1]) : bflo(pw[e >> 1]);
        float v = c + (p - c) * mu[e]; if (act == 1) v = tanhf(v); else if (act == 2) v = sigmoidf_(v); z[e] = v; }
    u32x4 o; o.x = pk2(z[0], z[1]); o.y = pk2(z[2], z[3]); o.z = pk2(z[4], z[5]); o.w = pk2(z[6], z[7]); return o;
}
__device__ __forceinline__ void rwkvprep_item(Frame& F, int l, int item) {
    const int t0 = item * 64;
    const bf16_t* P = (const bf16_t*)(F.ws + WS_P);
    const float* mu = F.in[12] + l * 896;
    ldsp Zw = F.lds, Za = F.lds + 4096, Zg = F.lds + 8192, Zv = F.lds + 16384, V1 = F.lds + 49152 + F.wave * 2048;
    const int nch = (l > 0) ? 48 : 16;
    for (int i = F.tid; i < 64 * nch; i += NTHR) { const int tok = i / nch, c = i % nch; const int t = t0 + tok;
        const int col = (c < 16) ? (768 + c * 8) : (512 + (c - 16) * 8);
        const u32x4 cur = *(const u32x4*)(P + (size_t)t * NINP + C_D + col);
        const u32x4 prv = (t > 0) ? *(const u32x4*)(P + (size_t)(t - 1) * NINP + C_D + col) : (u32x4){0u, 0u, 0u, 0u};
        const u32x4 z = lerp8(cur, prv, mu + col, c < 4 ? 1 : (c >= 8 && c < 16 ? 2 : 0));
        if (c < 4) *(LAS u32x4*)(Zw + tok * 64 + c * 16) = z;
        else if (c < 8) *(LAS u32x4*)(Za + tok * 64 + (c - 4) * 16) = z;
        else if (c < 16) *(LAS u32x4*)(Zg + swz128(tok, c - 8)) = z;
        else *(LAS u32x4*)(Zv + swz512(tok, c - 16)) = z; }
    __syncthreads();
    const int h = F.wave >> 1, half = F.wave & 1, fr = F.lane & 15, g = F.lane >> 4;
    const bf16_t* w2t = (const bf16_t*)(F.ws + WS_W2T); const bf16_t* a2t = (const bf16_t*)(F.ws + WS_A2T); const bf16_t* g2t = (const bf16_t*)(F.ws + WS_G2T);
    const bf16_t* v1t = (const bf16_t*)(F.ws + WS_V1T); const bf16_t* v2t = (const bf16_t*)(F.ws + WS_V2T);
    const float *w0 = F.in[13] + l * 256, *a0 = F.in[15] + l * 256, *kkp = F.in[18] + l * 256, *kap = F.in[19] + l * 256, *rkp = F.in[20] + l * 256;
    const float* v0 = (l > 0) ? F.in[23] + (l - 1) * 256 : nullptr;
    bf16_t *Rr = (bf16_t*)(F.ws + RW_R), *Rk = (bf16_t*)(F.ws + RW_K), *Rv = (bf16_t*)(F.ws + RW_V), *Rkap = (bf16_t*)(F.ws + RW_KAP), *Rb = (bf16_t*)(F.ws + RW_B), *Rg = (bf16_t*)(F.ws + RW_G);
    float* Rld = (float*)(F.ws + RW_LD); float* Rbon = (float*)(F.ws + RW_BONUS); bf16_t* VF = (bf16_t*)(F.ws + WS_VFIRST);
#pragma unroll 1
    for (int m = 0; m < 2; ++m) {
        asm volatile("" ::: "memory");
        f32x4 wl[4], al[4], gl[4], vl[4];
        { const int row = 32 * half + 16 * m + fr;
        const bf16x8 aw = *(const LAS bf16x8*)(Zw + row * 64 + g * 16), aa = *(const LAS bf16x8*)(Za + row * 64 + g * 16);
        const bf16x8 ag0 = *(const LAS bf16x8*)(Zg + swz128(row, g)), ag1 = *(const LAS bf16x8*)(Zg + swz128(row, 4 + g));
#pragma unroll
        for (int n = 0; n < 4; ++n) { const int nr = 64 * h + 16 * n + fr; const f32x4 z0 = (f32x4){0.f, 0.f, 0.f, 0.f};
            wl[n] = mfma16(*(const bf16x8*)(w2t + nr * 32 + g * 8), aw, z0);
            al[n] = mfma16(*(const bf16x8*)(a2t + nr * 32 + g * 8), aa, z0);
            gl[n] = mfma16(*(const bf16x8*)(g2t + nr * 64 + g * 8), ag0, z0); gl[n] = mfma16(*(const bf16x8*)(g2t + nr * 64 + 32 + g * 8), ag1, gl[n]);
            vl[n] = z0; }
        if (l > 0) {
            f32x4 t1[2]; t1[0] = (f32x4){0.f, 0.f, 0.f, 0.f}; t1[1] = t1[0];
#pragma unroll
            for (int ks = 0; ks < 8; ++ks) { const bf16x8 av = *(const LAS bf16x8*)(Zv + swz512(row, ks * 4 + g));
#pragma unroll
                for (int n = 0; n < 2; ++n) t1[n] = mfma16(*(const bf16x8*)(v1t + (16 * n + fr) * 256 + ks * 32 + g * 8), av, t1[n]); }
#pragma unroll
            for (int n = 0; n < 2; ++n) { u32x2 w; w.x = pk2(t1[n][0], t1[n][1]); w.y = pk2(t1[n][2], t1[n][3]); *(LAS u32x2*)(V1 + fr * 64 + (16 * n + 4 * g) * 2) = w; }
            LDS_WAIT();
            const bf16x8 a1 = *(const LAS bf16x8*)(V1 + fr * 64 + g * 16);
#pragma unroll
            for (int n = 0; n < 4; ++n) vl[n] = mfma16(*(const bf16x8*)(v2t + (64 * h + 16 * n + fr) * 32 + g * 8), a1, (f32x4){0.f, 0.f, 0.f, 0.f});
            LDS_WAIT();
        } }
        const int t = t0 + 32 * half + 16 * m + fr;
        float kkr[4][4], zr[4][4], kmod[4][4], av[4][4]; float ss = 0.f, bon = 0.f;
#pragma unroll
        for (int n = 0; n < 4; ++n) { const int ch = 64 * h + 16 * n + 4 * g;
            const bf16_t* pc = P + (size_t)t * NINP + C_D + ch; const bf16_t* pp = pc - NINP;
            const u32x2 rc = *(const u32x2*)(pc), kc = *(const u32x2*)(pc + 256), vc = *(const u32x2*)(pc + 512);
            u32x2 rp = (u32x2){0u, 0u}, kp = rp, vp = rp; if (t > 0) { rp = *(const u32x2*)(pp); kp = *(const u32x2*)(pp + 256); vp = *(const u32x2*)(pp + 512); }
            const float rcv[4] = {bflo(rc.x), bfhi(rc.x), bflo(rc.y), bfhi(rc.y)}, rpv[4] = {bflo(rp.x), bfhi(rp.x), bflo(rp.y), bfhi(rp.y)};
            const float kcv[4] = {bflo(kc.x), bfhi(kc.x), bflo(kc.y), bfhi(kc.y)}, kpv[4] = {bflo(kp.x), bfhi(kp.x), bflo(kp.y), bfhi(kp.y)};
            const float vcv[4] = {bflo(vc.x), bfhi(vc.x), bflo(vc.y), bfhi(vc.y)}, vpv[4] = {bflo(vp.x), bfhi(vp.x), bflo(vp.y), bfhi(vp.y)};
            float vout[4], ldv[4], gv[4];
            u32x2 vf = (u32x2){0u, 0u}; if (l > 0) vf = *(const u32x2*)(VF + (size_t)t * 256 + ch);
            const float vfv[4] = {bflo(vf.x), bfhi(vf.x), bflo(vf.y), bfhi(vf.y)};
#pragma unroll
            for (int j = 0; j < 4; ++j) { const int c = ch + j;
                const float r_ = rcv[j] + (rpv[j] - rcv[j]) * mu[c], k_ = kcv[j] + (kpv[j] - kcv[j]) * mu[256 + c], v_ = vcv[j] + (vpv[j] - vcv[j]) * mu[512 + c];
                const float wpre = w0[c] + wl[n][j]; const float y = -wpre; const float sp = fmaxf(y, 0.f) + log1pf(__expf(-fabsf(y)));
                const float w = -sp - 0.5f; ldv[j] = -__expf(w);
                const float a = sigmoidf_(a0[c] + al[n][j]); av[n][j] = a; gv[j] = gl[n][j];
                float vv = v_; if (l > 0) vv = v_ + (vfv[j] - v_) * sigmoidf_(v0[c] + vl[n][j]);
                vout[j] = vv; zr[n][j] = r_;
                const float kk = k_ * kkp[c]; kkr[n][j] = kk; ss += kk * kk;
                const float km = k_ * (1.f + (a - 1.f) * kap[c]); kmod[n][j] = km; bon += r_ * km * rkp[c]; }
            const size_t o = (size_t)t * 256 + ch;
            { u32x2 w; w.x = pk2(zr[n][0], zr[n][1]); w.y = pk2(zr[n][2], zr[n][3]); *(u32x2*)(Rr + o) = w; }
            { u32x2 w; w.x = pk2(kmod[n][0], kmod[n][1]); w.y = pk2(kmod[n][2], kmod[n][3]); *(u32x2*)(Rk + o) = w; }
            { u32x2 w; w.x = pk2(vout[0], vout[1]); w.y = pk2(vout[2], vout[3]); *(u32x2*)(Rv + o) = w; if (l == 0) *(u32x2*)(VF + o) = w; }
            { u32x2 w; w.x = pk2(gv[0], gv[1]); w.y = pk2(gv[2], gv[3]); *(u32x2*)(Rg + o) = w; }
            *(f32x4*)(Rld + o) = (f32x4){ldv[0], ldv[1], ldv[2], ldv[3]};
        }
        ss += __shfl_xor(ss, 16); ss += __shfl_xor(ss, 32); bon += __shfl_xor(bon, 16); bon += __shfl_xor(bon, 32);
        const float inn = 1.f / fmaxf(sqrtf(ss), 1e-12f);
#pragma unroll
        for (int n = 0; n < 4; ++n) { const size_t o = (size_t)t * 256 + 64 * h + 16 * n + 4 * g;
            float kp_[4], b_[4];
#pragma unroll
            for (int j = 0; j < 4; ++j) { kp_[j] = kkr[n][j] * inn; b_[j] = kp_[j] * av[n][j]; }
            { u32x2 w; w.x = pk2(kp_[0], kp_[1]); w.y = pk2(kp_[2], kp_[3]); *(u32x2*)(Rkap + o) = w; }
            { u32x2 w; w.x = pk2(b_[0], b_[1]); w.y = pk2(b_[2], b_[3]); *(u32x2*)(Rb + o) = w; } }
        if (g == 0) Rbon[(size_t)t * 4 + h] = bon;
    }
    __syncthreads();
}

__device__ __forceinline__ void scan_seq(Frame& F, int h) {
    const bf16_t *Rr = (const bf16_t*)(F.ws + RW_R), *Rk = (const bf16_t*)(F.ws + RW_K), *Rv = (const bf16_t*)(F.ws + RW_V), *Rkap = (const bf16_t*)(F.ws + RW_KAP), *Rb = (const bf16_t*)(F.ws + RW_B);
    const float* Rld = (const float*)(F.ws + RW_LD); float* Y = (float*)(F.ws + RW_Y);
    LAS float* L = (LAS float*)F.lds;
    const int i = F.tid >> 2, q = F.tid & 3;
    float S[16];
#pragma unroll
    for (int j = 0; j < 16; ++j) S[j] = 0.f;
    for (int c0 = 0; c0 < T_; c0 += 64) {
        __syncthreads();
        for (int e = F.tid; e < 64 * 64; e += NTHR) { const int s = e >> 6, ch = e & 63; const size_t o = (size_t)(c0 + s) * 256 + h * 64 + ch;
            L[(s * 6 + 0) * 64 + ch] = bf2f(Rkap[o]); L[(s * 6 + 1) * 64 + ch] = bf2f(Rb[o]); L[(s * 6 + 2) * 64 + ch] = bf2f(Rk[o]);
            L[(s * 6 + 3) * 64 + ch] = bf2f(Rr[o]); L[(s * 6 + 4) * 64 + ch] = __expf(Rld[o]); L[(s * 6 + 5) * 64 + ch] = bf2f(Rv[o]); }
        __syncthreads();
        if (F.tid < 256) {
            for (int s = 0; s < 64; ++s) {
                const LAS float* Ls = L + s * 384 + q * 16;
                float sa = 0.f;
#pragma unroll
                for (int j = 0; j < 16; ++j) sa += S[j] * Ls[j];
                sa += __shfl_xor(sa, 1); sa += __shfl_xor(sa, 2); sa = -sa;
                const float vi = L[s * 384 + 320 + i];
                float y = 0.f;
#pragma unroll
                for (int j = 0; j < 16; ++j) { S[j] = S[j] * Ls[256 + j] + sa * Ls[64 + j] + vi * Ls[128 + j]; y += S[j] * Ls[192 + j]; }
                y += __shfl_xor(y, 1); y += __shfl_xor(y, 2);
                if (q == 0) Y[(size_t)(c0 + s) * 256 + h * 64 + i] = y;
            }
        }
    }
    __syncthreads();
}

__device__ __forceinline__ void phase_post(Frame& F, int l) {
    const float* Y = (const float*)(F.ws + RW_Y); const bf16_t *Rv = (const bf16_t*)(F.ws + RW_V), *Rg = (const bf16_t*)(F.ws + RW_G); const float* Rbon = (const float*)(F.ws + RW_BONUS);
    bf16_t* ycat = (bf16_t*)(F.ws + WS_ACT);
    const float *lng = F.in[21] + l * 256, *lnb = F.in[22] + l * 256;
    const int gw = F.bid * NWAVES + F.wave, NGW = F.G * NWAVES;
    for (int it = gw; it < T_ * 4; it += NGW) { const int t = it >> 2, h = it & 3; const size_t o = (size_t)t * 256 + h * 64 + F.lane;
        const float y = Y[o]; const float mean = wave_sum(y) * (1.f / 64.f); const float d = y - mean; const float var = wave_sum(d * d) * (1.f / 64.f);
        const float yn = d * (1.f / sqrtf(var + 64e-5f)) * lng[h * 64 + F.lane] + lnb[h * 64 + F.lane];
        const float outv = (yn + Rbon[(size_t)t * 4 + h] * bf2f(Rv[o])) * bf2f(Rg[o]);
        ycat[(size_t)t * DM + 768 + h * 64 + F.lane] = (bf16_t)f2bf(outv); }
}

__device__ __forceinline__ void phase_router(Frame& F, int l) {
    const float* X = F.out;
    const bf16_t* WH = (const bf16_t*)(F.ws + WS_WRH); const bf16_t* WL = (const bf16_t*)(F.ws + WS_WRL);
    const float* bias_r = (const float*)(F.ws + WS_BR);
    float* rinv2 = (float*)(F.ws + WS_RINV2);
    unsigned* cnt = (unsigned*)(F.ws + WS_CTL) + l * 64;
    unsigned* list = (unsigned*)(F.ws + WS_LIST); float* wlist = (float*)(F.ws + WS_WLIST);
    LAS float* Lg = (LAS float*)(F.lds + F.wave * 4096);
    const int fr = F.lane & 15, g = F.lane >> 4;
    const int gw = F.bid * NWAVES + F.wave, NGW = F.G * NWAVES;
    for (int it = gw; it < T_ / 16; it += NGW) {
        const int t = it * 16 + fr;
        const float* xr = X + (size_t)t * DM + g * 8;
        f32x4 acc[3]; acc[0] = (f32x4){0.f, 0.f, 0.f, 0.f}; acc[1] = acc[0]; acc[2] = acc[0];
        float ss = 0.f;
#pragma unroll 2
        for (int ks = 0; ks < 32; ++ks) {
            const f32x4 x0 = *(const f32x4*)(xr + ks * 32), x1 = *(const f32x4*)(xr + ks * 32 + 4);
            const float xv[8] = {x0[0], x0[1], x0[2], x0[3], x1[0], x1[1], x1[2], x1[3]};
            unsigned hh[8], ll[8];
#pragma unroll
            for (int e = 0; e < 8; ++e) { ss += xv[e] * xv[e]; hh[e] = f2bf(xv[e]); ll[e] = f2bf(xv[e] - bf2f(hh[e])); }
            u32x4 hw, lw; hw.x = hh[0] | (hh[1] << 16); hw.y = hh[2] | (hh[3] << 16); hw.z = hh[4] | (hh[5] << 16); hw.w = hh[6] | (hh[7] << 16);
            lw.x = ll[0] | (ll[1] << 16); lw.y = ll[2] | (ll[3] << 16); lw.z = ll[4] | (ll[5] << 16); lw.w = ll[6] | (ll[7] << 16);
            const bf16x8 xh = __builtin_bit_cast(bf16x8, hw), xl = __builtin_bit_cast(bf16x8, lw);
#pragma unroll
            for (int n = 0; n < 3; ++n) { const bf16x8 wh = *(const bf16x8*)(WH + (16 * n + fr) * DM + ks * 32 + g * 8), wl = *(const bf16x8*)(WL + (16 * n + fr) * DM + ks * 32 + g * 8);
                acc[n] = mfma16(wh, xh, acc[n]); acc[n] = mfma16(wh, xl, acc[n]); acc[n] = mfma16(wl, xh, acc[n]); }
        }
        ss += __shfl_xor(ss, 16); ss += __shfl_xor(ss, 32);
        const float rinv = 1.f / sqrtf(ss * (1.f / DM) + 1e-6f);
#pragma unroll
        for (int n = 0; n < 3; ++n)
#pragma unroll
            for (int j = 0; j < 4; ++j) { const int c = 16 * n + 4 * g + j; Lg[fr * 48 + c] = acc[n][j] * rinv + bias_r[c]; }
        LDS_WAIT();
        if (F.lane < 16) {
            const LAS float* lg = Lg + F.lane * 48; const int tt = it * 16 + F.lane;
            rinv2[tt] = rinv;
            int gi = 0; float gm = lg[0];
#pragma unroll
            for (int k = 1; k < 4; ++k) if (lg[k] > gm) { gm = lg[k]; gi = k; }
            float gs = 0.f;
#pragma unroll
            for (int k = 0; k < 4; ++k) gs += __expf(lg[k] - gm);
            const float gp = 1.f / gs;
            int e0 = 0; float v0 = lg[4 + gi * 8];
#pragma unroll
            for (int k = 1; k < 8; ++k) { const float v = lg[4 + gi * 8 + k]; if (v > v0) { v0 = v; e0 = k; } }
            int e1 = -1; float v1 = -INFINITY;
#pragma unroll
            for (int k = 0; k < 8; ++k) { const float v = lg[4 + gi * 8 + k]; if (k != e0 && v > v1) { v1 = v; e1 = k; } }
            const float ex = __expf(v1 - v0); const float w0 = gp / (1.f + ex), w1 = gp * ex / (1.f + ex);
            const int E0 = gi * 8 + e0, E1 = gi * 8 + e1;
            const unsigned p0 = atomicAdd(&cnt[E0], 1u); list[(size_t)E0 * T_ + p0] = (unsigned)tt; wlist[(size_t)E0 * T_ + p0] = w0;
            const unsigned p1 = atomicAdd(&cnt[E1], 1u); list[(size_t)E1 * T_ + p1] = (unsigned)tt | 0x80000000u; wlist[(size_t)E1 * T_ + p1] = w1;
        }
        LDS_WAIT();
    }
}

__device__ __forceinline__ void phase_moe(Frame& F, int l) {
    const bf16_t* XB = (const bf16_t*)(F.ws + WS_RW);
    const bf16_t* WGU = (const bf16_t*)(F.ws + WS_WGU); const bf16_t* WD = (const bf16_t*)(F.ws + WS_WD);
    const float* bias_gu = (const float*)(F.ws + WS_BGU); const float* rinv2 = (const float*)(F.ws + WS_RINV2);
    const unsigned* cnt = (const unsigned*)(F.ws + WS_CTL) + l * 64;
    const unsigned* list = (const unsigned*)(F.ws + WS_LIST); const float* wlist = (const float*)(F.ws + WS_WLIST);
    bf16_t* ys = (bf16_t*)(F.ws + WS_P);
    ldsp At = F.lds, Bt = F.lds + 16384, Bd = F.lds, Act = F.lds + 65536;
    LAS unsigned* tokl = (LAS unsigned*)(F.lds + 98304); LAS float* wtl = (LAS float*)(F.lds + 98304 + 512); LAS float* rvl = (LAS float*)(F.lds + 98304 + 1024);
    const int wr = F.wave >> 2, wc = F.wave & 3, fr = F.lane & 15, g = F.lane >> 4;
    int total = 0;
    for (int e = 0; e < 32; ++e) total += ((int)cnt[e] + 127) >> 7;
    for (int ti = F.bid; ti < total; ti += F.G) {
        int e = 0, acc_t = 0, m0 = 0, ne = 0;
        for (int k = 0; k < 32; ++k) { const int n = (int)cnt[k]; const int nt = (n + 127) >> 7; if (ti >= acc_t && ti < acc_t + nt) { e = k; m0 = (ti - acc_t) * 128; ne = n; } acc_t += nt; }
        const int nrows = (ne - m0) < 128 ? (ne - m0) : 128;
        __syncthreads();
        if (F.tid < 128) { unsigned tk = 0u; float w = 0.f; if (F.tid < nrows) { tk = list[(size_t)e * T_ + m0 + F.tid]; w = wlist[(size_t)e * T_ + m0 + F.tid]; }
            tokl[F.tid] = tk; wtl[F.tid] = w; rvl[F.tid] = rinv2[tk & 0x7fffffffu]; }
        __syncthreads();
        f32x4 ag[4][2], au[4][2];
#pragma unroll
        for (int m = 0; m < 4; ++m)
#pragma unroll
            for (int n = 0; n < 2; ++n) { ag[m][n] = (f32x4){0.f, 0.f, 0.f, 0.f}; au[m][n] = ag[m][n]; }
        const bf16_t* wgu = WGU + (size_t)e * 256 * DM;
        for (int kt = 0; kt < 16; ++kt) {
            u32x4 ra[2], rb[4];
#pragma unroll
            for (int i = 0; i < 2; ++i) { const int idx = F.tid + i * NTHR, row = idx >> 3, c = idx & 7; const unsigned tk = tokl[row] & 0x7fffffffu; ra[i] = *(const u32x4*)(XB + (size_t)tk * DM + kt * 64 + c * 8); }
#pragma unroll
            for (int i = 0; i < 4; ++i) { const int idx = F.tid + i * NTHR, row = idx >> 3, c = idx & 7; rb[i] = *(const u32x4*)(wgu + (size_t)row * DM + kt * 64 + c * 8); }
            __syncthreads();
#pragma unroll
            for (int i = 0; i < 2; ++i) { const int idx = F.tid + i * NTHR, row = idx >> 3, c = idx & 7; *(LAS u32x4*)(At + swz128(row, c)) = ra[i]; }
#pragma unroll
            for (int i = 0; i < 4; ++i) { const int idx = F.tid + i * NTHR, row = idx >> 3, c = idx & 7; *(LAS u32x4*)(Bt + swz128(row, c)) = rb[i]; }
            __syncthreads();
#pragma unroll
            for (int ks = 0; ks < 2; ++ks) {
                bf16x8 af[4], bg_[2], bu_[2];
#pragma unroll
                for (int m = 0; m < 4; ++m) af[m] = *(const LAS bf16x8*)(At + swz128(64 * wr + 16 * m + fr, ks * 4 + g));
#pragma unroll
                for (int n = 0; n < 2; ++n) { bg_[n] = *(const LAS bf16x8*)(Bt + swz128(32 * wc + 16 * n + fr, ks * 4 + g)); bu_[n] = *(const LAS bf16x8*)(Bt + swz128(128 + 32 * wc + 16 * n + fr, ks * 4 + g)); }
#pragma unroll
                for (int m = 0; m < 4; ++m)
#pragma unroll
                    for (int n = 0; n < 2; ++n) { ag[m][n] = mfma16(bg_[n], af[m], ag[m][n]); au[m][n] = mfma16(bu_[n], af[m], au[m][n]); }
            }
        }
        const float* bge = bias_gu + e * 256;
#pragma unroll
        for (int m = 0; m < 4; ++m) { const int row = 64 * wr + 16 * m + fr; const float rv = rvl[row], wt = wtl[row];
#pragma unroll
            for (int n = 0; n < 2; ++n) { const int f0 = 32 * wc + 16 * n + 4 * g; float a_[4];
#pragma unroll
                for (int j = 0; j < 4; ++j) { const float gv = ag[m][n][j] * rv + bge[f0 + j], uv = au[m][n][j] * rv + bge[128 + f0 + j]; a_[j] = gv * sigmoidf_(gv) * uv * wt; }
                u32x2 w; w.x = pk2(a_[0], a_[1]); w.y = pk2(a_[2], a_[3]);
                *(LAS u32x2*)(Act + swz256(row, f0 >> 3) + (g & 1) * 8) = w; } }
        const bf16_t* wd = WD + (size_t)e * DM * 128;
#pragma unroll 1
        for (int nc = 0; nc < 4; ++nc) {
            __syncthreads();
#pragma unroll
            for (int i = 0; i < 8; ++i) { const int idx = F.tid + i * NTHR, row = idx >> 4, c = idx & 15; *(LAS u32x4*)(Bd + swz256(row, c)) = *(const u32x4*)(wd + (size_t)(nc * 256 + row) * 128 + c * 8); }
            __syncthreads();
            f32x4 ao[4][4];
#pragma unroll
            for (int m = 0; m < 4; ++m)
#pragma unroll
                for (int n = 0; n < 4; ++n) ao[m][n] = (f32x4){0.f, 0.f, 0.f, 0.f};
#pragma unroll
            for (int ks = 0; ks < 4; ++ks) {
                bf16x8 af[4], bf_[4];
#pragma unroll
                for (int m = 0; m < 4; ++m) af[m] = *(const LAS bf16x8*)(Act + swz256(64 * wr + 16 * m + fr, ks * 4 + g));
#pragma unroll
                for (int n = 0; n < 4; ++n) bf_[n] = *(const LAS bf16x8*)(Bd + swz256(64 * wc + 16 * n + fr, ks * 4 + g));
#pragma unroll
                for (int m = 0; m < 4; ++m)
#pragma unroll
                    for (int n = 0; n < 4; ++n) ao[m][n] = mfma16(bf_[n], af[m], ao[m][n]);
            }
#pragma unroll
            for (int m = 0; m < 4; ++m) { const int row = 64 * wr + 16 * m + fr;
                if (row < nrows) { const unsigned tk = tokl[row]; bf16_t* dst = ys + ((size_t)(tk >> 31) * T_ + (tk & 0x7fffffffu)) * DM + nc * 256 + 64 * wc + 4 * g;
#pragma unroll
                    for (int n = 0; n < 4; ++n) { u32x2 w; w.x = pk2(ao[m][n][0], ao[m][n][1]); w.y = pk2(ao[m][n][2], ao[m][n][3]); *(u32x2*)(dst + 16 * n) = w; } } }
        }
    }
    __syncthreads();
}

constexpr int NPHASE = 18;
template <int L> __device__ __forceinline__ void layer_phases(Frame& F, const int lo, const int hi) {
    constexpr int B = 1 + 8 * L;
#define IN(k) (lo <= (k) && (k) < hi)
#define SEAM(k) do { if (IN(k) && IN((k) + 1)) cg::this_grid().sync(); } while (0)
    if (IN(B + 0)) { phase_prep(F, L); __syncthreads(); phase_rownorm(F, L == 0 ? 0 : 1); } SEAM(B + 0);
    if (IN(B + 1)) {
        pg8::Gemm gm{(const bf16_t*)(F.ws + WS_ACT), (const bf16_t*)(F.ws + WS_WIN), T_, NINP, DM, DM, DM};
        pg8::StaticOrder S; S.init(T_, NINP, F.G, F.bid);
        pg8::EpiBf16Bias E{(bf16_t*)(F.ws + WS_P), NINP, (const float*)(F.ws + WS_BIN)};
        pg8::gemm_phase<pg8::EpiBf16Bias, pg8::StaticOrder, true, true>(F.lds, gm, S, E);
    } SEAM(B + 1);
    if (IN(B + 2)) {
#pragma unroll 1
        for (int it = F.bid; it < 512; it += F.G) { asm volatile("" ::: "memory"); if (it < 128) attn_item(F, L, it); }
#pragma unroll 1
        for (int it = F.bid; it < 512; it += F.G) { asm volatile("" ::: "memory"); if (it >= 128 && it < 256) poolconv_item(F, L, it - 128); }
#pragma unroll 1
        for (int it = F.bid; it < 512; it += F.G) { asm volatile("" ::: "memory"); if (it >= 256) rwkvprep_item(F, L, it - 256); }
    } SEAM(B + 2);
    if (IN(B + 3)) { if (F.bid < 4) scan_seq(F, F.bid); } SEAM(B + 3);
    if (IN(B + 4)) phase_post(F, L); SEAM(B + 4);
    if (IN(B + 5)) {
        pg8::Gemm gm{(const bf16_t*)(F.ws + WS_ACT), (const bf16_t*)(F.ws + WS_WOUT), T_, DM, DM, DM, DM};
        pg8::StaticOrder S; S.init(T_, DM, F.G, F.bid);
        pg8::EpiResF32 E{L == 0 ? F.in[0] : F.out, F.out, (bf16_t*)(F.ws + WS_RW), DM};
        pg8::gemm_phase<pg8::EpiResF32, pg8::StaticOrder, true, true>(F.lds, gm, S, E);
    } SEAM(B + 5);
    if (IN(B + 6)) phase_router(F, L); SEAM(B + 6);
    if (IN(B + 7)) phase_moe(F, L); SEAM(B + 7);
}

__global__ void __launch_bounds__(NTHR, 2) fwd_kernel(Args a) {
    extern __shared__ __attribute__((aligned(16))) unsigned char smem[];
    Frame F;
    F.lds = (ldsp)smem; F.tid = threadIdx.x; F.lane = F.tid & 63; F.wave = __builtin_amdgcn_readfirstlane(F.tid >> 6);
    F.G = gridDim.x; F.bid = blockIdx.x; F.in = a.in; F.out = a.out; F.ws = a.ws;
    const int lo = a.ph_lo, hi = a.ph_hi;
    if (IN(0)) phase_mod(F); SEAM(0);
    layer_phases<0>(F, lo, hi);
    layer_phases<1>(F, lo, hi);
    if (IN(17)) phase_rownorm(F, 2);
#undef IN
#undef SEAM
}

extern "C" void kernel_launch(void* const* d_in, const int* in_sizes, int n_in, void* d_out, int out_size, void* d_ws, size_t ws_size, hipStream_t stream) {
    static int grid = 0;
    if (grid == 0) {
        int dev = 0, cus = 0;
        if (n_in != 34 || out_size != T_ * DM || ws_size < WS_END) { fprintf(stderr, "kernel_launch: unexpected shapes n_in %d out %d ws %zu\n", n_in, out_size, ws_size); grid = -1; return; }
        if (hipGetDevice(&dev) != hipSuccess || hipDeviceGetAttribute(&cus, hipDeviceAttributeMultiprocessorCount, dev) != hipSuccess) { grid = -1; return; }
        if (hipFuncSetAttribute((const void*)fwd_kernel, hipFuncAttributeMaxDynamicSharedMemorySize, LDS_BYTES) != hipSuccess) { fprintf(stderr, "kernel_launch: hipFuncSetAttribute failed\n"); grid = -1; return; }
        int per_cu = 0;
        if (hipOccupancyMaxActiveBlocksPerMultiprocessor(&per_cu, (const void*)fwd_kernel, NTHR, LDS_BYTES) != hipSuccess || per_cu < 1) { fprintf(stderr, "kernel_launch: occupancy query failed (%d)\n", per_cu); per_cu = 1; }
        (void)hipGetLastError();
        grid = cus;
    }
    if (grid < 0) return;
    (void)hipMemsetAsync((char*)d_ws + WS_CTL, 0, CTL_BYTES, stream);
    Args a{};
    for (int i = 0; i < 34; ++i) a.in[i] = (const float*)d_in[i];
    a.out = (float*)d_out; a.ws = (unsigned char*)d_ws;
#ifdef MULTI_LAUNCH
    for (int ph = 0; ph < NPHASE; ++ph) { a.ph_lo = ph; a.ph_hi = ph + 1; hipLaunchKernelGGL(fwd_kernel, dim3(grid), dim3(NTHR), LDS_BYTES, stream, a); }
#else
    a.ph_lo = 0; a.ph_hi = NPHASE;
    void* args[] = {&a};
    hipError_t e = hipLaunchCooperativeKernel((void*)fwd_kernel, dim3(grid), dim3(NTHR), args, LDS_BYTES, stream);
    if (e != hipSuccess) fprintf(stderr, "cooperative launch failed: %s (grid %d)\n", hipGetErrorString(e), grid);
#endif
}
```

```cpp
#include <hip/hip_runtime.h>
#include <hip/hip_cooperative_groups.h>
#include <cstdio>
#include <cstdint>
namespace cg = cooperative_groups;

#define LAS __attribute__((address_space(3)))
typedef unsigned short bf16_t;
typedef short bf16x8 __attribute__((ext_vector_type(8)));
typedef float f32x4 __attribute__((ext_vector_type(4)));
typedef float f32x2 __attribute__((ext_vector_type(2)));
typedef unsigned u32x4 __attribute__((ext_vector_type(4)));
typedef unsigned u32x2 __attribute__((ext_vector_type(2)));
typedef LAS unsigned char* ldsp;

namespace pg8 {
#define PG8_LAS __attribute__((address_space(3)))
constexpr int BM = 256, BK = 64, HALF = 128, HTB = HALF * BK * 2, STAGE_BYTES = 8 * HTB, NXCD = 8, WGM = 8;
__host__ __device__ __forceinline__ int lds_byte(int r, int c) { const int st = (r >> 4) * 2 + (c >> 5), rr = r & 15, cc = c & 31, ob = rr * 64 + cc * 2; return st * 1024 + (ob ^ (((ob >> 9) & 1) << 5)); }
__host__ __device__ __forceinline__ void stage_rc(int b, int& R, int& C) { const int st = b / 1024, sb = b % 1024, swz = sb ^ (((sb >> 9) & 1) << 5); R = (st >> 1) * 16 + swz / 64; C = (st & 1) * 32 + (swz % 64) / 2; }
__host__ __device__ __forceinline__ int perm32(int rho) { const int n = rho >> 4, i = rho & 15; return 8 * (i >> 2) + 4 * n + (i & 3); }
struct Unit { int pm, pn; };
struct Gemm { const bf16_t* A; const bf16_t* Bt; int M, N, K, lda, ldb; };
struct StaticOrder {
    int nM, nN, nwg, G, c;
    __host__ __device__ void init(int M, int N, int G_, int c_) { nM = M / BM; nN = N / BM; nwg = nM * nN; G = G_; c = c_; }
    __host__ __device__ bool next(int i, Unit& u) const {
        const long L = (long)i * G + c; if (L >= nwg) return false;
        int wgid = (int)L; { const int q = nwg / NXCD, r = nwg % NXCD, xcd = wgid % NXCD, off = wgid / NXCD; wgid = (xcd < r ? xcd * (q + 1) : r * (q + 1) + (xcd - r) * q) + off; }
        const int nig = WGM * nN, gid = wgid / nig, fm = gid * WGM, gsz = (nM - fm) < WGM ? (nM - fm) : WGM;
        u.pm = fm + ((wgid % nig) % gsz); u.pn = (wgid % nig) / gsz; return true;
    }
    __device__ __forceinline__ void a_ready(const Unit&) const {}
    __device__ __forceinline__ void done(const Unit&) const {}
};
__device__ __forceinline__ unsigned cvt_pk_bf16(float lo, float hi) { unsigned r; asm volatile("v_cvt_pk_bf16_f32 %0, %1, %2" : "=v"(r) : "v"(lo), "v"(hi)); return r; }
struct EpiBf16Bias {
    static constexpr bool PERM = true, AFTER_DRAIN = false;
    bf16_t* O; int ldc; const float* bias;
    __device__ __forceinline__ void operator()(const f32x4 (&acc)[2][2][4][2], const Unit& u, int wr, int wc, int fr, int fq) const {
        const int row0 = u.pm * BM + wr * 64 + fr; const int col0 = u.pn * BM + wc * 32 + 8 * fq;
        f32x4 bv[2][2];
#pragma unroll
        for (int bj = 0; bj < 2; ++bj)
#pragma unroll
            for (int n = 0; n < 2; ++n) bv[bj][n] = *(const f32x4*)(bias + col0 + bj * HALF + 4 * n);
#pragma unroll
        for (int ai = 0; ai < 2; ++ai)
#pragma unroll
            for (int m = 0; m < 4; ++m) { bf16_t* rowp = O + (size_t)(row0 + ai * HALF + m * 16) * ldc + col0;
#pragma unroll
                for (int bj = 0; bj < 2; ++bj) { f32x4 v0 = acc[ai][bj][m][0] + bv[bj][0], v1 = acc[ai][bj][m][1] + bv[bj][1];
                    u32x4 w; w.x = cvt_pk_bf16(v0[0], v0[1]); w.y = cvt_pk_bf16(v0[2], v0[3]); w.z = cvt_pk_bf16(v1[0], v1[1]); w.w = cvt_pk_bf16(v1[2], v1[3]);
                    *(u32x4*)(rowp + bj * HALF) = w; } }
    }
};
struct EpiResF32 {
    static constexpr bool PERM = false, AFTER_DRAIN = false;
    const float* base; float* out; bf16_t* ob; int ldc;
    __device__ __forceinline__ void operator()(const f32x4 (&acc)[2][2][4][2], const Unit& u, int wr, int wc, int fr, int fq) const {
        const int row0 = u.pm * BM + wr * 64 + fr, col0 = u.pn * BM + wc * 32 + 4 * fq;
#pragma unroll
        for (int ai = 0; ai < 2; ++ai)
#pragma unroll
            for (int m = 0; m < 4; ++m) { const size_t off = (size_t)(row0 + ai * HALF + m * 16) * ldc + col0;
#pragma unroll
                for (int bj = 0; bj < 2; ++bj)
#pragma unroll
                    for (int n = 0; n < 2; ++n) { const f32x4 bs = *(const f32x4*)(base + off + bj * HALF + n * 16); const f32x4 o = bs + acc[ai][bj][m][n];
                        *(f32x4*)(out + off + bj * HALF + n * 16) = o;
                        u32x2 w; w.x = cvt_pk_bf16(o[0], o[1]); w.y = cvt_pk_bf16(o[2], o[3]); *(u32x2*)(ob + off + bj * HALF + n * 16) = w; }
                asm volatile("" ::: "memory"); }
    }
};
template <class Epi, class Sched, bool ALIGN_EPI = false, bool SP2 = false>
__device__ __forceinline__ void gemm_phase(PG8_LAS unsigned char* lds, const Gemm g, const Sched& S, const Epi& E) {
    const int tid = threadIdx.x, wid = __builtin_amdgcn_readfirstlane(tid >> 6), lane = tid & 63, wr = wid >> 2, wc = wid & 3, fr = lane & 15, fq = lane >> 4;
    const int K = g.K, nt = K / BK;
    unsigned voffA[2], voffB[2];
#pragma unroll
    for (int i = 0; i < 2; ++i) { int R, C; stage_rc(tid * 16 + i * 8192, R, C); const int Rb = Epi::PERM ? ((R & ~31) + perm32(R & 31)) : R;
        voffA[i] = (unsigned)(R * g.lda + C) * 2u; voffB[i] = (unsigned)(Rb * g.ldb + C) * 2u; }
    const size_t kstep = (size_t)(BK * 2);
    const size_t hstepA = (size_t)HALF * g.lda * 2, hstepB = (size_t)HALF * g.ldb * 2;
    const size_t tstepA = 2 * hstepA, tstepB = 2 * hstepB;
    const unsigned ldsw = (unsigned)wid * 1024u;
    const int aoff = lds_byte(wr * 64 + fr, fq * 8), boff = lds_byte(wc * 32 + fr, fq * 8);
#define PG8_SA(b, h) (((b) * 2 + (h)) * HTB)
#define PG8_SB(b, h) ((4 + (b) * 2 + (h)) * HTB)
#define PG8_STAGE(bufoff, gbase, voff) do { _Pragma("unroll") for (int _i = 0; _i < 2; ++_i) \
        __builtin_amdgcn_global_load_lds((const unsigned*)((const char*)(gbase) + (voff)[_i]), (PG8_LAS unsigned*)(lds + (bufoff) + ldsw + _i * 8192), 16, 0, 0); } while (0)
#define PG8_LDA(dst, b, h) do { _Pragma("unroll") for (int m = 0; m < 4; ++m) _Pragma("unroll") for (int k = 0; k < 2; ++k) dst[m][k] = *(const PG8_LAS bf16x8*)(lds + PG8_SA(b, h) + aoff + m * 2048 + k * 1024); } while (0)
#define PG8_LDB(dst, b, h) do { _Pragma("unroll") for (int n = 0; n < 2; ++n) _Pragma("unroll") for (int k = 0; k < 2; ++k) dst[n][k] = *(const PG8_LAS bf16x8*)(lds + PG8_SB(b, h) + boff + n * 2048 + k * 1024); } while (0)
#define PG8_MMA(ai, bj, At, Bt) do { __builtin_amdgcn_s_setprio(1); _Pragma("unroll") for (int m = 0; m < 4; ++m) _Pragma("unroll") for (int n = 0; n < 2; ++n) _Pragma("unroll") for (int k = 0; k < 2; ++k) \
        acc[ai][bj][m][n] = __builtin_amdgcn_mfma_f32_16x16x32_bf16(Bt[n][k], At[m][k], acc[ai][bj][m][n], 0, 0, 0); __builtin_amdgcn_s_setprio(0); } while (0)
#define PG8_WAIT_V(n) asm volatile("s_waitcnt vmcnt(" #n ")" ::: "memory")
#define PG8_WAIT_L(n) asm volatile("s_waitcnt lgkmcnt(" #n ")" ::: "memory")
#define PG8_BAR __builtin_amdgcn_s_barrier()
#define PG8_SCHED __builtin_amdgcn_sched_barrier(0)
    Unit cur, nxt; int ui = 0;
    if (!S.next(0, cur)) return;
    f32x4 acc[2][2][4][2];
#pragma unroll
    for (int a = 0; a < 2; ++a)
#pragma unroll
        for (int b = 0; b < 2; ++b)
#pragma unroll
            for (int m = 0; m < 4; ++m)
#pragma unroll
                for (int n = 0; n < 2; ++n) acc[a][b][m][n] = (f32x4){0.f, 0.f, 0.f, 0.f};
    bf16x8 At[4][2], B0[2][2], B1[2][2];
    const char* cA = (const char*)g.A + (size_t)cur.pm * tstepA; const char* cB = (const char*)g.Bt + (size_t)cur.pn * tstepB;
    S.a_ready(cur);
    if constexpr (SP2) {
        PG8_STAGE(PG8_SB(0, 0), cB, voffB); PG8_STAGE(PG8_SB(0, 1), cB + hstepB, voffB); PG8_STAGE(PG8_SA(0, 0), cA, voffA); PG8_STAGE(PG8_SA(0, 1), cA + hstepA, voffA);
        if (wr == 1) PG8_BAR;
        PG8_WAIT_V(2); PG8_BAR;
        PG8_STAGE(PG8_SB(1, 0), cB + kstep, voffB); PG8_STAGE(PG8_SA(1, 0), cA + kstep, voffA); PG8_STAGE(PG8_SB(1, 1), cB + hstepB + kstep, voffB);
        PG8_WAIT_V(6); PG8_BAR;
    } else {
        PG8_STAGE(PG8_SB(0, 0), cB, voffB); PG8_STAGE(PG8_SA(0, 0), cA, voffA); PG8_STAGE(PG8_SB(0, 1), cB + hstepB, voffB); PG8_STAGE(PG8_SA(0, 1), cA + hstepA, voffA);
        if (wr == 1) PG8_BAR;
        PG8_WAIT_V(4); PG8_BAR;
        PG8_STAGE(PG8_SB(1, 0), cB + kstep, voffB); PG8_STAGE(PG8_SA(1, 0), cA + kstep, voffA); PG8_STAGE(PG8_SB(1, 1), cB + hstepB + kstep, voffB);
        PG8_WAIT_V(6); PG8_BAR;
    }
    for (;;) {
        const bool has_next = S.next(ui + 1, nxt);
        const char* nA = has_next ? (const char*)g.A + (size_t)nxt.pm * tstepA : cA; const char* nB = has_next ? (const char*)g.Bt + (size_t)nxt.pn * tstepB : cB;
        for (int t = 0; t < nt; t += 2) {
            const bool last = (t == nt - 2);
            const char* a1 = cA + (size_t)(t + 1) * kstep;
            const char* a2 = last ? nA : cA + (size_t)(t + 2) * kstep; const char* b2 = last ? nB : cB + (size_t)(t + 2) * kstep;
            const char* a3 = a2 + kstep; const char* b3 = b2 + kstep;
            if (last && has_next) S.a_ready(nxt);
            if constexpr (SP2) {
            PG8_LDB(B0, 0, 0); PG8_LDB(B1, 0, 1); PG8_SCHED; PG8_LDA(At, 0, 0); PG8_STAGE(PG8_SA(1, 1), a1 + hstepA, voffA);
            PG8_WAIT_V(8); PG8_WAIT_L(0); PG8_BAR; PG8_MMA(0, 0, At, B0); PG8_MMA(0, 1, At, B1); PG8_BAR; PG8_SCHED;
            PG8_LDA(At, 0, 1); PG8_STAGE(PG8_SB(0, 0), b2, voffB); PG8_STAGE(PG8_SB(0, 1), b2 + hstepB, voffB); PG8_STAGE(PG8_SA(0, 0), a2, voffA);
            PG8_WAIT_V(8); PG8_WAIT_L(0); PG8_BAR; PG8_MMA(1, 0, At, B0); PG8_MMA(1, 1, At, B1); PG8_BAR; PG8_SCHED;
            PG8_LDB(B0, 1, 0); PG8_LDB(B1, 1, 1); PG8_SCHED; PG8_LDA(At, 1, 0); PG8_STAGE(PG8_SA(0, 1), a2 + hstepA, voffA);
            PG8_WAIT_V(8); PG8_WAIT_L(0); PG8_BAR; PG8_MMA(0, 0, At, B0); PG8_MMA(0, 1, At, B1); PG8_BAR; PG8_SCHED;
            PG8_LDA(At, 1, 1); PG8_STAGE(PG8_SB(1, 0), b3, voffB); PG8_STAGE(PG8_SB(1, 1), b3 + hstepB, voffB); PG8_STAGE(PG8_SA(1, 0), a3, voffA);
            PG8_WAIT_V(8); PG8_WAIT_L(0); PG8_BAR; PG8_MMA(1, 0, At, B0); PG8_MMA(1, 1, At, B1); PG8_BAR; PG8_SCHED;
            } else {
            PG8_LDB(B0, 0, 0); PG8_SCHED; PG8_LDA(At, 0, 0); PG8_STAGE(PG8_SA(1, 1), a1 + hstepA, voffA);
            PG8_WAIT_L(8); PG8_BAR; PG8_WAIT_L(0); PG8_MMA(0, 0, At, B0); PG8_BAR; PG8_SCHED;
            PG8_LDB(B1, 0, 1); PG8_STAGE(PG8_SB(0, 0), b2, voffB);
            PG8_BAR; PG8_WAIT_L(0); PG8_MMA(0, 1, At, B1); PG8_BAR;
            PG8_LDA(At, 0, 1); PG8_STAGE(PG8_SA(0, 0), a2, voffA);
            PG8_BAR; PG8_WAIT_L(0); PG8_MMA(1, 0, At, B0); PG8_BAR; PG8_SCHED;
            PG8_STAGE(PG8_SB(0, 1), b2 + hstepB, voffB);
            PG8_WAIT_V(6); PG8_BAR; PG8_MMA(1, 1, At, B1); PG8_BAR;
            PG8_LDB(B0, 1, 0); PG8_SCHED; PG8_LDA(At, 1, 0); PG8_STAGE(PG8_SA(0, 1), a2 + hstepA, voffA);
            PG8_WAIT_L(8); PG8_BAR; PG8_WAIT_L(0); PG8_MMA(0, 0, At, B0); PG8_BAR; PG8_SCHED;
            PG8_LDB(B1, 1, 1); PG8_STAGE(PG8_SB(1, 0), b3, voffB);
            PG8_BAR; PG8_WAIT_L(0); PG8_MMA(0, 1, At, B1); PG8_BAR;
            PG8_LDA(At, 1, 1); PG8_STAGE(PG8_SA(1, 0), a3, voffA);
            PG8_BAR; PG8_WAIT_L(0); PG8_MMA(1, 0, At, B0); PG8_BAR; PG8_SCHED;
            PG8_STAGE(PG8_SB(1, 1), b3 + hstepB, voffB);
            PG8_WAIT_V(6); PG8_BAR; PG8_MMA(1, 1, At, B1); PG8_BAR;
            }
        }
        if constexpr (ALIGN_EPI) { if (wr == 0) PG8_BAR; }
        if constexpr (!Epi::AFTER_DRAIN) { E(acc, cur, wr, wc, fr, fq); S.done(cur); }
        if (!has_next) break;
#pragma unroll
        for (int a = 0; a < 2; ++a)
#pragma unroll
            for (int b = 0; b < 2; ++b)
#pragma unroll
                for (int m = 0; m < 4; ++m)
#pragma unroll
                    for (int n = 0; n < 2; ++n) acc[a][b][m][n] = (f32x4){0.f, 0.f, 0.f, 0.f};
        cur = nxt; cA = nA; cB = nB; ++ui;
        if constexpr (ALIGN_EPI) { if (wr == 1) PG8_BAR; }
    }
    PG8_WAIT_V(0);
    if constexpr (!ALIGN_EPI) { if (wr == 0) PG8_BAR; }
    PG8_BAR;
    if constexpr (Epi::AFTER_DRAIN) { E.fused(acc, cur, wr, wc, fr, fq, lds, wid, lane); S.done(cur); }
#undef PG8_SA
#undef PG8_SB
#undef PG8_STAGE
#undef PG8_LDA
#undef PG8_LDB
#undef PG8_MMA
#undef PG8_WAIT_V
#undef PG8_WAIT_L
#undef PG8_BAR
#undef PG8_SCHED
}
}

constexpr int T_ = 16384, DM = 1024, NIN = 2432, NINP = 2560;
constexpr int C_Q = 256, C_K = 512, C_V = 640, C_BG = 768, C_CG = 1024, C_XIN = 1280, C_D = 1536;
constexpr int NWAVES = 8, NTHR = 512;
constexpr int LDS_BYTES = 147456;
constexpr size_t MiB = 1u << 20;
constexpr size_t WS_CTL = 0;
constexpr size_t CTL_BYTES = 65536;
constexpr size_t WS_MOD = 1 * MiB;
constexpr size_t WS_BIN = WS_MOD + 65536;
constexpr size_t WS_BGU = WS_BIN + 16384;
constexpr size_t WS_BR  = WS_BGU + 32768;
constexpr size_t WS_WRH = WS_BR + 1024;
constexpr size_t WS_WRL = WS_WRH + 98304;
constexpr size_t WS_W2T = WS_WRL + 98304;
constexpr size_t WS_A2T = WS_W2T + 16384;
constexpr size_t WS_G2T = WS_A2T + 16384;
constexpr size_t WS_V1T = WS_G2T + 32768;
constexpr size_t WS_V2T = WS_V1T + 16384;
constexpr size_t WS_PWT = WS_V2T + 16384;
constexpr size_t WS_RINV2 = WS_PWT + 32768;
static_assert(WS_RINV2 + 65536 <= 2 * MiB, "small region");
constexpr size_t WS_WIN = 2 * MiB;
constexpr size_t WS_WOUT = 7 * MiB;
constexpr size_t WS_WGU = 9 * MiB;
constexpr size_t WS_WD = 25 * MiB;
constexpr size_t WS_LIST = 33 * MiB;
constexpr size_t WS_WLIST = 35 * MiB;
constexpr size_t WS_VFIRST = 37 * MiB;
constexpr size_t WS_ACT = 45 * MiB;
constexpr size_t WS_P = 77 * MiB;
constexpr size_t WS_RW = 157 * MiB;
constexpr size_t RW_R = WS_RW, RW_K = WS_RW + 8 * MiB, RW_V = WS_RW + 16 * MiB, RW_KAP = WS_RW + 24 * MiB, RW_B = WS_RW + 32 * MiB, RW_G = WS_RW + 40 * MiB;
constexpr size_t RW_LD = WS_RW + 48 * MiB;
constexpr size_t RW_W1 = WS_RW + 56 * MiB, RW_U0T = WS_RW + 64 * MiB, RW_M = WS_RW + 72 * MiB, RW_N = WS_RW + 80 * MiB, RW_S0 = WS_RW + 88 * MiB;
constexpr size_t RW_BONUS = WS_RW + 96 * MiB;
constexpr size_t WS_END = WS_RW + 97 * MiB;
static_assert(WS_END <= 256 * MiB, "workspace");

struct Args { const float* in[34]; float* out; unsigned char* ws; int ph_lo, ph_hi; };

__device__ __forceinline__ unsigned f2bf(float f) { unsigned u = __builtin_bit_cast(unsigned, f); return (u + 0x7fffu + ((u >> 16) & 1u)) >> 16; }
__device__ __forceinline__ float bf2f(unsigned h) { return __builtin_bit_cast(float, h << 16); }
__device__ __forceinline__ unsigned pk2(float lo, float hi) { return f2bf(lo) | (f2bf(hi) << 16); }
__device__ __forceinline__ float bflo(unsigned w) { return __builtin_bit_cast(float, w << 16); }
__device__ __forceinline__ float bfhi(unsigned w) { return __builtin_bit_cast(float, w & 0xffff0000u); }
__device__ __forceinline__ float sigmoidf_(float x) { return 1.f / (1.f + __expf(-x)); }
__device__ __forceinline__ float wave_sum(float v) {
#pragma unroll
    for (int o = 1; o < 64; o <<= 1) v += __shfl_xor(v, o);
    return v;
}
#define LDS_WAIT() asm volatile("s_waitcnt lgkmcnt(0)" ::: "memory")
__device__ __forceinline__ int swz128(int r, int c) { return r * 128 + ((c ^ ((r >> 1) & 7)) << 4); }
__device__ __forceinline__ int swz256(int r, int c) { return r * 256 + ((c ^ (r & 15)) << 4); }
__device__ __forceinline__ int swz512(int r, int c) { return r * 512 + ((c ^ (r & 15)) << 4); }
__device__ __forceinline__ f32x4 mfma16(bf16x8 a, bf16x8 b, f32x4 c) { return __builtin_amdgcn_mfma_f32_16x16x32_bf16(a, b, c, 0, 0, 0); }

struct Frame {
    ldsp lds; int tid, lane, wave, G, bid;
    const float* const* in; float* out; unsigned char* ws;
};

__device__ __forceinline__ void phase_mod(Frame& F) {
    const float* c = F.in[1]; const float* w_ada = F.in[2]; const float* b_ada = F.in[3];
    float* mod = (float*)(F.ws + WS_MOD);
    LAS float* red = (LAS float*)F.lds;
    for (int it = F.bid; it < 192; it += F.G) {
        const int l = it / 96, n0 = (it % 96) * 64;
        const float* W = w_ada + (size_t)l * DM * 6144 + n0 + F.lane;
        const int k0 = F.wave * 128;
        float acc = 0.f;
#pragma unroll 8
        for (int k = 0; k < 128; ++k) { const float cv = c[k0 + k]; const float s = cv / (1.f + __expf(-cv)); acc += s * W[(size_t)(k0 + k) * 6144]; }
        red[F.wave * 64 + F.lane] = acc;
        __syncthreads();
        if (F.wave == 0) { float s = b_ada[l * 6144 + n0 + F.lane];
#pragma unroll
            for (int w = 0; w < 8; ++w) s += red[w * 64 + F.lane];
            mod[l * 6144 + n0 + F.lane] = s; }
        __syncthreads();
    }
}

__device__ __forceinline__ void transpose_strip(const float* W, int N, int K, int n0, const float* rs_a, const float* rs_b, const float* cs, const float* sh, float* bias_out,
                                                bf16_t* dst, int dst_row0, LAS float* scr, int lane) {
    const int col = lane & 31, kp = lane >> 5;
    const float csv = cs ? cs[n0 + col] : 1.f;
    float bacc = 0.f;
    for (int k0 = 0; k0 < K; k0 += 64) {
#pragma unroll 8
        for (int i = 0; i < 32; ++i) { const int kk = 2 * i + kp; const float wv = W[(size_t)(k0 + kk) * N + n0 + col];
            if (sh) bacc += sh[k0 + kk] * wv;
            float v = wv * csv; if (rs_a) v *= rs_a[k0 + kk] * (1.f + rs_b[k0 + kk]);
            scr[kk * 33 + col] = v; }
        LDS_WAIT();
        const int c = lane & 7;
#pragma unroll
        for (int j = 0; j < 4; ++j) { const int n = (lane >> 3) + 8 * j; const LAS float* s = scr + (8 * c) * 33 + n;
            u32x4 o; o.x = pk2(s[0 * 33], s[1 * 33]); o.y = pk2(s[2 * 33], s[3 * 33]); o.z = pk2(s[4 * 33], s[5 * 33]); o.w = pk2(s[6 * 33], s[7 * 33]);
            *(u32x4*)(dst + (size_t)(dst_row0 + n) * K + k0 + 8 * c) = o; }
        LDS_WAIT();
    }
    if (sh) { bacc += __shfl_xor(bacc, 32); if (lane < 32) bias_out[col] = bacc; }
}
__device__ __forceinline__ void phase_prep(Frame& F, int l) {
    LAS float* scr = (LAS float*)(F.lds + F.wave * 16384);
    const float* mod = (const float*)(F.ws + WS_MOD) + l * 6144;
    const float *sh1 = mod, *sc1 = mod + 1024, *gt1 = mod + 2048, *sh2 = mod + 3072, *sc2 = mod + 4096, *gt2 = mod + 5120;
    const float* n1g = F.in[4] + l * DM; const float* n2g = F.in[5] + l * DM;
    const float* w_in = F.in[6] + (size_t)l * DM * NIN; const float* w_out = F.in[7] + (size_t)l * DM * DM;
    const float* wg = F.in[30] + (size_t)l * 32 * DM * 128; const float* wu = F.in[31] + (size_t)l * 32 * DM * 128; const float* wd = F.in[32] + (size_t)l * 32 * 128 * DM;
    bf16_t* WIN = (bf16_t*)(F.ws + WS_WIN); bf16_t* WOUT = (bf16_t*)(F.ws + WS_WOUT); bf16_t* WGU = (bf16_t*)(F.ws + WS_WGU); bf16_t* WD = (bf16_t*)(F.ws + WS_WD);
    float* bias_in = (float*)(F.ws + WS_BIN); float* bias_gu = (float*)(F.ws + WS_BGU); float* bias_r = (float*)(F.ws + WS_BR);
    const int gw = F.bid * NWAVES + F.wave, NGW = F.G * NWAVES;
    constexpr int nA = 80, nB = 32, nC = 128, nD = 128, nE = 1024, nF = 48, nG = 6;
    constexpr int NIT = nA + nB + nC + nD + nE + nF + nG;
    for (int it = gw; it < NIT; it += NGW) {
        int r = it;
        if (r < nA) {
            if (r < 76) transpose_strip(w_in, NIN, DM, r * 32, n1g, sc1, nullptr, sh1, bias_in + r * 32, WIN, r * 32, scr, F.lane);
            else { for (int i = F.lane; i < 32 * 128; i += 64) { const int n = i >> 7, c = i & 127; *(u32x4*)(WIN + (size_t)(r * 32 + n) * DM + c * 8) = (u32x4){0u, 0u, 0u, 0u}; }
                   if (F.lane < 32) bias_in[r * 32 + F.lane] = 0.f; }
            continue; } r -= nA;
        if (r < nB) { transpose_strip(w_out, DM, DM, r * 32, nullptr, nullptr, gt1, nullptr, nullptr, WOUT, r * 32, scr, F.lane); continue; } r -= nB;
        if (r < nC) { const int e = r >> 2, s = r & 3; transpose_strip(wg + (size_t)e * DM * 128, 128, DM, s * 32, n2g, sc2, nullptr, sh2, bias_gu + e * 256 + s * 32, WGU + (size_t)e * 256 * DM, s * 32, scr, F.lane); continue; } r -= nC;
        if (r < nD) { const int e = r >> 2, s = r & 3; transpose_strip(wu + (size_t)e * DM * 128, 128, DM, s * 32, n2g, sc2, nullptr, sh2, bias_gu + e * 256 + 128 + s * 32, WGU + (size_t)e * 256 * DM, 128 + s * 32, scr, F.lane); continue; } r -= nD;
        if (r < nE) { const int e = r >> 5, s = r & 31; transpose_strip(wd + (size_t)e * 128 * DM, DM, 128, s * 32, nullptr, nullptr, gt2, nullptr, nullptr, WD + (size_t)e * DM * 128, s * 32, scr, F.lane); continue; } r -= nE;
        if (r < nF) {
            bf16_t* wh = (bf16_t*)(F.ws + WS_WRH) + r * DM; bf16_t* wl = (bf16_t*)(F.ws + WS_WRL) + r * DM;
            float bacc = 0.f;
            for (int k = F.lane; k < DM; k += 64) {
                float wv = 0.f;
                if (r < 4) wv = F.in[26][(size_t)l * DM * 4 + k * 4 + r]; else if (r < 36) wv = F.in[28][(size_t)l * DM * 32 + k * 32 + (r - 4)];
                bacc += sh2[k] * wv;
                const float v = wv * n2g[k] * (1.f + sc2[k]);
                const unsigned h = f2bf(v); const unsigned lo = f2bf(v - bf2f(h));
                wh[k] = (bf16_t)h; wl[k] = (bf16_t)lo; }
            bacc = wave_sum(bacc);
            if (F.lane == 0) { float b = 0.f; if (r < 4) b = F.in[27][l * 4 + r]; else if (r < 36) b = F.in[29][l * 32 + r - 4]; bias_r[r] = bacc + b; }
            continue; } r -= nF;
        if (r == 0) { const float* s = F.in[14] + l * 32 * 256; bf16_t* d = (bf16_t*)(F.ws + WS_W2T); for (int i = F.lane; i < 8192; i += 64) { const int n = i >> 5, k = i & 31; d[i] = (bf16_t)f2bf(s[k * 256 + n]); } }
        else if (r == 1) { const float* s = F.in[16] + l * 32 * 256; bf16_t* d = (bf16_t*)(F.ws + WS_A2T); for (int i = F.lane; i < 8192; i += 64) { const int n = i >> 5, k = i & 31; d[i] = (bf16_t)f2bf(s[k * 256 + n]); } }
        else if (r == 2) { const float* s = F.in[17] + l * 64 * 256; bf16_t* d = (bf16_t*)(F.ws + WS_G2T); for (int i = F.lane; i < 16384; i += 64) { const int n = i >> 6, k = i & 63; d[i] = (bf16_t)f2bf(s[k * 256 + n]); } }
        else if (r == 3) { if (l > 0) { const float* s = F.in[24] + (l - 1) * 256 * 32; bf16_t* d = (bf16_t*)(F.ws + WS_V1T); for (int i = F.lane; i < 8192; i += 64) { const int n = i >> 8, k = i & 255; d[i] = (bf16_t)f2bf(s[k * 32 + n]); } } }
        else if (r == 4) { if (l > 0) { const float* s = F.in[25] + (l - 1) * 32 * 256; bf16_t* d = (bf16_t*)(F.ws + WS_V2T); for (int i = F.lane; i < 8192; i += 64) { const int n = i >> 5, k = i & 31; d[i] = (bf16_t)f2bf(s[k * 256 + n]); } } }
        else { const float* s = F.in[8] + l * 4 * 64 * 64; bf16_t* d = (bf16_t*)(F.ws + WS_PWT); for (int i = F.lane; i < 16384; i += 64) { const int j = i >> 12, e = (i >> 6) & 63, c = i & 63; d[i] = (bf16_t)f2bf(s[(j * 64 + c) * 64 + e]); } }
    }
}

__device__ __forceinline__ void phase_rownorm(Frame& F, int mode) {
    const float* xin = (mode == 0) ? F.in[0] : F.out;
    const bf16_t* ys0 = (const bf16_t*)(F.ws + WS_P); const bf16_t* ys1 = ys0 + (size_t)T_ * DM;
    bf16_t* xn = (bf16_t*)(F.ws + WS_ACT);
    const float* fg = F.in[33];
    const int gw = F.bid * NWAVES + F.wave, NGW = F.G * NWAVES;
    for (int m = gw; m < T_; m += NGW) {
        const f32x4* xr = (const f32x4*)(xin + (size_t)m * DM) + F.lane;
        f32x4 v[4]; float s = 0.f;
#pragma unroll
        for (int j = 0; j < 4; ++j) v[j] = xr[64 * j];
        if (mode != 0) {
            const u32x2* a = (const u32x2*)(ys0 + (size_t)m * DM) + F.lane; const u32x2* b = (const u32x2*)(ys1 + (size_t)m * DM) + F.lane;
#pragma unroll
            for (int j = 0; j < 4; ++j) { const u32x2 ua = a[64 * j], ub = b[64 * j];
                v[j][0] += bflo(ua.x) + bflo(ub.x); v[j][1] += bfhi(ua.x) + bfhi(ub.x); v[j][2] += bflo(ua.y) + bflo(ub.y); v[j][3] += bfhi(ua.y) + bfhi(ub.y); }
        }
#pragma unroll
        for (int j = 0; j < 4; ++j) s += (v[j][0] * v[j][0] + v[j][1] * v[j][1]) + (v[j][2] * v[j][2] + v[j][3] * v[j][3]);
        const float rinv = 1.f / sqrtf(wave_sum(s) * (1.f / DM) + 1e-6f);
        if (mode == 2) {
            f32x4* o = (f32x4*)(F.out + (size_t)m * DM) + F.lane;
#pragma unroll
            for (int j = 0; j < 4; ++j) { const f32x4 g = *((const f32x4*)fg + F.lane + 64 * j); o[64 * j] = v[j] * rinv * g; }
        } else {
            if (mode == 1) { f32x4* o = (f32x4*)(F.out + (size_t)m * DM) + F.lane;
#pragma unroll
                for (int j = 0; j < 4; ++j) o[64 * j] = v[j]; }
            u32x2* o8 = (u32x2*)(xn + (size_t)m * DM) + F.lane;
#pragma unroll
            for (int j = 0; j < 4; ++j) { u32x2 w; w.x = pk2(v[j][0] * rinv, v[j][1] * rinv); w.y = pk2(v[j][2] * rinv, v[j][3] * rinv); o8[64 * j] = w; }
        }
    }
}

__device__ __forceinline__ void attn_item(Frame& F, int l, int item) {
    const int t0 = item * 128;
    const bf16_t* P = (const bf16_t*)(F.ws + WS_P);
    bf16_t* ycat = (bf16_t*)(F.ws + WS_ACT);
    ldsp Ks = F.lds, Vt = F.lds + 65536;
    for (int i = F.tid; i < 4096; i += NTHR) {
        const int ko = i >> 4, kvh = (i >> 3) & 1, c = i & 7; const int s = t0 - 128 + ko;
        u32x4 kv = (u32x4){0u, 0u, 0u, 0u}, vv = (u32x4){0u, 0u, 0u, 0u};
        if (s >= 0) { kv = *(const u32x4*)(P + (size_t)s * NINP + C_K + kvh * 64 + c * 8); vv = *(const u32x4*)(P + (size_t)s * NINP + C_V + kvh * 64 + c * 8); }
        *(LAS u32x4*)(Ks + kvh * 32768 + swz128(ko, c)) = kv;
        const int k32 = ko & 31, sg = ko >> 5, g = (k32 >> 2) & 3, j = ((k32 >> 4) << 2) | (k32 & 3), chunk = sg * 4 + g;
        const unsigned vw[4] = {vv.x, vv.y, vv.z, vv.w};
#pragma unroll
        for (int e = 0; e < 8; ++e) { const int d = c * 8 + e; const unsigned short val = (unsigned short)((e & 1) ? (vw[e >> 1] >> 16) : (vw[e >> 1] & 0xffffu));
            *(LAS unsigned short*)(Vt + kvh * 32768 + swz512(d, chunk) + j * 2) = val; }
    }
    __syncthreads();
    const int h = F.wave >> 1, half = F.wave & 1, kvh = h >> 1, fr = F.lane & 15, g = F.lane >> 4;
    const float slope = exp2f(-2.f * (float)(h + 1));
    const float sink = F.in[10][l * 4 + h];
    ldsp Kh = Ks + kvh * 32768, Vh = Vt + kvh * 32768;
#pragma unroll 1
    for (int qt = 0; qt < 4; ++qt) {
        const int q_lo = 64 * half + 16 * qt, qo = q_lo + fr, tile0 = (q_lo >> 5) << 1;
        bf16x8 qf[2];
#pragma unroll
        for (int ks = 0; ks < 2; ++ks) qf[ks] = *(const bf16x8*)(P + (size_t)(t0 + qo) * NINP + C_Q + h * 64 + ks * 32 + g * 8);
        f32x4 s[10];
#pragma unroll
        for (int kt = 0; kt < 10; ++kt) { s[kt] = (f32x4){0.f, 0.f, 0.f, 0.f};
#pragma unroll
            for (int ks = 0; ks < 2; ++ks) { const bf16x8 a = *(const LAS bf16x8*)(Kh + swz128((tile0 + kt) * 16 + fr, ks * 4 + g)); s[kt] = mfma16(a, qf[ks], s[kt]); } }
        float m = sink;
#pragma unroll
        for (int kt = 0; kt < 10; ++kt)
#pragma unroll
            for (int j = 0; j < 4; ++j) { const int ko = 16 * (tile0 + kt) + 4 * g + j; const int dist = qo + 128 - ko;
                const bool valid = (dist >= 0) && (dist < 128) && (t0 - 128 + ko >= 0);
                const float v = valid ? s[kt][j] * 0.125f - slope * (float)dist : -INFINITY; s[kt][j] = v; m = fmaxf(m, v); }
        m = fmaxf(m, __shfl_xor(m, 16)); m = fmaxf(m, __shfl_xor(m, 32));
        float sum = 0.f;
#pragma unroll
        for (int kt = 0; kt < 10; ++kt)
#pragma unroll
            for (int j = 0; j < 4; ++j) { const float p = __expf(s[kt][j] - m); s[kt][j] = p; sum += p; }
        sum += __shfl_xor(sum, 16); sum += __shfl_xor(sum, 32);
        const float inv = 1.f / (sum + __expf(sink - m));
        f32x4 o[4];
#pragma unroll
        for (int dt = 0; dt < 4; ++dt) o[dt] = (f32x4){0.f, 0.f, 0.f, 0.f};
#pragma unroll
        for (int ss = 0; ss < 5; ++ss) {
            u32x4 pw; pw.x = pk2(s[2 * ss][0], s[2 * ss][1]); pw.y = pk2(s[2 * ss][2], s[2 * ss][3]); pw.z = pk2(s[2 * ss + 1][0], s[2 * ss + 1][1]); pw.w = pk2(s[2 * ss + 1][2], s[2 * ss + 1][3]);
            const bf16x8 pb = __builtin_bit_cast(bf16x8, pw);
#pragma unroll
            for (int dt = 0; dt < 4; ++dt) { const bf16x8 a = *(const LAS bf16x8*)(Vh + swz512(dt * 16 + fr, ((tile0 >> 1) + ss) * 4 + g)); o[dt] = mfma16(a, pb, o[dt]); }
        }
#pragma unroll
        for (int dt = 0; dt < 4; ++dt) { u32x2 w; w.x = pk2(o[dt][0] * inv, o[dt][1] * inv); w.y = pk2(o[dt][2] * inv, o[dt][3] * inv);
            *(u32x2*)(ycat + (size_t)(t0 + qo) * DM + 256 + h * 64 + dt * 16 + 4 * g) = w; }
    }
    __syncthreads();
}

__device__ __forceinline__ void poolconv_item(Frame& F, int l, int item) {
    const int t0 = item * 128;
    const bf16_t* P = (const bf16_t*)(F.ws + WS_P);
    bf16_t* ycat = (bf16_t*)(F.ws + WS_ACT);
    ldsp U = F.lds;
    ldsp Dt = F.lds + 73728;
    for (int i = F.tid; i < 144 * 32; i += NTHR) { const int r = i >> 5, c = i & 31; const int s = t0 - 16 + r;
        u32x4 v = (u32x4){0u, 0u, 0u, 0u}; if (s >= 0) v = *(const u32x4*)(P + (size_t)s * NINP + c * 8);
        *(LAS u32x4*)(U + r * 512 + c * 16) = v; }
    __syncthreads();
    for (int i = F.tid; i < 128 * 32; i += NTHR) { const int tok = i >> 5, c8 = i & 31, j = c8 >> 3, w = 2 << j; const int t = t0 + tok;
        float acc[8];
#pragma unroll
        for (int e = 0; e < 8; ++e) acc[e] = 0.f;
        u32x4 cur = (u32x4){0u, 0u, 0u, 0u};
        for (int q = 0; q < w; ++q) { const u32x4 v = *(const LAS u32x4*)(U + (tok + 16 - q) * 512 + c8 * 16); if (q == 0) cur = v;
            acc[0] += bflo(v.x); acc[1] += bfhi(v.x); acc[2] += bflo(v.y); acc[3] += bfhi(v.y); acc[4] += bflo(v.z); acc[5] += bfhi(v.z); acc[6] += bflo(v.w); acc[7] += bfhi(v.w); }
        const float ic = 1.f / (float)((t + 1) < w ? (t + 1) : w);
        u32x4 o; o.x = pk2(acc[0] * ic - bflo(cur.x), acc[1] * ic - bfhi(cur.x)); o.y = pk2(acc[2] * ic - bflo(cur.y), acc[3] * ic - bfhi(cur.y));
        o.z = pk2(acc[4] * ic - bflo(cur.z), acc[5] * ic - bfhi(cur.z)); o.w = pk2(acc[6] * ic - bflo(cur.w), acc[7] * ic - bfhi(cur.w));
        *(LAS u32x4*)(Dt + j * 16384 + swz128(tok, c8 & 7)) = o; }
    __syncthreads();
    {
        const int j = F.wave >> 1, half = F.wave & 1, fr = F.lane & 15, g = F.lane >> 4;
        const bf16_t* pwt = (const bf16_t*)(F.ws + WS_PWT) + j * 4096;
        const float* psc = F.in[9] + l * 256 + j * 64;
        bf16x8 bfr[4][2];
#pragma unroll
        for (int n = 0; n < 4; ++n)
#pragma unroll
            for (int ks = 0; ks < 2; ++ks) bfr[n][ks] = *(const bf16x8*)(pwt + (16 * n + fr) * 64 + ks * 32 + g * 8);
#pragma unroll
        for (int m = 0; m < 4; ++m) {
            bf16x8 af[2];
#pragma unroll
            for (int ks = 0; ks < 2; ++ks) af[ks] = *(const LAS bf16x8*)(Dt + j * 16384 + swz128(64 * half + 16 * m + fr, ks * 4 + g));
#pragma unroll
            for (int n = 0; n < 4; ++n) { f32x4 acc = (f32x4){0.f, 0.f, 0.f, 0.f};
#pragma unroll
                for (int ks = 0; ks < 2; ++ks) acc = mfma16(bfr[n][ks], af[ks], acc);
                const f32x4 sc = *(const f32x4*)(psc + 16 * n + 4 * g);
                u32x2 w; w.x = pk2(acc[0] * sc[0], acc[1] * sc[1]); w.y = pk2(acc[2] * sc[2], acc[3] * sc[3]);
                *(u32x2*)(ycat + (size_t)(t0 + 64 * half + 16 * m + fr) * DM + j * 64 + 16 * n + 4 * g) = w; }
        }
    }
    const float* cw = F.in[11] + l * 3 * 256;
    for (int i = F.tid; i < 128 * 32; i += NTHR) { const int tok = i >> 5, c8 = i & 31; const int t = t0 + tok;
        float acc[8];
#pragma unroll
        for (int e = 0; e < 8; ++e) acc[e] = 0.f;
#pragma unroll
        for (int q = 0; q < 3; ++q) { const int s = t - 2 + q; if (s >= 0) {
                const u32x4 a = *(const u32x4*)(P + (size_t)s * NINP + C_CG + c8 * 8), b = *(const u32x4*)(P + (size_t)s * NINP + C_XIN + c8 * 8);
                const float* wq = cw + q * 256 + c8 * 8;
                acc[0] += wq[0] * bflo(a.x) * bflo(b.x); acc[1] += wq[1] * bfhi(a.x) * bfhi(b.x); acc[2] += wq[2] * bflo(a.y) * bflo(b.y); acc[3] += wq[3] * bfhi(a.y) * bfhi(b.y);
                acc[4] += wq[4] * bflo(a.z) * bflo(b.z); acc[5] += wq[5] * bfhi(a.z) * bfhi(b.z); acc[6] += wq[6] * bflo(a.w) * bflo(b.w); acc[7] += wq[7] * bfhi(a.w) * bfhi(b.w); } }
        const u32x4 bg = *(const u32x4*)(P + (size_t)t * NINP + C_BG + c8 * 8);
        u32x4 o; o.x = pk2(acc[0] * bflo(bg.x), acc[1] * bfhi(bg.x)); o.y = pk2(acc[2] * bflo(bg.y), acc[3] * bfhi(bg.y));
        o.z = pk2(acc[4] * bflo(bg.z), acc[5] * bfhi(bg.z)); o.w = pk2(acc[6] * bflo(bg.w), acc[7] * bfhi(bg.w));
        *(u32x4*)(ycat + (size_t)t * DM + 512 + c8 * 8) = o; }
    __syncthreads();
}

__device__ __forceinline__ u32x4 lerp8(u32x4 cur, u32x4 prv, const float* mu, int act) {
    const unsigned cw[4] = {cur.x, cur.y, cur.z, cur.w}, pw[4] = {prv.x, prv.y, prv.z, prv.w}; float z[8];
#pragma unroll
    for (int e = 0; e < 8; ++e) { const float c = (e & 1) ? bfhi(cw[e >> 1]) : bflo(cw[e >> 1]), p = (e & 1) ? bfhi(pw[e >> 1]) : bflo(pw[e >> 1]);
        float v = c + (p - c) * mu[e]; if (act == 1) v = tanhf(v); else if (act == 2) v = sigmoidf_(v); z[e] = v; }
    u32x4 o; o.x = pk2(z[0], z[1]); o.y = pk2(z[2], z[3]); o.z = pk2(z[4], z[5]); o.w = pk2(z[6], z[7]); return o;
}
__device__ __forceinline__ void rwkvprep_item(Frame& F, int l, int item) {
    const int t0 = item * 64;
    const bf16_t* P = (const bf16_t*)(F.ws + WS_P);
    const float* mu = F.in[12] + l * 896;
    ldsp Zw = F.lds, Za = F.lds + 4096, Zg = F.lds + 8192, Zv = F.lds + 16384, V1 = F.lds + 49152 + F.wave * 2048;
    const int nch = (l > 0) ? 48 : 16;
    for (int i = F.tid; i < 64 * nch; i += NTHR) { const int tok = i / nch, c = i % nch; const int t = t0 + tok;
        const int col = (c < 16) ? (768 + c * 8) : (512 + (c - 16) * 8);
        const u32x4 cur = *(const u32x4*)(P + (size_t)t * NINP + C_D + col);
        const u32x4 prv = (t > 0) ? *(const u32x4*)(P + (size_t)(t - 1) * NINP + C_D + col) : (u32x4){0u, 0u, 0u, 0u};
        const u32x4 z = lerp8(cur, prv, mu + col, c < 4 ? 1 : (c >= 8 && c < 16 ? 2 : 0));
        if (c < 4) *(LAS u32x4*)(Zw + tok * 64 + c * 16) = z;
        else if (c < 8) *(LAS u32x4*)(Za + tok * 64 + (c - 4) * 16) = z;
        else if (c < 16) *(LAS u32x4*)(Zg + swz128(tok, c - 8)) = z;
        else *(LAS u32x4*)(Zv + swz512(tok, c - 16)) = z; }
    __syncthreads();
    const int h = F.wave >> 1, half = F.wave & 1, fr = F.lane & 15, g = F.lane >> 4;
    const bf16_t* w2t = (const bf16_t*)(F.ws + WS_W2T); const bf16_t* a2t = (const bf16_t*)(F.ws + WS_A2T); const bf16_t* g2t = (const bf16_t*)(F.ws + WS_G2T);
    const bf16_t* v1t = (const bf16_t*)(F.ws + WS_V1T); const bf16_t* v2t = (const bf16_t*)(F.ws + WS_V2T);
    const float *w0 = F.in[13] + l * 256, *a0 = F.in[15] + l * 256, *kkp = F.in[18] + l * 256, *kap = F.in[19] + l * 256, *rkp = F.in[20] + l * 256;
    const float* v0 = (l > 0) ? F.in[23] + (l - 1) * 256 : nullptr;
    bf16_t *Rr = (bf16_t*)(F.ws + RW_R), *Rk = (bf16_t*)(F.ws + RW_K), *Rv = (bf16_t*)(F.ws + RW_V), *Rkap = (bf16_t*)(F.ws + RW_KAP), *Rb = (bf16_t*)(F.ws + RW_B), *Rg = (bf16_t*)(F.ws + RW_G);
    bf16_t* Rld = (bf16_t*)(F.ws + RW_LD); float* Rbon = (float*)(F.ws + RW_BONUS); bf16_t* VF = (bf16_t*)(F.ws + WS_VFIRST);
#pragma unroll 1
    for (int m = 0; m < 2; ++m) {
        asm volatile("" ::: "memory");
        f32x4 wl[4], al[4], gl[4], vl[4];
        { const int row = 32 * half + 16 * m + fr;
        const bf16x8 aw = *(const LAS bf16x8*)(Zw + row * 64 + g * 16), aa = *(const LAS bf16x8*)(Za + row * 64 + g * 16);
        const bf16x8 ag0 = *(const LAS bf16x8*)(Zg + swz128(row, g)), ag1 = *(const LAS bf16x8*)(Zg + swz128(row, 4 + g));
#pragma unroll
        for (int n = 0; n < 4; ++n) { const int nr = 64 * h + 16 * n + fr; const f32x4 z0 = (f32x4){0.f, 0.f, 0.f, 0.f};
            wl[n] = mfma16(*(const bf16x8*)(w2t + nr * 32 + g * 8), aw, z0);
            al[n] = mfma16(*(const bf16x8*)(a2t + nr * 32 + g * 8), aa, z0);
            gl[n] = mfma16(*(const bf16x8*)(g2t + nr * 64 + g * 8), ag0, z0); gl[n] = mfma16(*(const bf16x8*)(g2t + nr * 64 + 32 + g * 8), ag1, gl[n]);
            vl[n] = z0; }
        if (l > 0) {
            f32x4 t1[2]; t1[0] = (f32x4){0.f, 0.f, 0.f, 0.f}; t1[1] = t1[0];
#pragma unroll
            for (int ks = 0; ks < 8; ++ks) { const bf16x8 av = *(const LAS bf16x8*)(Zv + swz512(row, ks * 4 + g));
#pragma unroll
                for (int n = 0; n < 2; ++n) t1[n] = mfma16(*(const bf16x8*)(v1t + (16 * n + fr) * 256 + ks * 32 + g * 8), av, t1[n]); }
#pragma unroll
            for (int n = 0; n < 2; ++n) { u32x2 w; w.x = pk2(t1[n][0], t1[n][1]); w.y = pk2(t1[n][2], t1[n][3]); *(LAS u32x2*)(V1 + fr * 64 + (16 * n + 4 * g) * 2) = w; }
            LDS_WAIT();
            const bf16x8 a1 = *(const LAS bf16x8*)(V1 + fr * 64 + g * 16);
#pragma unroll
            for (int n = 0; n < 4; ++n) vl[n] = mfma16(*(const bf16x8*)(v2t + (64 * h + 16 * n + fr) * 32 + g * 8), a1, (f32x4){0.f, 0.f, 0.f, 0.f});
            LDS_WAIT();
        } }
        const int t = t0 + 32 * half + 16 * m + fr;
        float kkr[4][4], zr[4][4], kmod[4][4], av[4][4]; float ss = 0.f, bon = 0.f;
#pragma unroll
        for (int n = 0; n < 4; ++n) { const int ch = 64 * h + 16 * n + 4 * g;
            const bf16_t* pc = P + (size_t)t * NINP + C_D + ch; const bf16_t* pp = pc - NINP;
            const u32x2 rc = *(const u32x2*)(pc), kc = *(const u32x2*)(pc + 256), vc = *(const u32x2*)(pc + 512);
            u32x2 rp = (u32x2){0u, 0u}, kp = rp, vp = rp; if (t > 0) { rp = *(const u32x2*)(pp); kp = *(const u32x2*)(pp + 256); vp = *(const u32x2*)(pp + 512); }
            const float rcv[4] = {bflo(rc.x), bfhi(rc.x), bflo(rc.y), bfhi(rc.y)}, rpv[4] = {bflo(rp.x), bfhi(rp.x), bflo(rp.y), bfhi(rp.y)};
            const float kcv[4] = {bflo(kc.x), bfhi(kc.x), bflo(kc.y), bfhi(kc.y)}, kpv[4] = {bflo(kp.x), bfhi(kp.x), bflo(kp.y), bfhi(kp.y)};
            const float vcv[4] = {bflo(vc.x), bfhi(vc.x), bflo(vc.y), bfhi(vc.y)}, vpv[4] = {bflo(vp.x), bfhi(vp.x), bflo(vp.y), bfhi(vp.y)};
            float vout[4], ldv[4], gv[4];
            u32x2 vf = (u32x2){0u, 0u}; if (l > 0) vf = *(const u32x2*)(VF + (size_t)t * 256 + ch);
            const float vfv[4] = {bflo(vf.x), bfhi(vf.x), bflo(vf.y), bfhi(vf.y)};
#pragma unroll
            for (int j = 0; j < 4; ++j) { const int c = ch + j;
                const float r_ = rcv[j] + (rpv[j] - rcv[j]) * mu[c], k_ = kcv[j] + (kpv[j] - kcv[j]) * mu[256 + c], v_ = vcv[j] + (vpv[j] - vcv[j]) * mu[512 + c];
                const float wpre = w0[c] + wl[n][j]; const float y = -wpre; const float sp = fmaxf(y, 0.f) + log1pf(__expf(-fabsf(y)));
                const float w = -sp - 0.5f; ldv[j] = -__expf(w);
                const float a = sigmoidf_(a0[c] + al[n][j]); av[n][j] = a; gv[j] = gl[n][j];
                float vv = v_; if (l > 0) vv = v_ + (vfv[j] - v_) * sigmoidf_(v0[c] + vl[n][j]);
                vout[j] = vv; zr[n][j] = r_;
                const float kk = k_ * kkp[c]; kkr[n][j] = kk; ss += kk * kk;
                const float km = k_ * (1.f + (a - 1.f) * kap[c]); kmod[n][j] = km; bon += r_ * km * rkp[c]; }
            const size_t o = (size_t)t * 256 + ch;
            { u32x2 w; w.x = pk2(zr[n][0], zr[n][1]); w.y = pk2(zr[n][2], zr[n][3]); *(u32x2*)(Rr + o) = w; }
            { u32x2 w; w.x = pk2(kmod[n][0], kmod[n][1]); w.y = pk2(kmod[n][2], kmod[n][3]); *(u32x2*)(Rk + o) = w; }
            { u32x2 w; w.x = pk2(vout[0], vout[1]); w.y = pk2(vout[2], vout[3]); *(u32x2*)(Rv + o) = w; if (l == 0) *(u32x2*)(VF + o) = w; }
            { u32x2 w; w.x = pk2(gv[0], gv[1]); w.y = pk2(gv[2], gv[3]); *(u32x2*)(Rg + o) = w; }
            { u32x2 w; w.x = pk2(ldv[0], ldv[1]); w.y = pk2(ldv[2], ldv[3]); *(u32x2*)(Rld + o) = w; }
        }
        ss += __shfl_xor(ss, 16); ss += __shfl_xor(ss, 32); bon += __shfl_xor(bon, 16); bon += __shfl_xor(bon, 32);
        const float inn = 1.f / fmaxf(sqrtf(ss), 1e-12f);
#pragma unroll
        for (int n = 0; n < 4; ++n) { const size_t o = (size_t)t * 256 + 64 * h + 16 * n + 4 * g;
            float kp_[4], b_[4];
#pragma unroll
            for (int j = 0; j < 4; ++j) { kp_[j] = kkr[n][j] * inn; b_[j] = kp_[j] * av[n][j]; }
            { u32x2 w; w.x = pk2(kp_[0], kp_[1]); w.y = pk2(kp_[2], kp_[3]); *(u32x2*)(Rkap + o) = w; }
            { u32x2 w; w.x = pk2(b_[0], b_[1]); w.y = pk2(b_[2], b_[3]); *(u32x2*)(Rb + o) = w; } }
        if (g == 0) Rbon[(size_t)t * 4 + h] = bon;
    }
    __syncthreads();
}

__device__ __forceinline__ void mm_n(ldsp X, ldsp Y, int rb, int cb, int fr, int g, f32x4 (&acc)[2]) {
#pragma unroll
    for (int ks = 0; ks < 2; ++ks) { const bf16x8 xf = *(const LAS bf16x8*)(X + swz128(16 * rb + fr, ks * 4 + g));
#pragma unroll
        for (int n = 0; n < 2; ++n) { const bf16x8 yf = *(const LAS bf16x8*)(Y + swz128(32 * cb + 16 * n + fr, ks * 4 + g)); acc[n] = mfma16(yf, xf, acc[n]); } }
}
__device__ __forceinline__ void mm_t(ldsp X, ldsp Y, int rb, int cb, int fr, int g, f32x4 (&acc)[2]) {
#pragma unroll
    for (int ks = 0; ks < 2; ++ks) { const bf16x8 xf = *(const LAS bf16x8*)(X + swz128(16 * rb + fr, ks * 4 + g));
#pragma unroll
        for (int n = 0; n < 2; ++n) { const bf16x8 yf = *(const LAS bf16x8*)(Y + swz128(32 * cb + 16 * n + fr, ks * 4 + g)); acc[n] = mfma16(xf, yf, acc[n]); } }
}
__device__ __forceinline__ int adr_n(int rb, int cb, int n, int fr, int g) { return swz128(16 * rb + fr, 4 * cb + 2 * n + (g >> 1)) + (g & 1) * 8; }
__device__ __forceinline__ int adr_t(int rb, int cb, int n, int fr, int g) { return swz128(32 * cb + 16 * n + fr, 2 * rb + (g >> 1)) + (g & 1) * 8; }
__device__ __forceinline__ u32x2 pk4(f32x4 v) { u32x2 w; w.x = pk2(v[0], v[1]); w.y = pk2(v[2], v[3]); return w; }
__device__ __forceinline__ f32x4 up4(u32x2 w) { return (f32x4){bflo(w.x), bfhi(w.x), bflo(w.y), bfhi(w.y)}; }

__device__ __forceinline__ void chunk_prefix(Frame& F, const bf16_t* Rld, int t0, int h, LAS float* Lc, LAS float* seg) {
    { const int t = F.tid >> 3, c8 = F.tid & 7; const u32x4 v = *(const u32x4*)(Rld + (size_t)(t0 + t) * 256 + h * 64 + c8 * 8);
      LAS float* d = Lc + t * 64 + c8 * 8; d[0] = bflo(v.x); d[1] = bfhi(v.x); d[2] = bflo(v.y); d[3] = bfhi(v.y); d[4] = bflo(v.z); d[5] = bfhi(v.z); d[6] = bflo(v.w); d[7] = bfhi(v.w); }
    __syncthreads();
    { float s = 0.f;
#pragma unroll
      for (int i = 0; i < 8; ++i) { s += Lc[(8 * F.wave + i) * 64 + F.lane]; Lc[(8 * F.wave + i) * 64 + F.lane] = s; }
      seg[F.wave * 64 + F.lane] = s; }
    __syncthreads();
    { float off = 0.f;
      for (int w = 0; w < F.wave; ++w) off += seg[w * 64 + F.lane];
#pragma unroll
      for (int i = 0; i < 8; ++i) Lc[(8 * F.wave + i) * 64 + F.lane] += off; }
    __syncthreads();
}
__device__ __forceinline__ void unpack8(u32x4 v, float (&o)[8]) { o[0] = bflo(v.x); o[1] = bfhi(v.x); o[2] = bflo(v.y); o[3] = bfhi(v.y); o[4] = bflo(v.z); o[5] = bfhi(v.z); o[6] = bflo(v.w); o[7] = bfhi(v.w); }
__device__ __forceinline__ u32x4 pack8(const float (&o)[8]) { u32x4 w; w.x = pk2(o[0], o[1]); w.y = pk2(o[2], o[3]); w.z = pk2(o[4], o[5]); w.w = pk2(o[6], o[7]); return w; }
__device__ __forceinline__ void st_tr8(ldsp tile, int t, int c8, const float (&o)[8]) {
#pragma unroll
    for (int e = 0; e < 8; ++e) *(LAS unsigned short*)(tile + swz128(c8 * 8 + e, t >> 3) + (t & 7) * 2) = (unsigned short)f2bf(o[e]);
}

constexpr int R1_LC = 0, R1_SEG = 16384, R1_GC = 18432, R1_KQ = 20480, R1_BK = 28672, R1_KK = 36864, R1_KABS = 45056, R1_KABST = 53248, R1_BHT = 61440, R1_KHT = 69632, R1_VT = 77824,
              R1_E = 86016  , R1_Q = 102400  , R1_QT = 118784  , R1_AAK = 135168, R1_AVT = R1_Q, R1_W1T = R1_Q + 8192, R1_U0T = R1_QT;
__device__ __forceinline__ void rwkv_r1_item(Frame& F, int item) {
    const int c = item >> 2, h = item & 3, t0 = c * 64;
    const bf16_t *Rk = (const bf16_t*)(F.ws + RW_K), *Rv = (const bf16_t*)(F.ws + RW_V), *Rkap = (const bf16_t*)(F.ws + RW_KAP), *Rb = (const bf16_t*)(F.ws + RW_B), *Rld = (const bf16_t*)(F.ws + RW_LD);
    bf16_t *GW1 = (bf16_t*)(F.ws + RW_W1) + (size_t)item * 4096, *GU0T = (bf16_t*)(F.ws + RW_U0T) + (size_t)item * 4096, *GM = (bf16_t*)(F.ws + RW_M) + (size_t)item * 4096, *GN = (bf16_t*)(F.ws + RW_N) + (size_t)item * 4096;
    ldsp lds = F.lds; LAS float* Lc = (LAS float*)(lds + R1_LC); LAS float* seg = (LAS float*)(lds + R1_SEG); LAS float* GC = (LAS float*)(lds + R1_GC);
    const int rb = F.wave >> 1, cb = F.wave & 1, fr = F.lane & 15, g = F.lane >> 4;
    chunk_prefix(F, Rld, t0, h, Lc, seg);
    {   const int t = F.tid >> 3, c8 = F.tid & 7; const size_t go = (size_t)(t0 + t) * 256 + h * 64 + c8 * 8;
        float kap[8], b[8], k[8], v[8], o1[8], o2[8];
        unpack8(*(const u32x4*)(Rkap + go), kap); unpack8(*(const u32x4*)(Rb + go), b); unpack8(*(const u32x4*)(Rk + go), k); unpack8(*(const u32x4*)(Rv + go), v);
        float L[8], Lp[8], Lm[8], LC[8];
#pragma unroll
        for (int e = 0; e < 8; ++e) { const int cc = c8 * 8 + e; L[e] = Lc[t * 64 + cc]; Lp[e] = (t > 0) ? Lc[(t - 1) * 64 + cc] : 0.f; Lm[e] = Lc[31 * 64 + cc]; LC[e] = Lc[63 * 64 + cc]; }
#pragma unroll
        for (int e = 0; e < 8; ++e) o1[e] = kap[e] * __expf(Lp[e] - Lm[e]);
        *(LAS u32x4*)(lds + R1_KQ + swz128(t, c8)) = pack8(o1);
#pragma unroll
        for (int e = 0; e < 8; ++e) o1[e] = kap[e] * __expf(Lp[e]);
        *(LAS u32x4*)(lds + R1_KABS + swz128(t, c8)) = pack8(o1); st_tr8(lds + R1_KABST, t, c8, o1);
#pragma unroll
        for (int e = 0; e < 8; ++e) { const float s = __expf(Lm[e] - L[e]); o1[e] = b[e] * s; o2[e] = k[e] * s; }
        *(LAS u32x4*)(lds + R1_BK + swz128(t, c8)) = pack8(o1); *(LAS u32x4*)(lds + R1_KK + swz128(t, c8)) = pack8(o2);
#pragma unroll
        for (int e = 0; e < 8; ++e) { const float s = __expf(LC[e] - L[e]); o1[e] = b[e] * s; o2[e] = k[e] * s; }
        st_tr8(lds + R1_BHT, t, c8, o1); st_tr8(lds + R1_KHT, t, c8, o2); st_tr8(lds + R1_VT, t, c8, v);
        if (t == 63) {
#pragma unroll
            for (int e = 0; e < 8; ++e) GC[c8 * 8 + e] = __expf(LC[e]); }
    }
    __syncthreads();
    {
        f32x4 a[2] = {(f32x4){0.f, 0.f, 0.f, 0.f}, (f32x4){0.f, 0.f, 0.f, 0.f}}, at[2] = {a[0], a[0]}, k2[2] = {a[0], a[0]};
        mm_n(lds + R1_KQ, lds + R1_BK, rb, cb, fr, g, a); mm_t(lds + R1_KQ, lds + R1_BK, rb, cb, fr, g, at); mm_n(lds + R1_KQ, lds + R1_KK, rb, cb, fr, g, k2);
#pragma unroll
        for (int n = 0; n < 2; ++n) {
            f32x4 m1, m2, m3;
#pragma unroll
            for (int j = 0; j < 4; ++j) { const int tn = 16 * rb + fr, sn = 32 * cb + 16 * n + 4 * g + j; m1[j] = (sn < tn) ? a[n][j] : 0.f; m3[j] = (sn < tn) ? k2[n][j] : 0.f;
                const int tt = 16 * rb + 4 * g + j, st = 32 * cb + 16 * n + fr; m2[j] = (st < tt) ? at[n][j] : 0.f; }
            *(LAS u32x2*)(lds + R1_Q + adr_n(rb, cb, n, fr, g)) = pk4(m1); *(LAS u32x2*)(lds + R1_E + adr_n(rb, cb, n, fr, g)) = pk4(-m1);
            *(LAS u32x2*)(lds + R1_QT + adr_t(rb, cb, n, fr, g)) = pk4(m2); *(LAS u32x2*)(lds + R1_AAK + adr_n(rb, cb, n, fr, g)) = pk4(m3); }
    }
    __syncthreads();
    {
        f32x4 a[2] = {(f32x4){0.f, 0.f, 0.f, 0.f}, (f32x4){0.f, 0.f, 0.f, 0.f}}, at[2] = {a[0], a[0]};
        mm_n(lds + R1_Q, lds + R1_QT, rb, cb, fr, g, a); mm_t(lds + R1_Q, lds + R1_QT, rb, cb, fr, g, at);
#pragma unroll
        for (int n = 0; n < 2; ++n) { *(LAS u32x2*)(lds + R1_Q + 8192 + adr_n(rb, cb, n, fr, g)) = pk4(a[n]); *(LAS u32x2*)(lds + R1_QT + 8192 + adr_t(rb, cb, n, fr, g)) = pk4(at[n]); }
    }
    __syncthreads();
#pragma unroll 1
    for (int it = 0; it < 5; ++it) {
        ldsp Ecur = lds + R1_E + (it & 1) * 8192, Enew = lds + R1_E + ((it + 1) & 1) * 8192;
        ldsp Qcur = lds + R1_Q + ((it + 1) & 1) * 8192, Qnew = lds + R1_Q + (it & 1) * 8192, QTcur = lds + R1_QT + ((it + 1) & 1) * 8192, QTnew = lds + R1_QT + (it & 1) * 8192;
        f32x4 e[2];
#pragma unroll
        for (int n = 0; n < 2; ++n) e[n] = up4(*(const LAS u32x2*)(Ecur + adr_n(rb, cb, n, fr, g))) + up4(*(const LAS u32x2*)(Qcur + adr_n(rb, cb, n, fr, g)));
        mm_n(Ecur, QTcur, rb, cb, fr, g, e);
#pragma unroll
        for (int n = 0; n < 2; ++n) *(LAS u32x2*)(Enew + adr_n(rb, cb, n, fr, g)) = pk4(e[n]);
        if (it < 4) {
            f32x4 a[2] = {(f32x4){0.f, 0.f, 0.f, 0.f}, (f32x4){0.f, 0.f, 0.f, 0.f}}, at[2] = {a[0], a[0]};
            mm_n(Qcur, QTcur, rb, cb, fr, g, a); mm_t(Qcur, QTcur, rb, cb, fr, g, at);
#pragma unroll
            for (int n = 0; n < 2; ++n) { *(LAS u32x2*)(Qnew + adr_n(rb, cb, n, fr, g)) = pk4(a[n]); *(LAS u32x2*)(QTnew + adr_t(rb, cb, n, fr, g)) = pk4(at[n]); }
        }
        __syncthreads();
    }
    ldsp Ef = lds + R1_E + 8192;
    f32x4 avn[2];
    {
        avn[0] = (f32x4){0.f, 0.f, 0.f, 0.f}; avn[1] = avn[0]; f32x4 avt[2] = {avn[0], avn[0]};
        mm_n(lds + R1_AAK, lds + R1_VT, rb, cb, fr, g, avn); mm_t(lds + R1_AAK, lds + R1_VT, rb, cb, fr, g, avt);
        f32x4 w[2], wt[2];
#pragma unroll
        for (int n = 0; n < 2; ++n) { w[n] = up4(*(const LAS u32x2*)(lds + R1_KABS + adr_n(rb, cb, n, fr, g))); wt[n] = up4(*(const LAS u32x2*)(lds + R1_KABST + adr_t(rb, cb, n, fr, g))); }
        mm_n(Ef, lds + R1_KABST, rb, cb, fr, g, w); mm_t(Ef, lds + R1_KABST, rb, cb, fr, g, wt);
#pragma unroll
        for (int n = 0; n < 2; ++n) { *(LAS u32x2*)(lds + R1_AVT + adr_t(rb, cb, n, fr, g)) = pk4(avt[n]); *(LAS u32x2*)(lds + R1_W1T + adr_t(rb, cb, n, fr, g)) = pk4(wt[n]);
            *(u32x2*)(GW1 + (16 * rb + fr) * 64 + 32 * cb + 16 * n + 4 * g) = pk4(w[n]); }
    }
    __syncthreads();
    {
        f32x4 ut[2];
#pragma unroll
        for (int n = 0; n < 2; ++n) ut[n] = up4(*(const LAS u32x2*)(lds + R1_AVT + adr_t(rb, cb, n, fr, g)));
        mm_t(Ef, lds + R1_AVT, rb, cb, fr, g, ut);
        (void)avn;
#pragma unroll
        for (int n = 0; n < 2; ++n) { *(LAS u32x2*)(lds + R1_U0T + adr_t(rb, cb, n, fr, g)) = pk4(ut[n]); *(u32x2*)(GU0T + (32 * cb + 16 * n + fr) * 64 + 16 * rb + 4 * g) = pk4(ut[n]); }
    }
    __syncthreads();
    {
        f32x4 m[2] = {(f32x4){0.f, 0.f, 0.f, 0.f}, (f32x4){0.f, 0.f, 0.f, 0.f}}, n1[2] = {m[0], m[0]}, n2[2] = {m[0], m[0]};
        mm_n(lds + R1_BHT, lds + R1_W1T, rb, cb, fr, g, m); mm_t(lds + R1_KHT, lds + R1_VT, rb, cb, fr, g, n1); mm_t(lds + R1_BHT, lds + R1_U0T, rb, cb, fr, g, n2);
        float mo[8];
#pragma unroll
        for (int n = 0; n < 2; ++n)
#pragma unroll
            for (int j = 0; j < 4; ++j) { const int cr = 16 * rb + fr, cc = 32 * cb + 16 * n + 4 * g + j; mo[n * 4 + j] = ((cr == cc) ? GC[cr] : 0.f) - m[n][j]; }
        *(u32x4*)(GM + ((rb * 2 + cb) * 64 + F.lane) * 8) = pack8(mo);
#pragma unroll
        for (int n = 0; n < 2; ++n) *(u32x2*)(GN + (((2 * cb + n) * 4 + rb) * 64 + F.lane) * 4) = pk4(n1[n] - n2[n]);
    }
    __syncthreads();
}

__device__ __forceinline__ void rwkv_p2(Frame& F, int h) {
    if (F.wave >= 4) return;
    const int cb2 = F.wave, fr = F.lane & 15, g = F.lane >> 4;
    const bf16_t* GM = (const bf16_t*)(F.ws + RW_M); const bf16_t* GN = (const bf16_t*)(F.ws + RW_N); bf16_t* GS = (bf16_t*)(F.ws + RW_S0);
    f32x4 S[4];
#pragma unroll
    for (int mt = 0; mt < 4; ++mt) S[mt] = (f32x4){0.f, 0.f, 0.f, 0.f};
    bf16x8 Mf[4][2]; u32x2 Nf[4];
    { const size_t base = (size_t)(0 * 4 + h) * 4096;
#pragma unroll
      for (int mt = 0; mt < 4; ++mt) { Nf[mt] = *(const u32x2*)(GN + base + ((cb2 * 4 + mt) * 64 + F.lane) * 4);
#pragma unroll
        for (int ks = 0; ks < 2; ++ks) Mf[mt][ks] = *(const bf16x8*)(GM + base + ((mt * 2 + ks) * 64 + F.lane) * 8); } }
#pragma unroll 1
    for (int c = 0; c < T_ / 64; ++c) {
        const size_t base = (size_t)(c * 4 + h) * 4096;
        u32x4 sw[2];
#pragma unroll
        for (int ks = 0; ks < 2; ++ks) { const u32x2 lo = pk4(S[2 * ks]), hi = pk4(S[2 * ks + 1]); sw[ks] = (u32x4){lo.x, lo.y, hi.x, hi.y}; }
#pragma unroll
        for (int mt = 0; mt < 4; ++mt) { const u32x2 w = (mt & 1) ? (u32x2){sw[mt >> 1].z, sw[mt >> 1].w} : (u32x2){sw[mt >> 1].x, sw[mt >> 1].y};
            *(u32x2*)(GS + base + (16 * cb2 + fr) * 64 + 16 * mt + 4 * g) = w; }
        bf16x8 Mn[4][2]; u32x2 Nn[4];
        const size_t nb = (size_t)(((c + 1 < T_ / 64) ? c + 1 : c) * 4 + h) * 4096;
#pragma unroll
        for (int mt = 0; mt < 4; ++mt) { Nn[mt] = *(const u32x2*)(GN + nb + ((cb2 * 4 + mt) * 64 + F.lane) * 4);
#pragma unroll
            for (int ks = 0; ks < 2; ++ks) Mn[mt][ks] = *(const bf16x8*)(GM + nb + ((mt * 2 + ks) * 64 + F.lane) * 8); }
#pragma unroll
        for (int mt = 0; mt < 4; ++mt) { f32x4 a = up4(Nf[mt]);
#pragma unroll
            for (int ks = 0; ks < 2; ++ks) a = mfma16(Mf[mt][ks], __builtin_bit_cast(bf16x8, sw[ks]), a);
            S[mt] = a; }
#pragma unroll
        for (int mt = 0; mt < 4; ++mt) { Nf[mt] = Nn[mt];
#pragma unroll
            for (int ks = 0; ks < 2; ++ks) Mf[mt][ks] = Mn[mt][ks]; }
    }
}

constexpr int R3_RQ = 20480, R3_RABS = 28672, R3_BK = 36864, R3_KK = 45056, R3_VT = 53248, R3_S = 61440, R3_W1 = 69632, R3_UT = 77824, R3_ARB = 86016, R3_ARK = 94208, R3_ST = 102400;
__device__ __forceinline__ void rwkv_p3_item(Frame& F, int l, int item) {
    const int c = item >> 2, h = item & 3, t0 = c * 64;
    const bf16_t *Rr = (const bf16_t*)(F.ws + RW_R), *Rk = (const bf16_t*)(F.ws + RW_K), *Rv = (const bf16_t*)(F.ws + RW_V), *Rb = (const bf16_t*)(F.ws + RW_B), *Rg = (const bf16_t*)(F.ws + RW_G), *Rld = (const bf16_t*)(F.ws + RW_LD);
    const bf16_t *GW1 = (const bf16_t*)(F.ws + RW_W1) + (size_t)item * 4096, *GU0T = (const bf16_t*)(F.ws + RW_U0T) + (size_t)item * 4096, *GS = (const bf16_t*)(F.ws + RW_S0) + (size_t)item * 4096;
    const float* Rbon = (const float*)(F.ws + RW_BONUS); bf16_t* ycat = (bf16_t*)(F.ws + WS_ACT);
    ldsp lds = F.lds; LAS float* Lc = (LAS float*)(lds + R1_LC); LAS float* seg = (LAS float*)(lds + R1_SEG); LAS float* ST = (LAS float*)(lds + R3_ST);
    const int rb = F.wave >> 1, cb = F.wave & 1, fr = F.lane & 15, g = F.lane >> 4;
    chunk_prefix(F, Rld, t0, h, Lc, seg);
    {   const int t = F.tid >> 3, c8 = F.tid & 7; const size_t go = (size_t)(t0 + t) * 256 + h * 64 + c8 * 8;
        float r[8], b[8], k[8], v[8], o1[8], o2[8];
        unpack8(*(const u32x4*)(Rr + go), r); unpack8(*(const u32x4*)(Rb + go), b); unpack8(*(const u32x4*)(Rk + go), k); unpack8(*(const u32x4*)(Rv + go), v);
        float L[8], Lm[8];
#pragma unroll
        for (int e = 0; e < 8; ++e) { const int cc = c8 * 8 + e; L[e] = Lc[t * 64 + cc]; Lm[e] = Lc[31 * 64 + cc]; }
#pragma unroll
        for (int e = 0; e < 8; ++e) { o1[e] = r[e] * __expf(L[e] - Lm[e]); o2[e] = r[e] * __expf(L[e]); }
        *(LAS u32x4*)(lds + R3_RQ + swz128(t, c8)) = pack8(o1); *(LAS u32x4*)(lds + R3_RABS + swz128(t, c8)) = pack8(o2);
#pragma unroll
        for (int e = 0; e < 8; ++e) { const float s = __expf(Lm[e] - L[e]); o1[e] = b[e] * s; o2[e] = k[e] * s; }
        *(LAS u32x4*)(lds + R3_BK + swz128(t, c8)) = pack8(o1); *(LAS u32x4*)(lds + R3_KK + swz128(t, c8)) = pack8(o2);
        st_tr8(lds + R3_VT, t, c8, v);
        *(LAS u32x4*)(lds + R3_S + swz128(t, c8)) = *(const u32x4*)(GS + t * 64 + c8 * 8);
        *(LAS u32x4*)(lds + R3_W1 + swz128(t, c8)) = *(const u32x4*)(GW1 + t * 64 + c8 * 8);
    }
    __syncthreads();
    f32x4 y[2];
    {   f32x4 ut[2];
#pragma unroll
        for (int n = 0; n < 2; ++n) ut[n] = up4(*(const u32x2*)(GU0T + (32 * cb + 16 * n + fr) * 64 + 16 * rb + 4 * g));
        mm_t(lds + R3_W1, lds + R3_S, rb, cb, fr, g, ut);
        f32x4 ab[2] = {(f32x4){0.f, 0.f, 0.f, 0.f}, (f32x4){0.f, 0.f, 0.f, 0.f}}, ak[2] = {ab[0], ab[0]};
        mm_n(lds + R3_RQ, lds + R3_BK, rb, cb, fr, g, ab); mm_n(lds + R3_RQ, lds + R3_KK, rb, cb, fr, g, ak);
        y[0] = (f32x4){0.f, 0.f, 0.f, 0.f}; y[1] = y[0];
        mm_n(lds + R3_RABS, lds + R3_S, rb, cb, fr, g, y);
#pragma unroll
        for (int n = 0; n < 2; ++n) {
            f32x4 m1, m2;
#pragma unroll
            for (int j = 0; j < 4; ++j) { const int tn = 16 * rb + fr, sn = 32 * cb + 16 * n + 4 * g + j; m1[j] = (sn <= tn) ? ab[n][j] : 0.f; m2[j] = (sn <= tn) ? ak[n][j] : 0.f; }
            *(LAS u32x2*)(lds + R3_UT + adr_t(rb, cb, n, fr, g)) = pk4(ut[n]);
            *(LAS u32x2*)(lds + R3_ARB + adr_n(rb, cb, n, fr, g)) = pk4(m1); *(LAS u32x2*)(lds + R3_ARK + adr_n(rb, cb, n, fr, g)) = pk4(m2); }
    }
    __syncthreads();
    {   f32x4 z[2] = {(f32x4){0.f, 0.f, 0.f, 0.f}, (f32x4){0.f, 0.f, 0.f, 0.f}};
        mm_n(lds + R3_ARB, lds + R3_UT, rb, cb, fr, g, z); mm_n(lds + R3_ARK, lds + R3_VT, rb, cb, fr, g, y);
        y[0] -= z[0]; y[1] -= z[1];
        float s1 = 0.f, s2 = 0.f;
#pragma unroll
        for (int n = 0; n < 2; ++n)
#pragma unroll
            for (int j = 0; j < 4; ++j) { s1 += y[n][j]; s2 += y[n][j] * y[n][j]; }
        s1 += __shfl_xor(s1, 16); s1 += __shfl_xor(s1, 32); s2 += __shfl_xor(s2, 16); s2 += __shfl_xor(s2, 32);
        if (g == 0) { ST[((16 * rb + fr) * 2 + cb) * 2] = s1; ST[((16 * rb + fr) * 2 + cb) * 2 + 1] = s2; }
    }
    __syncthreads();
    {   const int tl = 16 * rb + fr; const int t = t0 + tl;
        const float s1 = ST[(tl * 2) * 2] + ST[(tl * 2 + 1) * 2], s2 = ST[(tl * 2) * 2 + 1] + ST[(tl * 2 + 1) * 2 + 1];
        const float mean = s1 * (1.f / 64.f), var = fmaxf(s2 * (1.f / 64.f) - mean * mean, 0.f), rstd = 1.f / sqrtf(var + 64e-5f);
        const float bon = Rbon[(size_t)t * 4 + h];
        const float *lng = F.in[21] + l * 256 + h * 64, *lnb = F.in[22] + l * 256 + h * 64;
#pragma unroll
        for (int n = 0; n < 2; ++n) { const int i0 = 32 * cb + 16 * n + 4 * g; const size_t go = (size_t)t * 256 + h * 64 + i0;
            const f32x4 vv = up4(*(const u32x2*)(Rv + go)), gg = up4(*(const u32x2*)(Rg + go)); const f32x4 lg = *(const f32x4*)(lng + i0), lb = *(const f32x4*)(lnb + i0);
            f32x4 o;
#pragma unroll
            for (int j = 0; j < 4; ++j) o[j] = ((y[n][j] - mean) * rstd * lg[j] + lb[j] + bon * vv[j]) * gg[j];
            *(u32x2*)(ycat + (size_t)t * DM + 768 + h * 64 + i0) = pk4(o); }
    }
    __syncthreads();
}

__device__ __forceinline__ void phase_router(Frame& F, int l) {
    const float* X = F.out;
    const bf16_t* WH = (const bf16_t*)(F.ws + WS_WRH); const bf16_t* WL = (const bf16_t*)(F.ws + WS_WRL);
    const float* bias_r = (const float*)(F.ws + WS_BR);
    float* rinv2 = (float*)(F.ws + WS_RINV2);
    unsigned* cnt = (unsigned*)(F.ws + WS_CTL) + l * 64;
    unsigned* list = (unsigned*)(F.ws + WS_LIST); float* wlist = (float*)(F.ws + WS_WLIST);
    LAS float* Lg = (LAS float*)(F.lds + F.wave * 4096);
    const int fr = F.lane & 15, g = F.lane >> 4;
    const int gw = F.bid * NWAVES + F.wave, NGW = F.G * NWAVES;
    for (int it = gw; it < T_ / 16; it += NGW) {
        const int t = it * 16 + fr;
        const float* xr = X + (size_t)t * DM + g * 8;
        f32x4 acc[3]; acc[0] = (f32x4){0.f, 0.f, 0.f, 0.f}; acc[1] = acc[0]; acc[2] = acc[0];
        float ss = 0.f;
#pragma unroll 2
        for (int ks = 0; ks < 32; ++ks) {
            const f32x4 x0 = *(const f32x4*)(xr + ks * 32), x1 = *(const f32x4*)(xr + ks * 32 + 4);
            const float xv[8] = {x0[0], x0[1], x0[2], x0[3], x1[0], x1[1], x1[2], x1[3]};
            unsigned hh[8], ll[8];
#pragma unroll
            for (int e = 0; e < 8; ++e) { ss += xv[e] * xv[e]; hh[e] = f2bf(xv[e]); ll[e] = f2bf(xv[e] - bf2f(hh[e])); }
            u32x4 hw, lw; hw.x = hh[0] | (hh[1] << 16); hw.y = hh[2] | (hh[3] << 16); hw.z = hh[4] | (hh[5] << 16); hw.w = hh[6] | (hh[7] << 16);
            lw.x = ll[0] | (ll[1] << 16); lw.y = ll[2] | (ll[3] << 16); lw.z = ll[4] | (ll[5] << 16); lw.w = ll[6] | (ll[7] << 16);
            const bf16x8 xh = __builtin_bit_cast(bf16x8, hw), xl = __builtin_bit_cast(bf16x8, lw);
#pragma unroll
            for (int n = 0; n < 3; ++n) { const bf16x8 wh = *(const bf16x8*)(WH + (16 * n + fr) * DM + ks * 32 + g * 8), wl = *(const bf16x8*)(WL + (16 * n + fr) * DM + ks * 32 + g * 8);
                acc[n] = mfma16(wh, xh, acc[n]); acc[n] = mfma16(wh, xl, acc[n]); acc[n] = mfma16(wl, xh, acc[n]); }
        }
        ss += __shfl_xor(ss, 16); ss += __shfl_xor(ss, 32);
        const float rinv = 1.f / sqrtf(ss * (1.f / DM) + 1e-6f);
#pragma unroll
        for (int n = 0; n < 3; ++n)
#pragma unroll
            for (int j = 0; j < 4; ++j) { const int c = 16 * n + 4 * g + j; Lg[fr * 48 + c] = acc[n][j] * rinv + bias_r[c]; }
        LDS_WAIT();
        if (F.lane < 16) {
            const LAS float* lg = Lg + F.lane * 48; const int tt = it * 16 + F.lane;
            rinv2[tt] = rinv;
            int gi = 0; float gm = lg[0];
#pragma unroll
            for (int k = 1; k < 4; ++k) if (lg[k] > gm) { gm = lg[k]; gi = k; }
            float gs = 0.f;
#pragma unroll
            for (int k = 0; k < 4; ++k) gs += __expf(lg[k] - gm);
            const float gp = 1.f / gs;
            int e0 = 0; float v0 = lg[4 + gi * 8];
#pragma unroll
            for (int k = 1; k < 8; ++k) { const float v = lg[4 + gi * 8 + k]; if (v > v0) { v0 = v; e0 = k; } }
            int e1 = -1; float v1 = -INFINITY;
#pragma unroll
            for (int k = 0; k < 8; ++k) { const float v = lg[4 + gi * 8 + k]; if (k != e0 && v > v1) { v1 = v; e1 = k; } }
            const float ex = __expf(v1 - v0); const float w0 = gp / (1.f + ex), w1 = gp * ex / (1.f + ex);
            const int E0 = gi * 8 + e0, E1 = gi * 8 + e1;
            const unsigned p0 = atomicAdd(&cnt[E0], 1u); list[(size_t)E0 * T_ + p0] = (unsigned)tt; wlist[(size_t)E0 * T_ + p0] = w0;
            const unsigned p1 = atomicAdd(&cnt[E1], 1u); list[(size_t)E1 * T_ + p1] = (unsigned)tt | 0x80000000u; wlist[(size_t)E1 * T_ + p1] = w1;
        }
        LDS_WAIT();
    }
}

__device__ __forceinline__ void phase_moe(Frame& F, int l) {
    const bf16_t* XB = (const bf16_t*)(F.ws + WS_RW);
    const bf16_t* WGU = (const bf16_t*)(F.ws + WS_WGU); const bf16_t* WD = (const bf16_t*)(F.ws + WS_WD);
    const float* bias_gu = (const float*)(F.ws + WS_BGU); const float* rinv2 = (const float*)(F.ws + WS_RINV2);
    const unsigned* cnt = (const unsigned*)(F.ws + WS_CTL) + l * 64;
    const unsigned* list = (const unsigned*)(F.ws + WS_LIST); const float* wlist = (const float*)(F.ws + WS_WLIST);
    bf16_t* ys = (bf16_t*)(F.ws + WS_P);
    ldsp At = F.lds, Bt = F.lds + 16384, Bd = F.lds, Act = F.lds + 65536;
    LAS unsigned* tokl = (LAS unsigned*)(F.lds + 98304); LAS float* wtl = (LAS float*)(F.lds + 98304 + 512); LAS float* rvl = (LAS float*)(F.lds + 98304 + 1024);
    const int wr = F.wave >> 2, wc = F.wave & 3, fr = F.lane & 15, g = F.lane >> 4;
    int total = 0;
    for (int e = 0; e < 32; ++e) total += ((int)cnt[e] + 127) >> 7;
    for (int ti = F.bid; ti < total; ti += F.G) {
        int e = 0, acc_t = 0, m0 = 0, ne = 0;
        for (int k = 0; k < 32; ++k) { const int n = (int)cnt[k]; const int nt = (n + 127) >> 7; if (ti >= acc_t && ti < acc_t + nt) { e = k; m0 = (ti - acc_t) * 128; ne = n; } acc_t += nt; }
        const int nrows = (ne - m0) < 128 ? (ne - m0) : 128;
        __syncthreads();
        if (F.tid < 128) { unsigned tk = 0u; float w = 0.f; if (F.tid < nrows) { tk = list[(size_t)e * T_ + m0 + F.tid]; w = wlist[(size_t)e * T_ + m0 + F.tid]; }
            tokl[F.tid] = tk; wtl[F.tid] = w; rvl[F.tid] = rinv2[tk & 0x7fffffffu]; }
        __syncthreads();
        f32x4 ag[4][2], au[4][2];
#pragma unroll
        for (int m = 0; m < 4; ++m)
#pragma unroll
            for (int n = 0; n < 2; ++n) { ag[m][n] = (f32x4){0.f, 0.f, 0.f, 0.f}; au[m][n] = ag[m][n]; }
        const bf16_t* wgu = WGU + (size_t)e * 256 * DM;
        for (int kt = 0; kt < 16; ++kt) {
            u32x4 ra[2], rb[4];
#pragma unroll
            for (int i = 0; i < 2; ++i) { const int idx = F.tid + i * NTHR, row = idx >> 3, c = idx & 7; const unsigned tk = tokl[row] & 0x7fffffffu; ra[i] = *(const u32x4*)(XB + (size_t)tk * DM + kt * 64 + c * 8); }
#pragma unroll
            for (int i = 0; i < 4; ++i) { const int idx = F.tid + i * NTHR, row = idx >> 3, c = idx & 7; rb[i] = *(const u32x4*)(wgu + (size_t)row * DM + kt * 64 + c * 8); }
            __syncthreads();
#pragma unroll
            for (int i = 0; i < 2; ++i) { const int idx = F.tid + i * NTHR, row = idx >> 3, c = idx & 7; *(LAS u32x4*)(At + swz128(row, c)) = ra[i]; }
#pragma unroll
            for (int i = 0; i < 4; ++i) { const int idx = F.tid + i * NTHR, row = idx >> 3, c = idx & 7; *(LAS u32x4*)(Bt + swz128(row, c)) = rb[i]; }
            __syncthreads();
#pragma unroll
            for (int ks = 0; ks < 2; ++ks) {
                bf16x8 af[4], bg_[2], bu_[2];
#pragma unroll
                for (int m = 0; m < 4; ++m) af[m] = *(const LAS bf16x8*)(At + swz128(64 * wr + 16 * m + fr, ks * 4 + g));
#pragma unroll
                for (int n = 0; n < 2; ++n) { bg_[n] = *(const LAS bf16x8*)(Bt + swz128(32 * wc + 16 * n + fr, ks * 4 + g)); bu_[n] = *(const LAS bf16x8*)(Bt + swz128(128 + 32 * wc + 16 * n + fr, ks * 4 + g)); }
#pragma unroll
                for (int m = 0; m < 4; ++m)
#pragma unroll
                    for (int n = 0; n < 2; ++n) { ag[m][n] = mfma16(bg_[n], af[m], ag[m][n]); au[m][n] = mfma16(bu_[n], af[m], au[m][n]); }
            }
        }
        const float* bge = bias_gu + e * 256;
#pragma unroll
        for (int m = 0; m < 4; ++m) { const int row = 64 * wr + 16 * m + fr; const float rv = rvl[row], wt = wtl[row];
#pragma unroll
            for (int n = 0; n < 2; ++n) { const int f0 = 32 * wc + 16 * n + 4 * g; float a_[4];
#pragma unroll
                for (int j = 0; j < 4; ++j) { const float gv = ag[m][n][j] * rv + bge[f0 + j], uv = au[m][n][j] * rv + bge[128 + f0 + j]; a_[j] = gv * sigmoidf_(gv) * uv * wt; }
                u32x2 w; w.x = pk2(a_[0], a_[1]); w.y = pk2(a_[2], a_[3]);
                *(LAS u32x2*)(Act + swz256(row, f0 >> 3) + (g & 1) * 8) = w; } }
        const bf16_t* wd = WD + (size_t)e * DM * 128;
#pragma unroll 1
        for (int nc = 0; nc < 4; ++nc) {
            __syncthreads();
#pragma unroll
            for (int i = 0; i < 8; ++i) { const int idx = F.tid + i * NTHR, row = idx >> 4, c = idx & 15; *(LAS u32x4*)(Bd + swz256(row, c)) = *(const u32x4*)(wd + (size_t)(nc * 256 + row) * 128 + c * 8); }
            __syncthreads();
            f32x4 ao[4][4];
#pragma unroll
            for (int m = 0; m < 4; ++m)
#pragma unroll
                for (int n = 0; n < 4; ++n) ao[m][n] = (f32x4){0.f, 0.f, 0.f, 0.f};
#pragma unroll
            for (int ks = 0; ks < 4; ++ks) {
                bf16x8 af[4], bf_[4];
#pragma unroll
                for (int m = 0; m < 4; ++m) af[m] = *(const LAS bf16x8*)(Act + swz256(64 * wr + 16 * m + fr, ks * 4 + g));
#pragma unroll
                for (int n = 0; n < 4; ++n) bf_[n] = *(const LAS bf16x8*)(Bd + swz256(64 * wc + 16 * n + fr, ks * 4 + g));
#pragma unroll
                for (int m = 0; m < 4; ++m)
#pragma unroll
                    for (int n = 0; n < 4; ++n) ao[m][n] = mfma16(bf_[n], af[m], ao[m][n]);
            }
#pragma unroll
            for (int m = 0; m < 4; ++m) { const int row = 64 * wr + 16 * m + fr;
                if (row < nrows) { const unsigned tk = tokl[row]; bf16_t* dst = ys + ((size_t)(tk >> 31) * T_ + (tk & 0x7fffffffu)) * DM + nc * 256 + 64 * wc + 4 * g;
#pragma unroll
                    for (int n = 0; n < 4; ++n) { u32x2 w; w.x = pk2(ao[m][n][0], ao[m][n][1]); w.y = pk2(ao[m][n][2], ao[m][n][3]); *(u32x2*)(dst + 16 * n) = w; } } }
        }
    }
    __syncthreads();
}

constexpr int NPHASE = 20;
__device__ __forceinline__ bool fresh(Frame& F) { int t = threadIdx.x; asm volatile("" : "+v"(t)); F.tid = t; F.lane = t & 63; F.wave = __builtin_amdgcn_readfirstlane(t >> 6); return true; }
template <int L> __device__ __forceinline__ void layer_phases(Frame& F, const int lo, const int hi) {
    constexpr int B = 1 + 9 * L;
#define INR(k) (lo <= (k) && (k) < hi)
#define IN(k) (INR(k) && fresh(F))
#define SEAM(k) do { if (INR(k) && INR((k) + 1)) cg::this_grid().sync(); } while (0)
    if (IN(B + 0)) { phase_prep(F, L); __syncthreads(); phase_rownorm(F, L == 0 ? 0 : 1); } SEAM(B + 0);
    if (IN(B + 1)) {
        pg8::Gemm gm{(const bf16_t*)(F.ws + WS_ACT), (const bf16_t*)(F.ws + WS_WIN), T_, NINP, DM, DM, DM};
        pg8::StaticOrder S; S.init(T_, NINP, F.G, F.bid);
        pg8::EpiBf16Bias E{(bf16_t*)(F.ws + WS_P), NINP, (const float*)(F.ws + WS_BIN)};
        pg8::gemm_phase<pg8::EpiBf16Bias, pg8::StaticOrder, true, true>(F.lds, gm, S, E);
    } SEAM(B + 1);
    if (IN(B + 2)) {
#pragma unroll 1
        for (int it = F.bid; it < 512; it += F.G) { asm volatile("" ::: "memory"); if (it < 128) attn_item(F, L, it); }
#pragma unroll 1
        for (int it = F.bid; it < 512; it += F.G) { asm volatile("" ::: "memory"); if (it >= 128 && it < 256) poolconv_item(F, L, it - 128); }
#pragma unroll 1
        for (int it = F.bid; it < 512; it += F.G) { asm volatile("" ::: "memory"); if (it >= 256) rwkvprep_item(F, L, it - 256); }
    } SEAM(B + 2);
    if (IN(B + 3)) {
#pragma unroll 1
        for (int it = F.bid; it < 1024; it += F.G) { asm volatile("" ::: "memory"); rwkv_r1_item(F, it); }
    } SEAM(B + 3);
    if (IN(B + 4)) { if (F.bid < 4) rwkv_p2(F, F.bid); } SEAM(B + 4);
    if (IN(B + 5)) {
#pragma unroll 1
        for (int it = F.bid; it < 1024; it += F.G) { asm volatile("" ::: "memory"); rwkv_p3_item(F, L, it); }
    } SEAM(B + 5);
    if (IN(B + 6)) {
        pg8::Gemm gm{(const bf16_t*)(F.ws + WS_ACT), (const bf16_t*)(F.ws + WS_WOUT), T_, DM, DM, DM, DM};
        pg8::StaticOrder S; S.init(T_, DM, F.G, F.bid);
        pg8::EpiResF32 E{L == 0 ? F.in[0] : F.out, F.out, (bf16_t*)(F.ws + WS_RW), DM};
        pg8::gemm_phase<pg8::EpiResF32, pg8::StaticOrder, true, true>(F.lds, gm, S, E);
    } SEAM(B + 6);
    if (IN(B + 7)) phase_router(F, L); SEAM(B + 7);
    if (IN(B + 8)) phase_moe(F, L); SEAM(B + 8);
}

__global__ void __launch_bounds__(NTHR, 2) fwd_kernel(Args a) {
    extern __shared__ __attribute__((aligned(16))) unsigned char smem[];
    Frame F;
    F.lds = (ldsp)smem; F.tid = threadIdx.x; F.lane = F.tid & 63; F.wave = __builtin_amdgcn_readfirstlane(F.tid >> 6);
    F.G = gridDim.x; F.bid = blockIdx.x; F.in = a.in; F.out = a.out; F.ws = a.ws;
    const int lo = a.ph_lo, hi = a.ph_hi;
    if (IN(0)) phase_mod(F); SEAM(0);
    layer_phases<0>(F, lo, hi);
    layer_phases<1>(F, lo, hi);
    if (IN(19)) phase_rownorm(F, 2);
#undef IN
#undef INR
#undef SEAM
}

extern "C" void kernel_launch(void* const* d_in, const int* in_sizes, int n_in, void* d_out, int out_size, void* d_ws, size_t ws_size, hipStream_t stream) {
    static int grid = 0;
    if (grid == 0) {
        int dev = 0, cus = 0;
        if (n_in != 34 || out_size != T_ * DM || ws_size < WS_END) { fprintf(stderr, "kernel_launch: unexpected shapes n_in %d out %d ws %zu\n", n_in, out_size, ws_size); grid = -1; return; }
        if (hipGetDevice(&dev) != hipSuccess || hipDeviceGetAttribute(&cus, hipDeviceAttributeMultiprocessorCount, dev) != hipSuccess) { grid = -1; return; }
        if (hipFuncSetAttribute((const void*)fwd_kernel, hipFuncAttributeMaxDynamicSharedMemorySize, LDS_BYTES) != hipSuccess) { fprintf(stderr, "kernel_launch: hipFuncSetAttribute failed\n"); grid = -1; return; }
        int per_cu = 0;
        if (hipOccupancyMaxActiveBlocksPerMultiprocessor(&per_cu, (const void*)fwd_kernel, NTHR, LDS_BYTES) != hipSuccess || per_cu < 1) { fprintf(stderr, "kernel_launch: occupancy query failed (%d)\n", per_cu); per_cu = 1; }
        (void)hipGetLastError();
        grid = cus;
    }
    if (grid < 0) return;
    (void)hipMemsetAsync((char*)d_ws + WS_CTL, 0, CTL_BYTES, stream);
    Args a{};
    for (int i = 0; i < 34; ++i) a.in[i] = (const float*)d_in[i];
    a.out = (float*)d_out; a.ws = (unsigned char*)d_ws;
#ifdef MULTI_LAUNCH
    for (int ph = 0; ph < NPHASE; ++ph) { a.ph_lo = ph; a.ph_hi = ph + 1; hipLaunchKernelGGL(fwd_kernel, dim3(grid), dim3(NTHR), LDS_BYTES, stream, a); }
#else
    a.ph_lo = 0; a.ph_hi = NPHASE;
    void* args[] = {&a};
    hipError_t e = hipLaunchCooperativeKernel((void*)fwd_kernel, dim3(grid), dim3(NTHR), args, LDS_BYTES, stream);
    if (e != hipSuccess) fprintf(stderr, "cooperative launch failed: %s (grid %d)\n", hipGetErrorString(e), grid);
#endif
}
```

```cpp
#include <hip/hip_runtime.h>
#include <hip/hip_cooperative_groups.h>
#include <cstdio>
#include <cstdint>
namespace cg = cooperative_groups;

#define LAS __attribute__((address_space(3)))
typedef unsigned short bf16_t;
typedef short bf16x8 __attribute__((ext_vector_type(8)));
typedef float f32x4 __attribute__((ext_vector_type(4)));
typedef float f32x2 __attribute__((ext_vector_type(2)));
typedef unsigned u32x4 __attribute__((ext_vector_type(4)));
typedef unsigned u32x2 __attribute__((ext_vector_type(2)));
typedef LAS unsigned char* ldsp;

namespace pg8 {
#define PG8_LAS __attribute__((address_space(3)))
constexpr int BM = 256, BK = 64, HALF = 128, HTB = HALF * BK * 2, STAGE_BYTES = 8 * HTB, NXCD = 8, WGM = 8;
__host__ __device__ __forceinline__ int lds_byte(int r, int c) { const int st = (r >> 4) * 2 + (c >> 5), rr = r & 15, cc = c & 31, ob = rr * 64 + cc * 2; return st * 1024 + (ob ^ (((ob >> 9) & 1) << 5)); }
__host__ __device__ __forceinline__ void stage_rc(int b, int& R, int& C) { const int st = b / 1024, sb = b % 1024, swz = sb ^ (((sb >> 9) & 1) << 5); R = (st >> 1) * 16 + swz / 64; C = (st & 1) * 32 + (swz % 64) / 2; }
__host__ __device__ __forceinline__ int perm32(int rho) { const int n = rho >> 4, i = rho & 15; return 8 * (i >> 2) + 4 * n + (i & 3); }
struct Unit { int pm, pn; };
struct Gemm { const bf16_t* A; const bf16_t* Bt; int M, N, K, lda, ldb; };
struct StaticOrder {
    int nM, nN, nwg, G, c;
    __host__ __device__ void init(int M, int N, int G_, int c_) { nM = M / BM; nN = N / BM; nwg = nM * nN; G = G_; c = c_; }
    __host__ __device__ bool next(int i, Unit& u) const {
        const long L = (long)i * G + c; if (L >= nwg) return false;
        int wgid = (int)L; { const int q = nwg / NXCD, r = nwg % NXCD, xcd = wgid % NXCD, off = wgid / NXCD; wgid = (xcd < r ? xcd * (q + 1) : r * (q + 1) + (xcd - r) * q) + off; }
        const int nig = WGM * nN, gid = wgid / nig, fm = gid * WGM, gsz = (nM - fm) < WGM ? (nM - fm) : WGM;
        u.pm = fm + ((wgid % nig) % gsz); u.pn = (wgid % nig) / gsz; return true;
    }
    __device__ __forceinline__ void a_ready(const Unit&) const {}
    __device__ __forceinline__ void done(const Unit&) const {}
};
__device__ __forceinline__ unsigned cvt_pk_bf16(float lo, float hi) { unsigned r; asm volatile("v_cvt_pk_bf16_f32 %0, %1, %2" : "=v"(r) : "v"(lo), "v"(hi)); return r; }
struct EpiBf16Bias {
    static constexpr bool PERM = true, AFTER_DRAIN = false;
    bf16_t* O; int ldc; const float* bias;
    __device__ __forceinline__ void operator()(const f32x4 (&acc)[2][2][4][2], const Unit& u, int wr, int wc, int fr, int fq) const {
        const int row0 = u.pm * BM + wr * 64 + fr; const int col0 = u.pn * BM + wc * 32 + 8 * fq;
        f32x4 bv[2][2];
#pragma unroll
        for (int bj = 0; bj < 2; ++bj)
#pragma unroll
            for (int n = 0; n < 2; ++n) bv[bj][n] = *(const f32x4*)(bias + col0 + bj * HALF + 4 * n);
#pragma unroll
        for (int ai = 0; ai < 2; ++ai)
#pragma unroll
            for (int m = 0; m < 4; ++m) { bf16_t* rowp = O + (size_t)(row0 + ai * HALF + m * 16) * ldc + col0;
#pragma unroll
                for (int bj = 0; bj < 2; ++bj) { f32x4 v0 = acc[ai][bj][m][0] + bv[bj][0], v1 = acc[ai][bj][m][1] + bv[bj][1];
                    u32x4 w; w.x = cvt_pk_bf16(v0[0], v0[1]); w.y = cvt_pk_bf16(v0[2], v0[3]); w.z = cvt_pk_bf16(v1[0], v1[1]); w.w = cvt_pk_bf16(v1[2], v1[3]);
                    *(u32x4*)(rowp + bj * HALF) = w; } }
    }
};
struct EpiResF32 {
    static constexpr bool PERM = false, AFTER_DRAIN = false;
    const float* base; float* out; bf16_t* ob; int ldc;
    __device__ __forceinline__ void operator()(const f32x4 (&acc)[2][2][4][2], const Unit& u, int wr, int wc, int fr, int fq) const {
        const int row0 = u.pm * BM + wr * 64 + fr, col0 = u.pn * BM + wc * 32 + 4 * fq;
#pragma unroll
        for (int ai = 0; ai < 2; ++ai)
#pragma unroll
            for (int m = 0; m < 4; ++m) { const size_t off = (size_t)(row0 + ai * HALF + m * 16) * ldc + col0;
#pragma unroll
                for (int bj = 0; bj < 2; ++bj)
#pragma unroll
                    for (int n = 0; n < 2; ++n) { const f32x4 bs = *(const f32x4*)(base + off + bj * HALF + n * 16); const f32x4 o = bs + acc[ai][bj][m][n];
                        *(f32x4*)(out + off + bj * HALF + n * 16) = o;
                        u32x2 w; w.x = cvt_pk_bf16(o[0], o[1]); w.y = cvt_pk_bf16(o[2], o[3]); *(u32x2*)(ob + off + bj * HALF + n * 16) = w; }
                asm volatile("" ::: "memory"); }
    }
};
template <class Epi, class Sched, bool ALIGN_EPI = false, bool SP2 = false>
__device__ __forceinline__ void gemm_phase(PG8_LAS unsigned char* lds, const Gemm g, const Sched& S, const Epi& E) {
    const int tid = threadIdx.x, wid = __builtin_amdgcn_readfirstlane(tid >> 6), lane = tid & 63, wr = wid >> 2, wc = wid & 3, fr = lane & 15, fq = lane >> 4;
    const int K = g.K, nt = K / BK;
    unsigned voffA[2], voffB[2];
#pragma unroll
    for (int i = 0; i < 2; ++i) { int R, C; stage_rc(tid * 16 + i * 8192, R, C); const int Rb = Epi::PERM ? ((R & ~31) + perm32(R & 31)) : R;
        voffA[i] = (unsigned)(R * g.lda + C) * 2u; voffB[i] = (unsigned)(Rb * g.ldb + C) * 2u; }
    const size_t kstep = (size_t)(BK * 2);
    const size_t hstepA = (size_t)HALF * g.lda * 2, hstepB = (size_t)HALF * g.ldb * 2;
    const size_t tstepA = 2 * hstepA, tstepB = 2 * hstepB;
    const unsigned ldsw = (unsigned)wid * 1024u;
    const int aoff = lds_byte(wr * 64 + fr, fq * 8), boff = lds_byte(wc * 32 + fr, fq * 8);
#define PG8_SA(b, h) (((b) * 2 + (h)) * HTB)
#define PG8_SB(b, h) ((4 + (b) * 2 + (h)) * HTB)
#define PG8_STAGE(bufoff, gbase, voff) do { _Pragma("unroll") for (int _i = 0; _i < 2; ++_i) \
        __builtin_amdgcn_global_load_lds((const unsigned*)((const char*)(gbase) + (voff)[_i]), (PG8_LAS unsigned*)(lds + (bufoff) + ldsw + _i * 8192), 16, 0, 0); } while (0)
#define PG8_LDA(dst, b, h) do { _Pragma("unroll") for (int m = 0; m < 4; ++m) _Pragma("unroll") for (int k = 0; k < 2; ++k) dst[m][k] = *(const PG8_LAS bf16x8*)(lds + PG8_SA(b, h) + aoff + m * 2048 + k * 1024); } while (0)
#define PG8_LDB(dst, b, h) do { _Pragma("unroll") for (int n = 0; n < 2; ++n) _Pragma("unroll") for (int k = 0; k < 2; ++k) dst[n][k] = *(const PG8_LAS bf16x8*)(lds + PG8_SB(b, h) + boff + n * 2048 + k * 1024); } while (0)
#define PG8_MMA(ai, bj, At, Bt) do { __builtin_amdgcn_s_setprio(1); _Pragma("unroll") for (int m = 0; m < 4; ++m) _Pragma("unroll") for (int n = 0; n < 2; ++n) _Pragma("unroll") for (int k = 0; k < 2; ++k) \
        acc[ai][bj][m][n] = __builtin_amdgcn_mfma_f32_16x16x32_bf16(Bt[n][k], At[m][k], acc[ai][bj][m][n], 0, 0, 0); __builtin_amdgcn_s_setprio(0); } while (0)
#define PG8_WAIT_V(n) asm volatile("s_waitcnt vmcnt(" #n ")" ::: "memory")
#define PG8_WAIT_L(n) asm volatile("s_waitcnt lgkmcnt(" #n ")" ::: "memory")
#define PG8_BAR __builtin_amdgcn_s_barrier()
#define PG8_SCHED __builtin_amdgcn_sched_barrier(0)
    Unit cur, nxt; int ui = 0;
    if (!S.next(0, cur)) return;
    f32x4 acc[2][2][4][2];
#pragma unroll
    for (int a = 0; a < 2; ++a)
#pragma unroll
        for (int b = 0; b < 2; ++b)
#pragma unroll
            for (int m = 0; m < 4; ++m)
#pragma unroll
                for (int n = 0; n < 2; ++n) acc[a][b][m][n] = (f32x4){0.f, 0.f, 0.f, 0.f};
    bf16x8 At[4][2], B0[2][2], B1[2][2];
    const char* cA = (const char*)g.A + (size_t)cur.pm * tstepA; const char* cB = (const char*)g.Bt + (size_t)cur.pn * tstepB;
    S.a_ready(cur);
    if constexpr (SP2) {
        PG8_STAGE(PG8_SB(0, 0), cB, voffB); PG8_STAGE(PG8_SB(0, 1), cB + hstepB, voffB); PG8_STAGE(PG8_SA(0, 0), cA, voffA); PG8_STAGE(PG8_SA(0, 1), cA + hstepA, voffA);
        if (wr == 1) PG8_BAR;
        PG8_WAIT_V(2); PG8_BAR;
        PG8_STAGE(PG8_SB(1, 0), cB + kstep, voffB); PG8_STAGE(PG8_SA(1, 0), cA + kstep, voffA); PG8_STAGE(PG8_SB(1, 1), cB + hstepB + kstep, voffB);
        PG8_WAIT_V(6); PG8_BAR;
    } else {
        PG8_STAGE(PG8_SB(0, 0), cB, voffB); PG8_STAGE(PG8_SA(0, 0), cA, voffA); PG8_STAGE(PG8_SB(0, 1), cB + hstepB, voffB); PG8_STAGE(PG8_SA(0, 1), cA + hstepA, voffA);
        if (wr == 1) PG8_BAR;
        PG8_WAIT_V(4); PG8_BAR;
        PG8_STAGE(PG8_SB(1, 0), cB + kstep, voffB); PG8_STAGE(PG8_SA(1, 0), cA + kstep, voffA); PG8_STAGE(PG8_SB(1, 1), cB + hstepB + kstep, voffB);
        PG8_WAIT_V(6); PG8_BAR;
    }
    for (;;) {
        const bool has_next = S.next(ui + 1, nxt);
        const char* nA = has_next ? (const char*)g.A + (size_t)nxt.pm * tstepA : cA; const char* nB = has_next ? (const char*)g.Bt + (size_t)nxt.pn * tstepB : cB;
        for (int t = 0; t < nt; t += 2) {
            const bool last = (t == nt - 2);
            const char* a1 = cA + (size_t)(t + 1) * kstep;
            const char* a2 = last ? nA : cA + (size_t)(t + 2) * kstep; const char* b2 = last ? nB : cB + (size_t)(t + 2) * kstep;
            const char* a3 = a2 + kstep; const char* b3 = b2 + kstep;
            if (last && has_next) S.a_ready(nxt);
            if constexpr (SP2) {
            PG8_LDB(B0, 0, 0); PG8_LDB(B1, 0, 1); PG8_SCHED; PG8_LDA(At, 0, 0); PG8_STAGE(PG8_SA(1, 1), a1 + hstepA, voffA);
            PG8_WAIT_V(8); PG8_WAIT_L(0); PG8_BAR; PG8_MMA(0, 0, At, B0); PG8_MMA(0, 1, At, B1); PG8_BAR; PG8_SCHED;
            PG8_LDA(At, 0, 1); PG8_STAGE(PG8_SB(0, 0), b2, voffB); PG8_STAGE(PG8_SB(0, 1), b2 + hstepB, voffB); PG8_STAGE(PG8_SA(0, 0), a2, voffA);
            PG8_WAIT_V(8); PG8_WAIT_L(0); PG8_BAR; PG8_MMA(1, 0, At, B0); PG8_MMA(1, 1, At, B1); PG8_BAR; PG8_SCHED;
            PG8_LDB(B0, 1, 0); PG8_LDB(B1, 1, 1); PG8_SCHED; PG8_LDA(At, 1, 0); PG8_STAGE(PG8_SA(0, 1), a2 + hstepA, voffA);
            PG8_WAIT_V(8); PG8_WAIT_L(0); PG8_BAR; PG8_MMA(0, 0, At, B0); PG8_MMA(0, 1, At, B1); PG8_BAR; PG8_SCHED;
            PG8_LDA(At, 1, 1); PG8_STAGE(PG8_SB(1, 0), b3, voffB); PG8_STAGE(PG8_SB(1, 1), b3 + hstepB, voffB); PG8_STAGE(PG8_SA(1, 0), a3, voffA);
            PG8_WAIT_V(8); PG8_WAIT_L(0); PG8_BAR; PG8_MMA(1, 0, At, B0); PG8_MMA(1, 1, At, B1); PG8_BAR; PG8_SCHED;
            } else {
            PG8_LDB(B0, 0, 0); PG8_SCHED; PG8_LDA(At, 0, 0); PG8_STAGE(PG8_SA(1, 1), a1 + hstepA, voffA);
            PG8_WAIT_L(8); PG8_BAR; PG8_WAIT_L(0); PG8_MMA(0, 0, At, B0); PG8_BAR; PG8_SCHED;
            PG8_LDB(B1, 0, 1); PG8_STAGE(PG8_SB(0, 0), b2, voffB);
            PG8_BAR; PG8_WAIT_L(0); PG8_MMA(0, 1, At, B1); PG8_BAR;
            PG8_LDA(At, 0, 1); PG8_STAGE(PG8_SA(0, 0), a2, voffA);
            PG8_BAR; PG8_WAIT_L(0); PG8_MMA(1, 0, At, B0); PG8_BAR; PG8_SCHED;
            PG8_STAGE(PG8_SB(0, 1), b2 + hstepB, voffB);
            PG8_WAIT_V(6); PG8_BAR; PG8_MMA(1, 1, At, B1); PG8_BAR;
            PG8_LDB(B0, 1, 0); PG8_SCHED; PG8_LDA(At, 1, 0); PG8_STAGE(PG8_SA(0, 1), a2 + hstepA, voffA);
            PG8_WAIT_L(8); PG8_BAR; PG8_WAIT_L(0); PG8_MMA(0, 0, At, B0); PG8_BAR; PG8_SCHED;
            PG8_LDB(B1, 1, 1); PG8_STAGE(PG8_SB(1, 0), b3, voffB);
            PG8_BAR; PG8_WAIT_L(0); PG8_MMA(0, 1, At, B1); PG8_BAR;
            PG8_LDA(At, 1, 1); PG8_STAGE(PG8_SA(1, 0), a3, voffA);
            PG8_BAR; PG8_WAIT_L(0); PG8_MMA(1, 0, At, B0); PG8_BAR; PG8_SCHED;
            PG8_STAGE(PG8_SB(1, 1), b3 + hstepB, voffB);
            PG8_WAIT_V(6); PG8_BAR; PG8_MMA(1, 1, At, B1); PG8_BAR;
            }
        }
        if constexpr (ALIGN_EPI) { if (wr == 0) PG8_BAR; }
        if constexpr (!Epi::AFTER_DRAIN) { E(acc, cur, wr, wc, fr, fq); S.done(cur); }
        if (!has_next) break;
#pragma unroll
        for (int a = 0; a < 2; ++a)
#pragma unroll
            for (int b = 0; b < 2; ++b)
#pragma unroll
                for (int m = 0; m < 4; ++m)
#pragma unroll
                    for (int n = 0; n < 2; ++n) acc[a][b][m][n] = (f32x4){0.f, 0.f, 0.f, 0.f};
        cur = nxt; cA = nA; cB = nB; ++ui;
        if constexpr (ALIGN_EPI) { if (wr == 1) PG8_BAR; }
    }
    PG8_WAIT_V(0);
    if constexpr (!ALIGN_EPI) { if (wr == 0) PG8_BAR; }
    PG8_BAR;
    if constexpr (Epi::AFTER_DRAIN) { E.fused(acc, cur, wr, wc, fr, fq, lds, wid, lane); S.done(cur); }
#undef PG8_SA
#undef PG8_SB
#undef PG8_STAGE
#undef PG8_LDA
#undef PG8_LDB
#undef PG8_MMA
#undef PG8_WAIT_V
#undef PG8_WAIT_L
#undef PG8_BAR
#undef PG8_SCHED
}
}

constexpr int T_ = 16384, DM = 1024, NIN = 2432, NINP = 2560;
constexpr int C_Q = 256, C_K = 512, C_V = 640, C_BG = 768, C_CG = 1024, C_XIN = 1280, C_D = 1536;
constexpr int NWAVES = 8, NTHR = 512;
constexpr int LDS_BYTES = 147456;
constexpr size_t MiB = 1u << 20;
constexpr size_t WS_CTL = 0;
constexpr size_t CTL_BYTES = 65536;
constexpr size_t WS_MOD = 1 * MiB;
constexpr size_t WS_BIN = WS_MOD + 65536;
constexpr size_t WS_BGU = WS_BIN + 16384;
constexpr size_t WS_BR  = WS_BGU + 32768;
constexpr size_t WS_WRH = WS_BR + 1024;
constexpr size_t WS_WRL = WS_WRH + 98304;
constexpr size_t WS_W2T = WS_WRL + 98304;
constexpr size_t WS_A2T = WS_W2T + 16384;
constexpr size_t WS_G2T = WS_A2T + 16384;
constexpr size_t WS_V1T = WS_G2T + 32768;
constexpr size_t WS_V2T = WS_V1T + 16384;
constexpr size_t WS_PWT = WS_V2T + 16384;
constexpr size_t WS_RINV2 = WS_PWT + 32768;
static_assert(WS_RINV2 + 65536 <= 2 * MiB, "small region");
constexpr size_t WS_WIN = 2 * MiB;
constexpr size_t WS_WOUT = 7 * MiB;
constexpr size_t WS_WGU = 9 * MiB;
constexpr size_t WS_WD = 25 * MiB;
constexpr size_t WS_LIST = 33 * MiB;
constexpr size_t WS_WLIST = 35 * MiB;
constexpr size_t WS_VFIRST = 37 * MiB;
constexpr size_t WS_ACT = 45 * MiB;
constexpr size_t WS_P = 77 * MiB;
constexpr size_t WS_RW = 157 * MiB;
constexpr size_t RW_R = WS_RW, RW_K = WS_RW + 8 * MiB, RW_V = WS_RW + 16 * MiB, RW_KAP = WS_RW + 24 * MiB, RW_B = WS_RW + 32 * MiB, RW_G = WS_RW + 40 * MiB;
constexpr size_t RW_LD = WS_RW + 48 * MiB;
constexpr size_t RW_W1 = WS_RW + 56 * MiB, RW_U0T = WS_RW + 64 * MiB, RW_M = WS_RW + 72 * MiB, RW_N = WS_RW + 80 * MiB, RW_S0 = WS_RW + 88 * MiB;
constexpr size_t RW_BONUS = WS_RW + 96 * MiB;
constexpr size_t WS_END = WS_RW + 97 * MiB;
static_assert(WS_END <= 256 * MiB, "workspace");

struct Args { const float* in[34]; float* out; unsigned char* ws; int ph_lo, ph_hi; };

__device__ __forceinline__ unsigned f2bf(float f) { unsigned u = __builtin_bit_cast(unsigned, f); return (u + 0x7fffu + ((u >> 16) & 1u)) >> 16; }
__device__ __forceinline__ float bf2f(unsigned h) { return __builtin_bit_cast(float, h << 16); }
__device__ __forceinline__ unsigned pk2(float lo, float hi) { return f2bf(lo) | (f2bf(hi) << 16); }
__device__ __forceinline__ float bflo(unsigned w) { return __builtin_bit_cast(float, w << 16); }
__device__ __forceinline__ float bfhi(unsigned w) { return __builtin_bit_cast(float, w & 0xffff0000u); }
__device__ __forceinline__ float sigmoidf_(float x) { return 1.f / (1.f + __expf(-x)); }
__device__ __forceinline__ float wave_sum(float v) {
#pragma unroll
    for (int o = 1; o < 64; o <<= 1) v += __shfl_xor(v, o);
    return v;
}
#define LDS_WAIT() asm volatile("s_waitcnt lgkmcnt(0)" ::: "memory")
__device__ __forceinline__ int swz128(int r, int c) { return r * 128 + ((c ^ ((r >> 1) & 7)) << 4); }
__device__ __forceinline__ int swz256(int r, int c) { return r * 256 + ((c ^ (r & 15)) << 4); }
__device__ __forceinline__ int swz512(int r, int c) { return r * 512 + ((c ^ (r & 15)) << 4); }
__device__ __forceinline__ f32x4 mfma16(bf16x8 a, bf16x8 b, f32x4 c) { return __builtin_amdgcn_mfma_f32_16x16x32_bf16(a, b, c, 0, 0, 0); }

struct Frame {
    ldsp lds; int tid, lane, wave, G, bid;
    const float* const* in; float* out; unsigned char* ws;
};

__device__ __forceinline__ void phase_mod(Frame& F) {
    const float* c = F.in[1]; const float* w_ada = F.in[2]; const float* b_ada = F.in[3];
    float* mod = (float*)(F.ws + WS_MOD);
    LAS float* red = (LAS float*)F.lds;
    for (int it = F.bid; it < 192; it += F.G) {
        const int l = it / 96, n0 = (it % 96) * 64;
        const float* W = w_ada + (size_t)l * DM * 6144 + n0 + F.lane;
        const int k0 = F.wave * 128;
        float acc = 0.f;
#pragma unroll 8
        for (int k = 0; k < 128; ++k) { const float cv = c[k0 + k]; const float s = cv / (1.f + __expf(-cv)); acc += s * W[(size_t)(k0 + k) * 6144]; }
        red[F.wave * 64 + F.lane] = acc;
        __syncthreads();
        if (F.wave == 0) { float s = b_ada[l * 6144 + n0 + F.lane];
#pragma unroll
            for (int w = 0; w < 8; ++w) s += red[w * 64 + F.lane];
            mod[l * 6144 + n0 + F.lane] = s; }
        __syncthreads();
    }
}

__device__ __forceinline__ void transpose_strip(const float* W, int N, int K, int n0, const float* rs_a, const float* rs_b, const float* cs, const float* sh, float* bias_out,
                                                bf16_t* dst, int dst_row0, LAS float* scr, int lane) {
    const int col = lane & 31, kp = lane >> 5;
    const float csv = cs ? cs[n0 + col] : 1.f;
    float bacc = 0.f;
    for (int k0 = 0; k0 < K; k0 += 64) {
#pragma unroll 8
        for (int i = 0; i < 32; ++i) { const int kk = 2 * i + kp; const float wv = W[(size_t)(k0 + kk) * N + n0 + col];
            if (sh) bacc += sh[k0 + kk] * wv;
            float v = wv * csv; if (rs_a) v *= rs_a[k0 + kk] * (1.f + rs_b[k0 + kk]);
            scr[kk * 33 + col] = v; }
        LDS_WAIT();
        const int c = lane & 7;
#pragma unroll
        for (int j = 0; j < 4; ++j) { const int n = (lane >> 3) + 8 * j; const LAS float* s = scr + (8 * c) * 33 + n;
            u32x4 o; o.x = pk2(s[0 * 33], s[1 * 33]); o.y = pk2(s[2 * 33], s[3 * 33]); o.z = pk2(s[4 * 33], s[5 * 33]); o.w = pk2(s[6 * 33], s[7 * 33]);
            *(u32x4*)(dst + (size_t)(dst_row0 + n) * K + k0 + 8 * c) = o; }
        LDS_WAIT();
    }
    if (sh) { bacc += __shfl_xor(bacc, 32); if (lane < 32) bias_out[col] = bacc; }
}
__device__ __forceinline__ void phase_prep(Frame& F, int l) {
    LAS float* scr = (LAS float*)(F.lds + F.wave * 16384);
    const float* mod = (const float*)(F.ws + WS_MOD) + l * 6144;
    const float *sh1 = mod, *sc1 = mod + 1024, *gt1 = mod + 2048, *sh2 = mod + 3072, *sc2 = mod + 4096, *gt2 = mod + 5120;
    const float* n1g = F.in[4] + l * DM; const float* n2g = F.in[5] + l * DM;
    const float* w_in = F.in[6] + (size_t)l * DM * NIN; const float* w_out = F.in[7] + (size_t)l * DM * DM;
    const float* wg = F.in[30] + (size_t)l * 32 * DM * 128; const float* wu = F.in[31] + (size_t)l * 32 * DM * 128; const float* wd = F.in[32] + (size_t)l * 32 * 128 * DM;
    bf16_t* WIN = (bf16_t*)(F.ws + WS_WIN); bf16_t* WOUT = (bf16_t*)(F.ws + WS_WOUT); bf16_t* WGU = (bf16_t*)(F.ws + WS_WGU); bf16_t* WD = (bf16_t*)(F.ws + WS_WD);
    float* bias_in = (float*)(F.ws + WS_BIN); float* bias_gu = (float*)(F.ws + WS_BGU); float* bias_r = (float*)(F.ws + WS_BR);
    const int gw = F.bid * NWAVES + F.wave, NGW = F.G * NWAVES;
    constexpr int nA = 80, nB = 32, nC = 128, nD = 128, nE = 1024, nF = 48, nG = 6;
    constexpr int NIT = nA + nB + nC + nD + nE + nF + nG;
    for (int it = gw; it < NIT; it += NGW) {
        int r = it;
        if (r < nA) {
            if (r < 76) transpose_strip(w_in, NIN, DM, r * 32, n1g, sc1, nullptr, sh1, bias_in + r * 32, WIN, r * 32, scr, F.lane);
            else { for (int i = F.lane; i < 32 * 128; i += 64) { const int n = i >> 7, c = i & 127; *(u32x4*)(WIN + (size_t)(r * 32 + n) * DM + c * 8) = (u32x4){0u, 0u, 0u, 0u}; }
                   if (F.lane < 32) bias_in[r * 32 + F.lane] = 0.f; }
            continue; } r -= nA;
        if (r < nB) { transpose_strip(w_out, DM, DM, r * 32, nullptr, nullptr, gt1, nullptr, nullptr, WOUT, r * 32, scr, F.lane); continue; } r -= nB;
        if (r < nC) { const int e = r >> 2, s = r & 3; transpose_strip(wg + (size_t)e * DM * 128, 128, DM, s * 32, n2g, sc2, nullptr, sh2, bias_gu + e * 256 + s * 32, WGU + (size_t)e * 256 * DM, s * 32, scr, F.lane); continue; } r -= nC;
        if (r < nD) { const int e = r >> 2, s = r & 3; transpose_strip(wu + (size_t)e * DM * 128, 128, DM, s * 32, n2g, sc2, nullptr, sh2, bias_gu + e * 256 + 128 + s * 32, WGU + (size_t)e * 256 * DM, 128 + s * 32, scr, F.lane); continue; } r -= nD;
        if (r < nE) { const int e = r >> 5, s = r & 31; transpose_strip(wd + (size_t)e * 128 * DM, DM, 128, s * 32, nullptr, nullptr, gt2, nullptr, nullptr, WD + (size_t)e * DM * 128, s * 32, scr, F.lane); continue; } r -= nE;
        if (r < nF) {
            bf16_t* wh = (bf16_t*)(F.ws + WS_WRH) + r * DM; bf16_t* wl = (bf16_t*)(F.ws + WS_WRL) + r * DM;
            float bacc = 0.f;
            for (int k = F.lane; k < DM; k += 64) {
                float wv = 0.f;
                if (r < 4) wv = F.in[26][(size_t)l * DM * 4 + k * 4 + r]; else if (r < 36) wv = F.in[28][(size_t)l * DM * 32 + k * 32 + (r - 4)];
                bacc += sh2[k] * wv;
                const float v = wv * n2g[k] * (1.f + sc2[k]);
                const unsigned h = f2bf(v); const unsigned lo = f2bf(v - bf2f(h));
                wh[k] = (bf16_t)h; wl[k] = (bf16_t)lo; }
            bacc = wave_sum(bacc);
            if (F.lane == 0) { float b = 0.f; if (r < 4) b = F.in[27][l * 4 + r]; else if (r < 36) b = F.in[29][l * 32 + r - 4]; bias_r[r] = bacc + b; }
            continue; } r -= nF;
        if (r == 0) { const float* s = F.in[14] + l * 32 * 256; bf16_t* d = (bf16_t*)(F.ws + WS_W2T); for (int i = F.lane; i < 8192; i += 64) { const int n = i >> 5, k = i & 31; d[i] = (bf16_t)f2bf(s[k * 256 + n]); } }
        else if (r == 1) { const float* s = F.in[16] + l * 32 * 256; bf16_t* d = (bf16_t*)(F.ws + WS_A2T); for (int i = F.lane; i < 8192; i += 64) { const int n = i >> 5, k = i & 31; d[i] = (bf16_t)f2bf(s[k * 256 + n]); } }
        else if (r == 2) { const float* s = F.in[17] + l * 64 * 256; bf16_t* d = (bf16_t*)(F.ws + WS_G2T); for (int i = F.lane; i < 16384; i += 64) { const int n = i >> 6, k = i & 63; d[i] = (bf16_t)f2bf(s[k * 256 + n]); } }
        else if (r == 3) { if (l > 0) { const float* s = F.in[24] + (l - 1) * 256 * 32; bf16_t* d = (bf16_t*)(F.ws + WS_V1T); for (int i = F.lane; i < 8192; i += 64) { const int n = i >> 8, k = i & 255; d[i] = (bf16_t)f2bf(s[k * 32 + n]); } } }
        else if (r == 4) { if (l > 0) { const float* s = F.in[25] + (l - 1) * 32 * 256; bf16_t* d = (bf16_t*)(F.ws + WS_V2T); for (int i = F.lane; i < 8192; i += 64) { const int n = i >> 5, k = i & 31; d[i] = (bf16_t)f2bf(s[k * 256 + n]); } } }
        else { const float* s = F.in[8] + l * 4 * 64 * 64; bf16_t* d = (bf16_t*)(F.ws + WS_PWT); for (int i = F.lane; i < 16384; i += 64) { const int j = i >> 12, e = (i >> 6) & 63, c = i & 63; d[i] = (bf16_t)f2bf(s[(j * 64 + c) * 64 + e]); } }
    }
}

__device__ __forceinline__ void phase_rownorm(Frame& F, int mode) {
    const float* xin = (mode == 0) ? F.in[0] : F.out;
    const bf16_t* ys0 = (const bf16_t*)(F.ws + WS_P); const bf16_t* ys1 = ys0 + (size_t)T_ * DM;
    bf16_t* xn = (bf16_t*)(F.ws + WS_ACT);
    const float* fg = F.in[33];
    const int gw = F.bid * NWAVES + F.wave, NGW = F.G * NWAVES;
    for (int m = gw; m < T_; m += NGW) {
        const f32x4* xr = (const f32x4*)(xin + (size_t)m * DM) + F.lane;
        f32x4 v[4]; float s = 0.f;
#pragma unroll
        for (int j = 0; j < 4; ++j) v[j] = xr[64 * j];
        if (mode != 0) {
            const u32x2* a = (const u32x2*)(ys0 + (size_t)m * DM) + F.lane; const u32x2* b = (const u32x2*)(ys1 + (size_t)m * DM) + F.lane;
#pragma unroll
            for (int j = 0; j < 4; ++j) { const u32x2 ua = a[64 * j], ub = b[64 * j];
                v[j][0] += bflo(ua.x) + bflo(ub.x); v[j][1] += bfhi(ua.x) + bfhi(ub.x); v[j][2] += bflo(ua.y) + bflo(ub.y); v[j][3] += bfhi(ua.y) + bfhi(ub.y); }
        }
#pragma unroll
        for (int j = 0; j < 4; ++j) s += (v[j][0] * v[j][0] + v[j][1] * v[j][1]) + (v[j][2] * v[j][2] + v[j][3] * v[j][3]);
        const float rinv = 1.f / sqrtf(wave_sum(s) * (1.f / DM) + 1e-6f);
        if (mode == 2) {
            f32x4* o = (f32x4*)(F.out + (size_t)m * DM) + F.lane;
#pragma unroll
            for (int j = 0; j < 4; ++j) { const f32x4 g = *((const f32x4*)fg + F.lane + 64 * j); o[64 * j] = v[j] * rinv * g; }
        } else {
            if (mode == 1) { f32x4* o = (f32x4*)(F.out + (size_t)m * DM) + F.lane;
#pragma unroll
                for (int j = 0; j < 4; ++j) o[64 * j] = v[j]; }
            u32x2* o8 = (u32x2*)(xn + (size_t)m * DM) + F.lane;
#pragma unroll
            for (int j = 0; j < 4; ++j) { u32x2 w; w.x = pk2(v[j][0] * rinv, v[j][1] * rinv); w.y = pk2(v[j][2] * rinv, v[j][3] * rinv); o8[64 * j] = w; }
        }
    }
}

__device__ __forceinline__ void attn_item(Frame& F, int l, int item) {
    const int t0 = item * 128;
    const bf16_t* P = (const bf16_t*)(F.ws + WS_P);
    bf16_t* ycat = (bf16_t*)(F.ws + WS_ACT);
    ldsp Ks = F.lds, Vt = F.lds + 65536;
    for (int i = F.tid; i < 4096; i += NTHR) {
        const int ko = i >> 4, kvh = (i >> 3) & 1, c = i & 7; const int s = t0 - 128 + ko;
        u32x4 kv = (u32x4){0u, 0u, 0u, 0u}, vv = (u32x4){0u, 0u, 0u, 0u};
        if (s >= 0) { kv = *(const u32x4*)(P + (size_t)s * NINP + C_K + kvh * 64 + c * 8); vv = *(const u32x4*)(P + (size_t)s * NINP + C_V + kvh * 64 + c * 8); }
        *(LAS u32x4*)(Ks + kvh * 32768 + swz128(ko, c)) = kv;
        const int k32 = ko & 31, sg = ko >> 5, g = (k32 >> 2) & 3, j = ((k32 >> 4) << 2) | (k32 & 3), chunk = sg * 4 + g;
        const unsigned vw[4] = {vv.x, vv.y, vv.z, vv.w};
#pragma unroll
        for (int e = 0; e < 8; ++e) { const int d = c * 8 + e; const unsigned short val = (unsigned short)((e & 1) ? (vw[e >> 1] >> 16) : (vw[e >> 1] & 0xffffu));
            *(LAS unsigned short*)(Vt + kvh * 32768 + swz512(d, chunk) + j * 2) = val; }
    }
    __syncthreads();
    const int h = F.wave >> 1, half = F.wave & 1, kvh = h >> 1, fr = F.lane & 15, g = F.lane >> 4;
    const float slope = exp2f(-2.f * (float)(h + 1));
    const float sink = F.in[10][l * 4 + h];
    ldsp Kh = Ks + kvh * 32768, Vh = Vt + kvh * 32768;
#pragma unroll 1
    for (int qt = 0; qt < 4; ++qt) {
        const int q_lo = 64 * half + 16 * qt, qo = q_lo + fr, tile0 = (q_lo >> 5) << 1;
        bf16x8 qf[2];
#pragma unroll
        for (int ks = 0; ks < 2; ++ks) qf[ks] = *(const bf16x8*)(P + (size_t)(t0 + qo) * NINP + C_Q + h * 64 + ks * 32 + g * 8);
        f32x4 s[10];
#pragma unroll
        for (int kt = 0; kt < 10; ++kt) { s[kt] = (f32x4){0.f, 0.f, 0.f, 0.f};
#pragma unroll
            for (int ks = 0; ks < 2; ++ks) { const bf16x8 a = *(const LAS bf16x8*)(Kh + swz128((tile0 + kt) * 16 + fr, ks * 4 + g)); s[kt] = mfma16(a, qf[ks], s[kt]); } }
        float m = sink;
#pragma unroll
        for (int kt = 0; kt < 10; ++kt)
#pragma unroll
            for (int j = 0; j < 4; ++j) { const int ko = 16 * (tile0 + kt) + 4 * g + j; const int dist = qo + 128 - ko;
                const bool valid = (dist >= 0) && (dist < 128) && (t0 - 128 + ko >= 0);
                const float v = valid ? s[kt][j] * 0.125f - slope * (float)dist : -INFINITY; s[kt][j] = v; m = fmaxf(m, v); }
        m = fmaxf(m, __shfl_xor(m, 16)); m = fmaxf(m, __shfl_xor(m, 32));
        float sum = 0.f;
#pragma unroll
        for (int kt = 0; kt < 10; ++kt)
#pragma unroll
            for (int j = 0; j < 4; ++j) { const float p = __expf(s[kt][j] - m); s[kt][j] = p; sum += p; }
        sum += __shfl_xor(sum, 16); sum += __shfl_xor(sum, 32);
        const float inv = 1.f / (sum + __expf(sink - m));
        f32x4 o[4];
#pragma unroll
        for (int dt = 0; dt < 4; ++dt) o[dt] = (f32x4){0.f, 0.f, 0.f, 0.f};
#pragma unroll
        for (int ss = 0; ss < 5; ++ss) {
            u32x4 pw; pw.x = pk2(s[2 * ss][0], s[2 * ss][1]); pw.y = pk2(s[2 * ss][2], s[2 * ss][3]); pw.z = pk2(s[2 * ss + 1][0], s[2 * ss + 1][1]); pw.w = pk2(s[2 * ss + 1][2], s[2 * ss + 1][3]);
            const bf16x8 pb = __builtin_bit_cast(bf16x8, pw);
#pragma unroll
            for (int dt = 0; dt < 4; ++dt) { const bf16x8 a = *(const LAS bf16x8*)(Vh + swz512(dt * 16 + fr, ((tile0 >> 1) + ss) * 4 + g)); o[dt] = mfma16(a, pb, o[dt]); }
        }
#pragma unroll
        for (int dt = 0; dt < 4; ++dt) { u32x2 w; w.x = pk2(o[dt][0] * inv, o[dt][1] * inv); w.y = pk2(o[dt][2] * inv, o[dt][3] * inv);
            *(u32x2*)(ycat + (size_t)(t0 + qo) * DM + 256 + h * 64 + dt * 16 + 4 * g) = w; }
    }
    __syncthreads();
}

__device__ __forceinline__ void poolconv_item(Frame& F, int l, int item) {
    const int t0 = item * 128;
    const bf16_t* P = (const bf16_t*)(F.ws + WS_P);
    bf16_t* ycat = (bf16_t*)(F.ws + WS_ACT);
    ldsp U = F.lds;
    ldsp Dt = F.lds + 73728;
    for (int i = F.tid; i < 144 * 32; i += NTHR) { const int r = i >> 5, c = i & 31; const int s = t0 - 16 + r;
        u32x4 v = (u32x4){0u, 0u, 0u, 0u}; if (s >= 0) v = *(const u32x4*)(P + (size_t)s * NINP + c * 8);
        *(LAS u32x4*)(U + r * 512 + c * 16) = v; }
    __syncthreads();
    for (int i = F.tid; i < 128 * 32; i += NTHR) { const int tok = i >> 5, c8 = i & 31, j = c8 >> 3, w = 2 << j; const int t = t0 + tok;
        float acc[8];
#pragma unroll
        for (int e = 0; e < 8; ++e) acc[e] = 0.f;
        u32x4 cur = (u32x4){0u, 0u, 0u, 0u};
        for (int q = 0; q < w; ++q) { const u32x4 v = *(const LAS u32x4*)(U + (tok + 16 - q) * 512 + c8 * 16); if (q == 0) cur = v;
            acc[0] += bflo(v.x); acc[1] += bfhi(v.x); acc[2] += bflo(v.y); acc[3] += bfhi(v.y); acc[4] += bflo(v.z); acc[5] += bfhi(v.z); acc[6] += bflo(v.w); acc[7] += bfhi(v.w); }
        const float ic = 1.f / (float)((t + 1) < w ? (t + 1) : w);
        u32x4 o; o.x = pk2(acc[0] * ic - bflo(cur.x), acc[1] * ic - bfhi(cur.x)); o.y = pk2(acc[2] * ic - bflo(cur.y), acc[3] * ic - bfhi(cur.y));
        o.z = pk2(acc[4] * ic - bflo(cur.z), acc[5] * ic - bfhi(cur.z)); o.w = pk2(acc[6] * ic - bflo(cur.w), acc[7] * ic - bfhi(cur.w));
        *(LAS u32x4*)(Dt + j * 16384 + swz128(tok, c8 & 7)) = o; }
    __syncthreads();
    {
        const int j = F.wave >> 1, half = F.wave & 1, fr = F.lane & 15, g = F.lane >> 4;
        const bf16_t* pwt = (const bf16_t*)(F.ws + WS_PWT) + j * 4096;
        const float* psc = F.in[9] + l * 256 + j * 64;
        bf16x8 bfr[4][2];
#pragma unroll
        for (int n = 0; n < 4; ++n)
#pragma unroll
            for (int ks = 0; ks < 2; ++ks) bfr[n][ks] = *(const bf16x8*)(pwt + (16 * n + fr) * 64 + ks * 32 + g * 8);
#pragma unroll
        for (int m = 0; m < 4; ++m) {
            bf16x8 af[2];
#pragma unroll
            for (int ks = 0; ks < 2; ++ks) af[ks] = *(const LAS bf16x8*)(Dt + j * 16384 + swz128(64 * half + 16 * m + fr, ks * 4 + g));
#pragma unroll
            for (int n = 0; n < 4; ++n) { f32x4 acc = (f32x4){0.f, 0.f, 0.f, 0.f};
#pragma unroll
                for (int ks = 0; ks < 2; ++ks) acc = mfma16(bfr[n][ks], af[ks], acc);
                const f32x4 sc = *(const f32x4*)(psc + 16 * n + 4 * g);
                u32x2 w; w.x = pk2(acc[0] * sc[0], acc[1] * sc[1]); w.y = pk2(acc[2] * sc[2], acc[3] * sc[3]);
                *(u32x2*)(ycat + (size_t)(t0 + 64 * half + 16 * m + fr) * DM + j * 64 + 16 * n + 4 * g) = w; }
        }
    }
    const float* cw = F.in[11] + l * 3 * 256;
    for (int i = F.tid; i < 128 * 32; i += NTHR) { const int tok = i >> 5, c8 = i & 31; const int t = t0 + tok;
        float acc[8];
#pragma unroll
        for (int e = 0; e < 8; ++e) acc[e] = 0.f;
#pragma unroll
        for (int q = 0; q < 3; ++q) { const int s = t - 2 + q; if (s >= 0) {
                const u32x4 a = *(const u32x4*)(P + (size_t)s * NINP + C_CG + c8 * 8), b = *(const u32x4*)(P + (size_t)s * NINP + C_XIN + c8 * 8);
                const float* wq = cw + q * 256 + c8 * 8;
                acc[0] += wq[0] * bflo(a.x) * bflo(b.x); acc[1] += wq[1] * bfhi(a.x) * bfhi(b.x); acc[2] += wq[2] * bflo(a.y) * bflo(b.y); acc[3] += wq[3] * bfhi(a.y) * bfhi(b.y);
                acc[4] += wq[4] * bflo(a.z) * bflo(b.z); acc[5] += wq[5] * bfhi(a.z) * bfhi(b.z); acc[6] += wq[6] * bflo(a.w) * bflo(b.w); acc[7] += wq[7] * bfhi(a.w) * bfhi(b.w); } }
        const u32x4 bg = *(const u32x4*)(P + (size_t)t * NINP + C_BG + c8 * 8);
        u32x4 o; o.x = pk2(acc[0] * bflo(bg.x), acc[1] * bfhi(bg.x)); o.y = pk2(acc[2] * bflo(bg.y), acc[3] * bfhi(bg.y));
        o.z = pk2(acc[4] * bflo(bg.z), acc[5] * bfhi(bg.z)); o.w = pk2(acc[6] * bflo(bg.w), acc[7] * bfhi(bg.w));
        *(u32x4*)(ycat + (size_t)t * DM + 512 + c8 * 8) = o; }
    __syncthreads();
}

__device__ __forceinline__ u32x4 lerp8(u32x4 cur, u32x4 prv, const float* mu, int act) {
    const unsigned cw[4] = {cur.x, cur.y, cur.z, cur.w}, pw[4] = {prv.x, prv.y, prv.z, prv.w}; float z[8];
#pragma unroll
    for (int e = 0; e < 8; ++e) { const float c = (e & 1) ? bfhi(cw[e >> 1]) : bflo(cw[e >> 1]), p = (e & 1) ? bfhi(pw[e >> 1]) : bflo(pw[e >> 1]);
        float v = c + (p - c) * mu[e]; if (act == 1) v = tanhf(v); else if (act == 2) v = sigmoidf_(v); z[e] = v; }
    u32x4 o; o.x = pk2(z[0], z[1]); o.y = pk2(z[2], z[3]); o.z = pk2(z[4], z[5]); o.w = pk2(z[6], z[7]); return o;
}
__device__ __forceinline__ void rwkvprep_item(Frame& F, int l, int item) {
    const int t0 = item * 64;
    const bf16_t* P = (const bf16_t*)(F.ws + WS_P);
    const float* mu = F.in[12] + l * 896;
    ldsp Zw = F.lds, Za = F.lds + 4096, Zg = F.lds + 8192, Zv = F.lds + 16384, V1 = F.lds + 49152 + F.wave * 2048;
    const int nch = (l > 0) ? 48 : 16;
    for (int i = F.tid; i < 64 * nch; i += NTHR) { const int tok = i / nch, c = i % nch; const int t = t0 + tok;
        const int col = (c < 16) ? (768 + c * 8) : (512 + (c - 16) * 8);
        const u32x4 cur = *(const u32x4*)(P + (size_t)t * NINP + C_D + col);
        const u32x4 prv = (t > 0) ? *(const u32x4*)(P + (size_t)(t - 1) * NINP + C_D + col) : (u32x4){0u, 0u, 0u, 0u};
        const u32x4 z = lerp8(cur, prv, mu + col, c < 4 ? 1 : (c >= 8 && c < 16 ? 2 : 0));
        if (c < 4) *(LAS u32x4*)(Zw + tok * 64 + c * 16) = z;
        else if (c < 8) *(LAS u32x4*)(Za + tok * 64 + (c - 4) * 16) = z;
        else if (c < 16) *(LAS u32x4*)(Zg + swz128(tok, c - 8)) = z;
        else *(LAS u32x4*)(Zv + swz512(tok, c - 16)) = z; }
    __syncthreads();
    const int h = F.wave >> 1, half = F.wave & 1, fr = F.lane & 15, g = F.lane >> 4;
    const bf16_t* w2t = (const bf16_t*)(F.ws + WS_W2T); const bf16_t* a2t = (const bf16_t*)(F.ws + WS_A2T); const bf16_t* g2t = (const bf16_t*)(F.ws + WS_G2T);
    const bf16_t* v1t = (const bf16_t*)(F.ws + WS_V1T); const bf16_t* v2t = (const bf16_t*)(F.ws + WS_V2T);
    const float *w0 = F.in[13] + l * 256, *a0 = F.in[15] + l * 256, *kkp = F.in[18] + l * 256, *kap = F.in[19] + l * 256, *rkp = F.in[20] + l * 256;
    const float* v0 = (l > 0) ? F.in[23] + (l - 1) * 256 : nullptr;
    bf16_t *Rr = (bf16_t*)(F.ws + RW_R), *Rk = (bf16_t*)(F.ws + RW_K), *Rv = (bf16_t*)(F.ws + RW_V), *Rkap = (bf16_t*)(F.ws + RW_KAP), *Rb = (bf16_t*)(F.ws + RW_B), *Rg = (bf16_t*)(F.ws + RW_G);
    bf16_t* Rld = (bf16_t*)(F.ws + RW_LD); float* Rbon = (float*)(F.ws + RW_BONUS); bf16_t* VF = (bf16_t*)(F.ws + WS_VFIRST);
#pragma unroll 1
    for (int m = 0; m < 2; ++m) {
        asm volatile("" ::: "memory");
        f32x4 wl[4], al[4], gl[4], vl[4];
        { const int row = 32 * half + 16 * m + fr;
        const bf16x8 aw = *(const LAS bf16x8*)(Zw + row * 64 + g * 16), aa = *(const LAS bf16x8*)(Za + row * 64 + g * 16);
        const bf16x8 ag0 = *(const LAS bf16x8*)(Zg + swz128(row, g)), ag1 = *(const LAS bf16x8*)(Zg + swz128(row, 4 + g));
#pragma unroll
        for (int n = 0; n < 4; ++n) { const int nr = 64 * h + 16 * n + fr; const f32x4 z0 = (f32x4){0.f, 0.f, 0.f, 0.f};
            wl[n] = mfma16(*(const bf16x8*)(w2t + nr * 32 + g * 8), aw, z0);
            al[n] = mfma16(*(const bf16x8*)(a2t + nr * 32 + g * 8), aa, z0);
            gl[n] = mfma16(*(const bf16x8*)(g2t + nr * 64 + g * 8), ag0, z0); gl[n] = mfma16(*(const bf16x8*)(g2t + nr * 64 + 32 + g * 8), ag1, gl[n]);
            vl[n] = z0; }
        if (l > 0) {
            f32x4 t1[2]; t1[0] = (f32x4){0.f, 0.f, 0.f, 0.f}; t1[1] = t1[0];
#pragma unroll
            for (int ks = 0; ks < 8; ++ks) { const bf16x8 av = *(const LAS bf16x8*)(Zv + swz512(row, ks * 4 + g));
#pragma unroll
                for (int n = 0; n < 2; ++n) t1[n] = mfma16(*(const bf16x8*)(v1t + (16 * n + fr) * 256 + ks * 32 + g * 8), av, t1[n]); }
#pragma unroll
            for (int n = 0; n < 2; ++n) { u32x2 w; w.x = pk2(t1[n][0], t1[n][1]); w.y = pk2(t1[n][2], t1[n][3]); *(LAS u32x2*)(V1 + fr * 64 + (16 * n + 4 * g) * 2) = w; }
            LDS_WAIT();
            const bf16x8 a1 = *(const LAS bf16x8*)(V1 + fr * 64 + g * 16);
#pragma unroll
            for (int n = 0; n < 4; ++n) vl[n] = mfma16(*(const bf16x8*)(v2t + (64 * h + 16 * n + fr) * 32 + g * 8), a1, (f32x4){0.f, 0.f, 0.f, 0.f});
            LDS_WAIT();
        } }
        const int t = t0 + 32 * half + 16 * m + fr;
        float kkr[4][4], zr[4][4], kmod[4][4], av[4][4]; float ss = 0.f, bon = 0.f;
#pragma unroll
        for (int n = 0; n < 4; ++n) { const int ch = 64 * h + 16 * n + 4 * g;
            const bf16_t* pc = P + (size_t)t * NINP + C_D + ch; const bf16_t* pp = pc - NINP;
            const u32x2 rc = *(const u32x2*)(pc), kc = *(const u32x2*)(pc + 256), vc = *(const u32x2*)(pc + 512);
            u32x2 rp = (u32x2){0u, 0u}, kp = rp, vp = rp; if (t > 0) { rp = *(const u32x2*)(pp); kp = *(const u32x2*)(pp + 256); vp = *(const u32x2*)(pp + 512); }
            const float rcv[4] = {bflo(rc.x), bfhi(rc.x), bflo(rc.y), bfhi(rc.y)}, rpv[4] = {bflo(rp.x), bfhi(rp.x), bflo(rp.y), bfhi(rp.y)};
            const float kcv[4] = {bflo(kc.x), bfhi(kc.x), bflo(kc.y), bfhi(kc.y)}, kpv[4] = {bflo(kp.x), bfhi(kp.x), bflo(kp.y), bfhi(kp.y)};
            const float vcv[4] = {bflo(vc.x), bfhi(vc.x), bflo(vc.y), bfhi(vc.y)}, vpv[4] = {bflo(vp.x), bfhi(vp.x), bflo(vp.y), bfhi(vp.y)};
            float vout[4], ldv[4], gv[4];
            u32x2 vf = (u32x2){0u, 0u}; if (l > 0) vf = *(const u32x2*)(VF + (size_t)t * 256 + ch);
            const float vfv[4] = {bflo(vf.x), bfhi(vf.x), bflo(vf.y), bfhi(vf.y)};
#pragma unroll
            for (int j = 0; j < 4; ++j) { const int c = ch + j;
                const float r_ = rcv[j] + (rpv[j] - rcv[j]) * mu[c], k_ = kcv[j] + (kpv[j] - kcv[j]) * mu[256 + c], v_ = vcv[j] + (vpv[j] - vcv[j]) * mu[512 + c];
                const float wpre = w0[c] + wl[n][j]; const float y = -wpre; const float sp = fmaxf(y, 0.f) + log1pf(__expf(-fabsf(y)));
                const float w = -sp - 0.5f; ldv[j] = -__expf(w);
                const float a = sigmoidf_(a0[c] + al[n][j]); av[n][j] = a; gv[j] = gl[n][j];
                float vv = v_; if (l > 0) vv = v_ + (vfv[j] - v_) * sigmoidf_(v0[c] + vl[n][j]);
                vout[j] = vv; zr[n][j] = r_;
                const float kk = k_ * kkp[c]; kkr[n][j] = kk; ss += kk * kk;
                const float km = k_ * (1.f + (a - 1.f) * kap[c]); kmod[n][j] = km; bon += r_ * km * rkp[c]; }
            const size_t o = (size_t)t * 256 + ch;
            { u32x2 w; w.x = pk2(zr[n][0], zr[n][1]); w.y = pk2(zr[n][2], zr[n][3]); *(u32x2*)(Rr + o) = w; }
            { u32x2 w; w.x = pk2(kmod[n][0], kmod[n][1]); w.y = pk2(kmod[n][2], kmod[n][3]); *(u32x2*)(Rk + o) = w; }
            { u32x2 w; w.x = pk2(vout[0], vout[1]); w.y = pk2(vout[2], vout[3]); *(u32x2*)(Rv + o) = w; if (l == 0) *(u32x2*)(VF + o) = w; }
            { u32x2 w; w.x = pk2(gv[0], gv[1]); w.y = pk2(gv[2], gv[3]); *(u32x2*)(Rg + o) = w; }
            { u32x2 w; w.x = pk2(ldv[0], ldv[1]); w.y = pk2(ldv[2], ldv[3]); *(u32x2*)(Rld + o) = w; }
        }
        ss += __shfl_xor(ss, 16); ss += __shfl_xor(ss, 32); bon += __shfl_xor(bon, 16); bon += __shfl_xor(bon, 32);
        const float inn = 1.f / fmaxf(sqrtf(ss), 1e-12f);
#pragma unroll
        for (int n = 0; n < 4; ++n) { const size_t o = (size_t)t * 256 + 64 * h + 16 * n + 4 * g;
            float kp_[4], b_[4];
#pragma unroll
            for (int j = 0; j < 4; ++j) { kp_[j] = kkr[n][j] * inn; b_[j] = kp_[j] * av[n][j]; }
            { u32x2 w; w.x = pk2(kp_[0], kp_[1]); w.y = pk2(kp_[2], kp_[3]); *(u32x2*)(Rkap + o) = w; }
            { u32x2 w; w.x = pk2(b_[0], b_[1]); w.y = pk2(b_[2], b_[3]); *(u32x2*)(Rb + o) = w; } }
        if (g == 0) Rbon[(size_t)t * 4 + h] = bon;
    }
    __syncthreads();
}

__device__ __forceinline__ void mm_n(ldsp X, ldsp Y, int rb, int cb, int fr, int g, f32x4 (&acc)[2]) {
#pragma unroll
    for (int ks = 0; ks < 2; ++ks) { const bf16x8 xf = *(const LAS bf16x8*)(X + swz128(16 * rb + fr, ks * 4 + g));
#pragma unroll
        for (int n = 0; n < 2; ++n) { const bf16x8 yf = *(const LAS bf16x8*)(Y + swz128(32 * cb + 16 * n + fr, ks * 4 + g)); acc[n] = mfma16(yf, xf, acc[n]); } }
}
__device__ __forceinline__ void mm_t(ldsp X, ldsp Y, int rb, int cb, int fr, int g, f32x4 (&acc)[2]) {
#pragma unroll
    for (int ks = 0; ks < 2; ++ks) { const bf16x8 xf = *(const LAS bf16x8*)(X + swz128(16 * rb + fr, ks * 4 + g));
#pragma unroll
        for (int n = 0; n < 2; ++n) { const bf16x8 yf = *(const LAS bf16x8*)(Y + swz128(32 * cb + 16 * n + fr, ks * 4 + g)); acc[n] = mfma16(xf, yf, acc[n]); } }
}
__device__ __forceinline__ int adr_n(int rb, int cb, int n, int fr, int g) { return swz128(16 * rb + fr, 4 * cb + 2 * n + (g >> 1)) + (g & 1) * 8; }
__device__ __forceinline__ int adr_t(int rb, int cb, int n, int fr, int g) { return swz128(32 * cb + 16 * n + fr, 2 * rb + (g >> 1)) + (g & 1) * 8; }
__device__ __forceinline__ u32x2 pk4(f32x4 v) { u32x2 w; w.x = pk2(v[0], v[1]); w.y = pk2(v[2], v[3]); return w; }
__device__ __forceinline__ f32x4 up4(u32x2 w) { return (f32x4){bflo(w.x), bfhi(w.x), bflo(w.y), bfhi(w.y)}; }

__device__ __forceinline__ void chunk_prefix(Frame& F, const bf16_t* Rld, int t0, int h, LAS float* Lc, LAS float* seg) {
    { const int t = F.tid >> 3, c8 = F.tid & 7; const u32x4 v = *(const u32x4*)(Rld + (size_t)(t0 + t) * 256 + h * 64 + c8 * 8);
      LAS float* d = Lc + t * 64 + c8 * 8; d[0] = bflo(v.x); d[1] = bfhi(v.x); d[2] = bflo(v.y); d[3] = bfhi(v.y); d[4] = bflo(v.z); d[5] = bfhi(v.z); d[6] = bflo(v.w); d[7] = bfhi(v.w); }
    __syncthreads();
    { float s = 0.f;
#pragma unroll
      for (int i = 0; i < 8; ++i) { s += Lc[(8 * F.wave + i) * 64 + F.lane]; Lc[(8 * F.wave + i) * 64 + F.lane] = s; }
      seg[F.wave * 64 + F.lane] = s; }
    __syncthreads();
    { float off = 0.f;
      for (int w = 0; w < F.wave; ++w) off += seg[w * 64 + F.lane];
#pragma unroll
      for (int i = 0; i < 8; ++i) Lc[(8 * F.wave + i) * 64 + F.lane] += off; }
    __syncthreads();
}
__device__ __forceinline__ void unpack8(u32x4 v, float (&o)[8]) { o[0] = bflo(v.x); o[1] = bfhi(v.x); o[2] = bflo(v.y); o[3] = bfhi(v.y); o[4] = bflo(v.z); o[5] = bfhi(v.z); o[6] = bflo(v.w); o[7] = bfhi(v.w); }
__device__ __forceinline__ u32x4 pack8(const float (&o)[8]) { u32x4 w; w.x = pk2(o[0], o[1]); w.y = pk2(o[2], o[3]); w.z = pk2(o[4], o[5]); w.w = pk2(o[6], o[7]); return w; }
__device__ __forceinline__ void st_tr8(ldsp tile, int t, int c8, const float (&o)[8]) {
#pragma unroll
    for (int e = 0; e < 8; ++e) *(LAS unsigned short*)(tile + swz128(c8 * 8 + e, t >> 3) + (t & 7) * 2) = (unsigned short)f2bf(o[e]);
}

constexpr int R1_LC = 0, R1_SEG = 16384, R1_GC = 18432, R1_KQ = 20480, R1_BK = 28672, R1_KK = 36864, R1_KABS = 45056, R1_KABST = 53248, R1_BHT = 61440, R1_KHT = 69632, R1_VT = 77824,
              R1_E = 86016  , R1_Q = 102400  , R1_QT = 118784  , R1_AAK = 135168, R1_AVT = R1_Q, R1_W1T = R1_Q + 8192, R1_U0T = R1_QT;
__device__ __forceinline__ void rwkv_r1_item(Frame& F, int item) {
    const int c = item >> 2, h = item & 3, t0 = c * 64;
    const bf16_t *Rk = (const bf16_t*)(F.ws + RW_K), *Rv = (const bf16_t*)(F.ws + RW_V), *Rkap = (const bf16_t*)(F.ws + RW_KAP), *Rb = (const bf16_t*)(F.ws + RW_B), *Rld = (const bf16_t*)(F.ws + RW_LD);
    bf16_t *GW1 = (bf16_t*)(F.ws + RW_W1) + (size_t)item * 4096, *GU0T = (bf16_t*)(F.ws + RW_U0T) + (size_t)item * 4096, *GM = (bf16_t*)(F.ws + RW_M) + (size_t)item * 4096, *GN = (bf16_t*)(F.ws + RW_N) + (size_t)item * 4096;
    ldsp lds = F.lds; LAS float* Lc = (LAS float*)(lds + R1_LC); LAS float* seg = (LAS float*)(lds + R1_SEG); LAS float* GC = (LAS float*)(lds + R1_GC);
    const int rb = F.wave >> 1, cb = F.wave & 1, fr = F.lane & 15, g = F.lane >> 4;
    chunk_prefix(F, Rld, t0, h, Lc, seg);
    {   const int t = F.tid >> 3, c8 = F.tid & 7; const size_t go = (size_t)(t0 + t) * 256 + h * 64 + c8 * 8;
        float kap[8], b[8], k[8], v[8], o1[8], o2[8];
        unpack8(*(const u32x4*)(Rkap + go), kap); unpack8(*(const u32x4*)(Rb + go), b); unpack8(*(const u32x4*)(Rk + go), k); unpack8(*(const u32x4*)(Rv + go), v);
        float L[8], Lp[8], Lm[8], LC[8];
#pragma unroll
        for (int e = 0; e < 8; ++e) { const int cc = c8 * 8 + e; L[e] = Lc[t * 64 + cc]; Lp[e] = (t > 0) ? Lc[(t - 1) * 64 + cc] : 0.f; Lm[e] = Lc[31 * 64 + cc]; LC[e] = Lc[63 * 64 + cc]; }
#pragma unroll
        for (int e = 0; e < 8; ++e) o1[e] = kap[e] * __expf(Lp[e] - Lm[e]);
        *(LAS u32x4*)(lds + R1_KQ + swz128(t, c8)) = pack8(o1);
#pragma unroll
        for (int e = 0; e < 8; ++e) o1[e] = kap[e] * __expf(Lp[e]);
        *(LAS u32x4*)(lds + R1_KABS + swz128(t, c8)) = pack8(o1); st_tr8(lds + R1_KABST, t, c8, o1);
#pragma unroll
        for (int e = 0; e < 8; ++e) { const float s = __expf(Lm[e] - L[e]); o1[e] = b[e] * s; o2[e] = k[e] * s; }
        *(LAS u32x4*)(lds + R1_BK + swz128(t, c8)) = pack8(o1); *(LAS u32x4*)(lds + R1_KK + swz128(t, c8)) = pack8(o2);
#pragma unroll
        for (int e = 0; e < 8; ++e) { const float s = __expf(LC[e] - L[e]); o1[e] = b[e] * s; o2[e] = k[e] * s; }
        st_tr8(lds + R1_BHT, t, c8, o1); st_tr8(lds + R1_KHT, t, c8, o2); st_tr8(lds + R1_VT, t, c8, v);
        if (t == 63) {
#pragma unroll
            for (int e = 0; e < 8; ++e) GC[c8 * 8 + e] = __expf(LC[e]); }
    }
    __syncthreads();
    {
        f32x4 a[2] = {(f32x4){0.f, 0.f, 0.f, 0.f}, (f32x4){0.f, 0.f, 0.f, 0.f}}, at[2] = {a[0], a[0]}, k2[2] = {a[0], a[0]};
        mm_n(lds + R1_KQ, lds + R1_BK, rb, cb, fr, g, a); mm_t(lds + R1_KQ, lds + R1_BK, rb, cb, fr, g, at); mm_n(lds + R1_KQ, lds + R1_KK, rb, cb, fr, g, k2);
#pragma unroll
        for (int n = 0; n < 2; ++n) {
            f32x4 m1, m2, m3;
#pragma unroll
            for (int j = 0; j < 4; ++j) { const int tn = 16 * rb + fr, sn = 32 * cb + 16 * n + 4 * g + j; m1[j] = (sn < tn) ? a[n][j] : 0.f; m3[j] = (sn < tn) ? k2[n][j] : 0.f;
                const int tt = 16 * rb + 4 * g + j, st = 32 * cb + 16 * n + fr; m2[j] = (st < tt) ? at[n][j] : 0.f; }
            *(LAS u32x2*)(lds + R1_Q + adr_n(rb, cb, n, fr, g)) = pk4(m1); *(LAS u32x2*)(lds + R1_E + adr_n(rb, cb, n, fr, g)) = pk4(-m1);
            *(LAS u32x2*)(lds + R1_QT + adr_t(rb, cb, n, fr, g)) = pk4(m2); *(LAS u32x2*)(lds + R1_AAK + adr_n(rb, cb, n, fr, g)) = pk4(m3); }
    }
    __syncthreads();
    {
        f32x4 a[2] = {(f32x4){0.f, 0.f, 0.f, 0.f}, (f32x4){0.f, 0.f, 0.f, 0.f}}, at[2] = {a[0], a[0]};
        mm_n(lds + R1_Q, lds + R1_QT, rb, cb, fr, g, a); mm_t(lds + R1_Q, lds + R1_QT, rb, cb, fr, g, at);
#pragma unroll
        for (int n = 0; n < 2; ++n) { *(LAS u32x2*)(lds + R1_Q + 8192 + adr_n(rb, cb, n, fr, g)) = pk4(a[n]); *(LAS u32x2*)(lds + R1_QT + 8192 + adr_t(rb, cb, n, fr, g)) = pk4(at[n]); }
    }
    __syncthreads();
#pragma unroll 1
    for (int it = 0; it < 5; ++it) {
        ldsp Ecur = lds + R1_E + (it & 1) * 8192, Enew = lds + R1_E + ((it + 1) & 1) * 8192;
        ldsp Qcur = lds + R1_Q + ((it + 1) & 1) * 8192, Qnew = lds + R1_Q + (it & 1) * 8192, QTcur = lds + R1_QT + ((it + 1) & 1) * 8192, QTnew = lds + R1_QT + (it & 1) * 8192;
        f32x4 e[2];
#pragma unroll
        for (int n = 0; n < 2; ++n) e[n] = up4(*(const LAS u32x2*)(Ecur + adr_n(rb, cb, n, fr, g))) + up4(*(const LAS u32x2*)(Qcur + adr_n(rb, cb, n, fr, g)));
        mm_n(Ecur, QTcur, rb, cb, fr, g, e);
#pragma unroll
        for (int n = 0; n < 2; ++n) *(LAS u32x2*)(Enew + adr_n(rb, cb, n, fr, g)) = pk4(e[n]);
        if (it < 4) {
            f32x4 a[2] = {(f32x4){0.f, 0.f, 0.f, 0.f}, (f32x4){0.f, 0.f, 0.f, 0.f}}, at[2] = {a[0], a[0]};
            mm_n(Qcur, QTcur, rb, cb, fr, g, a); mm_t(Qcur, QTcur, rb, cb, fr, g, at);
#pragma unroll
            for (int n = 0; n < 2; ++n) { *(LAS u32x2*)(Qnew + adr_n(rb, cb, n, fr, g)) = pk4(a[n]); *(LAS u32x2*)(QTnew + adr_t(rb, cb, n, fr, g)) = pk4(at[n]); }
        }
        __syncthreads();
    }
    ldsp Ef = lds + R1_E + 8192;
    f32x4 avn[2];
    {
        avn[0] = (f32x4){0.f, 0.f, 0.f, 0.f}; avn[1] = avn[0]; f32x4 avt[2] = {avn[0], avn[0]};
        mm_n(lds + R1_AAK, lds + R1_VT, rb, cb, fr, g, avn); mm_t(lds + R1_AAK, lds + R1_VT, rb, cb, fr, g, avt);
        f32x4 w[2], wt[2];
#pragma unroll
        for (int n = 0; n < 2; ++n) { w[n] = up4(*(const LAS u32x2*)(lds + R1_KABS + adr_n(rb, cb, n, fr, g))); wt[n] = up4(*(const LAS u32x2*)(lds + R1_KABST + adr_t(rb, cb, n, fr, g))); }
        mm_n(Ef, lds + R1_KABST, rb, cb, fr, g, w); mm_t(Ef, lds + R1_KABST, rb, cb, fr, g, wt);
#pragma unroll
        for (int n = 0; n < 2; ++n) { *(LAS u32x2*)(lds + R1_AVT + adr_t(rb, cb, n, fr, g)) = pk4(avt[n]); *(LAS u32x2*)(lds + R1_W1T + adr_t(rb, cb, n, fr, g)) = pk4(wt[n]);
            *(u32x2*)(GW1 + (16 * rb + fr) * 64 + 32 * cb + 16 * n + 4 * g) = pk4(w[n]); }
    }
    __syncthreads();
    {
        f32x4 ut[2];
#pragma unroll
        for (int n = 0; n < 2; ++n) ut[n] = up4(*(const LAS u32x2*)(lds + R1_AVT + adr_t(rb, cb, n, fr, g)));
        mm_t(Ef, lds + R1_AVT, rb, cb, fr, g, ut);
        (void)avn;
#pragma unroll
        for (int n = 0; n < 2; ++n) { *(LAS u32x2*)(lds + R1_U0T + adr_t(rb, cb, n, fr, g)) = pk4(ut[n]); *(u32x2*)(GU0T + (32 * cb + 16 * n + fr) * 64 + 16 * rb + 4 * g) = pk4(ut[n]); }
    }
    __syncthreads();
    {
        f32x4 m[2] = {(f32x4){0.f, 0.f, 0.f, 0.f}, (f32x4){0.f, 0.f, 0.f, 0.f}}, n1[2] = {m[0], m[0]}, n2[2] = {m[0], m[0]};
        mm_n(lds + R1_BHT, lds + R1_W1T, rb, cb, fr, g, m); mm_t(lds + R1_KHT, lds + R1_VT, rb, cb, fr, g, n1); mm_t(lds + R1_BHT, lds + R1_U0T, rb, cb, fr, g, n2);
        float mo[8];
#pragma unroll
        for (int n = 0; n < 2; ++n)
#pragma unroll
            for (int j = 0; j < 4; ++j) { const int cr = 16 * rb + fr, cc = 32 * cb + 16 * n + 4 * g + j; mo[n * 4 + j] = ((cr == cc) ? GC[cr] : 0.f) - m[n][j]; }
        *(u32x4*)(GM + ((rb * 2 + cb) * 64 + F.lane) * 8) = pack8(mo);
#pragma unroll
        for (int n = 0; n < 2; ++n) *(u32x2*)(GN + (((2 * cb + n) * 4 + rb) * 64 + F.lane) * 4) = pk4(n1[n] - n2[n]);
    }
    __syncthreads();
}

__device__ __forceinline__ void rwkv_p2(Frame& F, int h) {
    if (F.wave >= 4) return;
    const int cb2 = F.wave, fr = F.lane & 15, g = F.lane >> 4;
    const bf16_t* GM = (const bf16_t*)(F.ws + RW_M); const bf16_t* GN = (const bf16_t*)(F.ws + RW_N); bf16_t* GS = (bf16_t*)(F.ws + RW_S0);
    f32x4 S[4];
#pragma unroll
    for (int mt = 0; mt < 4; ++mt) S[mt] = (f32x4){0.f, 0.f, 0.f, 0.f};
    bf16x8 Mf[4][2]; u32x2 Nf[4];
    { const size_t base = (size_t)(0 * 4 + h) * 4096;
#pragma unroll
      for (int mt = 0; mt < 4; ++mt) { Nf[mt] = *(const u32x2*)(GN + base + ((cb2 * 4 + mt) * 64 + F.lane) * 4);
#pragma unroll
        for (int ks = 0; ks < 2; ++ks) Mf[mt][ks] = *(const bf16x8*)(GM + base + ((mt * 2 + ks) * 64 + F.lane) * 8); } }
#pragma unroll 1
    for (int c = 0; c < T_ / 64; ++c) {
        const size_t base = (size_t)(c * 4 + h) * 4096;
        u32x4 sw[2];
#pragma unroll
        for (int ks = 0; ks < 2; ++ks) { const u32x2 lo = pk4(S[2 * ks]), hi = pk4(S[2 * ks + 1]); sw[ks] = (u32x4){lo.x, lo.y, hi.x, hi.y}; }
#pragma unroll
        for (int mt = 0; mt < 4; ++mt) { const u32x2 w = (mt & 1) ? (u32x2){sw[mt >> 1].z, sw[mt >> 1].w} : (u32x2){sw[mt >> 1].x, sw[mt >> 1].y};
            *(u32x2*)(GS + base + (16 * cb2 + fr) * 64 + 16 * mt + 4 * g) = w; }
        bf16x8 Mn[4][2]; u32x2 Nn[4];
        const size_t nb = (size_t)(((c + 1 < T_ / 64) ? c + 1 : c) * 4 + h) * 4096;
#pragma unroll
        for (int mt = 0; mt < 4; ++mt) { Nn[mt] = *(const u32x2*)(GN + nb + ((cb2 * 4 + mt) * 64 + F.lane) * 4);
#pragma unroll
            for (int ks = 0; ks < 2; ++ks) Mn[mt][ks] = *(const bf16x8*)(GM + nb + ((mt * 2 + ks) * 64 + F.lane) * 8); }
#pragma unroll
        for (int mt = 0; mt < 4; ++mt) { f32x4 a = up4(Nf[mt]);
#pragma unroll
            for (int ks = 0; ks < 2; ++ks) a = mfma16(Mf[mt][ks], __builtin_bit_cast(bf16x8, sw[ks]), a);
            S[mt] = a; }
#pragma unroll
        for (int mt = 0; mt < 4; ++mt) { Nf[mt] = Nn[mt];
#pragma unroll
            for (int ks = 0; ks < 2; ++ks) Mf[mt][ks] = Mn[mt][ks]; }
    }
}

constexpr int R3_RQ = 20480, R3_RABS = 28672, R3_BK = 36864, R3_KK = 45056, R3_VT = 53248, R3_S = 61440, R3_W1 = 69632, R3_UT = 77824, R3_ARB = 86016, R3_ARK = 94208, R3_ST = 102400;
__device__ __forceinline__ void rwkv_p3_item(Frame& F, int l, int item) {
    const int c = item >> 2, h = item & 3, t0 = c * 64;
    const bf16_t *Rr = (const bf16_t*)(F.ws + RW_R), *Rk = (const bf16_t*)(F.ws + RW_K), *Rv = (const bf16_t*)(F.ws + RW_V), *Rb = (const bf16_t*)(F.ws + RW_B), *Rg = (const bf16_t*)(F.ws + RW_G), *Rld = (const bf16_t*)(F.ws + RW_LD);
    const bf16_t *GW1 = (const bf16_t*)(F.ws + RW_W1) + (size_t)item * 4096, *GU0T = (const bf16_t*)(F.ws + RW_U0T) + (size_t)item * 4096, *GS = (const bf16_t*)(F.ws + RW_S0) + (size_t)item * 4096;
    const float* Rbon = (const float*)(F.ws + RW_BONUS); bf16_t* ycat = (bf16_t*)(F.ws + WS_ACT);
    ldsp lds = F.lds; LAS float* Lc = (LAS float*)(lds + R1_LC); LAS float* seg = (LAS float*)(lds + R1_SEG); LAS float* ST = (LAS float*)(lds + R3_ST);
    const int rb = F.wave >> 1, cb = F.wave & 1, fr = F.lane & 15, g = F.lane >> 4;
    chunk_prefix(F, Rld, t0, h, Lc, seg);
    {   const int t = F.tid >> 3, c8 = F.tid & 7; const size_t go = (size_t)(t0 + t) * 256 + h * 64 + c8 * 8;
        float r[8], b[8], k[8], v[8], o1[8], o2[8];
        unpack8(*(const u32x4*)(Rr + go), r); unpack8(*(const u32x4*)(Rb + go), b); unpack8(*(const u32x4*)(Rk + go), k); unpack8(*(const u32x4*)(Rv + go), v);
        float L[8], Lm[8];
#pragma unroll
        for (int e = 0; e < 8; ++e) { const int cc = c8 * 8 + e; L[e] = Lc[t * 64 + cc]; Lm[e] = Lc[31 * 64 + cc]; }
#pragma unroll
        for (int e = 0; e < 8; ++e) { o1[e] = r[e] * __expf(L[e] - Lm[e]); o2[e] = r[e] * __expf(L[e]); }
        *(LAS u32x4*)(lds + R3_RQ + swz128(t, c8)) = pack8(o1); *(LAS u32x4*)(lds + R3_RABS + swz128(t, c8)) = pack8(o2);
#pragma unroll
        for (int e = 0; e < 8; ++e) { const float s = __expf(Lm[e] - L[e]); o1[e] = b[e] * s; o2[e] = k[e] * s; }
        *(LAS u32x4*)(lds + R3_BK + swz128(t, c8)) = pack8(o1); *(LAS u32x4*)(lds + R3_KK + swz128(t, c8)) = pack8(o2);
        st_tr8(lds + R3_VT, t, c8, v);
        *(LAS u32x4*)(lds + R3_S + swz128(t, c8)) = *(const u32x4*)(GS + t * 64 + c8 * 8);
        *(LAS u32x4*)(lds + R3_W1 + swz128(t, c8)) = *(const u32x4*)(GW1 + t * 64 + c8 * 8);
    }
    __syncthreads();
    f32x4 y[2];
    {   f32x4 ut[2];
#pragma unroll
        for (int n = 0; n < 2; ++n) ut[n] = up4(*(const u32x2*)(GU0T + (32 * cb + 16 * n + fr) * 64 + 16 * rb + 4 * g));
        mm_t(lds + R3_W1, lds + R3_S, rb, cb, fr, g, ut);
        f32x4 ab[2] = {(f32x4){0.f, 0.f, 0.f, 0.f}, (f32x4){0.f, 0.f, 0.f, 0.f}}, ak[2] = {ab[0], ab[0]};
        mm_n(lds + R3_RQ, lds + R3_BK, rb, cb, fr, g, ab); mm_n(lds + R3_RQ, lds + R3_KK, rb, cb, fr, g, ak);
        y[0] = (f32x4){0.f, 0.f, 0.f, 0.f}; y[1] = y[0];
        mm_n(lds + R3_RABS, lds + R3_S, rb, cb, fr, g, y);
#pragma unroll
        for (int n = 0; n < 2; ++n) {
            f32x4 m1, m2;
#pragma unroll
            for (int j = 0; j < 4; ++j) { const int tn = 16 * rb + fr, sn = 32 * cb + 16 * n + 4 * g + j; m1[j] = (sn <= tn) ? ab[n][j] : 0.f; m2[j] = (sn <= tn) ? ak[n][j] : 0.f; }
            *(LAS u32x2*)(lds + R3_UT + adr_t(rb, cb, n, fr, g)) = pk4(ut[n]);
            *(LAS u32x2*)(lds + R3_ARB + adr_n(rb, cb, n, fr, g)) = pk4(m1); *(LAS u32x2*)(lds + R3_ARK + adr_n(rb, cb, n, fr, g)) = pk4(m2); }
    }
    __syncthreads();
    {   f32x4 z[2] = {(f32x4){0.f, 0.f, 0.f, 0.f}, (f32x4){0.f, 0.f, 0.f, 0.f}};
        mm_n(lds + R3_ARB, lds + R3_UT, rb, cb, fr, g, z); mm_n(lds + R3_ARK, lds + R3_VT, rb, cb, fr, g, y);
        y[0] -= z[0]; y[1] -= z[1];
        float s1 = 0.f, s2 = 0.f;
#pragma unroll
        for (int n = 0; n < 2; ++n)
#pragma unroll
            for (int j = 0; j < 4; ++j) { s1 += y[n][j]; s2 += y[n][j] * y[n][j]; }
        s1 += __shfl_xor(s1, 16); s1 += __shfl_xor(s1, 32); s2 += __shfl_xor(s2, 16); s2 += __shfl_xor(s2, 32);
        if (g == 0) { ST[((16 * rb + fr) * 2 + cb) * 2] = s1; ST[((16 * rb + fr) * 2 + cb) * 2 + 1] = s2; }
    }
    __syncthreads();
    {   const int tl = 16 * rb + fr; const int t = t0 + tl;
        const float s1 = ST[(tl * 2) * 2] + ST[(tl * 2 + 1) * 2], s2 = ST[(tl * 2) * 2 + 1] + ST[(tl * 2 + 1) * 2 + 1];
        const float mean = s1 * (1.f / 64.f), var = fmaxf(s2 * (1.f / 64.f) - mean * mean, 0.f), rstd = 1.f / sqrtf(var + 64e-5f);
        const float bon = Rbon[(size_t)t * 4 + h];
        const float *lng = F.in[21] + l * 256 + h * 64, *lnb = F.in[22] + l * 256 + h * 64;
#pragma unroll
        for (int n = 0; n < 2; ++n) { const int i0 = 32 * cb + 16 * n + 4 * g; const size_t go = (size_t)t * 256 + h * 64 + i0;
            const f32x4 vv = up4(*(const u32x2*)(Rv + go)), gg = up4(*(const u32x2*)(Rg + go)); const f32x4 lg = *(const f32x4*)(lng + i0), lb = *(const f32x4*)(lnb + i0);
            f32x4 o;
#pragma unroll
            for (int j = 0; j < 4; ++j) o[j] = ((y[n][j] - mean) * rstd * lg[j] + lb[j] + bon * vv[j]) * gg[j];
            *(u32x2*)(ycat + (size_t)t * DM + 768 + h * 64 + i0) = pk4(o); }
    }
    __syncthreads();
}

__device__ __forceinline__ void phase_router(Frame& F, int l) {
    const float* X = F.out;
    const bf16_t* WH = (const bf16_t*)(F.ws + WS_WRH); const bf16_t* WL = (const bf16_t*)(F.ws + WS_WRL);
    const float* bias_r = (const float*)(F.ws + WS_BR);
    float* rinv2 = (float*)(F.ws + WS_RINV2);
    unsigned* cnt = (unsigned*)(F.ws + WS_CTL) + l * 64;
    unsigned* list = (unsigned*)(F.ws + WS_LIST); float* wlist = (float*)(F.ws + WS_WLIST);
    LAS float* Lg = (LAS float*)(F.lds + F.wave * 4096);
    const int fr = F.lane & 15, g = F.lane >> 4;
    const int gw = F.bid * NWAVES + F.wave, NGW = F.G * NWAVES;
    for (int it = gw; it < T_ / 16; it += NGW) {
        const int t = it * 16 + fr;
        const float* xr = X + (size_t)t * DM + g * 8;
        f32x4 acc[3]; acc[0] = (f32x4){0.f, 0.f, 0.f, 0.f}; acc[1] = acc[0]; acc[2] = acc[0];
        float ss = 0.f;
#pragma unroll 2
        for (int ks = 0; ks < 32; ++ks) {
            const f32x4 x0 = *(const f32x4*)(xr + ks * 32), x1 = *(const f32x4*)(xr + ks * 32 + 4);
            const float xv[8] = {x0[0], x0[1], x0[2], x0[3], x1[0], x1[1], x1[2], x1[3]};
            unsigned hh[8], ll[8];
#pragma unroll
            for (int e = 0; e < 8; ++e) { ss += xv[e] * xv[e]; hh[e] = f2bf(xv[e]); ll[e] = f2bf(xv[e] - bf2f(hh[e])); }
            u32x4 hw, lw; hw.x = hh[0] | (hh[1] << 16); hw.y = hh[2] | (hh[3] << 16); hw.z = hh[4] | (hh[5] << 16); hw.w = hh[6] | (hh[7] << 16);
            lw.x = ll[0] | (ll[1] << 16); lw.y = ll[2] | (ll[3] << 16); lw.z = ll[4] | (ll[5] << 16); lw.w = ll[6] | (ll[7] << 16);
            const bf16x8 xh = __builtin_bit_cast(bf16x8, hw), xl = __builtin_bit_cast(bf16x8, lw);
#pragma unroll
            for (int n = 0; n < 3; ++n) { const bf16x8 wh = *(const bf16x8*)(WH + (16 * n + fr) * DM + ks * 32 + g * 8), wl = *(const bf16x8*)(WL + (16 * n + fr) * DM + ks * 32 + g * 8);
                acc[n] = mfma16(wh, xh, acc[n]); acc[n] = mfma16(wh, xl, acc[n]); acc[n] = mfma16(wl, xh, acc[n]); }
        }
        ss += __shfl_xor(ss, 16); ss += __shfl_xor(ss, 32);
        const float rinv = 1.f / sqrtf(ss * (1.f / DM) + 1e-6f);
#pragma unroll
        for (int n = 0; n < 3; ++n)
#pragma unroll
            for (int j = 0; j < 4; ++j) { const int c = 16 * n + 4 * g + j; Lg[fr * 48 + c] = acc[n][j] * rinv + bias_r[c]; }
        LDS_WAIT();
        if (F.lane < 16) {
            const LAS float* lg = Lg + F.lane * 48; const int tt = it * 16 + F.lane;
            rinv2[tt] = rinv;
            int gi = 0; float gm = lg[0];
#pragma unroll
            for (int k = 1; k < 4; ++k) if (lg[k] > gm) { gm = lg[k]; gi = k; }
            float gs = 0.f;
#pragma unroll
            for (int k = 0; k < 4; ++k) gs += __expf(lg[k] - gm);
            const float gp = 1.f / gs;
            int e0 = 0; float v0 = lg[4 + gi * 8];
#pragma unroll
            for (int k = 1; k < 8; ++k) { const float v = lg[4 + gi * 8 + k]; if (v > v0) { v0 = v; e0 = k; } }
            int e1 = -1; float v1 = -INFINITY;
#pragma unroll
            for (int k = 0; k < 8; ++k) { const float v = lg[4 + gi * 8 + k]; if (k != e0 && v > v1) { v1 = v; e1 = k; } }
            const float ex = __expf(v1 - v0); const float w0 = gp / (1.f + ex), w1 = gp * ex / (1.f + ex);
            const int E0 = gi * 8 + e0, E1 = gi * 8 + e1;
            const unsigned p0 = atomicAdd(&cnt[E0], 1u); list[(size_t)E0 * T_ + p0] = (unsigned)tt; wlist[(size_t)E0 * T_ + p0] = w0;
            const unsigned p1 = atomicAdd(&cnt[E1], 1u); list[(size_t)E1 * T_ + p1] = (unsigned)tt | 0x80000000u; wlist[(size_t)E1 * T_ + p1] = w1;
        }
        LDS_WAIT();
    }
}

__device__ __forceinline__ void phase_moe(Frame& F, int l) {
    const bf16_t* XB = (const bf16_t*)(F.ws + WS_RW);
    const bf16_t* WGU = (const bf16_t*)(F.ws + WS_WGU); const bf16_t* WD = (const bf16_t*)(F.ws + WS_WD);
    const float* bias_gu = (const float*)(F.ws + WS_BGU); const float* rinv2 = (const float*)(F.ws + WS_RINV2);
    const unsigned* cnt = (const unsigned*)(F.ws + WS_CTL) + l * 64;
    const unsigned* list = (const unsigned*)(F.ws + WS_LIST); const float* wlist = (const float*)(F.ws + WS_WLIST);
    bf16_t* ys = (bf16_t*)(F.ws + WS_P);
    ldsp At = F.lds, Bt = F.lds + 16384, Bd = F.lds, Act = F.lds + 65536;
    LAS unsigned* tokl = (LAS unsigned*)(F.lds + 98304); LAS float* wtl = (LAS float*)(F.lds + 98304 + 512); LAS float* rvl = (LAS float*)(F.lds + 98304 + 1024);
    const int wr = F.wave >> 2, wc = F.wave & 3, fr = F.lane & 15, g = F.lane >> 4;
    int total = 0;
    for (int e = 0; e < 32; ++e) total += ((int)cnt[e] + 127) >> 7;
    for (int ti = F.bid; ti < total; ti += F.G) {
        int e = 0, acc_t = 0, m0 = 0, ne = 0;
        for (int k = 0; k < 32; ++k) { const int n = (int)cnt[k]; const int nt = (n + 127) >> 7; if (ti >= acc_t && ti < acc_t + nt) { e = k; m0 = (ti - acc_t) * 128; ne = n; } acc_t += nt; }
        const int nrows = (ne - m0) < 128 ? (ne - m0) : 128;
        __syncthreads();
        if (F.tid < 128) { unsigned tk = 0u; float w = 0.f; if (F.tid < nrows) { tk = list[(size_t)e * T_ + m0 + F.tid]; w = wlist[(size_t)e * T_ + m0 + F.tid]; }
            tokl[F.tid] = tk; wtl[F.tid] = w; rvl[F.tid] = rinv2[tk & 0x7fffffffu]; }
        __syncthreads();
        f32x4 ag[4][2], au[4][2];
#pragma unroll
        for (int m = 0; m < 4; ++m)
#pragma unroll
            for (int n = 0; n < 2; ++n) { ag[m][n] = (f32x4){0.f, 0.f, 0.f, 0.f}; au[m][n] = ag[m][n]; }
        const bf16_t* wgu = WGU + (size_t)e * 256 * DM;
        for (int kt = 0; kt < 16; ++kt) {
            u32x4 ra[2], rb[4];
#pragma unroll
            for (int i = 0; i < 2; ++i) { const int idx = F.tid + i * NTHR, row = idx >> 3, c = idx & 7; const unsigned tk = tokl[row] & 0x7fffffffu; ra[i] = *(const u32x4*)(XB + (size_t)tk * DM + kt * 64 + c * 8); }
#pragma unroll
            for (int i = 0; i < 4; ++i) { const int idx = F.tid + i * NTHR, row = idx >> 3, c = idx & 7; rb[i] = *(const u32x4*)(wgu + (size_t)row * DM + kt * 64 + c * 8); }
            __syncthreads();
#pragma unroll
            for (int i = 0; i < 2; ++i) { const int idx = F.tid + i * NTHR, row = idx >> 3, c = idx & 7; *(LAS u32x4*)(At + swz128(row, c)) = ra[i]; }
#pragma unroll
            for (int i = 0; i < 4; ++i) { const int idx = F.tid + i * NTHR, row = idx >> 3, c = idx & 7; *(LAS u32x4*)(Bt + swz128(row, c)) = rb[i]; }
            __syncthreads();
#pragma unroll
            for (int ks = 0; ks < 2; ++ks) {
                bf16x8 af[4], bg_[2], bu_[2];
#pragma unroll
                for (int m = 0; m < 4; ++m) af[m] = *(const LAS bf16x8*)(At + swz128(64 * wr + 16 * m + fr, ks * 4 + g));
#pragma unroll
                for (int n = 0; n < 2; ++n) { bg_[n] = *(const LAS bf16x8*)(Bt + swz128(32 * wc + 16 * n + fr, ks * 4 + g)); bu_[n] = *(const LAS bf16x8*)(Bt + swz128(128 + 32 * wc + 16 * n + fr, ks * 4 + g)); }
#pragma unroll
                for (int m = 0; m < 4; ++m)
#pragma unroll
                    for (int n = 0; n < 2; ++n) { ag[m][n] = mfma16(bg_[n], af[m], ag[m][n]); au[m][n] = mfma16(bu_[n], af[m], au[m][n]); }
            }
        }
        const float* bge = bias_gu + e * 256;
#pragma unroll
        for (int m = 0; m < 4; ++m) { const int row = 64 * wr + 16 * m + fr; const float rv = rvl[row], wt = wtl[row];
#pragma unroll
            for (int n = 0; n < 2; ++n) { const int f0 = 32 * wc + 16 * n + 4 * g; float a_[4];
#pragma unroll
                for (int j = 0; j < 4; ++j) { const float gv = ag[m][n][j] * rv + bge[f0 + j], uv = au[m][n][j] * rv + bge[128 + f0 + j]; a_[j] = gv * sigmoidf_(gv) * uv * wt; }
                u32x2 w; w.x = pk2(a_[0], a_[1]); w.y = pk2(a_[2], a_[3]);
                *(LAS u32x2*)(Act + swz256(row, f0 >> 3) + (g & 1) * 8) = w; } }
        const bf16_t* wd = WD + (size_t)e * DM * 128;
#pragma unroll 1
        for (int nc = 0; nc < 4; ++nc) {
            __syncthreads();
#pragma unroll
            for (int i = 0; i < 8; ++i) { const int idx = F.tid + i * NTHR, row = idx >> 4, c = idx & 15; *(LAS u32x4*)(Bd + swz256(row, c)) = *(const u32x4*)(wd + (size_t)(nc * 256 + row) * 128 + c * 8); }
            __syncthreads();
            f32x4 ao[4][4];
#pragma unroll
            for (int m = 0; m < 4; ++m)
#pragma unroll
                for (int n = 0; n < 4; ++n) ao[m][n] = (f32x4){0.f, 0.f, 0.f, 0.f};
#pragma unroll
            for (int ks = 0; ks < 4; ++ks) {
                bf16x8 af[4], bf_[4];
#pragma unroll
                for (int m = 0; m < 4; ++m) af[m] = *(const LAS bf16x8*)(Act + swz256(64 * wr + 16 * m + fr, ks * 4 + g));
#pragma unroll
                for (int n = 0; n < 4; ++n) bf_[n] = *(const LAS bf16x8*)(Bd + swz256(64 * wc + 16 * n + fr, ks * 4 + g));
#pragma unroll
                for (int m = 0; m < 4; ++m)
#pragma unroll
                    for (int n = 0; n < 4; ++n) ao[m][n] = mfma16(bf_[n], af[m], ao[m][n]);
            }
#pragma unroll
            for (int m = 0; m < 4; ++m) { const int row = 64 * wr + 16 * m + fr;
                if (row < nrows) { const unsigned tk = tokl[row]; bf16_t* dst = ys + ((size_t)(tk >> 31) * T_ + (tk & 0x7fffffffu)) * DM + nc * 256 + 64 * wc + 4 * g;
#pragma unroll
                    for (int n = 0; n < 4; ++n) { u32x2 w; w.x = pk2(ao[m][n][0], ao[m][n][1]); w.y = pk2(ao[m][n][2], ao[m][n][3]); *(u32x2*)(dst + 16 * n) = w; } } }
        }
    }
    __syncthreads();
}

#define XB_TMO      128
#define XB_XCNT(j)  (256  + 64 * (j))
#define XB_XSUB(j)  (1280 + 64 * (j))
#define XB_XGEN(j)  (2304 + 64 * (j))
#define XB_TOP      3328
#define XB_TOPGEN   3392
#define XCD_BAR_WORDS 3456
#define XB_SPIN_CAP (1u << 18)
__device__ __forceinline__ unsigned xb_ld(unsigned* p)              { return __hip_atomic_load(p, __ATOMIC_RELAXED, __HIP_MEMORY_SCOPE_AGENT); }
__device__ __forceinline__ unsigned xb_add(unsigned* p, unsigned v) { return __hip_atomic_fetch_add(p, v, __ATOMIC_RELAXED, __HIP_MEMORY_SCOPE_AGENT); }
__device__ __forceinline__ unsigned xb_xcc_id() { return (unsigned)__builtin_amdgcn_s_getreg((3 << 11) | 20) & 0xFu; }
#define XB_SPIN(cond, bar) do { unsigned _sp = 0; while (cond) { __builtin_amdgcn_s_sleep(1); \
    if ((++_sp & 255u) == 0u) { if (xb_ld(&(bar)[XB_TMO])) break; if (_sp > XB_SPIN_CAP) { atomicAdd(&(bar)[XB_TMO], 1u); break; } } } } while (0)
struct XcdBarrier { unsigned* bar; unsigned x; volatile LAS unsigned* st; };
__device__ __forceinline__ XcdBarrier xcd_barrier_post(unsigned* bar, volatile LAS unsigned* st) {
    XcdBarrier b; b.bar = bar; b.x = xb_xcc_id(); b.st = st;
    if (threadIdx.x == 0) (void)xb_add(&bar[XB_XCNT(b.x)], 1u);
    return b;
}
__device__ __forceinline__ void xcd_barrier_complete(unsigned* bar, unsigned x, unsigned& nloc, unsigned& nx) {
    const unsigned G = gridDim.x * gridDim.y * gridDim.z;
    unsigned sum, cnt, mine, sp = 0u;
    for (;;) {
        sum = 0u; cnt = 0u; mine = 0u;
#pragma unroll
        for (unsigned j = 0; j < 16; ++j) { const unsigned c = xb_ld(&bar[XB_XCNT(j)]); sum += c; cnt += (c > 0u) ? 1u : 0u; mine = (j == x) ? c : mine; }
        if (sum == G) break;
        __builtin_amdgcn_s_sleep(1);
        if ((++sp & 255u) == 0u) { if (xb_ld(&bar[XB_TMO])) break; if (sp > XB_SPIN_CAP) { atomicAdd(&bar[XB_TMO], 1u); break; } }
    }
    nloc = mine > 0u ? mine : 1u; nx = cnt > 0u ? cnt : 1u;
}
__device__ __forceinline__ void xcd_barrier(const XcdBarrier& b) {
    asm volatile("s_waitcnt vmcnt(0)" ::: "memory");
    __syncthreads();
    if (threadIdx.x == 0) {
        unsigned* bar = b.bar;
        __builtin_amdgcn_s_waitcnt(0);
        unsigned nloc = b.st[0], nx = b.st[1];
        if (nloc == 0u) { xcd_barrier_complete(bar, b.x, nloc, nx); b.st[0] = nloc; b.st[1] = nx; }
        const unsigned old = xb_add(&bar[XB_XSUB(b.x)], 1u);
        const unsigned gen = old / nloc;
        if (old + 1u == (gen + 1u) * nloc) {
            __builtin_amdgcn_fence(__ATOMIC_RELEASE, "agent");
            asm volatile("s_waitcnt vmcnt(0)" ::: "memory");
            const unsigned og = xb_add(&bar[XB_TOP], 1u);
            const unsigned tg = og / nx;
            if (og + 1u == (tg + 1u) * nx) xb_add(&bar[XB_TOPGEN], 1u);
            else XB_SPIN(xb_ld(&bar[XB_TOPGEN]) == tg, bar);
            __builtin_amdgcn_fence(__ATOMIC_ACQUIRE, "agent");
            xb_add(&bar[XB_XGEN(b.x)], 1u);
            asm volatile("s_waitcnt vmcnt(0)" ::: "memory");
        } else {
            XB_SPIN(xb_ld(&bar[XB_XGEN(b.x)]) == gen, bar);
            __builtin_amdgcn_fence(__ATOMIC_ACQUIRE, "agent");
            asm volatile("s_waitcnt vmcnt(0)" ::: "memory");
        }
    }
    __syncthreads();
}

constexpr int NPHASE = 20;
__device__ __forceinline__ bool fresh(Frame& F) { int t = threadIdx.x; asm volatile("" : "+v"(t)); F.tid = t; F.lane = t & 63; F.wave = __builtin_amdgcn_readfirstlane(t >> 6); return true; }
template <int L> __device__ __forceinline__ void layer_phases(Frame& F, const XcdBarrier& bar, const int lo, const int hi) {
    constexpr int B = 1 + 9 * L;
#define INR(k) (lo <= (k) && (k) < hi)
#define IN(k) (INR(k) && fresh(F))
#define SEAM(k) do { if (INR(k) && INR((k) + 1)) xcd_barrier(bar); } while (0)
    if (IN(B + 0)) { phase_prep(F, L); __syncthreads(); phase_rownorm(F, L == 0 ? 0 : 1); } SEAM(B + 0);
    if (IN(B + 1)) {
        pg8::Gemm gm{(const bf16_t*)(F.ws + WS_ACT), (const bf16_t*)(F.ws + WS_WIN), T_, NINP, DM, DM, DM};
        pg8::StaticOrder S; S.init(T_, NINP, F.G, F.bid);
        pg8::EpiBf16Bias E{(bf16_t*)(F.ws + WS_P), NINP, (const float*)(F.ws + WS_BIN)};
        pg8::gemm_phase<pg8::EpiBf16Bias, pg8::StaticOrder, true, true>(F.lds, gm, S, E);
    } SEAM(B + 1);
    if (IN(B + 2)) {
#pragma unroll 1
        for (int it = F.bid; it < 512; it += F.G) { asm volatile("" ::: "memory"); if (it < 128) attn_item(F, L, it); }
#pragma unroll 1
        for (int it = F.bid; it < 512; it += F.G) { asm volatile("" ::: "memory"); if (it >= 128 && it < 256) poolconv_item(F, L, it - 128); }
#pragma unroll 1
        for (int it = F.bid; it < 512; it += F.G) { asm volatile("" ::: "memory"); if (it >= 256) rwkvprep_item(F, L, it - 256); }
    } SEAM(B + 2);
    if (IN(B + 3)) {
#pragma unroll 1
        for (int it = F.bid; it < 1024; it += F.G) { asm volatile("" ::: "memory"); rwkv_r1_item(F, it); }
    } SEAM(B + 3);
    if (IN(B + 4)) { if (F.bid < 4) rwkv_p2(F, F.bid); } SEAM(B + 4);
    if (IN(B + 5)) {
#pragma unroll 1
        for (int it = F.bid; it < 1024; it += F.G) { asm volatile("" ::: "memory"); rwkv_p3_item(F, L, it); }
    } SEAM(B + 5);
    if (IN(B + 6)) {
        pg8::Gemm gm{(const bf16_t*)(F.ws + WS_ACT), (const bf16_t*)(F.ws + WS_WOUT), T_, DM, DM, DM, DM};
        pg8::StaticOrder S; S.init(T_, DM, F.G, F.bid);
        pg8::EpiResF32 E{L == 0 ? F.in[0] : F.out, F.out, (bf16_t*)(F.ws + WS_RW), DM};
        pg8::gemm_phase<pg8::EpiResF32, pg8::StaticOrder, true, true>(F.lds, gm, S, E);
    } SEAM(B + 6);
    if (IN(B + 7)) phase_router(F, L); SEAM(B + 7);
    if (IN(B + 8)) phase_moe(F, L); SEAM(B + 8);
}

__global__ void __launch_bounds__(NTHR, 2) fwd_kernel(Args a) {
    extern __shared__ __attribute__((aligned(16))) unsigned char smem[];
    Frame F;
    F.lds = (ldsp)smem; F.tid = threadIdx.x; F.lane = F.tid & 63; F.wave = __builtin_amdgcn_readfirstlane(F.tid >> 6);
    F.G = gridDim.x; F.bid = blockIdx.x; F.in = a.in; F.out = a.out; F.ws = a.ws;
    const int lo = a.ph_lo, hi = a.ph_hi;
    volatile LAS unsigned* bst = (volatile LAS unsigned*)(F.lds + LDS_BYTES - 64);
    if (F.tid < 16) bst[F.tid] = 0u;
    __syncthreads();
    const XcdBarrier bar = xcd_barrier_post((unsigned*)(F.ws + WS_CTL) + 1024, bst);
    if (IN(0)) phase_mod(F); SEAM(0);
    layer_phases<0>(F, bar, lo, hi);
    layer_phases<1>(F, bar, lo, hi);
    if (IN(19)) phase_rownorm(F, 2);
#undef IN
#undef INR
#undef SEAM
}

extern "C" void kernel_launch(void* const* d_in, const int* in_sizes, int n_in, void* d_out, int out_size, void* d_ws, size_t ws_size, hipStream_t stream) {
    static int grid = 0;
    if (grid == 0) {
        int dev = 0, cus = 0;
        if (n_in != 34 || out_size != T_ * DM || ws_size < WS_END) { fprintf(stderr, "kernel_launch: unexpected shapes n_in %d out %d ws %zu\n", n_in, out_size, ws_size); grid = -1; return; }
        if (hipGetDevice(&dev) != hipSuccess || hipDeviceGetAttribute(&cus, hipDeviceAttributeMultiprocessorCount, dev) != hipSuccess) { grid = -1; return; }
        if (hipFuncSetAttribute((const void*)fwd_kernel, hipFuncAttributeMaxDynamicSharedMemorySize, LDS_BYTES) != hipSuccess) { fprintf(stderr, "kernel_launch: hipFuncSetAttribute failed\n"); grid = -1; return; }
        int per_cu = 0;
        if (hipOccupancyMaxActiveBlocksPerMultiprocessor(&per_cu, (const void*)fwd_kernel, NTHR, LDS_BYTES) != hipSuccess || per_cu < 1) { fprintf(stderr, "kernel_launch: occupancy query failed (%d)\n", per_cu); per_cu = 1; }
        (void)hipGetLastError();
        grid = cus;
    }
    if (grid < 0) return;
    (void)hipMemsetAsync((char*)d_ws + WS_CTL, 0, CTL_BYTES, stream);
    Args a{};
    for (int i = 0; i < 34; ++i) a.in[i] = (const float*)d_in[i];
    a.out = (float*)d_out; a.ws = (unsigned char*)d_ws;
#ifdef MULTI_LAUNCH
    for (int ph = 0; ph < NPHASE; ++ph) { a.ph_lo = ph; a.ph_hi = ph + 1; hipLaunchKernelGGL(fwd_kernel, dim3(grid), dim3(NTHR), LDS_BYTES, stream, a); }
#else
    a.ph_lo = 0; a.ph_hi = NPHASE;
    hipLaunchKernelGGL(fwd_kernel, dim3(grid), dim3(NTHR), LDS_BYTES, stream, a);
#endif
}
```

```cpp
#define PROBE_PH -1
#include <hip/hip_runtime.h>
#include <hip/hip_cooperative_groups.h>
#include <cstdio>
#include <cstdint>
namespace cg = cooperative_groups;

#define LAS __attribute__((address_space(3)))
typedef unsigned short bf16_t;
typedef short bf16x8 __attribute__((ext_vector_type(8)));
typedef float f32x4 __attribute__((ext_vector_type(4)));
typedef float f32x2 __attribute__((ext_vector_type(2)));
typedef unsigned u32x4 __attribute__((ext_vector_type(4)));
typedef unsigned u32x2 __attribute__((ext_vector_type(2)));
typedef LAS unsigned char* ldsp;

namespace pg8 {
#define PG8_LAS __attribute__((address_space(3)))
constexpr int BM = 256, BK = 64, HALF = 128, HTB = HALF * BK * 2, STAGE_BYTES = 8 * HTB, NXCD = 8, WGM = 8;
__host__ __device__ __forceinline__ int lds_byte(int r, int c) { const int st = (r >> 4) * 2 + (c >> 5), rr = r & 15, cc = c & 31, ob = rr * 64 + cc * 2; return st * 1024 + (ob ^ (((ob >> 9) & 1) << 5)); }
__host__ __device__ __forceinline__ void stage_rc(int b, int& R, int& C) { const int st = b / 1024, sb = b % 1024, swz = sb ^ (((sb >> 9) & 1) << 5); R = (st >> 1) * 16 + swz / 64; C = (st & 1) * 32 + (swz % 64) / 2; }
__host__ __device__ __forceinline__ int perm32(int rho) { const int n = rho >> 4, i = rho & 15; return 8 * (i >> 2) + 4 * n + (i & 3); }
struct Unit { int pm, pn; };
struct Gemm { const bf16_t* A; const bf16_t* Bt; int M, N, K, lda, ldb; };
struct StaticOrder {
    int nM, nN, nwg, G, c;
    __host__ __device__ void init(int M, int N, int G_, int c_) { nM = M / BM; nN = N / BM; nwg = nM * nN; G = G_; c = c_; }
    __host__ __device__ bool next(int i, Unit& u) const {
        const long L = (long)i * G + c; if (L >= nwg) return false;
        int wgid = (int)L; { const int q = nwg / NXCD, r = nwg % NXCD, xcd = wgid % NXCD, off = wgid / NXCD; wgid = (xcd < r ? xcd * (q + 1) : r * (q + 1) + (xcd - r) * q) + off; }
        const int nig = WGM * nN, gid = wgid / nig, fm = gid * WGM, gsz = (nM - fm) < WGM ? (nM - fm) : WGM;
        u.pm = fm + ((wgid % nig) % gsz); u.pn = (wgid % nig) / gsz; return true;
    }
    __device__ __forceinline__ void a_ready(const Unit&) const {}
    __device__ __forceinline__ void done(const Unit&) const {}
};
__device__ __forceinline__ unsigned cvt_pk_bf16(float lo, float hi) { unsigned r; asm volatile("v_cvt_pk_bf16_f32 %0, %1, %2" : "=v"(r) : "v"(lo), "v"(hi)); return r; }
struct EpiBf16Bias {
    static constexpr bool PERM = true, AFTER_DRAIN = false;
    bf16_t* O; int ldc; const float* bias;
    __device__ __forceinline__ void operator()(const f32x4 (&acc)[2][2][4][2], const Unit& u, int wr, int wc, int fr, int fq) const {
        const int row0 = u.pm * BM + wr * 64 + fr; const int col0 = u.pn * BM + wc * 32 + 8 * fq;
        f32x4 bv[2][2];
#pragma unroll
        for (int bj = 0; bj < 2; ++bj)
#pragma unroll
            for (int n = 0; n < 2; ++n) bv[bj][n] = *(const f32x4*)(bias + col0 + bj * HALF + 4 * n);
#pragma unroll
        for (int ai = 0; ai < 2; ++ai)
#pragma unroll
            for (int m = 0; m < 4; ++m) { bf16_t* rowp = O + (size_t)(row0 + ai * HALF + m * 16) * ldc + col0;
#pragma unroll
                for (int bj = 0; bj < 2; ++bj) { f32x4 v0 = acc[ai][bj][m][0] + bv[bj][0], v1 = acc[ai][bj][m][1] + bv[bj][1];
                    u32x4 w; w.x = cvt_pk_bf16(v0[0], v0[1]); w.y = cvt_pk_bf16(v0[2], v0[3]); w.z = cvt_pk_bf16(v1[0], v1[1]); w.w = cvt_pk_bf16(v1[2], v1[3]);
                    *(u32x4*)(rowp + bj * HALF) = w; } }
    }
};
struct EpiResF32 {
    static constexpr bool PERM = false, AFTER_DRAIN = false;
    const float* base; float* out; bf16_t* ob; int ldc;
    __device__ __forceinline__ void operator()(const f32x4 (&acc)[2][2][4][2], const Unit& u, int wr, int wc, int fr, int fq) const {
        const int row0 = u.pm * BM + wr * 64 + fr, col0 = u.pn * BM + wc * 32 + 4 * fq;
#pragma unroll
        for (int ai = 0; ai < 2; ++ai)
#pragma unroll
            for (int m = 0; m < 4; ++m) { const size_t off = (size_t)(row0 + ai * HALF + m * 16) * ldc + col0;
#pragma unroll
                for (int bj = 0; bj < 2; ++bj)
#pragma unroll
                    for (int n = 0; n < 2; ++n) { const f32x4 bs = *(const f32x4*)(base + off + bj * HALF + n * 16); const f32x4 o = bs + acc[ai][bj][m][n];
                        *(f32x4*)(out + off + bj * HALF + n * 16) = o;
                        u32x2 w; w.x = cvt_pk_bf16(o[0], o[1]); w.y = cvt_pk_bf16(o[2], o[3]); *(u32x2*)(ob + off + bj * HALF + n * 16) = w; }
                asm volatile("" ::: "memory"); }
    }
};
template <class Epi, class Sched, bool ALIGN_EPI = false, bool SP2 = false>
__device__ __forceinline__ void gemm_phase(PG8_LAS unsigned char* lds, const Gemm g, const Sched& S, const Epi& E) {
    const int tid = threadIdx.x, wid = __builtin_amdgcn_readfirstlane(tid >> 6), lane = tid & 63, wr = wid >> 2, wc = wid & 3, fr = lane & 15, fq = lane >> 4;
    const int K = g.K, nt = K / BK;
    unsigned voffA[2], voffB[2];
#pragma unroll
    for (int i = 0; i < 2; ++i) { int R, C; stage_rc(tid * 16 + i * 8192, R, C); const int Rb = Epi::PERM ? ((R & ~31) + perm32(R & 31)) : R;
        voffA[i] = (unsigned)(R * g.lda + C) * 2u; voffB[i] = (unsigned)(Rb * g.ldb + C) * 2u; }
    const size_t kstep = (size_t)(BK * 2);
    const size_t hstepA = (size_t)HALF * g.lda * 2, hstepB = (size_t)HALF * g.ldb * 2;
    const size_t tstepA = 2 * hstepA, tstepB = 2 * hstepB;
    const unsigned ldsw = (unsigned)wid * 1024u;
    const int aoff = lds_byte(wr * 64 + fr, fq * 8), boff = lds_byte(wc * 32 + fr, fq * 8);
#define PG8_SA(b, h) (((b) * 2 + (h)) * HTB)
#define PG8_SB(b, h) ((4 + (b) * 2 + (h)) * HTB)
#define PG8_STAGE(bufoff, gbase, voff) do { _Pragma("unroll") for (int _i = 0; _i < 2; ++_i) \
        __builtin_amdgcn_global_load_lds((const unsigned*)((const char*)(gbase) + (voff)[_i]), (PG8_LAS unsigned*)(lds + (bufoff) + ldsw + _i * 8192), 16, 0, 0); } while (0)
#define PG8_LDA(dst, b, h) do { _Pragma("unroll") for (int m = 0; m < 4; ++m) _Pragma("unroll") for (int k = 0; k < 2; ++k) dst[m][k] = *(const PG8_LAS bf16x8*)(lds + PG8_SA(b, h) + aoff + m * 2048 + k * 1024); } while (0)
#define PG8_LDB(dst, b, h) do { _Pragma("unroll") for (int n = 0; n < 2; ++n) _Pragma("unroll") for (int k = 0; k < 2; ++k) dst[n][k] = *(const PG8_LAS bf16x8*)(lds + PG8_SB(b, h) + boff + n * 2048 + k * 1024); } while (0)
#define PG8_MMA(ai, bj, At, Bt) do { __builtin_amdgcn_s_setprio(1); _Pragma("unroll") for (int m = 0; m < 4; ++m) _Pragma("unroll") for (int n = 0; n < 2; ++n) _Pragma("unroll") for (int k = 0; k < 2; ++k) \
        acc[ai][bj][m][n] = __builtin_amdgcn_mfma_f32_16x16x32_bf16(Bt[n][k], At[m][k], acc[ai][bj][m][n], 0, 0, 0); __builtin_amdgcn_s_setprio(0); } while (0)
#define PG8_WAIT_V(n) asm volatile("s_waitcnt vmcnt(" #n ")" ::: "memory")
#define PG8_WAIT_L(n) asm volatile("s_waitcnt lgkmcnt(" #n ")" ::: "memory")
#define PG8_BAR __builtin_amdgcn_s_barrier()
#define PG8_SCHED __builtin_amdgcn_sched_barrier(0)
    Unit cur, nxt; int ui = 0;
    if (!S.next(0, cur)) return;
    f32x4 acc[2][2][4][2];
#pragma unroll
    for (int a = 0; a < 2; ++a)
#pragma unroll
        for (int b = 0; b < 2; ++b)
#pragma unroll
            for (int m = 0; m < 4; ++m)
#pragma unroll
                for (int n = 0; n < 2; ++n) acc[a][b][m][n] = (f32x4){0.f, 0.f, 0.f, 0.f};
    bf16x8 At[4][2], B0[2][2], B1[2][2];
    const char* cA = (const char*)g.A + (size_t)cur.pm * tstepA; const char* cB = (const char*)g.Bt + (size_t)cur.pn * tstepB;
    S.a_ready(cur);
    if constexpr (SP2) {
        PG8_STAGE(PG8_SB(0, 0), cB, voffB); PG8_STAGE(PG8_SB(0, 1), cB + hstepB, voffB); PG8_STAGE(PG8_SA(0, 0), cA, voffA); PG8_STAGE(PG8_SA(0, 1), cA + hstepA, voffA);
        if (wr == 1) PG8_BAR;
        PG8_WAIT_V(2); PG8_BAR;
        PG8_STAGE(PG8_SB(1, 0), cB + kstep, voffB); PG8_STAGE(PG8_SA(1, 0), cA + kstep, voffA); PG8_STAGE(PG8_SB(1, 1), cB + hstepB + kstep, voffB);
        PG8_WAIT_V(6); PG8_BAR;
    } else {
        PG8_STAGE(PG8_SB(0, 0), cB, voffB); PG8_STAGE(PG8_SA(0, 0), cA, voffA); PG8_STAGE(PG8_SB(0, 1), cB + hstepB, voffB); PG8_STAGE(PG8_SA(0, 1), cA + hstepA, voffA);
        if (wr == 1) PG8_BAR;
        PG8_WAIT_V(4); PG8_BAR;
        PG8_STAGE(PG8_SB(1, 0), cB + kstep, voffB); PG8_STAGE(PG8_SA(1, 0), cA + kstep, voffA); PG8_STAGE(PG8_SB(1, 1), cB + hstepB + kstep, voffB);
        PG8_WAIT_V(6); PG8_BAR;
    }
    for (;;) {
        const bool has_next = S.next(ui + 1, nxt);
        const char* nA = has_next ? (const char*)g.A + (size_t)nxt.pm * tstepA : cA; const char* nB = has_next ? (const char*)g.Bt + (size_t)nxt.pn * tstepB : cB;
        for (int t = 0; t < nt; t += 2) {
            const bool last = (t == nt - 2);
            const char* a1 = cA + (size_t)(t + 1) * kstep;
            const char* a2 = last ? nA : cA + (size_t)(t + 2) * kstep; const char* b2 = last ? nB : cB + (size_t)(t + 2) * kstep;
            const char* a3 = a2 + kstep; const char* b3 = b2 + kstep;
            if (last && has_next) S.a_ready(nxt);
            if constexpr (SP2) {
            PG8_LDB(B0, 0, 0); PG8_LDB(B1, 0, 1); PG8_SCHED; PG8_LDA(At, 0, 0); PG8_STAGE(PG8_SA(1, 1), a1 + hstepA, voffA);
            PG8_WAIT_V(8); PG8_WAIT_L(0); PG8_BAR; PG8_MMA(0, 0, At, B0); PG8_MMA(0, 1, At, B1); PG8_BAR; PG8_SCHED;
            PG8_LDA(At, 0, 1); PG8_STAGE(PG8_SB(0, 0), b2, voffB); PG8_STAGE(PG8_SB(0, 1), b2 + hstepB, voffB); PG8_STAGE(PG8_SA(0, 0), a2, voffA);
            PG8_WAIT_V(8); PG8_WAIT_L(0); PG8_BAR; PG8_MMA(1, 0, At, B0); PG8_MMA(1, 1, At, B1); PG8_BAR; PG8_SCHED;
            PG8_LDB(B0, 1, 0); PG8_LDB(B1, 1, 1); PG8_SCHED; PG8_LDA(At, 1, 0); PG8_STAGE(PG8_SA(0, 1), a2 + hstepA, voffA);
            PG8_WAIT_V(8); PG8_WAIT_L(0); PG8_BAR; PG8_MMA(0, 0, At, B0); PG8_MMA(0, 1, At, B1); PG8_BAR; PG8_SCHED;
            PG8_LDA(At, 1, 1); PG8_STAGE(PG8_SB(1, 0), b3, voffB); PG8_STAGE(PG8_SB(1, 1), b3 + hstepB, voffB); PG8_STAGE(PG8_SA(1, 0), a3, voffA);
            PG8_WAIT_V(8); PG8_WAIT_L(0); PG8_BAR; PG8_MMA(1, 0, At, B0); PG8_MMA(1, 1, At, B1); PG8_BAR; PG8_SCHED;
            } else {
            PG8_LDB(B0, 0, 0); PG8_SCHED; PG8_LDA(At, 0, 0); PG8_STAGE(PG8_SA(1, 1), a1 + hstepA, voffA);
            PG8_WAIT_L(8); PG8_BAR; PG8_WAIT_L(0); PG8_MMA(0, 0, At, B0); PG8_BAR; PG8_SCHED;
            PG8_LDB(B1, 0, 1); PG8_STAGE(PG8_SB(0, 0), b2, voffB);
            PG8_BAR; PG8_WAIT_L(0); PG8_MMA(0, 1, At, B1); PG8_BAR;
            PG8_LDA(At, 0, 1); PG8_STAGE(PG8_SA(0, 0), a2, voffA);
            PG8_BAR; PG8_WAIT_L(0); PG8_MMA(1, 0, At, B0); PG8_BAR; PG8_SCHED;
            PG8_STAGE(PG8_SB(0, 1), b2 + hstepB, voffB);
            PG8_WAIT_V(6); PG8_BAR; PG8_MMA(1, 1, At, B1); PG8_BAR;
            PG8_LDB(B0, 1, 0); PG8_SCHED; PG8_LDA(At, 1, 0); PG8_STAGE(PG8_SA(0, 1), a2 + hstepA, voffA);
            PG8_WAIT_L(8); PG8_BAR; PG8_WAIT_L(0); PG8_MMA(0, 0, At, B0); PG8_BAR; PG8_SCHED;
            PG8_LDB(B1, 1, 1); PG8_STAGE(PG8_SB(1, 0), b3, voffB);
            PG8_BAR; PG8_WAIT_L(0); PG8_MMA(0, 1, At, B1); PG8_BAR;
            PG8_LDA(At, 1, 1); PG8_STAGE(PG8_SA(1, 0), a3, voffA);
            PG8_BAR; PG8_WAIT_L(0); PG8_MMA(1, 0, At, B0); PG8_BAR; PG8_SCHED;
            PG8_STAGE(PG8_SB(1, 1), b3 + hstepB, voffB);
            PG8_WAIT_V(6); PG8_BAR; PG8_MMA(1, 1, At, B1); PG8_BAR;
            }
        }
        if constexpr (ALIGN_EPI) { if (wr == 0) PG8_BAR; }
        if constexpr (!Epi::AFTER_DRAIN) { E(acc, cur, wr, wc, fr, fq); S.done(cur); }
        if (!has_next) break;
#pragma unroll
        for (int a = 0; a < 2; ++a)
#pragma unroll
            for (int b = 0; b < 2; ++b)
#pragma unroll
                for (int m = 0; m < 4; ++m)
#pragma unroll
                    for (int n = 0; n < 2; ++n) acc[a][b][m][n] = (f32x4){0.f, 0.f, 0.f, 0.f};
        cur = nxt; cA = nA; cB = nB; ++ui;
        if constexpr (ALIGN_EPI) { if (wr == 1) PG8_BAR; }
    }
    PG8_WAIT_V(0);
    if constexpr (!ALIGN_EPI) { if (wr == 0) PG8_BAR; }
    PG8_BAR;
    if constexpr (Epi::AFTER_DRAIN) { E.fused(acc, cur, wr, wc, fr, fq, lds, wid, lane); S.done(cur); }
#undef PG8_SA
#undef PG8_SB
#undef PG8_STAGE
#undef PG8_LDA
#undef PG8_LDB
#undef PG8_MMA
#undef PG8_WAIT_V
#undef PG8_WAIT_L
#undef PG8_BAR
#undef PG8_SCHED
}
}

constexpr int T_ = 16384, DM = 1024, NIN = 2432, NINP = 2560;
constexpr int C_Q = 256, C_K = 512, C_V = 640, C_BG = 768, C_CG = 1024, C_XIN = 1280, C_D = 1536;
constexpr int NWAVES = 8, NTHR = 512;
constexpr int LDS_BYTES = 147456;
constexpr size_t MiB = 1u << 20;
constexpr size_t WS_CTL = 0;
constexpr size_t CTL_BYTES = 65536;
constexpr size_t WS_MOD = 1 * MiB;
constexpr size_t WS_BIN = WS_MOD + 65536;
constexpr size_t WS_BGU = WS_BIN + 16384;
constexpr size_t WS_BR  = WS_BGU + 32768;
constexpr size_t WS_WRH = WS_BR + 1024;
constexpr size_t WS_WRL = WS_WRH + 98304;
constexpr size_t WS_W2T = WS_WRL + 98304;
constexpr size_t WS_A2T = WS_W2T + 16384;
constexpr size_t WS_G2T = WS_A2T + 16384;
constexpr size_t WS_V1T = WS_G2T + 32768;
constexpr size_t WS_V2T = WS_V1T + 16384;
constexpr size_t WS_PWT = WS_V2T + 16384;
constexpr size_t WS_RINV2 = WS_PWT + 32768;
static_assert(WS_RINV2 + 65536 <= 2 * MiB, "small region");
constexpr size_t WS_WIN = 2 * MiB;
constexpr size_t WS_WOUT = 7 * MiB;
constexpr size_t WS_WGU = 9 * MiB;
constexpr size_t WS_WD = 25 * MiB;
constexpr size_t WS_LIST = 33 * MiB;
constexpr size_t WS_WLIST = 35 * MiB;
constexpr size_t WS_VFIRST = 37 * MiB;
constexpr size_t WS_ACT = 45 * MiB;
constexpr size_t WS_P = 77 * MiB;
constexpr size_t WS_RW = 157 * MiB;
constexpr size_t RW_R = WS_RW, RW_K = WS_RW + 8 * MiB, RW_V = WS_RW + 16 * MiB, RW_KAP = WS_RW + 24 * MiB, RW_B = WS_RW + 32 * MiB, RW_G = WS_RW + 40 * MiB;
constexpr size_t RW_LD = WS_RW + 48 * MiB;
constexpr size_t RW_W1 = WS_RW + 56 * MiB, RW_U0T = WS_RW + 64 * MiB, RW_M = WS_RW + 72 * MiB, RW_N = WS_RW + 80 * MiB, RW_S0 = WS_RW + 88 * MiB;
constexpr size_t RW_BONUS = WS_RW + 96 * MiB;
constexpr size_t WS_END = WS_RW + 97 * MiB;
static_assert(WS_END <= 256 * MiB, "workspace");

struct Args { const float* in[34]; float* out; unsigned char* ws; int ph_lo, ph_hi; };

__device__ __forceinline__ unsigned f2bf(float f) { unsigned u = __builtin_bit_cast(unsigned, f); return (u + 0x7fffu + ((u >> 16) & 1u)) >> 16; }
__device__ __forceinline__ float bf2f(unsigned h) { return __builtin_bit_cast(float, h << 16); }
__device__ __forceinline__ unsigned pk2(float lo, float hi) { return f2bf(lo) | (f2bf(hi) << 16); }
__device__ __forceinline__ float bflo(unsigned w) { return __builtin_bit_cast(float, w << 16); }
__device__ __forceinline__ float bfhi(unsigned w) { return __builtin_bit_cast(float, w & 0xffff0000u); }
__device__ __forceinline__ float sigmoidf_(float x) { return 1.f / (1.f + __expf(-x)); }
__device__ __forceinline__ float wave_sum(float v) {
#pragma unroll
    for (int o = 1; o < 64; o <<= 1) v += __shfl_xor(v, o);
    return v;
}
#define LDS_WAIT() asm volatile("s_waitcnt lgkmcnt(0)" ::: "memory")
__device__ __forceinline__ int swz128(int r, int c) { return r * 128 + ((c ^ ((r >> 1) & 7)) << 4); }
__device__ __forceinline__ int swz256(int r, int c) { return r * 256 + ((c ^ (r & 15)) << 4); }
__device__ __forceinline__ int swz512(int r, int c) { return r * 512 + ((c ^ (r & 15)) << 4); }
__device__ __forceinline__ f32x4 mfma16(bf16x8 a, bf16x8 b, f32x4 c) { return __builtin_amdgcn_mfma_f32_16x16x32_bf16(a, b, c, 0, 0, 0); }

struct Frame {
    ldsp lds; int tid, lane, wave, G, bid;
    const float* const* in; float* out; unsigned char* ws;
};

__device__ __forceinline__ void phase_mod(Frame& F) {
    const float* c = F.in[1]; const float* w_ada = F.in[2]; const float* b_ada = F.in[3];
    float* mod = (float*)(F.ws + WS_MOD);
    LAS float* red = (LAS float*)F.lds;
    for (int it = F.bid; it < 192; it += F.G) {
        const int l = it / 96, n0 = (it % 96) * 64;
        const float* W = w_ada + (size_t)l * DM * 6144 + n0 + F.lane;
        const int k0 = F.wave * 128;
        float acc = 0.f;
#pragma unroll 8
        for (int k = 0; k < 128; ++k) { const float cv = c[k0 + k]; const float s = cv / (1.f + __expf(-cv)); acc += s * W[(size_t)(k0 + k) * 6144]; }
        red[F.wave * 64 + F.lane] = acc;
        __syncthreads();
        if (F.wave == 0) { float s = b_ada[l * 6144 + n0 + F.lane];
#pragma unroll
            for (int w = 0; w < 8; ++w) s += red[w * 64 + F.lane];
            mod[l * 6144 + n0 + F.lane] = s; }
        __syncthreads();
    }
}

__device__ __forceinline__ void transpose_strip(const float* W, int N, int K, int n0, const float* rs_a, const float* rs_b, const float* cs, const float* sh, float* bias_out,
                                                bf16_t* dst, int dst_row0, LAS float* scr, int lane) {
    const int col = lane & 31, kp = lane >> 5;
    const float csv = cs ? cs[n0 + col] : 1.f;
    LAS float* scl = scr + 64 * 33;
    float bacc = 0.f;
    for (int k0 = 0; k0 < K; k0 += 64) {
        float wv[32];
#pragma unroll
        for (int i = 0; i < 32; ++i) wv[i] = W[(size_t)(k0 + 2 * i + kp) * N + n0 + col];
        scl[lane] = rs_a ? rs_a[k0 + lane] * (1.f + rs_b[k0 + lane]) : 1.f;
        scl[64 + lane] = sh ? sh[k0 + lane] : 0.f;
        LDS_WAIT();
#pragma unroll
        for (int i = 0; i < 32; ++i) { const int kk = 2 * i + kp; bacc += scl[64 + kk] * wv[i]; scr[kk * 33 + col] = wv[i] * csv * scl[kk]; }
        LDS_WAIT();
        const int c = lane & 7;
#pragma unroll
        for (int j = 0; j < 4; ++j) { const int n = (lane >> 3) + 8 * j; const LAS float* s = scr + (8 * c) * 33 + n;
            u32x4 o; o.x = pk2(s[0 * 33], s[1 * 33]); o.y = pk2(s[2 * 33], s[3 * 33]); o.z = pk2(s[4 * 33], s[5 * 33]); o.w = pk2(s[6 * 33], s[7 * 33]);
            *(u32x4*)(dst + (size_t)(dst_row0 + n) * K + k0 + 8 * c) = o; }
        LDS_WAIT();
    }
    if (sh) { bacc += __shfl_xor(bacc, 32); if (lane < 32) bias_out[col] = bacc; }
}
__device__ __forceinline__ void phase_prep(Frame& F, int l) {
    LAS float* scr = (LAS float*)(F.lds + F.wave * 16384);
    const float* mod = (const float*)(F.ws + WS_MOD) + l * 6144;
    const float *sh1 = mod, *sc1 = mod + 1024, *gt1 = mod + 2048, *sh2 = mod + 3072, *sc2 = mod + 4096, *gt2 = mod + 5120;
    const float* n1g = F.in[4] + l * DM; const float* n2g = F.in[5] + l * DM;
    const float* w_in = F.in[6] + (size_t)l * DM * NIN; const float* w_out = F.in[7] + (size_t)l * DM * DM;
    const float* wg = F.in[30] + (size_t)l * 32 * DM * 128; const float* wu = F.in[31] + (size_t)l * 32 * DM * 128; const float* wd = F.in[32] + (size_t)l * 32 * 128 * DM;
    bf16_t* WIN = (bf16_t*)(F.ws + WS_WIN); bf16_t* WOUT = (bf16_t*)(F.ws + WS_WOUT); bf16_t* WGU = (bf16_t*)(F.ws + WS_WGU); bf16_t* WD = (bf16_t*)(F.ws + WS_WD);
    float* bias_in = (float*)(F.ws + WS_BIN); float* bias_gu = (float*)(F.ws + WS_BGU); float* bias_r = (float*)(F.ws + WS_BR);
    const int gw = F.bid * NWAVES + F.wave, NGW = F.G * NWAVES;
    constexpr int nA = 80, nB = 32, nC = 128, nD = 128, nE = 1024, nF = 48, nG = 6;
    constexpr int NIT = nA + nB + nC + nD + nE + nF + nG;
    for (int it = gw; it < NIT; it += NGW) {
        int r = it;
        if (r < nA) {
            if (r < 76) transpose_strip(w_in, NIN, DM, r * 32, n1g, sc1, nullptr, sh1, bias_in + r * 32, WIN, r * 32, scr, F.lane);
            else { for (int i = F.lane; i < 32 * 128; i += 64) { const int n = i >> 7, c = i & 127; *(u32x4*)(WIN + (size_t)(r * 32 + n) * DM + c * 8) = (u32x4){0u, 0u, 0u, 0u}; }
                   if (F.lane < 32) bias_in[r * 32 + F.lane] = 0.f; }
            continue; } r -= nA;
        if (r < nB) { transpose_strip(w_out, DM, DM, r * 32, nullptr, nullptr, gt1, nullptr, nullptr, WOUT, r * 32, scr, F.lane); continue; } r -= nB;
        if (r < nC) { const int e = r >> 2, s = r & 3; transpose_strip(wg + (size_t)e * DM * 128, 128, DM, s * 32, n2g, sc2, nullptr, sh2, bias_gu + e * 256 + s * 32, WGU + (size_t)e * 256 * DM, s * 32, scr, F.lane); continue; } r -= nC;
        if (r < nD) { const int e = r >> 2, s = r & 3; transpose_strip(wu + (size_t)e * DM * 128, 128, DM, s * 32, n2g, sc2, nullptr, sh2, bias_gu + e * 256 + 128 + s * 32, WGU + (size_t)e * 256 * DM, 128 + s * 32, scr, F.lane); continue; } r -= nD;
        if (r < nE) { const int e = r >> 5, s = r & 31; transpose_strip(wd + (size_t)e * 128 * DM, DM, 128, s * 32, nullptr, nullptr, gt2, nullptr, nullptr, WD + (size_t)e * DM * 128, s * 32, scr, F.lane); continue; } r -= nE;
        if (r < nF) {
            bf16_t* wh = (bf16_t*)(F.ws + WS_WRH) + r * DM; bf16_t* wl = (bf16_t*)(F.ws + WS_WRL) + r * DM;
            float bacc = 0.f;
            for (int k = F.lane; k < DM; k += 64) {
                float wv = 0.f;
                if (r < 4) wv = F.in[26][(size_t)l * DM * 4 + k * 4 + r]; else if (r < 36) wv = F.in[28][(size_t)l * DM * 32 + k * 32 + (r - 4)];
                bacc += sh2[k] * wv;
                const float v = wv * n2g[k] * (1.f + sc2[k]);
                const unsigned h = f2bf(v); const unsigned lo = f2bf(v - bf2f(h));
                wh[k] = (bf16_t)h; wl[k] = (bf16_t)lo; }
            bacc = wave_sum(bacc);
            if (F.lane == 0) { float b = 0.f; if (r < 4) b = F.in[27][l * 4 + r]; else if (r < 36) b = F.in[29][l * 32 + r - 4]; bias_r[r] = bacc + b; }
            continue; } r -= nF;
        if (r == 0) { const float* s = F.in[14] + l * 32 * 256; bf16_t* d = (bf16_t*)(F.ws + WS_W2T); for (int i = F.lane; i < 8192; i += 64) { const int n = i >> 5, k = i & 31; d[i] = (bf16_t)f2bf(s[k * 256 + n]); } }
        else if (r == 1) { const float* s = F.in[16] + l * 32 * 256; bf16_t* d = (bf16_t*)(F.ws + WS_A2T); for (int i = F.lane; i < 8192; i += 64) { const int n = i >> 5, k = i & 31; d[i] = (bf16_t)f2bf(s[k * 256 + n]); } }
        else if (r == 2) { const float* s = F.in[17] + l * 64 * 256; bf16_t* d = (bf16_t*)(F.ws + WS_G2T); for (int i = F.lane; i < 16384; i += 64) { const int n = i >> 6, k = i & 63; d[i] = (bf16_t)f2bf(s[k * 256 + n]); } }
        else if (r == 3) { if (l > 0) { const float* s = F.in[24] + (l - 1) * 256 * 32; bf16_t* d = (bf16_t*)(F.ws + WS_V1T); for (int i = F.lane; i < 8192; i += 64) { const int n = i >> 8, k = i & 255; d[i] = (bf16_t)f2bf(s[k * 32 + n]); } } }
        else if (r == 4) { if (l > 0) { const float* s = F.in[25] + (l - 1) * 32 * 256; bf16_t* d = (bf16_t*)(F.ws + WS_V2T); for (int i = F.lane; i < 8192; i += 64) { const int n = i >> 5, k = i & 31; d[i] = (bf16_t)f2bf(s[k * 256 + n]); } } }
        else { const float* s = F.in[8] + l * 4 * 64 * 64; bf16_t* d = (bf16_t*)(F.ws + WS_PWT); for (int i = F.lane; i < 16384; i += 64) { const int j = i >> 12, e = (i >> 6) & 63, c = i & 63; d[i] = (bf16_t)f2bf(s[(j * 64 + c) * 64 + e]); } }
    }
}

__device__ __forceinline__ void phase_rownorm(Frame& F, int mode) {
    const float* xin = (mode == 0) ? F.in[0] : F.out;
    const bf16_t* ys0 = (const bf16_t*)(F.ws + WS_P); const bf16_t* ys1 = ys0 + (size_t)T_ * DM;
    bf16_t* xn = (bf16_t*)(F.ws + WS_ACT);
    const float* fg = F.in[33];
    const int gw = F.bid * NWAVES + F.wave, NGW = F.G * NWAVES;
    for (int m = gw; m < T_; m += NGW) {
        const f32x4* xr = (const f32x4*)(xin + (size_t)m * DM) + F.lane;
        f32x4 v[4]; float s = 0.f;
#pragma unroll
        for (int j = 0; j < 4; ++j) v[j] = xr[64 * j];
        if (mode != 0) {
            const u32x2* a = (const u32x2*)(ys0 + (size_t)m * DM) + F.lane; const u32x2* b = (const u32x2*)(ys1 + (size_t)m * DM) + F.lane;
#pragma unroll
            for (int j = 0; j < 4; ++j) { const u32x2 ua = a[64 * j], ub = b[64 * j];
                v[j][0] += bflo(ua.x) + bflo(ub.x); v[j][1] += bfhi(ua.x) + bfhi(ub.x); v[j][2] += bflo(ua.y) + bflo(ub.y); v[j][3] += bfhi(ua.y) + bfhi(ub.y); }
        }
#pragma unroll
        for (int j = 0; j < 4; ++j) s += (v[j][0] * v[j][0] + v[j][1] * v[j][1]) + (v[j][2] * v[j][2] + v[j][3] * v[j][3]);
        const float rinv = 1.f / sqrtf(wave_sum(s) * (1.f / DM) + 1e-6f);
        if (mode == 2) {
            f32x4* o = (f32x4*)(F.out + (size_t)m * DM) + F.lane;
#pragma unroll
            for (int j = 0; j < 4; ++j) { const f32x4 g = *((const f32x4*)fg + F.lane + 64 * j); o[64 * j] = v[j] * rinv * g; }
        } else {
            if (mode == 1) { f32x4* o = (f32x4*)(F.out + (size_t)m * DM) + F.lane;
#pragma unroll
                for (int j = 0; j < 4; ++j) o[64 * j] = v[j]; }
            u32x2* o8 = (u32x2*)(xn + (size_t)m * DM) + F.lane;
#pragma unroll
            for (int j = 0; j < 4; ++j) { u32x2 w; w.x = pk2(v[j][0] * rinv, v[j][1] * rinv); w.y = pk2(v[j][2] * rinv, v[j][3] * rinv); o8[64 * j] = w; }
        }
    }
}

__device__ __forceinline__ void attn_item(Frame& F, int l, int item) {
    const int t0 = item * 128;
    const bf16_t* P = (const bf16_t*)(F.ws + WS_P);
    bf16_t* ycat = (bf16_t*)(F.ws + WS_ACT);
    ldsp Ks = F.lds, Vt = F.lds + 65536;
    for (int i = F.tid; i < 4096; i += NTHR) {
        const int ko = i >> 4, kvh = (i >> 3) & 1, c = i & 7; const int s = t0 - 128 + ko;
        u32x4 kv = (u32x4){0u, 0u, 0u, 0u}, vv = (u32x4){0u, 0u, 0u, 0u};
        if (s >= 0) { kv = *(const u32x4*)(P + (size_t)s * NINP + C_K + kvh * 64 + c * 8); vv = *(const u32x4*)(P + (size_t)s * NINP + C_V + kvh * 64 + c * 8); }
        *(LAS u32x4*)(Ks + kvh * 32768 + swz128(ko, c)) = kv;
        const int k32 = ko & 31, sg = ko >> 5, g = (k32 >> 2) & 3, j = ((k32 >> 4) << 2) | (k32 & 3), chunk = sg * 4 + g;
        const unsigned vw[4] = {vv.x, vv.y, vv.z, vv.w};
#pragma unroll
        for (int e = 0; e < 8; ++e) { const int d = c * 8 + e; const unsigned short val = (unsigned short)((e & 1) ? (vw[e >> 1] >> 16) : (vw[e >> 1] & 0xffffu));
            *(LAS unsigned short*)(Vt + kvh * 32768 + swz512(d, chunk) + j * 2) = val; }
    }
    __syncthreads();
    const int h = F.wave >> 1, half = F.wave & 1, kvh = h >> 1, fr = F.lane & 15, g = F.lane >> 4;
    const float slope = exp2f(-2.f * (float)(h + 1));
    const float sink = F.in[10][l * 4 + h];
    ldsp Kh = Ks + kvh * 32768, Vh = Vt + kvh * 32768;
#pragma unroll 1
    for (int qt = 0; qt < 4; ++qt) {
        const int q_lo = 64 * half + 16 * qt, qo = q_lo + fr, tile0 = (q_lo >> 5) << 1;
        bf16x8 qf[2];
#pragma unroll
        for (int ks = 0; ks < 2; ++ks) qf[ks] = *(const bf16x8*)(P + (size_t)(t0 + qo) * NINP + C_Q + h * 64 + ks * 32 + g * 8);
        f32x4 s[10];
#pragma unroll
        for (int kt = 0; kt < 10; ++kt) { s[kt] = (f32x4){0.f, 0.f, 0.f, 0.f};
#pragma unroll
            for (int ks = 0; ks < 2; ++ks) { const bf16x8 a = *(const LAS bf16x8*)(Kh + swz128((tile0 + kt) * 16 + fr, ks * 4 + g)); s[kt] = mfma16(a, qf[ks], s[kt]); } }
        float m = sink;
#pragma unroll
        for (int kt = 0; kt < 10; ++kt)
#pragma unroll
            for (int j = 0; j < 4; ++j) { const int ko = 16 * (tile0 + kt) + 4 * g + j; const int dist = qo + 128 - ko;
                const bool valid = (dist >= 0) && (dist < 128) && (t0 - 128 + ko >= 0);
                const float v = valid ? s[kt][j] * 0.125f - slope * (float)dist : -INFINITY; s[kt][j] = v; m = fmaxf(m, v); }
        m = fmaxf(m, __shfl_xor(m, 16)); m = fmaxf(m, __shfl_xor(m, 32));
        float sum = 0.f;
#pragma unroll
        for (int kt = 0; kt < 10; ++kt)
#pragma unroll
            for (int j = 0; j < 4; ++j) { const float p = __expf(s[kt][j] - m); s[kt][j] = p; sum += p; }
        sum += __shfl_xor(sum, 16); sum += __shfl_xor(sum, 32);
        const float inv = 1.f / (sum + __expf(sink - m));
        f32x4 o[4];
#pragma unroll
        for (int dt = 0; dt < 4; ++dt) o[dt] = (f32x4){0.f, 0.f, 0.f, 0.f};
#pragma unroll
        for (int ss = 0; ss < 5; ++ss) {
            u32x4 pw; pw.x = pk2(s[2 * ss][0], s[2 * ss][1]); pw.y = pk2(s[2 * ss][2], s[2 * ss][3]); pw.z = pk2(s[2 * ss + 1][0], s[2 * ss + 1][1]); pw.w = pk2(s[2 * ss + 1][2], s[2 * ss + 1][3]);
            const bf16x8 pb = __builtin_bit_cast(bf16x8, pw);
#pragma unroll
            for (int dt = 0; dt < 4; ++dt) { const bf16x8 a = *(const LAS bf16x8*)(Vh + swz512(dt * 16 + fr, ((tile0 >> 1) + ss) * 4 + g)); o[dt] = mfma16(a, pb, o[dt]); }
        }
#pragma unroll
        for (int dt = 0; dt < 4; ++dt) { u32x2 w; w.x = pk2(o[dt][0] * inv, o[dt][1] * inv); w.y = pk2(o[dt][2] * inv, o[dt][3] * inv);
            *(u32x2*)(ycat + (size_t)(t0 + qo) * DM + 256 + h * 64 + dt * 16 + 4 * g) = w; }
    }
    __syncthreads();
}

__device__ __forceinline__ void poolconv_item(Frame& F, int l, int item) {
    const int t0 = item * 128;
    const bf16_t* P = (const bf16_t*)(F.ws + WS_P);
    bf16_t* ycat = (bf16_t*)(F.ws + WS_ACT);
    ldsp U = F.lds;
    ldsp Dt = F.lds + 73728;
    for (int i = F.tid; i < 144 * 32; i += NTHR) { const int r = i >> 5, c = i & 31; const int s = t0 - 16 + r;
        u32x4 v = (u32x4){0u, 0u, 0u, 0u}; if (s >= 0) v = *(const u32x4*)(P + (size_t)s * NINP + c * 8);
        *(LAS u32x4*)(U + r * 512 + c * 16) = v; }
    __syncthreads();
    for (int i = F.tid; i < 128 * 32; i += NTHR) { const int tok = i >> 5, c8 = i & 31, j = c8 >> 3, w = 2 << j; const int t = t0 + tok;
        float acc[8];
#pragma unroll
        for (int e = 0; e < 8; ++e) acc[e] = 0.f;
        u32x4 cur = (u32x4){0u, 0u, 0u, 0u};
        for (int q = 0; q < w; ++q) { const u32x4 v = *(const LAS u32x4*)(U + (tok + 16 - q) * 512 + c8 * 16); if (q == 0) cur = v;
            acc[0] += bflo(v.x); acc[1] += bfhi(v.x); acc[2] += bflo(v.y); acc[3] += bfhi(v.y); acc[4] += bflo(v.z); acc[5] += bfhi(v.z); acc[6] += bflo(v.w); acc[7] += bfhi(v.w); }
        const float ic = 1.f / (float)((t + 1) < w ? (t + 1) : w);
        u32x4 o; o.x = pk2(acc[0] * ic - bflo(cur.x), acc[1] * ic - bfhi(cur.x)); o.y = pk2(acc[2] * ic - bflo(cur.y), acc[3] * ic - bfhi(cur.y));
        o.z = pk2(acc[4] * ic - bflo(cur.z), acc[5] * ic - bfhi(cur.z)); o.w = pk2(acc[6] * ic - bflo(cur.w), acc[7] * ic - bfhi(cur.w));
        *(LAS u32x4*)(Dt + j * 16384 + swz128(tok, c8 & 7)) = o; }
    __syncthreads();
    {
        const int j = F.wave >> 1, half = F.wave & 1, fr = F.lane & 15, g = F.lane >> 4;
        const bf16_t* pwt = (const bf16_t*)(F.ws + WS_PWT) + j * 4096;
        const float* psc = F.in[9] + l * 256 + j * 64;
        bf16x8 bfr[4][2];
#pragma unroll
        for (int n = 0; n < 4; ++n)
#pragma unroll
            for (int ks = 0; ks < 2; ++ks) bfr[n][ks] = *(const bf16x8*)(pwt + (16 * n + fr) * 64 + ks * 32 + g * 8);
#pragma unroll
        for (int m = 0; m < 4; ++m) {
            bf16x8 af[2];
#pragma unroll
            for (int ks = 0; ks < 2; ++ks) af[ks] = *(const LAS bf16x8*)(Dt + j * 16384 + swz128(64 * half + 16 * m + fr, ks * 4 + g));
#pragma unroll
            for (int n = 0; n < 4; ++n) { f32x4 acc = (f32x4){0.f, 0.f, 0.f, 0.f};
#pragma unroll
                for (int ks = 0; ks < 2; ++ks) acc = mfma16(bfr[n][ks], af[ks], acc);
                const f32x4 sc = *(const f32x4*)(psc + 16 * n + 4 * g);
                u32x2 w; w.x = pk2(acc[0] * sc[0], acc[1] * sc[1]); w.y = pk2(acc[2] * sc[2], acc[3] * sc[3]);
                *(u32x2*)(ycat + (size_t)(t0 + 64 * half + 16 * m + fr) * DM + j * 64 + 16 * n + 4 * g) = w; }
        }
    }
    const float* cw = F.in[11] + l * 3 * 256;
    for (int i = F.tid; i < 128 * 32; i += NTHR) { const int tok = i >> 5, c8 = i & 31; const int t = t0 + tok;
        float acc[8];
#pragma unroll
        for (int e = 0; e < 8; ++e) acc[e] = 0.f;
#pragma unroll
        for (int q = 0; q < 3; ++q) { const int s = t - 2 + q; if (s >= 0) {
                const u32x4 a = *(const u32x4*)(P + (size_t)s * NINP + C_CG + c8 * 8), b = *(const u32x4*)(P + (size_t)s * NINP + C_XIN + c8 * 8);
                const float* wq = cw + q * 256 + c8 * 8;
                acc[0] += wq[0] * bflo(a.x) * bflo(b.x); acc[1] += wq[1] * bfhi(a.x) * bfhi(b.x); acc[2] += wq[2] * bflo(a.y) * bflo(b.y); acc[3] += wq[3] * bfhi(a.y) * bfhi(b.y);
                acc[4] += wq[4] * bflo(a.z) * bflo(b.z); acc[5] += wq[5] * bfhi(a.z) * bfhi(b.z); acc[6] += wq[6] * bflo(a.w) * bflo(b.w); acc[7] += wq[7] * bfhi(a.w) * bfhi(b.w); } }
        const u32x4 bg = *(const u32x4*)(P + (size_t)t * NINP + C_BG + c8 * 8);
        u32x4 o; o.x = pk2(acc[0] * bflo(bg.x), acc[1] * bfhi(bg.x)); o.y = pk2(acc[2] * bflo(bg.y), acc[3] * bfhi(bg.y));
        o.z = pk2(acc[4] * bflo(bg.z), acc[5] * bfhi(bg.z)); o.w = pk2(acc[6] * bflo(bg.w), acc[7] * bfhi(bg.w));
        *(u32x4*)(ycat + (size_t)t * DM + 512 + c8 * 8) = o; }
    __syncthreads();
}

__device__ __forceinline__ f32x4 up4_(u32x2 w) { return (f32x4){bflo(w.x), bfhi(w.x), bflo(w.y), bfhi(w.y)}; }
__device__ __forceinline__ u32x2 pk4_(f32x4 v) { u32x2 w; w.x = pk2(v[0], v[1]); w.y = pk2(v[2], v[3]); return w; }
__device__ __forceinline__ u32x4 lerp8(u32x4 cur, u32x4 prv, const float* mu, int act) {
    const unsigned cw[4] = {cur.x, cur.y, cur.z, cur.w}, pw[4] = {prv.x, prv.y, prv.z, prv.w}; float z[8];
#pragma unroll
    for (int e = 0; e < 8; ++e) { const float c = (e & 1) ? bfhi(cw[e >> 1]) : bflo(cw[e >> 1]), p = (e & 1) ? bfhi(pw[e >> 1]) : bflo(pw[e >> 1]);
        float v = c + (p - c) * mu[e]; if (act == 1) v = tanhf(v); else if (act == 2) v = sigmoidf_(v); z[e] = v; }
    u32x4 o; o.x = pk2(z[0], z[1]); o.y = pk2(z[2], z[3]); o.z = pk2(z[4], z[5]); o.w = pk2(z[6], z[7]); return o;
}
__device__ __forceinline__ void rwkvprep_item(Frame& F, int l, int item) {
    const int t0 = item * 64;
    const bf16_t* P = (const bf16_t*)(F.ws + WS_P);
    const float* mu = F.in[12] + l * 896;
    ldsp Zw = F.lds, Za = F.lds + 4096, Zg = F.lds + 8192, Zv = F.lds + 16384, V1 = F.lds + 49152 + F.wave * 2048;
    const int nch = (l > 0) ? 48 : 16;
    for (int i = F.tid; i < 64 * nch; i += NTHR) { const int tok = i / nch, c = i % nch; const int t = t0 + tok;
        const int col = (c < 16) ? (768 + c * 8) : (512 + (c - 16) * 8);
        const u32x4 cur = *(const u32x4*)(P + (size_t)t * NINP + C_D + col);
        const u32x4 prv = (t > 0) ? *(const u32x4*)(P + (size_t)(t - 1) * NINP + C_D + col) : (u32x4){0u, 0u, 0u, 0u};
        const u32x4 z = lerp8(cur, prv, mu + col, c < 4 ? 1 : (c >= 8 && c < 16 ? 2 : 0));
        if (c < 4) *(LAS u32x4*)(Zw + tok * 64 + c * 16) = z;
        else if (c < 8) *(LAS u32x4*)(Za + tok * 64 + (c - 4) * 16) = z;
        else if (c < 16) *(LAS u32x4*)(Zg + swz128(tok, c - 8)) = z;
        else *(LAS u32x4*)(Zv + swz512(tok, c - 16)) = z; }
    __syncthreads();
    const int h = F.wave >> 1, half = F.wave & 1, fr = F.lane & 15, g = F.lane >> 4;
    const bf16_t* w2t = (const bf16_t*)(F.ws + WS_W2T); const bf16_t* a2t = (const bf16_t*)(F.ws + WS_A2T); const bf16_t* g2t = (const bf16_t*)(F.ws + WS_G2T);
    const bf16_t* v1t = (const bf16_t*)(F.ws + WS_V1T); const bf16_t* v2t = (const bf16_t*)(F.ws + WS_V2T);
    const float *w0 = F.in[13] + l * 256, *a0 = F.in[15] + l * 256, *kkp = F.in[18] + l * 256, *kap = F.in[19] + l * 256, *rkp = F.in[20] + l * 256;
    const float* v0 = (l > 0) ? F.in[23] + (l - 1) * 256 : nullptr;
    bf16_t *Rr = (bf16_t*)(F.ws + RW_R), *Rk = (bf16_t*)(F.ws + RW_K), *Rv = (bf16_t*)(F.ws + RW_V), *Rkap = (bf16_t*)(F.ws + RW_KAP), *Rb = (bf16_t*)(F.ws + RW_B), *Rg = (bf16_t*)(F.ws + RW_G);
    bf16_t* Rld = (bf16_t*)(F.ws + RW_LD); float* Rbon = (float*)(F.ws + RW_BONUS); bf16_t* VF = (bf16_t*)(F.ws + WS_VFIRST);
#pragma unroll 1
    for (int m = 0; m < 2; ++m) {
        asm volatile("" ::: "memory");
        const int row = 32 * half + 16 * m + fr;
        const bf16x8 aw = *(const LAS bf16x8*)(Zw + row * 64 + g * 16), aa = *(const LAS bf16x8*)(Za + row * 64 + g * 16);
        const bf16x8 ag0 = *(const LAS bf16x8*)(Zg + swz128(row, g)), ag1 = *(const LAS bf16x8*)(Zg + swz128(row, 4 + g));
        bf16x8 a1 = aw;
        if (l > 0) {
            f32x4 t1[2]; t1[0] = (f32x4){0.f, 0.f, 0.f, 0.f}; t1[1] = t1[0];
#pragma unroll
            for (int ks = 0; ks < 8; ++ks) { const bf16x8 av_ = *(const LAS bf16x8*)(Zv + swz512(row, ks * 4 + g));
#pragma unroll
                for (int n = 0; n < 2; ++n) t1[n] = mfma16(*(const bf16x8*)(v1t + (16 * n + fr) * 256 + ks * 32 + g * 8), av_, t1[n]); }
#pragma unroll
            for (int n = 0; n < 2; ++n) { u32x2 w; w.x = pk2(t1[n][0], t1[n][1]); w.y = pk2(t1[n][2], t1[n][3]); *(LAS u32x2*)(V1 + fr * 64 + (16 * n + 4 * g) * 2) = w; }
            LDS_WAIT();
            a1 = *(const LAS bf16x8*)(V1 + fr * 64 + g * 16);
            LDS_WAIT();
        }
        const int t = t0 + 32 * half + 16 * m + fr;
        float ss = 0.f, bon = 0.f;
#pragma unroll 1
        for (int n = 0; n < 4; ++n) { const int ch = 64 * h + 16 * n + 4 * g;
            const bf16_t* pc = P + (size_t)t * NINP + C_D + ch; const bf16_t* pp = pc - NINP;
            const u32x2 kc = *(const u32x2*)(pc + 256); u32x2 kp = (u32x2){0u, 0u}; if (t > 0) kp = *(const u32x2*)(pp + 256);
            const f32x4 kcv = up4_(kc), kpv = up4_(kp), muk = *(const f32x4*)(mu + 256 + ch), kkv = *(const f32x4*)(kkp + ch);
#pragma unroll
            for (int j = 0; j < 4; ++j) { const float kk = (kcv[j] + (kpv[j] - kcv[j]) * muk[j]) * kkv[j]; ss += kk * kk; } }
        ss += __shfl_xor(ss, 16); ss += __shfl_xor(ss, 32);
        const float inn = 1.f / fmaxf(sqrtf(ss), 1e-12f);
#pragma unroll 1
        for (int n = 0; n < 4; ++n) { const int ch = 64 * h + 16 * n + 4 * g;
            asm volatile("" ::: "memory");
            const int nr = 64 * h + 16 * n + fr; const f32x4 z0 = (f32x4){0.f, 0.f, 0.f, 0.f};
            const f32x4 wl = mfma16(*(const bf16x8*)(w2t + nr * 32 + g * 8), aw, z0);
            const f32x4 al = mfma16(*(const bf16x8*)(a2t + nr * 32 + g * 8), aa, z0);
            f32x4 gl = mfma16(*(const bf16x8*)(g2t + nr * 64 + g * 8), ag0, z0); gl = mfma16(*(const bf16x8*)(g2t + nr * 64 + 32 + g * 8), ag1, gl);
            f32x4 vl = z0; if (l > 0) vl = mfma16(*(const bf16x8*)(v2t + nr * 32 + g * 8), a1, z0);
            const bf16_t* pc = P + (size_t)t * NINP + C_D + ch; const bf16_t* pp = pc - NINP;
            const u32x2 rc = *(const u32x2*)(pc), kc = *(const u32x2*)(pc + 256), vc = *(const u32x2*)(pc + 512);
            u32x2 rp = (u32x2){0u, 0u}, kp = rp, vp = rp; if (t > 0) { rp = *(const u32x2*)(pp); kp = *(const u32x2*)(pp + 256); vp = *(const u32x2*)(pp + 512); }
            const f32x4 rcv = up4_(rc), rpv = up4_(rp), kcv = up4_(kc), kpv = up4_(kp), vcv = up4_(vc), vpv = up4_(vp);
            u32x2 vf = (u32x2){0u, 0u}; if (l > 0) vf = *(const u32x2*)(VF + (size_t)t * 256 + ch);
            const f32x4 vfv = up4_(vf);
            const f32x4 mur = *(const f32x4*)(mu + ch), muk = *(const f32x4*)(mu + 256 + ch), muv = *(const f32x4*)(mu + 512 + ch);
            const f32x4 w0v = *(const f32x4*)(w0 + ch), a0v = *(const f32x4*)(a0 + ch), kkv = *(const f32x4*)(kkp + ch), kav = *(const f32x4*)(kap + ch), rkv = *(const f32x4*)(rkp + ch);
            f32x4 v0v = z0; if (l > 0) v0v = *(const f32x4*)(v0 + ch);
            f32x4 vout, ldv, zr, kmod, kp_, b_;
#pragma unroll
            for (int j = 0; j < 4; ++j) {
                const float r_ = rcv[j] + (rpv[j] - rcv[j]) * mur[j], k_ = kcv[j] + (kpv[j] - kcv[j]) * muk[j], v_ = vcv[j] + (vpv[j] - vcv[j]) * muv[j];
                const float wpre = w0v[j] + wl[j]; const float y = -wpre; const float sp = fmaxf(y, 0.f) + log1pf(__expf(-fabsf(y)));
                const float w = -sp - 0.5f; ldv[j] = -__expf(w);
                const float a = sigmoidf_(a0v[j] + al[j]);
                float vv = v_; if (l > 0) vv = v_ + (vfv[j] - v_) * sigmoidf_(v0v[j] + vl[j]);
                vout[j] = vv; zr[j] = r_;
                kp_[j] = k_ * kkv[j] * inn; b_[j] = kp_[j] * a;
                const float km = k_ * (1.f + (a - 1.f) * kav[j]); kmod[j] = km; bon += r_ * km * rkv[j]; }
            const size_t o = (size_t)t * 256 + ch;
            *(u32x2*)(Rr + o) = pk4_(zr); *(u32x2*)(Rk + o) = pk4_(kmod);
            { const u32x2 w = pk4_(vout); *(u32x2*)(Rv + o) = w; if (l == 0) *(u32x2*)(VF + o) = w; }
            *(u32x2*)(Rg + o) = pk4_(gl); *(u32x2*)(Rld + o) = pk4_(ldv);
            *(u32x2*)(Rkap + o) = pk4_(kp_); *(u32x2*)(Rb + o) = pk4_(b_);
        }
        bon += __shfl_xor(bon, 16); bon += __shfl_xor(bon, 32);
        if (g == 0) Rbon[(size_t)t * 4 + h] = bon;
    }
    __syncthreads();
}

__device__ __forceinline__ void mm_n(ldsp X, ldsp Y, int rb, int cb, int fr, int g, f32x4 (&acc)[2]) {
#pragma unroll
    for (int ks = 0; ks < 2; ++ks) { const bf16x8 xf = *(const LAS bf16x8*)(X + swz128(16 * rb + fr, ks * 4 + g));
#pragma unroll
        for (int n = 0; n < 2; ++n) { const bf16x8 yf = *(const LAS bf16x8*)(Y + swz128(32 * cb + 16 * n + fr, ks * 4 + g)); acc[n] = mfma16(yf, xf, acc[n]); } }
}
__device__ __forceinline__ void mm_t(ldsp X, ldsp Y, int rb, int cb, int fr, int g, f32x4 (&acc)[2]) {
#pragma unroll
    for (int ks = 0; ks < 2; ++ks) { const bf16x8 xf = *(const LAS bf16x8*)(X + swz128(16 * rb + fr, ks * 4 + g));
#pragma unroll
        for (int n = 0; n < 2; ++n) { const bf16x8 yf = *(const LAS bf16x8*)(Y + swz128(32 * cb + 16 * n + fr, ks * 4 + g)); acc[n] = mfma16(xf, yf, acc[n]); } }
}
__device__ __forceinline__ int adr_n(int rb, int cb, int n, int fr, int g) { return swz128(16 * rb + fr, 4 * cb + 2 * n + (g >> 1)) + (g & 1) * 8; }
__device__ __forceinline__ int adr_t(int rb, int cb, int n, int fr, int g) { return swz128(32 * cb + 16 * n + fr, 2 * rb + (g >> 1)) + (g & 1) * 8; }
__device__ __forceinline__ u32x2 pk4(f32x4 v) { u32x2 w; w.x = pk2(v[0], v[1]); w.y = pk2(v[2], v[3]); return w; }
__device__ __forceinline__ f32x4 up4(u32x2 w) { return (f32x4){bflo(w.x), bfhi(w.x), bflo(w.y), bfhi(w.y)}; }

__device__ __forceinline__ void chunk_prefix(Frame& F, const bf16_t* Rld, int t0, int h, LAS float* Lc, LAS float* seg) {
    { const int t = F.tid >> 3, c8 = F.tid & 7; const u32x4 v = *(const u32x4*)(Rld + (size_t)(t0 + t) * 256 + h * 64 + c8 * 8);
      LAS float* d = Lc + t * 64 + c8 * 8; d[0] = bflo(v.x); d[1] = bfhi(v.x); d[2] = bflo(v.y); d[3] = bfhi(v.y); d[4] = bflo(v.z); d[5] = bfhi(v.z); d[6] = bflo(v.w); d[7] = bfhi(v.w); }
    __syncthreads();
    { float s = 0.f;
#pragma unroll
      for (int i = 0; i < 8; ++i) { s += Lc[(8 * F.wave + i) * 64 + F.lane]; Lc[(8 * F.wave + i) * 64 + F.lane] = s; }
      seg[F.wave * 64 + F.lane] = s; }
    __syncthreads();
    { float off = 0.f;
      for (int w = 0; w < F.wave; ++w) off += seg[w * 64 + F.lane];
#pragma unroll
      for (int i = 0; i < 8; ++i) Lc[(8 * F.wave + i) * 64 + F.lane] += off; }
    __syncthreads();
}
__device__ __forceinline__ void unpack8(u32x4 v, float (&o)[8]) { o[0] = bflo(v.x); o[1] = bfhi(v.x); o[2] = bflo(v.y); o[3] = bfhi(v.y); o[4] = bflo(v.z); o[5] = bfhi(v.z); o[6] = bflo(v.w); o[7] = bfhi(v.w); }
__device__ __forceinline__ u32x4 pack8(const float (&o)[8]) { u32x4 w; w.x = pk2(o[0], o[1]); w.y = pk2(o[2], o[3]); w.z = pk2(o[4], o[5]); w.w = pk2(o[6], o[7]); return w; }
__device__ __forceinline__ void st_tr8(ldsp tile, int t, int c8, const float (&o)[8]) {
#pragma unroll
    for (int e = 0; e < 8; ++e) *(LAS unsigned short*)(tile + swz128(c8 * 8 + e, t >> 3) + (t & 7) * 2) = (unsigned short)f2bf(o[e]);
}

constexpr int R1_LC = 0, R1_SEG = 16384, R1_GC = 18432, R1_KQ = 20480, R1_BK = 28672, R1_KK = 36864, R1_KABS = 45056, R1_KABST = 53248, R1_BHT = 61440, R1_KHT = 69632, R1_VT = 77824,
              R1_E = 86016  , R1_Q = 102400  , R1_QT = 118784  , R1_AAK = 135168, R1_AVT = R1_Q, R1_W1T = R1_Q + 8192, R1_U0T = R1_QT;
__device__ __forceinline__ void rwkv_r1_item(Frame& F, int item) {
    const int c = item >> 2, h = item & 3, t0 = c * 64;
    const bf16_t *Rk = (const bf16_t*)(F.ws + RW_K), *Rv = (const bf16_t*)(F.ws + RW_V), *Rkap = (const bf16_t*)(F.ws + RW_KAP), *Rb = (const bf16_t*)(F.ws + RW_B), *Rld = (const bf16_t*)(F.ws + RW_LD);
    bf16_t *GW1 = (bf16_t*)(F.ws + RW_W1) + (size_t)item * 4096, *GU0T = (bf16_t*)(F.ws + RW_U0T) + (size_t)item * 4096, *GM = (bf16_t*)(F.ws + RW_M) + (size_t)item * 4096, *GN = (bf16_t*)(F.ws + RW_N) + (size_t)item * 4096;
    ldsp lds = F.lds; LAS float* Lc = (LAS float*)(lds + R1_LC); LAS float* seg = (LAS float*)(lds + R1_SEG); LAS float* GC = (LAS float*)(lds + R1_GC);
    const int rb = F.wave >> 1, cb = F.wave & 1, fr = F.lane & 15, g = F.lane >> 4;
    chunk_prefix(F, Rld, t0, h, Lc, seg);
    {   const int t = F.tid >> 3, c8 = F.tid & 7; const size_t go = (size_t)(t0 + t) * 256 + h * 64 + c8 * 8;
        float kap[8], b[8], k[8], v[8], o1[8], o2[8];
        unpack8(*(const u32x4*)(Rkap + go), kap); unpack8(*(const u32x4*)(Rb + go), b); unpack8(*(const u32x4*)(Rk + go), k); unpack8(*(const u32x4*)(Rv + go), v);
        float L[8], Lp[8], Lm[8], LC[8];
#pragma unroll
        for (int e = 0; e < 8; ++e) { const int cc = c8 * 8 + e; L[e] = Lc[t * 64 + cc]; Lp[e] = (t > 0) ? Lc[(t - 1) * 64 + cc] : 0.f; Lm[e] = Lc[31 * 64 + cc]; LC[e] = Lc[63 * 64 + cc]; }
#pragma unroll
        for (int e = 0; e < 8; ++e) o1[e] = kap[e] * __expf(Lp[e] - Lm[e]);
        *(LAS u32x4*)(lds + R1_KQ + swz128(t, c8)) = pack8(o1);
#pragma unroll
        for (int e = 0; e < 8; ++e) o1[e] = kap[e] * __expf(Lp[e]);
        *(LAS u32x4*)(lds + R1_KABS + swz128(t, c8)) = pack8(o1); st_tr8(lds + R1_KABST, t, c8, o1);
#pragma unroll
        for (int e = 0; e < 8; ++e) { const float s = __expf(Lm[e] - L[e]); o1[e] = b[e] * s; o2[e] = k[e] * s; }
        *(LAS u32x4*)(lds + R1_BK + swz128(t, c8)) = pack8(o1); *(LAS u32x4*)(lds + R1_KK + swz128(t, c8)) = pack8(o2);
#pragma unroll
        for (int e = 0; e < 8; ++e) { const float s = __expf(LC[e] - L[e]); o1[e] = b[e] * s; o2[e] = k[e] * s; }
        st_tr8(lds + R1_BHT, t, c8, o1); st_tr8(lds + R1_KHT, t, c8, o2); st_tr8(lds + R1_VT, t, c8, v);
        if (t == 63) {
#pragma unroll
            for (int e = 0; e < 8; ++e) GC[c8 * 8 + e] = __expf(LC[e]); }
    }
    __syncthreads();
    {
        f32x4 a[2] = {(f32x4){0.f, 0.f, 0.f, 0.f}, (f32x4){0.f, 0.f, 0.f, 0.f}}, at[2] = {a[0], a[0]}, k2[2] = {a[0], a[0]};
        mm_n(lds + R1_KQ, lds + R1_BK, rb, cb, fr, g, a); mm_t(lds + R1_KQ, lds + R1_BK, rb, cb, fr, g, at); mm_n(lds + R1_KQ, lds + R1_KK, rb, cb, fr, g, k2);
#pragma unroll
        for (int n = 0; n < 2; ++n) {
            f32x4 m1, m2, m3;
#pragma unroll
            for (int j = 0; j < 4; ++j) { const int tn = 16 * rb + fr, sn = 32 * cb + 16 * n + 4 * g + j; m1[j] = (sn < tn) ? a[n][j] : 0.f; m3[j] = (sn < tn) ? k2[n][j] : 0.f;
                const int tt = 16 * rb + 4 * g + j, st = 32 * cb + 16 * n + fr; m2[j] = (st < tt) ? at[n][j] : 0.f; }
            *(LAS u32x2*)(lds + R1_Q + adr_n(rb, cb, n, fr, g)) = pk4(m1); *(LAS u32x2*)(lds + R1_E + adr_n(rb, cb, n, fr, g)) = pk4(-m1);
            *(LAS u32x2*)(lds + R1_QT + adr_t(rb, cb, n, fr, g)) = pk4(m2); *(LAS u32x2*)(lds + R1_AAK + adr_n(rb, cb, n, fr, g)) = pk4(m3); }
    }
    __syncthreads();
    {
        f32x4 a[2] = {(f32x4){0.f, 0.f, 0.f, 0.f}, (f32x4){0.f, 0.f, 0.f, 0.f}}, at[2] = {a[0], a[0]};
        mm_n(lds + R1_Q, lds + R1_QT, rb, cb, fr, g, a); mm_t(lds + R1_Q, lds + R1_QT, rb, cb, fr, g, at);
#pragma unroll
        for (int n = 0; n < 2; ++n) { *(LAS u32x2*)(lds + R1_Q + 8192 + adr_n(rb, cb, n, fr, g)) = pk4(a[n]); *(LAS u32x2*)(lds + R1_QT + 8192 + adr_t(rb, cb, n, fr, g)) = pk4(at[n]); }
    }
    __syncthreads();
#pragma unroll 1
    for (int it = 0; it < 5; ++it) {
        ldsp Ecur = lds + R1_E + (it & 1) * 8192, Enew = lds + R1_E + ((it + 1) & 1) * 8192;
        ldsp Qcur = lds + R1_Q + ((it + 1) & 1) * 8192, Qnew = lds + R1_Q + (it & 1) * 8192, QTcur = lds + R1_QT + ((it + 1) & 1) * 8192, QTnew = lds + R1_QT + (it & 1) * 8192;
        f32x4 e[2];
#pragma unroll
        for (int n = 0; n < 2; ++n) e[n] = up4(*(const LAS u32x2*)(Ecur + adr_n(rb, cb, n, fr, g))) + up4(*(const LAS u32x2*)(Qcur + adr_n(rb, cb, n, fr, g)));
        mm_n(Ecur, QTcur, rb, cb, fr, g, e);
#pragma unroll
        for (int n = 0; n < 2; ++n) *(LAS u32x2*)(Enew + adr_n(rb, cb, n, fr, g)) = pk4(e[n]);
        if (it < 4) {
            f32x4 a[2] = {(f32x4){0.f, 0.f, 0.f, 0.f}, (f32x4){0.f, 0.f, 0.f, 0.f}}, at[2] = {a[0], a[0]};
            mm_n(Qcur, QTcur, rb, cb, fr, g, a); mm_t(Qcur, QTcur, rb, cb, fr, g, at);
#pragma unroll
            for (int n = 0; n < 2; ++n) { *(LAS u32x2*)(Qnew + adr_n(rb, cb, n, fr, g)) = pk4(a[n]); *(LAS u32x2*)(QTnew + adr_t(rb, cb, n, fr, g)) = pk4(at[n]); }
        }
        __syncthreads();
    }
    ldsp Ef = lds + R1_E + 8192;
    f32x4 avn[2];
    {
        avn[0] = (f32x4){0.f, 0.f, 0.f, 0.f}; avn[1] = avn[0]; f32x4 avt[2] = {avn[0], avn[0]};
        mm_n(lds + R1_AAK, lds + R1_VT, rb, cb, fr, g, avn); mm_t(lds + R1_AAK, lds + R1_VT, rb, cb, fr, g, avt);
        f32x4 w[2], wt[2];
#pragma unroll
        for (int n = 0; n < 2; ++n) { w[n] = up4(*(const LAS u32x2*)(lds + R1_KABS + adr_n(rb, cb, n, fr, g))); wt[n] = up4(*(const LAS u32x2*)(lds + R1_KABST + adr_t(rb, cb, n, fr, g))); }
        mm_n(Ef, lds + R1_KABST, rb, cb, fr, g, w); mm_t(Ef, lds + R1_KABST, rb, cb, fr, g, wt);
#pragma unroll
        for (int n = 0; n < 2; ++n) { *(LAS u32x2*)(lds + R1_AVT + adr_t(rb, cb, n, fr, g)) = pk4(avt[n]); *(LAS u32x2*)(lds + R1_W1T + adr_t(rb, cb, n, fr, g)) = pk4(wt[n]);
            *(u32x2*)(GW1 + (16 * rb + fr) * 64 + 32 * cb + 16 * n + 4 * g) = pk4(w[n]); }
    }
    __syncthreads();
    {
        f32x4 ut[2];
#pragma unroll
        for (int n = 0; n < 2; ++n) ut[n] = up4(*(const LAS u32x2*)(lds + R1_AVT + adr_t(rb, cb, n, fr, g)));
        mm_t(Ef, lds + R1_AVT, rb, cb, fr, g, ut);
        (void)avn;
#pragma unroll
        for (int n = 0; n < 2; ++n) { *(LAS u32x2*)(lds + R1_U0T + adr_t(rb, cb, n, fr, g)) = pk4(ut[n]); *(u32x2*)(GU0T + (32 * cb + 16 * n + fr) * 64 + 16 * rb + 4 * g) = pk4(ut[n]); }
    }
    __syncthreads();
    {
        f32x4 m[2] = {(f32x4){0.f, 0.f, 0.f, 0.f}, (f32x4){0.f, 0.f, 0.f, 0.f}}, n1[2] = {m[0], m[0]}, n2[2] = {m[0], m[0]};
        mm_n(lds + R1_BHT, lds + R1_W1T, rb, cb, fr, g, m); mm_t(lds + R1_KHT, lds + R1_VT, rb, cb, fr, g, n1); mm_t(lds + R1_BHT, lds + R1_U0T, rb, cb, fr, g, n2);
        float mo[8];
#pragma unroll
        for (int n = 0; n < 2; ++n)
#pragma unroll
            for (int j = 0; j < 4; ++j) { const int cr = 16 * rb + fr, cc = 32 * cb + 16 * n + 4 * g + j; mo[n * 4 + j] = ((cr == cc) ? GC[cr] : 0.f) - m[n][j]; }
        *(u32x4*)(GM + ((rb * 2 + cb) * 64 + F.lane) * 8) = pack8(mo);
#pragma unroll
        for (int n = 0; n < 2; ++n) *(u32x2*)(GN + (((2 * cb + n) * 4 + rb) * 64 + F.lane) * 4) = pk4(n1[n] - n2[n]);
    }
    __syncthreads();
}

constexpr int P2_NS = 8, P2_CTR = P2_NS * 16384;
__device__ __forceinline__ unsigned lds_poll(volatile LAS unsigned* p) { return *p; }
__device__ __forceinline__ void rwkv_p2(Frame& F, int h) {
    constexpr int NCH = T_ / 64;
    ldsp lds = F.lds;
    volatile LAS unsigned* full = (volatile LAS unsigned*)(lds + P2_CTR); volatile LAS unsigned* done = full + 16;
    if (F.tid < 32) full[F.tid] = 0u;
    __syncthreads();
    const bf16_t* GM = (const bf16_t*)(F.ws + RW_M); const bf16_t* GN = (const bf16_t*)(F.ws + RW_N); bf16_t* GS = (bf16_t*)(F.ws + RW_S0);
    if (F.wave >= 4) {
        const int lw = F.wave - 4;
        u32x4 r[8][4];
#pragma unroll
        for (int d = 0; d < 8; ++d) { const size_t base = (size_t)(d * 4 + h) * 4096;
#pragma unroll
            for (int i = 0; i < 4; ++i) { const int q = (i & 1) * 256 + lw * 64 + F.lane; r[d][i] = *(const u32x4*)(((i < 2) ? GM : GN) + base + q * 8); } }
#pragma unroll 1
        for (int s0 = 0; s0 < NCH; s0 += 8) {
#pragma unroll
            for (int d = 0; d < 8; ++d) { const int s = s0 + d;
                const unsigned need = 4u * (unsigned)(s >> 3);
                while (lds_poll(done + d) < need) __builtin_amdgcn_s_sleep(1);
                asm volatile("" ::: "memory");
#pragma unroll
                for (int i = 0; i < 4; ++i) { const int q = (i & 1) * 256 + lw * 64 + F.lane; *(LAS u32x4*)(lds + d * 16384 + (i >> 1) * 8192 + q * 16) = r[d][i]; }
                asm volatile("s_waitcnt lgkmcnt(0)" ::: "memory");
                if (F.lane == 0) __hip_atomic_fetch_add((LAS unsigned*)(full + d), 1u, __ATOMIC_RELAXED, __HIP_MEMORY_SCOPE_WORKGROUP);
                if (s + 8 < NCH) { const size_t base = (size_t)((s + 8) * 4 + h) * 4096;
#pragma unroll
                    for (int i = 0; i < 4; ++i) { const int q = (i & 1) * 256 + lw * 64 + F.lane; r[d][i] = *(const u32x4*)(((i < 2) ? GM : GN) + base + q * 8); } }
            }
        }
    } else {
        const int cb2 = F.wave, fr = F.lane & 15, g = F.lane >> 4;
        f32x4 S[4];
#pragma unroll
        for (int mt = 0; mt < 4; ++mt) S[mt] = (f32x4){0.f, 0.f, 0.f, 0.f};
#pragma unroll 1
        for (int c = 0; c < NCH; ++c) {
            const int slot = c & 7; const size_t base = (size_t)(c * 4 + h) * 4096;
            u32x4 sw[2];
#pragma unroll
            for (int ks = 0; ks < 2; ++ks) { const u32x2 lo = pk4(S[2 * ks]), hi = pk4(S[2 * ks + 1]); sw[ks] = (u32x4){lo.x, lo.y, hi.x, hi.y}; }
#pragma unroll
            for (int mt = 0; mt < 4; ++mt) { const u32x2 w = (mt & 1) ? (u32x2){sw[mt >> 1].z, sw[mt >> 1].w} : (u32x2){sw[mt >> 1].x, sw[mt >> 1].y};
                *(u32x2*)(GS + base + (16 * cb2 + fr) * 64 + 16 * mt + 4 * g) = w; }
            const unsigned need = 4u * (unsigned)((c >> 3) + 1);
            while (lds_poll(full + slot) < need) __builtin_amdgcn_s_sleep(0);
            asm volatile("" ::: "memory");
            bf16x8 Mf[4][2]; u32x2 Nf[4];
            ldsp sl = lds + slot * 16384;
#pragma unroll
            for (int mt = 0; mt < 4; ++mt) { Nf[mt] = *(const LAS u32x2*)(sl + 8192 + ((cb2 * 4 + mt) * 64 + F.lane) * 8);
#pragma unroll
                for (int ks = 0; ks < 2; ++ks) Mf[mt][ks] = *(const LAS bf16x8*)(sl + ((mt * 2 + ks) * 64 + F.lane) * 16); }
            asm volatile("s_waitcnt lgkmcnt(0)" ::: "memory");
            if (F.lane == 0) __hip_atomic_fetch_add((LAS unsigned*)(done + slot), 1u, __ATOMIC_RELAXED, __HIP_MEMORY_SCOPE_WORKGROUP);
#pragma unroll
            for (int mt = 0; mt < 4; ++mt) { f32x4 a = up4(Nf[mt]);
#pragma unroll
                for (int ks = 0; ks < 2; ++ks) a = mfma16(Mf[mt][ks], __builtin_bit_cast(bf16x8, sw[ks]), a);
                S[mt] = a; }
        }
    }
    __syncthreads();
}

constexpr int R3_RQ = 20480, R3_RABS = 28672, R3_BK = 36864, R3_KK = 45056, R3_VT = 53248, R3_S = 61440, R3_W1 = 69632, R3_UT = 77824, R3_ARB = 86016, R3_ARK = 94208, R3_ST = 102400;
__device__ __forceinline__ void rwkv_p3_item(Frame& F, int l, int item) {
    const int c = item >> 2, h = item & 3, t0 = c * 64;
    const bf16_t *Rr = (const bf16_t*)(F.ws + RW_R), *Rk = (const bf16_t*)(F.ws + RW_K), *Rv = (const bf16_t*)(F.ws + RW_V), *Rb = (const bf16_t*)(F.ws + RW_B), *Rg = (const bf16_t*)(F.ws + RW_G), *Rld = (const bf16_t*)(F.ws + RW_LD);
    const bf16_t *GW1 = (const bf16_t*)(F.ws + RW_W1) + (size_t)item * 4096, *GU0T = (const bf16_t*)(F.ws + RW_U0T) + (size_t)item * 4096, *GS = (const bf16_t*)(F.ws + RW_S0) + (size_t)item * 4096;
    const float* Rbon = (const float*)(F.ws + RW_BONUS); bf16_t* ycat = (bf16_t*)(F.ws + WS_ACT);
    ldsp lds = F.lds; LAS float* Lc = (LAS float*)(lds + R1_LC); LAS float* seg = (LAS float*)(lds + R1_SEG); LAS float* ST = (LAS float*)(lds + R3_ST);
    const int rb = F.wave >> 1, cb = F.wave & 1, fr = F.lane & 15, g = F.lane >> 4;
    chunk_prefix(F, Rld, t0, h, Lc, seg);
    {   const int t = F.tid >> 3, c8 = F.tid & 7; const size_t go = (size_t)(t0 + t) * 256 + h * 64 + c8 * 8;
        float r[8], b[8], k[8], v[8], o1[8], o2[8];
        unpack8(*(const u32x4*)(Rr + go), r); unpack8(*(const u32x4*)(Rb + go), b); unpack8(*(const u32x4*)(Rk + go), k); unpack8(*(const u32x4*)(Rv + go), v);
        float L[8], Lm[8];
#pragma unroll
        for (int e = 0; e < 8; ++e) { const int cc = c8 * 8 + e; L[e] = Lc[t * 64 + cc]; Lm[e] = Lc[31 * 64 + cc]; }
#pragma unroll
        for (int e = 0; e < 8; ++e) { o1[e] = r[e] * __expf(L[e] - Lm[e]); o2[e] = r[e] * __expf(L[e]); }
        *(LAS u32x4*)(lds + R3_RQ + swz128(t, c8)) = pack8(o1); *(LAS u32x4*)(lds + R3_RABS + swz128(t, c8)) = pack8(o2);
#pragma unroll
        for (int e = 0; e < 8; ++e) { const float s = __expf(Lm[e] - L[e]); o1[e] = b[e] * s; o2[e] = k[e] * s; }
        *(LAS u32x4*)(lds + R3_BK + swz128(t, c8)) = pack8(o1); *(LAS u32x4*)(lds + R3_KK + swz128(t, c8)) = pack8(o2);
        st_tr8(lds + R3_VT, t, c8, v);
        *(LAS u32x4*)(lds + R3_S + swz128(t, c8)) = *(const u32x4*)(GS + t * 64 + c8 * 8);
        *(LAS u32x4*)(lds + R3_W1 + swz128(t, c8)) = *(const u32x4*)(GW1 + t * 64 + c8 * 8);
    }
    __syncthreads();
    f32x4 y[2];
    {   f32x4 ut[2];
#pragma unroll
        for (int n = 0; n < 2; ++n) ut[n] = up4(*(const u32x2*)(GU0T + (32 * cb + 16 * n + fr) * 64 + 16 * rb + 4 * g));
        mm_t(lds + R3_W1, lds + R3_S, rb, cb, fr, g, ut);
        f32x4 ab[2] = {(f32x4){0.f, 0.f, 0.f, 0.f}, (f32x4){0.f, 0.f, 0.f, 0.f}}, ak[2] = {ab[0], ab[0]};
        mm_n(lds + R3_RQ, lds + R3_BK, rb, cb, fr, g, ab); mm_n(lds + R3_RQ, lds + R3_KK, rb, cb, fr, g, ak);
        y[0] = (f32x4){0.f, 0.f, 0.f, 0.f}; y[1] = y[0];
        mm_n(lds + R3_RABS, lds + R3_S, rb, cb, fr, g, y);
#pragma unroll
        for (int n = 0; n < 2; ++n) {
            f32x4 m1, m2;
#pragma unroll
            for (int j = 0; j < 4; ++j) { const int tn = 16 * rb + fr, sn = 32 * cb + 16 * n + 4 * g + j; m1[j] = (sn <= tn) ? ab[n][j] : 0.f; m2[j] = (sn <= tn) ? ak[n][j] : 0.f; }
            *(LAS u32x2*)(lds + R3_UT + adr_t(rb, cb, n, fr, g)) = pk4(ut[n]);
            *(LAS u32x2*)(lds + R3_ARB + adr_n(rb, cb, n, fr, g)) = pk4(m1); *(LAS u32x2*)(lds + R3_ARK + adr_n(rb, cb, n, fr, g)) = pk4(m2); }
    }
    __syncthreads();
    {   f32x4 z[2] = {(f32x4){0.f, 0.f, 0.f, 0.f}, (f32x4){0.f, 0.f, 0.f, 0.f}};
        mm_n(lds + R3_ARB, lds + R3_UT, rb, cb, fr, g, z); mm_n(lds + R3_ARK, lds + R3_VT, rb, cb, fr, g, y);
        y[0] -= z[0]; y[1] -= z[1];
        float s1 = 0.f, s2 = 0.f;
#pragma unroll
        for (int n = 0; n < 2; ++n)
#pragma unroll
            for (int j = 0; j < 4; ++j) { s1 += y[n][j]; s2 += y[n][j] * y[n][j]; }
        s1 += __shfl_xor(s1, 16); s1 += __shfl_xor(s1, 32); s2 += __shfl_xor(s2, 16); s2 += __shfl_xor(s2, 32);
        if (g == 0) { ST[((16 * rb + fr) * 2 + cb) * 2] = s1; ST[((16 * rb + fr) * 2 + cb) * 2 + 1] = s2; }
    }
    __syncthreads();
    {   const int tl = 16 * rb + fr; const int t = t0 + tl;
        const float s1 = ST[(tl * 2) * 2] + ST[(tl * 2 + 1) * 2], s2 = ST[(tl * 2) * 2 + 1] + ST[(tl * 2 + 1) * 2 + 1];
        const float mean = s1 * (1.f / 64.f), var = fmaxf(s2 * (1.f / 64.f) - mean * mean, 0.f), rstd = 1.f / sqrtf(var + 64e-5f);
        const float bon = Rbon[(size_t)t * 4 + h];
        const float *lng = F.in[21] + l * 256 + h * 64, *lnb = F.in[22] + l * 256 + h * 64;
#pragma unroll
        for (int n = 0; n < 2; ++n) { const int i0 = 32 * cb + 16 * n + 4 * g; const size_t go = (size_t)t * 256 + h * 64 + i0;
            const f32x4 vv = up4(*(const u32x2*)(Rv + go)), gg = up4(*(const u32x2*)(Rg + go)); const f32x4 lg = *(const f32x4*)(lng + i0), lb = *(const f32x4*)(lnb + i0);
            f32x4 o;
#pragma unroll
            for (int j = 0; j < 4; ++j) o[j] = ((y[n][j] - mean) * rstd * lg[j] + lb[j] + bon * vv[j]) * gg[j];
            *(u32x2*)(ycat + (size_t)t * DM + 768 + h * 64 + i0) = pk4(o); }
    }
    __syncthreads();
}

__device__ __forceinline__ void phase_router(Frame& F, int l, int alt = 0) {
    const float* X = F.out;
    const bf16_t* WH = (const bf16_t*)(F.ws + WS_WRH); const bf16_t* WL = (const bf16_t*)(F.ws + WS_WRL);
    const float* bias_r = (const float*)(F.ws + WS_BR);
    float* rinv2 = (float*)(F.ws + WS_RINV2);
    unsigned* cnt = (unsigned*)(F.ws + WS_CTL) + l * 64 + alt * 128;
    unsigned* list = (unsigned*)(F.ws + (alt ? WS_P + (size_t)alt * 8 * MiB : WS_LIST)); float* wlist = (float*)(F.ws + (alt ? WS_P + (size_t)alt * 8 * MiB + 2 * MiB : WS_WLIST));
    LAS float* Lg = (LAS float*)(F.lds + F.wave * 4096);
    const int fr = F.lane & 15, g = F.lane >> 4;
    const int gw = F.bid * NWAVES + F.wave, NGW = F.G * NWAVES;
    for (int it = gw; it < T_ / 16; it += NGW) {
        const int t = it * 16 + fr;
        const float* xr = X + (size_t)t * DM + g * 8;
        f32x4 acc[3]; acc[0] = (f32x4){0.f, 0.f, 0.f, 0.f}; acc[1] = acc[0]; acc[2] = acc[0];
        float ss = 0.f;
#pragma unroll 2
        for (int ks = 0; ks < 32; ++ks) {
            const f32x4 x0 = *(const f32x4*)(xr + ks * 32), x1 = *(const f32x4*)(xr + ks * 32 + 4);
            const float xv[8] = {x0[0], x0[1], x0[2], x0[3], x1[0], x1[1], x1[2], x1[3]};
            unsigned hh[8], ll[8];
#pragma unroll
            for (int e = 0; e < 8; ++e) { ss += xv[e] * xv[e]; hh[e] = f2bf(xv[e]); ll[e] = f2bf(xv[e] - bf2f(hh[e])); }
            u32x4 hw, lw; hw.x = hh[0] | (hh[1] << 16); hw.y = hh[2] | (hh[3] << 16); hw.z = hh[4] | (hh[5] << 16); hw.w = hh[6] | (hh[7] << 16);
            lw.x = ll[0] | (ll[1] << 16); lw.y = ll[2] | (ll[3] << 16); lw.z = ll[4] | (ll[5] << 16); lw.w = ll[6] | (ll[7] << 16);
            const bf16x8 xh = __builtin_bit_cast(bf16x8, hw), xl = __builtin_bit_cast(bf16x8, lw);
#pragma unroll
            for (int n = 0; n < 3; ++n) { const bf16x8 wh = *(const bf16x8*)(WH + (16 * n + fr) * DM + ks * 32 + g * 8), wl = *(const bf16x8*)(WL + (16 * n + fr) * DM + ks * 32 + g * 8);
                acc[n] = mfma16(wh, xh, acc[n]); acc[n] = mfma16(wh, xl, acc[n]); acc[n] = mfma16(wl, xh, acc[n]); }
        }
        ss += __shfl_xor(ss, 16); ss += __shfl_xor(ss, 32);
        const float rinv = 1.f / sqrtf(ss * (1.f / DM) + 1e-6f);
#pragma unroll
        for (int n = 0; n < 3; ++n)
#pragma unroll
            for (int j = 0; j < 4; ++j) { const int c = 16 * n + 4 * g + j; Lg[fr * 48 + c] = acc[n][j] * rinv + bias_r[c]; }
        LDS_WAIT();
        if (F.lane < 16) {
            const LAS float* lg = Lg + F.lane * 48; const int tt = it * 16 + F.lane;
            rinv2[tt] = rinv;
            int gi = 0; float gm = lg[0];
#pragma unroll
            for (int k = 1; k < 4; ++k) if (lg[k] > gm) { gm = lg[k]; gi = k; }
            float gs = 0.f;
#pragma unroll
            for (int k = 0; k < 4; ++k) gs += __expf(lg[k] - gm);
            const float gp = 1.f / gs;
            int e0 = 0; float v0 = lg[4 + gi * 8];
#pragma unroll
            for (int k = 1; k < 8; ++k) { const float v = lg[4 + gi * 8 + k]; if (v > v0) { v0 = v; e0 = k; } }
            int e1 = -1; float v1 = -INFINITY;
#pragma unroll
            for (int k = 0; k < 8; ++k) { const float v = lg[4 + gi * 8 + k]; if (k != e0 && v > v1) { v1 = v; e1 = k; } }
            const float ex = __expf(v1 - v0); const float w0 = gp / (1.f + ex), w1 = gp * ex / (1.f + ex);
            const int E0 = gi * 8 + e0, E1 = gi * 8 + e1;
            const unsigned p0 = atomicAdd(&cnt[E0], 1u); list[(size_t)E0 * T_ + p0] = (unsigned)tt; wlist[(size_t)E0 * T_ + p0] = w0;
            const unsigned p1 = atomicAdd(&cnt[E1], 1u); list[(size_t)E1 * T_ + p1] = (unsigned)tt | 0x80000000u; wlist[(size_t)E1 * T_ + p1] = w1;
        }
        LDS_WAIT();
    }
}

__device__ __forceinline__ void phase_moe(Frame& F, int l) {
    const bf16_t* XB = (const bf16_t*)(F.ws + WS_RW);
    const bf16_t* WGU = (const bf16_t*)(F.ws + WS_WGU); const bf16_t* WD = (const bf16_t*)(F.ws + WS_WD);
    const float* bias_gu = (const float*)(F.ws + WS_BGU); const float* rinv2 = (const float*)(F.ws + WS_RINV2);
    const unsigned* cnt = (const unsigned*)(F.ws + WS_CTL) + l * 64;
    const unsigned* list = (const unsigned*)(F.ws + WS_LIST); const float* wlist = (const float*)(F.ws + WS_WLIST);
    bf16_t* ys = (bf16_t*)(F.ws + WS_P);
    ldsp At = F.lds, Bt = F.lds + 16384, Bd = F.lds, Act = F.lds + 65536;
    LAS unsigned* tokl = (LAS unsigned*)(F.lds + 98304); LAS float* wtl = (LAS float*)(F.lds + 98304 + 512); LAS float* rvl = (LAS float*)(F.lds + 98304 + 1024);
    const int wr = F.wave >> 2, wc = F.wave & 3, fr = F.lane & 15, g = F.lane >> 4;
    int total = 0;
    for (int e = 0; e < 32; ++e) total += ((int)cnt[e] + 127) >> 7;
    for (int ti = F.bid; ti < total; ti += F.G) {
        int e = 0, acc_t = 0, m0 = 0, ne = 0;
        for (int k = 0; k < 32; ++k) { const int n = (int)cnt[k]; const int nt = (n + 127) >> 7; if (ti >= acc_t && ti < acc_t + nt) { e = k; m0 = (ti - acc_t) * 128; ne = n; } acc_t += nt; }
        const int nrows = (ne - m0) < 128 ? (ne - m0) : 128;
        __syncthreads();
        if (F.tid < 128) { unsigned tk = 0u; float w = 0.f; if (F.tid < nrows) { tk = list[(size_t)e * T_ + m0 + F.tid]; w = wlist[(size_t)e * T_ + m0 + F.tid]; }
            tokl[F.tid] = tk; wtl[F.tid] = w; rvl[F.tid] = rinv2[tk & 0x7fffffffu]; }
        __syncthreads();
        f32x4 ag[4][2], au[4][2];
#pragma unroll
        for (int m = 0; m < 4; ++m)
#pragma unroll
            for (int n = 0; n < 2; ++n) { ag[m][n] = (f32x4){0.f, 0.f, 0.f, 0.f}; au[m][n] = ag[m][n]; }
        const bf16_t* wgu = WGU + (size_t)e * 256 * DM;
        for (int kt = 0; kt < 16; ++kt) {
            u32x4 ra[2], rb[4];
#pragma unroll
            for (int i = 0; i < 2; ++i) { const int idx = F.tid + i * NTHR, row = idx >> 3, c = idx & 7; const unsigned tk = tokl[row] & 0x7fffffffu; ra[i] = *(const u32x4*)(XB + (size_t)tk * DM + kt * 64 + c * 8); }
#pragma unroll
            for (int i = 0; i < 4; ++i) { const int idx = F.tid + i * NTHR, row = idx >> 3, c = idx & 7; rb[i] = *(const u32x4*)(wgu + (size_t)row * DM + kt * 64 + c * 8); }
            __syncthreads();
#pragma unroll
            for (int i = 0; i < 2; ++i) { const int idx = F.tid + i * NTHR, row = idx >> 3, c = idx & 7; *(LAS u32x4*)(At + swz128(row, c)) = ra[i]; }
#pragma unroll
            for (int i = 0; i < 4; ++i) { const int idx = F.tid + i * NTHR, row = idx >> 3, c = idx & 7; *(LAS u32x4*)(Bt + swz128(row, c)) = rb[i]; }
            __syncthreads();
#pragma unroll
            for (int ks = 0; ks < 2; ++ks) {
                bf16x8 af[4], bg_[2], bu_[2];
#pragma unroll
                for (int m = 0; m < 4; ++m) af[m] = *(const LAS bf16x8*)(At + swz128(64 * wr + 16 * m + fr, ks * 4 + g));
#pragma unroll
                for (int n = 0; n < 2; ++n) { bg_[n] = *(const LAS bf16x8*)(Bt + swz128(32 * wc + 16 * n + fr, ks * 4 + g)); bu_[n] = *(const LAS bf16x8*)(Bt + swz128(128 + 32 * wc + 16 * n + fr, ks * 4 + g)); }
#pragma unroll
                for (int m = 0; m < 4; ++m)
#pragma unroll
                    for (int n = 0; n < 2; ++n) { ag[m][n] = mfma16(bg_[n], af[m], ag[m][n]); au[m][n] = mfma16(bu_[n], af[m], au[m][n]); }
            }
        }
        const float* bge = bias_gu + e * 256;
#pragma unroll
        for (int m = 0; m < 4; ++m) { const int row = 64 * wr + 16 * m + fr; const float rv = rvl[row], wt = wtl[row];
#pragma unroll
            for (int n = 0; n < 2; ++n) { const int f0 = 32 * wc + 16 * n + 4 * g; float a_[4];
#pragma unroll
                for (int j = 0; j < 4; ++j) { const float gv = ag[m][n][j] * rv + bge[f0 + j], uv = au[m][n][j] * rv + bge[128 + f0 + j]; a_[j] = gv * sigmoidf_(gv) * uv * wt; }
                u32x2 w; w.x = pk2(a_[0], a_[1]); w.y = pk2(a_[2], a_[3]);
                *(LAS u32x2*)(Act + swz256(row, f0 >> 3) + (g & 1) * 8) = w; } }
        const bf16_t* wd = WD + (size_t)e * DM * 128;
#pragma unroll 1
        for (int nc = 0; nc < 4; ++nc) {
            __syncthreads();
#pragma unroll
            for (int i = 0; i < 8; ++i) { const int idx = F.tid + i * NTHR, row = idx >> 4, c = idx & 15; *(LAS u32x4*)(Bd + swz256(row, c)) = *(const u32x4*)(wd + (size_t)(nc * 256 + row) * 128 + c * 8); }
            __syncthreads();
            f32x4 ao[4][4];
#pragma unroll
            for (int m = 0; m < 4; ++m)
#pragma unroll
                for (int n = 0; n < 4; ++n) ao[m][n] = (f32x4){0.f, 0.f, 0.f, 0.f};
#pragma unroll
            for (int ks = 0; ks < 4; ++ks) {
                bf16x8 af[4], bf_[4];
#pragma unroll
                for (int m = 0; m < 4; ++m) af[m] = *(const LAS bf16x8*)(Act + swz256(64 * wr + 16 * m + fr, ks * 4 + g));
#pragma unroll
                for (int n = 0; n < 4; ++n) bf_[n] = *(const LAS bf16x8*)(Bd + swz256(64 * wc + 16 * n + fr, ks * 4 + g));
#pragma unroll
                for (int m = 0; m < 4; ++m)
#pragma unroll
                    for (int n = 0; n < 4; ++n) ao[m][n] = mfma16(bf_[n], af[m], ao[m][n]);
            }
#pragma unroll
            for (int m = 0; m < 4; ++m) { const int row = 64 * wr + 16 * m + fr;
                if (row < nrows) { const unsigned tk = tokl[row]; bf16_t* dst = ys + ((size_t)(tk >> 31) * T_ + (tk & 0x7fffffffu)) * DM + nc * 256 + 64 * wc + 4 * g;
#pragma unroll
                    for (int n = 0; n < 4; ++n) { u32x2 w; w.x = pk2(ao[m][n][0], ao[m][n][1]); w.y = pk2(ao[m][n][2], ao[m][n][3]); *(u32x2*)(dst + 16 * n) = w; } } }
        }
    }
    __syncthreads();
}

#define XB_TMO      128
#define XB_XCNT(j)  (256  + 64 * (j))
#define XB_XSUB(j)  (1280 + 64 * (j))
#define XB_XGEN(j)  (2304 + 64 * (j))
#define XB_TOP      3328
#define XB_TOPGEN   3392
#define XCD_BAR_WORDS 3456
#define XB_SPIN_CAP (1u << 18)
__device__ __forceinline__ unsigned xb_ld(unsigned* p)              { return __hip_atomic_load(p, __ATOMIC_RELAXED, __HIP_MEMORY_SCOPE_AGENT); }
__device__ __forceinline__ unsigned xb_add(unsigned* p, unsigned v) { return __hip_atomic_fetch_add(p, v, __ATOMIC_RELAXED, __HIP_MEMORY_SCOPE_AGENT); }
__device__ __forceinline__ unsigned xb_xcc_id() { return (unsigned)__builtin_amdgcn_s_getreg((3 << 11) | 20) & 0xFu; }
#define XB_SPIN(cond, bar) do { unsigned _sp = 0; while (cond) { __builtin_amdgcn_s_sleep(1); \
    if ((++_sp & 255u) == 0u) { if (xb_ld(&(bar)[XB_TMO])) break; if (_sp > XB_SPIN_CAP) { atomicAdd(&(bar)[XB_TMO], 1u); break; } } } } while (0)
struct XcdBarrier { unsigned* bar; unsigned x; volatile LAS unsigned* st; };
__device__ __forceinline__ XcdBarrier xcd_barrier_post(unsigned* bar, volatile LAS unsigned* st) {
    XcdBarrier b; b.bar = bar; b.x = xb_xcc_id(); b.st = st;
    if (threadIdx.x == 0) (void)xb_add(&bar[XB_XCNT(b.x)], 1u);
    return b;
}
__device__ __forceinline__ void xcd_barrier_complete(unsigned* bar, unsigned x, unsigned& nloc, unsigned& nx) {
    const unsigned G = gridDim.x * gridDim.y * gridDim.z;
    unsigned sum, cnt, mine, sp = 0u;
    for (;;) {
        sum = 0u; cnt = 0u; mine = 0u;
#pragma unroll
        for (unsigned j = 0; j < 16; ++j) { const unsigned c = xb_ld(&bar[XB_XCNT(j)]); sum += c; cnt += (c > 0u) ? 1u : 0u; mine = (j == x) ? c : mine; }
        if (sum == G) break;
        __builtin_amdgcn_s_sleep(1);
        if ((++sp & 255u) == 0u) { if (xb_ld(&bar[XB_TMO])) break; if (sp > XB_SPIN_CAP) { atomicAdd(&bar[XB_TMO], 1u); break; } }
    }
    nloc = mine > 0u ? mine : 1u; nx = cnt > 0u ? cnt : 1u;
}
__device__ __forceinline__ void xcd_barrier(const XcdBarrier& b) {
    asm volatile("s_waitcnt vmcnt(0)" ::: "memory");
    __syncthreads();
    if (threadIdx.x == 0) {
        unsigned* bar = b.bar;
        __builtin_amdgcn_s_waitcnt(0);
        unsigned nloc = b.st[0], nx = b.st[1];
        if (nloc == 0u) { xcd_barrier_complete(bar, b.x, nloc, nx); b.st[0] = nloc; b.st[1] = nx; }
        const unsigned old = xb_add(&bar[XB_XSUB(b.x)], 1u);
        const unsigned gen = old / nloc;
        if (old + 1u == (gen + 1u) * nloc) {
            __builtin_amdgcn_fence(__ATOMIC_RELEASE, "agent");
            asm volatile("s_waitcnt vmcnt(0)" ::: "memory");
            const unsigned og = xb_add(&bar[XB_TOP], 1u);
            const unsigned tg = og / nx;
            if (og + 1u == (tg + 1u) * nx) xb_add(&bar[XB_TOPGEN], 1u);
            else XB_SPIN(xb_ld(&bar[XB_TOPGEN]) == tg, bar);
            __builtin_amdgcn_fence(__ATOMIC_ACQUIRE, "agent");
            xb_add(&bar[XB_XGEN(b.x)], 1u);
            asm volatile("s_waitcnt vmcnt(0)" ::: "memory");
        } else {
            XB_SPIN(xb_ld(&bar[XB_XGEN(b.x)]) == gen, bar);
            __builtin_amdgcn_fence(__ATOMIC_ACQUIRE, "agent");
            asm volatile("s_waitcnt vmcnt(0)" ::: "memory");
        }
    }
    __syncthreads();
}

constexpr int NPHASE = 20;
__device__ __forceinline__ bool fresh(Frame& F) { int t = threadIdx.x; asm volatile("" : "+v"(t)); F.tid = t; F.lane = t & 63; F.wave = __builtin_amdgcn_readfirstlane(t >> 6); return true; }
template <int L> __device__ __forceinline__ void layer_phases(Frame& F, const XcdBarrier& bar, const int lo, const int hi) {
    constexpr int B = 1 + 9 * L;
#ifndef PROBE_PH
#define PROBE_PH -1
#endif
#define RP(k) for (int rep_ = 0; rep_ < (((k) == PROBE_PH) ? 3 : 1); ++rep_)
#define INR(k) (lo <= (k) && (k) < hi)
#define IN(k) (INR(k) && fresh(F))
#define SEAM(k) do { if (INR(k) && INR((k) + 1)) xcd_barrier(bar); } while (0)
    if (IN(B + 0)) RP(B + 0) { phase_prep(F, L); __syncthreads(); phase_rownorm(F, L == 0 ? 0 : 1); } SEAM(B + 0);
    if (IN(B + 1)) RP(B + 1) {
        pg8::Gemm gm{(const bf16_t*)(F.ws + WS_ACT), (const bf16_t*)(F.ws + WS_WIN), T_, NINP, DM, DM, DM};
        pg8::StaticOrder S; S.init(T_, NINP, F.G, F.bid);
        pg8::EpiBf16Bias E{(bf16_t*)(F.ws + WS_P), NINP, (const float*)(F.ws + WS_BIN)};
        pg8::gemm_phase<pg8::EpiBf16Bias, pg8::StaticOrder, true, true>(F.lds, gm, S, E);
    } SEAM(B + 1);
    if (IN(B + 2)) RP(B + 2) {
#pragma unroll 1
        for (int it = F.bid; it < 512; it += F.G) { asm volatile("" ::: "memory"); if (it < 128) attn_item(F, L, it); }
#pragma unroll 1
        for (int it = F.bid; it < 512; it += F.G) { asm volatile("" ::: "memory"); if (it >= 128 && it < 256) poolconv_item(F, L, it - 128); }
#pragma unroll 1
        for (int it = F.bid; it < 512; it += F.G) { asm volatile("" ::: "memory"); if (it >= 256) rwkvprep_item(F, L, it - 256); }
    } SEAM(B + 2);
    if (IN(B + 3)) RP(B + 3) {
#pragma unroll 1
        for (int it = F.bid; it < 1024; it += F.G) { asm volatile("" ::: "memory"); rwkv_r1_item(F, it); }
    } SEAM(B + 3);
    if (IN(B + 4)) RP(B + 4) { if (F.bid < 4) rwkv_p2(F, F.bid); } SEAM(B + 4);
    if (IN(B + 5)) RP(B + 5) {
#pragma unroll 1
        for (int it = F.bid; it < 1024; it += F.G) { asm volatile("" ::: "memory"); rwkv_p3_item(F, L, it); }
    } SEAM(B + 5);
    if (IN(B + 6)) RP(B + 6) {
        pg8::Gemm gm{(const bf16_t*)(F.ws + WS_ACT), (const bf16_t*)(F.ws + WS_WOUT), T_, DM, DM, DM, DM};
        pg8::StaticOrder S; S.init(T_, DM, F.G, F.bid);
        pg8::EpiResF32 E{L == 0 ? F.in[0] : F.out, F.out, (bf16_t*)(F.ws + WS_RW), DM};
        pg8::gemm_phase<pg8::EpiResF32, pg8::StaticOrder, true, true>(F.lds, gm, S, E);
    } SEAM(B + 6);
    if (IN(B + 7)) RP(B + 7) phase_router(F, L, rep_); SEAM(B + 7);
    if (IN(B + 8)) RP(B + 8) phase_moe(F, L); SEAM(B + 8);
}

__global__ void __launch_bounds__(NTHR, 2) fwd_kernel(Args a) {
    extern __shared__ __attribute__((aligned(16))) unsigned char smem[];
    Frame F;
    F.lds = (ldsp)smem; F.tid = threadIdx.x; F.lane = F.tid & 63; F.wave = __builtin_amdgcn_readfirstlane(F.tid >> 6);
    F.G = gridDim.x; F.bid = blockIdx.x; F.in = a.in; F.out = a.out; F.ws = a.ws;
    const int lo = a.ph_lo, hi = a.ph_hi;
    volatile LAS unsigned* bst = (volatile LAS unsigned*)(F.lds + LDS_BYTES - 64);
    if (F.tid < 16) bst[F.tid] = 0u;
    __syncthreads();
    const XcdBarrier bar = xcd_barrier_post((unsigned*)(F.ws + WS_CTL) + 1024, bst);
    if (IN(0)) RP(0) phase_mod(F); SEAM(0);
    layer_phases<0>(F, bar, lo, hi);
    layer_phases<1>(F, bar, lo, hi);
    if (IN(19)) phase_rownorm(F, 2);
#undef IN
#undef INR
#undef SEAM
}

extern "C" void kernel_launch(void* const* d_in, const int* in_sizes, int n_in, void* d_out, int out_size, void* d_ws, size_t ws_size, hipStream_t stream) {
    static int grid = 0;
    if (grid == 0) {
        int dev = 0, cus = 0;
        if (n_in != 34 || out_size != T_ * DM || ws_size < WS_END) { fprintf(stderr, "kernel_launch: unexpected shapes n_in %d out %d ws %zu\n", n_in, out_size, ws_size); grid = -1; return; }
        if (hipGetDevice(&dev) != hipSuccess || hipDeviceGetAttribute(&cus, hipDeviceAttributeMultiprocessorCount, dev) != hipSuccess) { grid = -1; return; }
        if (hipFuncSetAttribute((const void*)fwd_kernel, hipFuncAttributeMaxDynamicSharedMemorySize, LDS_BYTES) != hipSuccess) { fprintf(stderr, "kernel_launch: hipFuncSetAttribute failed\n"); grid = -1; return; }
        int per_cu = 0;
        if (hipOccupancyMaxActiveBlocksPerMultiprocessor(&per_cu, (const void*)fwd_kernel, NTHR, LDS_BYTES) != hipSuccess || per_cu < 1) { fprintf(stderr, "kernel_launch: occupancy query failed (%d)\n", per_cu); per_cu = 1; }
        (void)hipGetLastError();
        grid = cus;
    }
    if (grid < 0) return;
    (void)hipMemsetAsync((char*)d_ws + WS_CTL, 0, CTL_BYTES, stream);
    Args a{};
    for (int i = 0; i < 34; ++i) a.in[i] = (const float*)d_in[i];
    a.out = (float*)d_out; a.ws = (unsigned char*)d_ws;
#ifdef MULTI_LAUNCH
    for (int ph = 0; ph < NPHASE; ++ph) { a.ph_lo = ph; a.ph_hi = ph + 1; hipLaunchKernelGGL(fwd_kernel, dim3(grid), dim3(NTHR), LDS_BYTES, stream, a); }
#else
    a.ph_lo = 0; a.ph_hi = NPHASE;
    hipLaunchKernelGGL(fwd_kernel, dim3(grid), dim3(NTHR), LDS_BYTES, stream, a);
#endif
}
```

```cpp
#define PROBE_PH -1
#include <hip/hip_runtime.h>
#include <hip/hip_cooperative_groups.h>
#include <cstdio>
#include <cstdint>
namespace cg = cooperative_groups;

#define LAS __attribute__((address_space(3)))
typedef unsigned short bf16_t;
typedef short bf16x8 __attribute__((ext_vector_type(8)));
typedef float f32x4 __attribute__((ext_vector_type(4)));
typedef float f32x2 __attribute__((ext_vector_type(2)));
typedef unsigned u32x4 __attribute__((ext_vector_type(4)));
typedef unsigned u32x2 __attribute__((ext_vector_type(2)));
typedef LAS unsigned char* ldsp;

namespace pg8 {
#define PG8_LAS __attribute__((address_space(3)))
constexpr int BM = 256, BK = 64, HALF = 128, HTB = HALF * BK * 2, STAGE_BYTES = 8 * HTB, NXCD = 8, WGM = 8;
__host__ __device__ __forceinline__ int lds_byte(int r, int c) { const int st = (r >> 4) * 2 + (c >> 5), rr = r & 15, cc = c & 31, ob = rr * 64 + cc * 2; return st * 1024 + (ob ^ (((ob >> 9) & 1) << 5)); }
__host__ __device__ __forceinline__ void stage_rc(int b, int& R, int& C) { const int st = b / 1024, sb = b % 1024, swz = sb ^ (((sb >> 9) & 1) << 5); R = (st >> 1) * 16 + swz / 64; C = (st & 1) * 32 + (swz % 64) / 2; }
__host__ __device__ __forceinline__ int perm32(int rho) { const int n = rho >> 4, i = rho & 15; return 8 * (i >> 2) + 4 * n + (i & 3); }
struct Unit { int pm, pn; };
struct Gemm { const bf16_t* A; const bf16_t* Bt; int M, N, K, lda, ldb; };
struct StaticOrder {
    int nM, nN, nwg, G, c;
    __host__ __device__ void init(int M, int N, int G_, int c_) { nM = M / BM; nN = N / BM; nwg = nM * nN; G = G_; c = c_; }
    __host__ __device__ bool next(int i, Unit& u) const {
        const long L = (long)i * G + c; if (L >= nwg) return false;
        int wgid = (int)L; { const int q = nwg / NXCD, r = nwg % NXCD, xcd = wgid % NXCD, off = wgid / NXCD; wgid = (xcd < r ? xcd * (q + 1) : r * (q + 1) + (xcd - r) * q) + off; }
        const int nig = WGM * nN, gid = wgid / nig, fm = gid * WGM, gsz = (nM - fm) < WGM ? (nM - fm) : WGM;
        u.pm = fm + ((wgid % nig) % gsz); u.pn = (wgid % nig) / gsz; return true;
    }
    __device__ __forceinline__ void a_ready(const Unit&) const {}
    __device__ __forceinline__ void done(const Unit&) const {}
};
__device__ __forceinline__ unsigned cvt_pk_bf16(float lo, float hi) { unsigned r; asm volatile("v_cvt_pk_bf16_f32 %0, %1, %2" : "=v"(r) : "v"(lo), "v"(hi)); return r; }
struct EpiBf16Bias {
    static constexpr bool PERM = true, AFTER_DRAIN = false;
    bf16_t* O; int ldc; const float* bias;
    __device__ __forceinline__ void operator()(const f32x4 (&acc)[2][2][4][2], const Unit& u, int wr, int wc, int fr, int fq) const {
        const int row0 = u.pm * BM + wr * 64 + fr; const int col0 = u.pn * BM + wc * 32 + 8 * fq;
        f32x4 bv[2][2];
#pragma unroll
        for (int bj = 0; bj < 2; ++bj)
#pragma unroll
            for (int n = 0; n < 2; ++n) bv[bj][n] = *(const f32x4*)(bias + col0 + bj * HALF + 4 * n);
#pragma unroll
        for (int ai = 0; ai < 2; ++ai)
#pragma unroll
            for (int m = 0; m < 4; ++m) { bf16_t* rowp = O + (size_t)(row0 + ai * HALF + m * 16) * ldc + col0;
#pragma unroll
                for (int bj = 0; bj < 2; ++bj) { f32x4 v0 = acc[ai][bj][m][0] + bv[bj][0], v1 = acc[ai][bj][m][1] + bv[bj][1];
                    u32x4 w; w.x = cvt_pk_bf16(v0[0], v0[1]); w.y = cvt_pk_bf16(v0[2], v0[3]); w.z = cvt_pk_bf16(v1[0], v1[1]); w.w = cvt_pk_bf16(v1[2], v1[3]);
                    *(u32x4*)(rowp + bj * HALF) = w; } }
    }
};
struct EpiResF32 {
    static constexpr bool PERM = false, AFTER_DRAIN = false;
    const float* base; float* out; bf16_t* ob; int ldc;
    __device__ __forceinline__ void operator()(const f32x4 (&acc)[2][2][4][2], const Unit& u, int wr, int wc, int fr, int fq) const {
        const int row0 = u.pm * BM + wr * 64 + fr, col0 = u.pn * BM + wc * 32 + 4 * fq;
#pragma unroll
        for (int ai = 0; ai < 2; ++ai)
#pragma unroll
            for (int m = 0; m < 4; ++m) { const size_t off = (size_t)(row0 + ai * HALF + m * 16) * ldc + col0;
#pragma unroll
                for (int bj = 0; bj < 2; ++bj)
#pragma unroll
                    for (int n = 0; n < 2; ++n) { const f32x4 bs = *(const f32x4*)(base + off + bj * HALF + n * 16); const f32x4 o = bs + acc[ai][bj][m][n];
                        *(f32x4*)(out + off + bj * HALF + n * 16) = o;
                        u32x2 w; w.x = cvt_pk_bf16(o[0], o[1]); w.y = cvt_pk_bf16(o[2], o[3]); *(u32x2*)(ob + off + bj * HALF + n * 16) = w; }
                asm volatile("" ::: "memory"); }
    }
};
template <class Epi, class Sched, bool ALIGN_EPI = false, bool SP2 = false>
__device__ __forceinline__ void gemm_phase(PG8_LAS unsigned char* lds, const Gemm g, const Sched& S, const Epi& E) {
    const int tid = threadIdx.x, wid = __builtin_amdgcn_readfirstlane(tid >> 6), lane = tid & 63, wr = wid >> 2, wc = wid & 3, fr = lane & 15, fq = lane >> 4;
    const int K = g.K, nt = K / BK;
    unsigned voffA[2], voffB[2];
#pragma unroll
    for (int i = 0; i < 2; ++i) { int R, C; stage_rc(tid * 16 + i * 8192, R, C); const int Rb = Epi::PERM ? ((R & ~31) + perm32(R & 31)) : R;
        voffA[i] = (unsigned)(R * g.lda + C) * 2u; voffB[i] = (unsigned)(Rb * g.ldb + C) * 2u; }
    const size_t kstep = (size_t)(BK * 2);
    const size_t hstepA = (size_t)HALF * g.lda * 2, hstepB = (size_t)HALF * g.ldb * 2;
    const size_t tstepA = 2 * hstepA, tstepB = 2 * hstepB;
    const unsigned ldsw = (unsigned)wid * 1024u;
    const int aoff = lds_byte(wr * 64 + fr, fq * 8), boff = lds_byte(wc * 32 + fr, fq * 8);
#define PG8_SA(b, h) (((b) * 2 + (h)) * HTB)
#define PG8_SB(b, h) ((4 + (b) * 2 + (h)) * HTB)
#define PG8_STAGE(bufoff, gbase, voff) do { _Pragma("unroll") for (int _i = 0; _i < 2; ++_i) \
        __builtin_amdgcn_global_load_lds((const unsigned*)((const char*)(gbase) + (voff)[_i]), (PG8_LAS unsigned*)(lds + (bufoff) + ldsw + _i * 8192), 16, 0, 0); } while (0)
#define PG8_LDA(dst, b, h) do { _Pragma("unroll") for (int m = 0; m < 4; ++m) _Pragma("unroll") for (int k = 0; k < 2; ++k) dst[m][k] = *(const PG8_LAS bf16x8*)(lds + PG8_SA(b, h) + aoff + m * 2048 + k * 1024); } while (0)
#define PG8_LDB(dst, b, h) do { _Pragma("unroll") for (int n = 0; n < 2; ++n) _Pragma("unroll") for (int k = 0; k < 2; ++k) dst[n][k] = *(const PG8_LAS bf16x8*)(lds + PG8_SB(b, h) + boff + n * 2048 + k * 1024); } while (0)
#define PG8_MMA(ai, bj, At, Bt) do { __builtin_amdgcn_s_setprio(1); _Pragma("unroll") for (int m = 0; m < 4; ++m) _Pragma("unroll") for (int n = 0; n < 2; ++n) _Pragma("unroll") for (int k = 0; k < 2; ++k) \
        acc[ai][bj][m][n] = __builtin_amdgcn_mfma_f32_16x16x32_bf16(Bt[n][k], At[m][k], acc[ai][bj][m][n], 0, 0, 0); __builtin_amdgcn_s_setprio(0); } while (0)
#define PG8_WAIT_V(n) asm volatile("s_waitcnt vmcnt(" #n ")" ::: "memory")
#define PG8_WAIT_L(n) asm volatile("s_waitcnt lgkmcnt(" #n ")" ::: "memory")
#define PG8_BAR __builtin_amdgcn_s_barrier()
#define PG8_SCHED __builtin_amdgcn_sched_barrier(0)
    Unit cur, nxt; int ui = 0;
    if (!S.next(0, cur)) return;
    f32x4 acc[2][2][4][2];
#pragma unroll
    for (int a = 0; a < 2; ++a)
#pragma unroll
        for (int b = 0; b < 2; ++b)
#pragma unroll
            for (int m = 0; m < 4; ++m)
#pragma unroll
                for (int n = 0; n < 2; ++n) acc[a][b][m][n] = (f32x4){0.f, 0.f, 0.f, 0.f};
    bf16x8 At[4][2], B0[2][2], B1[2][2];
    const char* cA = (const char*)g.A + (size_t)cur.pm * tstepA; const char* cB = (const char*)g.Bt + (size_t)cur.pn * tstepB;
    S.a_ready(cur);
    if constexpr (SP2) {
        PG8_STAGE(PG8_SB(0, 0), cB, voffB); PG8_STAGE(PG8_SB(0, 1), cB + hstepB, voffB); PG8_STAGE(PG8_SA(0, 0), cA, voffA); PG8_STAGE(PG8_SA(0, 1), cA + hstepA, voffA);
        if (wr == 1) PG8_BAR;
        PG8_WAIT_V(2); PG8_BAR;
        PG8_STAGE(PG8_SB(1, 0), cB + kstep, voffB); PG8_STAGE(PG8_SA(1, 0), cA + kstep, voffA); PG8_STAGE(PG8_SB(1, 1), cB + hstepB + kstep, voffB);
        PG8_WAIT_V(6); PG8_BAR;
    } else {
        PG8_STAGE(PG8_SB(0, 0), cB, voffB); PG8_STAGE(PG8_SA(0, 0), cA, voffA); PG8_STAGE(PG8_SB(0, 1), cB + hstepB, voffB); PG8_STAGE(PG8_SA(0, 1), cA + hstepA, voffA);
        if (wr == 1) PG8_BAR;
        PG8_WAIT_V(4); PG8_BAR;
        PG8_STAGE(PG8_SB(1, 0), cB + kstep, voffB); PG8_STAGE(PG8_SA(1, 0), cA + kstep, voffA); PG8_STAGE(PG8_SB(1, 1), cB + hstepB + kstep, voffB);
        PG8_WAIT_V(6); PG8_BAR;
    }
    for (;;) {
        const bool has_next = S.next(ui + 1, nxt);
        const char* nA = has_next ? (const char*)g.A + (size_t)nxt.pm * tstepA : cA; const char* nB = has_next ? (const char*)g.Bt + (size_t)nxt.pn * tstepB : cB;
        for (int t = 0; t < nt; t += 2) {
            const bool last = (t == nt - 2);
            const char* a1 = cA + (size_t)(t + 1) * kstep;
            const char* a2 = last ? nA : cA + (size_t)(t + 2) * kstep; const char* b2 = last ? nB : cB + (size_t)(t + 2) * kstep;
            const char* a3 = a2 + kstep; const char* b3 = b2 + kstep;
            if (last && has_next) S.a_ready(nxt);
            if constexpr (SP2) {
            PG8_LDB(B0, 0, 0); PG8_LDB(B1, 0, 1); PG8_SCHED; PG8_LDA(At, 0, 0); PG8_STAGE(PG8_SA(1, 1), a1 + hstepA, voffA);
            PG8_WAIT_V(8); PG8_WAIT_L(0); PG8_BAR; PG8_MMA(0, 0, At, B0); PG8_MMA(0, 1, At, B1); PG8_BAR; PG8_SCHED;
            PG8_LDA(At, 0, 1); PG8_STAGE(PG8_SB(0, 0), b2, voffB); PG8_STAGE(PG8_SB(0, 1), b2 + hstepB, voffB); PG8_STAGE(PG8_SA(0, 0), a2, voffA);
            PG8_WAIT_V(8); PG8_WAIT_L(0); PG8_BAR; PG8_MMA(1, 0, At, B0); PG8_MMA(1, 1, At, B1); PG8_BAR; PG8_SCHED;
            PG8_LDB(B0, 1, 0); PG8_LDB(B1, 1, 1); PG8_SCHED; PG8_LDA(At, 1, 0); PG8_STAGE(PG8_SA(0, 1), a2 + hstepA, voffA);
            PG8_WAIT_V(8); PG8_WAIT_L(0); PG8_BAR; PG8_MMA(0, 0, At, B0); PG8_MMA(0, 1, At, B1); PG8_BAR; PG8_SCHED;
            PG8_LDA(At, 1, 1); PG8_STAGE(PG8_SB(1, 0), b3, voffB); PG8_STAGE(PG8_SB(1, 1), b3 + hstepB, voffB); PG8_STAGE(PG8_SA(1, 0), a3, voffA);
            PG8_WAIT_V(8); PG8_WAIT_L(0); PG8_BAR; PG8_MMA(1, 0, At, B0); PG8_MMA(1, 1, At, B1); PG8_BAR; PG8_SCHED;
            } else {
            PG8_LDB(B0, 0, 0); PG8_SCHED; PG8_LDA(At, 0, 0); PG8_STAGE(PG8_SA(1, 1), a1 + hstepA, voffA);
            PG8_WAIT_L(8); PG8_BAR; PG8_WAIT_L(0); PG8_MMA(0, 0, At, B0); PG8_BAR; PG8_SCHED;
            PG8_LDB(B1, 0, 1); PG8_STAGE(PG8_SB(0, 0), b2, voffB);
            PG8_BAR; PG8_WAIT_L(0); PG8_MMA(0, 1, At, B1); PG8_BAR;
            PG8_LDA(At, 0, 1); PG8_STAGE(PG8_SA(0, 0), a2, voffA);
            PG8_BAR; PG8_WAIT_L(0); PG8_MMA(1, 0, At, B0); PG8_BAR; PG8_SCHED;
            PG8_STAGE(PG8_SB(0, 1), b2 + hstepB, voffB);
            PG8_WAIT_V(6); PG8_BAR; PG8_MMA(1, 1, At, B1); PG8_BAR;
            PG8_LDB(B0, 1, 0); PG8_SCHED; PG8_LDA(At, 1, 0); PG8_STAGE(PG8_SA(0, 1), a2 + hstepA, voffA);
            PG8_WAIT_L(8); PG8_BAR; PG8_WAIT_L(0); PG8_MMA(0, 0, At, B0); PG8_BAR; PG8_SCHED;
            PG8_LDB(B1, 1, 1); PG8_STAGE(PG8_SB(1, 0), b3, voffB);
            PG8_BAR; PG8_WAIT_L(0); PG8_MMA(0, 1, At, B1); PG8_BAR;
            PG8_LDA(At, 1, 1); PG8_STAGE(PG8_SA(1, 0), a3, voffA);
            PG8_BAR; PG8_WAIT_L(0); PG8_MMA(1, 0, At, B0); PG8_BAR; PG8_SCHED;
            PG8_STAGE(PG8_SB(1, 1), b3 + hstepB, voffB);
            PG8_WAIT_V(6); PG8_BAR; PG8_MMA(1, 1, At, B1); PG8_BAR;
            }
        }
        if constexpr (ALIGN_EPI) { if (wr == 0) PG8_BAR; }
        if constexpr (!Epi::AFTER_DRAIN) { E(acc, cur, wr, wc, fr, fq); S.done(cur); }
        if (!has_next) break;
#pragma unroll
        for (int a = 0; a < 2; ++a)
#pragma unroll
            for (int b = 0; b < 2; ++b)
#pragma unroll
                for (int m = 0; m < 4; ++m)
#pragma unroll
                    for (int n = 0; n < 2; ++n) acc[a][b][m][n] = (f32x4){0.f, 0.f, 0.f, 0.f};
        cur = nxt; cA = nA; cB = nB; ++ui;
        if constexpr (ALIGN_EPI) { if (wr == 1) PG8_BAR; }
    }
    PG8_WAIT_V(0);
    if constexpr (!ALIGN_EPI) { if (wr == 0) PG8_BAR; }
    PG8_BAR;
    if constexpr (Epi::AFTER_DRAIN) { E.fused(acc, cur, wr, wc, fr, fq, lds, wid, lane); S.done(cur); }
#undef PG8_SA
#undef PG8_SB
#undef PG8_STAGE
#undef PG8_LDA
#undef PG8_LDB
#undef PG8_MMA
#undef PG8_WAIT_V
#undef PG8_WAIT_L
#undef PG8_BAR
#undef PG8_SCHED
}
}

constexpr int T_ = 16384, DM = 1024, NIN = 2432, NINP = 2560;
constexpr int C_Q = 256, C_K = 512, C_V = 640, C_BG = 768, C_CG = 1024, C_XIN = 1280, C_D = 1536;
constexpr int NWAVES = 8, NTHR = 512;
constexpr int LDS_BYTES = 147456;
constexpr size_t MiB = 1u << 20;
constexpr size_t WS_CTL = 0;
constexpr size_t CTL_BYTES = 131072;
constexpr int CNT_W0 = 8192;
constexpr size_t WS_MOD = 1 * MiB;
constexpr size_t WS_BIN = WS_MOD + 65536;
constexpr size_t WS_BGU = WS_BIN + 16384;
constexpr size_t WS_BR  = WS_BGU + 32768;
constexpr size_t WS_WRH = WS_BR + 1024;
constexpr size_t WS_WRL = WS_WRH + 98304;
constexpr size_t WS_W2T = WS_WRL + 98304;
constexpr size_t WS_A2T = WS_W2T + 16384;
constexpr size_t WS_G2T = WS_A2T + 16384;
constexpr size_t WS_V1T = WS_G2T + 32768;
constexpr size_t WS_V2T = WS_V1T + 16384;
constexpr size_t WS_PWT = WS_V2T + 16384;
constexpr size_t WS_RINV2 = WS_PWT + 32768;
static_assert(WS_RINV2 + 65536 <= 2 * MiB, "small region");
constexpr size_t WS_WIN = 2 * MiB;
constexpr size_t WS_WOUT = 7 * MiB;
constexpr size_t WS_WGU = 9 * MiB;
constexpr size_t WS_WD = 25 * MiB;
constexpr size_t WS_LIST = 33 * MiB;
constexpr size_t WS_WLIST = 35 * MiB;
constexpr size_t WS_VFIRST = 37 * MiB;
constexpr size_t WS_ACT = 45 * MiB;
constexpr size_t WS_P = 77 * MiB;
constexpr size_t WS_RW = 157 * MiB;
constexpr size_t RW_R = WS_RW, RW_K = WS_RW + 8 * MiB, RW_V = WS_RW + 16 * MiB, RW_KAP = WS_RW + 24 * MiB, RW_B = WS_RW + 32 * MiB, RW_G = WS_RW + 40 * MiB;
constexpr size_t RW_LD = WS_RW + 48 * MiB;
constexpr size_t RW_W1 = WS_RW + 56 * MiB, RW_U0T = WS_RW + 64 * MiB, RW_M = WS_RW + 72 * MiB, RW_N = WS_RW + 80 * MiB, RW_S0 = WS_RW + 88 * MiB;
constexpr size_t RW_BONUS = WS_RW + 96 * MiB;
constexpr size_t RW_MG = RW_BONUS + 256 * 1024, RW_NG = RW_MG + 512 * 1024, RW_SG = RW_NG + 512 * 1024;
constexpr size_t WS_END = WS_RW + 98 * MiB;
static_assert(WS_END <= 256 * MiB, "workspace");

struct Args { const float* in[34]; float* out; unsigned char* ws; int ph_lo, ph_hi; };

__device__ __forceinline__ unsigned f2bf(float f) { unsigned u = __builtin_bit_cast(unsigned, f); return (u + 0x7fffu + ((u >> 16) & 1u)) >> 16; }
__device__ __forceinline__ float bf2f(unsigned h) { return __builtin_bit_cast(float, h << 16); }
__device__ __forceinline__ unsigned pk2(float lo, float hi) { return f2bf(lo) | (f2bf(hi) << 16); }
__device__ __forceinline__ float bflo(unsigned w) { return __builtin_bit_cast(float, w << 16); }
__device__ __forceinline__ float bfhi(unsigned w) { return __builtin_bit_cast(float, w & 0xffff0000u); }
__device__ __forceinline__ float sigmoidf_(float x) { return 1.f / (1.f + __expf(-x)); }
__device__ __forceinline__ float wave_sum(float v) {
#pragma unroll
    for (int o = 1; o < 64; o <<= 1) v += __shfl_xor(v, o);
    return v;
}
#define LDS_WAIT() asm volatile("s_waitcnt lgkmcnt(0)" ::: "memory")
__device__ __forceinline__ int swz128(int r, int c) { return r * 128 + ((c ^ ((r >> 1) & 7)) << 4); }
__device__ __forceinline__ int swz256(int r, int c) { return r * 256 + ((c ^ (r & 15)) << 4); }
__device__ __forceinline__ int swz512(int r, int c) { return r * 512 + ((c ^ (r & 15)) << 4); }
__device__ __forceinline__ f32x4 mfma16(bf16x8 a, bf16x8 b, f32x4 c) { return __builtin_amdgcn_mfma_f32_16x16x32_bf16(a, b, c, 0, 0, 0); }

struct Frame {
    ldsp lds; int tid, lane, wave, G, bid;
    const float* const* in; float* out; unsigned char* ws;
};

__device__ __forceinline__ void phase_mod(Frame& F) {
    const float* c = F.in[1]; const float* w_ada = F.in[2]; const float* b_ada = F.in[3];
    float* mod = (float*)(F.ws + WS_MOD);
    LAS float* red = (LAS float*)F.lds;
    for (int it = F.bid; it < 192; it += F.G) {
        const int l = it / 96, n0 = (it % 96) * 64;
        const float* W = w_ada + (size_t)l * DM * 6144 + n0 + F.lane;
        const int k0 = F.wave * 128;
        float acc = 0.f;
#pragma unroll 8
        for (int k = 0; k < 128; ++k) { const float cv = c[k0 + k]; const float s = cv / (1.f + __expf(-cv)); acc += s * W[(size_t)(k0 + k) * 6144]; }
        red[F.wave * 64 + F.lane] = acc;
        __syncthreads();
        if (F.wave == 0) { float s = b_ada[l * 6144 + n0 + F.lane];
#pragma unroll
            for (int w = 0; w < 8; ++w) s += red[w * 64 + F.lane];
            mod[l * 6144 + n0 + F.lane] = s; }
        __syncthreads();
    }
}

__device__ __forceinline__ void transpose_strip(const float* W, int N, int K, int n0, const float* rs_a, const float* rs_b, const float* cs, const float* sh, float* bias_out,
                                                bf16_t* dst, int dst_row0, LAS float* scr, int lane) {
    const int col = lane & 31, kp = lane >> 5;
    const float csv = cs ? cs[n0 + col] : 1.f;
    LAS float* scl = scr + 64 * 33;
    float bacc = 0.f;
    for (int k0 = 0; k0 < K; k0 += 64) {
        float wv[32];
#pragma unroll
        for (int i = 0; i < 32; ++i) wv[i] = W[(size_t)(k0 + 2 * i + kp) * N + n0 + col];
        scl[lane] = rs_a ? rs_a[k0 + lane] * (1.f + rs_b[k0 + lane]) : 1.f;
        scl[64 + lane] = sh ? sh[k0 + lane] : 0.f;
        LDS_WAIT();
#pragma unroll
        for (int i = 0; i < 32; ++i) { const int kk = 2 * i + kp; bacc += scl[64 + kk] * wv[i]; scr[kk * 33 + col] = wv[i] * csv * scl[kk]; }
        LDS_WAIT();
        const int c = lane & 7;
#pragma unroll
        for (int j = 0; j < 4; ++j) { const int n = (lane >> 3) + 8 * j; const LAS float* s = scr + (8 * c) * 33 + n;
            u32x4 o; o.x = pk2(s[0 * 33], s[1 * 33]); o.y = pk2(s[2 * 33], s[3 * 33]); o.z = pk2(s[4 * 33], s[5 * 33]); o.w = pk2(s[6 * 33], s[7 * 33]);
            *(u32x4*)(dst + (size_t)(dst_row0 + n) * K + k0 + 8 * c) = o; }
        LDS_WAIT();
    }
    if (sh) { bacc += __shfl_xor(bacc, 32); if (lane < 32) bias_out[col] = bacc; }
}
__device__ __forceinline__ void phase_prep(Frame& F, int l) {
    LAS float* scr = (LAS float*)(F.lds + F.wave * 16384);
    const float* mod = (const float*)(F.ws + WS_MOD) + l * 6144;
    const float *sh1 = mod, *sc1 = mod + 1024, *gt1 = mod + 2048, *sh2 = mod + 3072, *sc2 = mod + 4096, *gt2 = mod + 5120;
    const float* n1g = F.in[4] + l * DM; const float* n2g = F.in[5] + l * DM;
    const float* w_in = F.in[6] + (size_t)l * DM * NIN; const float* w_out = F.in[7] + (size_t)l * DM * DM;
    const float* wg = F.in[30] + (size_t)l * 32 * DM * 128; const float* wu = F.in[31] + (size_t)l * 32 * DM * 128; const float* wd = F.in[32] + (size_t)l * 32 * 128 * DM;
    bf16_t* WIN = (bf16_t*)(F.ws + WS_WIN); bf16_t* WOUT = (bf16_t*)(F.ws + WS_WOUT); bf16_t* WGU = (bf16_t*)(F.ws + WS_WGU); bf16_t* WD = (bf16_t*)(F.ws + WS_WD);
    float* bias_in = (float*)(F.ws + WS_BIN); float* bias_gu = (float*)(F.ws + WS_BGU); float* bias_r = (float*)(F.ws + WS_BR);
    const int gw = F.bid * NWAVES + F.wave, NGW = F.G * NWAVES;
    constexpr int nA = 80, nB = 32, nC = 128, nD = 128, nE = 1024, nF = 48, nG = 6;
    constexpr int NIT = nA + nB + nC + nD + nE + nF + nG;
    for (int it = gw; it < NIT; it += NGW) {
        int r = it;
        if (r < nA) {
            if (r < 76) transpose_strip(w_in, NIN, DM, r * 32, n1g, sc1, nullptr, sh1, bias_in + r * 32, WIN, r * 32, scr, F.lane);
            else { for (int i = F.lane; i < 32 * 128; i += 64) { const int n = i >> 7, c = i & 127; *(u32x4*)(WIN + (size_t)(r * 32 + n) * DM + c * 8) = (u32x4){0u, 0u, 0u, 0u}; }
                   if (F.lane < 32) bias_in[r * 32 + F.lane] = 0.f; }
            continue; } r -= nA;
        if (r < nB) { transpose_strip(w_out, DM, DM, r * 32, nullptr, nullptr, gt1, nullptr, nullptr, WOUT, r * 32, scr, F.lane); continue; } r -= nB;
        if (r < nC) { const int e = r >> 2, s = r & 3; transpose_strip(wg + (size_t)e * DM * 128, 128, DM, s * 32, n2g, sc2, nullptr, sh2, bias_gu + e * 256 + s * 32, WGU + (size_t)e * 256 * DM, s * 32, scr, F.lane); continue; } r -= nC;
        if (r < nD) { const int e = r >> 2, s = r & 3; transpose_strip(wu + (size_t)e * DM * 128, 128, DM, s * 32, n2g, sc2, nullptr, sh2, bias_gu + e * 256 + 128 + s * 32, WGU + (size_t)e * 256 * DM, 128 + s * 32, scr, F.lane); continue; } r -= nD;
        if (r < nE) { const int e = r >> 5, s = r & 31; transpose_strip(wd + (size_t)e * 128 * DM, DM, 128, s * 32, nullptr, nullptr, gt2, nullptr, nullptr, WD + (size_t)e * DM * 128, s * 32, scr, F.lane); continue; } r -= nE;
        if (r < nF) {
            bf16_t* wh = (bf16_t*)(F.ws + WS_WRH) + r * DM; bf16_t* wl = (bf16_t*)(F.ws + WS_WRL) + r * DM;
            float bacc = 0.f;
            for (int k = F.lane; k < DM; k += 64) {
                float wv = 0.f;
                if (r < 4) wv = F.in[26][(size_t)l * DM * 4 + k * 4 + r]; else if (r < 36) wv = F.in[28][(size_t)l * DM * 32 + k * 32 + (r - 4)];
                bacc += sh2[k] * wv;
                const float v = wv * n2g[k] * (1.f + sc2[k]);
                const unsigned h = f2bf(v); const unsigned lo = f2bf(v - bf2f(h));
                wh[k] = (bf16_t)h; wl[k] = (bf16_t)lo; }
            bacc = wave_sum(bacc);
            if (F.lane == 0) { float b = 0.f; if (r < 4) b = F.in[27][l * 4 + r]; else if (r < 36) b = F.in[29][l * 32 + r - 4]; bias_r[r] = bacc + b; }
            continue; } r -= nF;
        if (r == 0) { const float* s = F.in[14] + l * 32 * 256; bf16_t* d = (bf16_t*)(F.ws + WS_W2T); for (int i = F.lane; i < 8192; i += 64) { const int n = i >> 5, k = i & 31; d[i] = (bf16_t)f2bf(s[k * 256 + n]); } }
        else if (r == 1) { const float* s = F.in[16] + l * 32 * 256; bf16_t* d = (bf16_t*)(F.ws + WS_A2T); for (int i = F.lane; i < 8192; i += 64) { const int n = i >> 5, k = i & 31; d[i] = (bf16_t)f2bf(s[k * 256 + n]); } }
        else if (r == 2) { const float* s = F.in[17] + l * 64 * 256; bf16_t* d = (bf16_t*)(F.ws + WS_G2T); for (int i = F.lane; i < 16384; i += 64) { const int n = i >> 6, k = i & 63; d[i] = (bf16_t)f2bf(s[k * 256 + n]); } }
        else if (r == 3) { if (l > 0) { const float* s = F.in[24] + (l - 1) * 256 * 32; bf16_t* d = (bf16_t*)(F.ws + WS_V1T); for (int i = F.lane; i < 8192; i += 64) { const int n = i >> 8, k = i & 255; d[i] = (bf16_t)f2bf(s[k * 32 + n]); } } }
        else if (r == 4) { if (l > 0) { const float* s = F.in[25] + (l - 1) * 32 * 256; bf16_t* d = (bf16_t*)(F.ws + WS_V2T); for (int i = F.lane; i < 8192; i += 64) { const int n = i >> 5, k = i & 31; d[i] = (bf16_t)f2bf(s[k * 256 + n]); } } }
        else { const float* s = F.in[8] + l * 4 * 64 * 64; bf16_t* d = (bf16_t*)(F.ws + WS_PWT); for (int i = F.lane; i < 16384; i += 64) { const int j = i >> 12, e = (i >> 6) & 63, c = i & 63; d[i] = (bf16_t)f2bf(s[(j * 64 + c) * 64 + e]); } }
    }
}

__device__ __forceinline__ void phase_rownorm(Frame& F, int mode) {
    const float* xin = (mode == 0) ? F.in[0] : F.out;
    const bf16_t* ys0 = (const bf16_t*)(F.ws + WS_P); const bf16_t* ys1 = ys0 + (size_t)T_ * DM;
    bf16_t* xn = (bf16_t*)(F.ws + WS_ACT);
    const float* fg = F.in[33];
    const int gw = F.bid * NWAVES + F.wave, NGW = F.G * NWAVES;
    for (int m = gw; m < T_; m += NGW) {
        const f32x4* xr = (const f32x4*)(xin + (size_t)m * DM) + F.lane;
        f32x4 v[4]; float s = 0.f;
#pragma unroll
        for (int j = 0; j < 4; ++j) v[j] = xr[64 * j];
        if (mode != 0) {
            const u32x2* a = (const u32x2*)(ys0 + (size_t)m * DM) + F.lane; const u32x2* b = (const u32x2*)(ys1 + (size_t)m * DM) + F.lane;
#pragma unroll
            for (int j = 0; j < 4; ++j) { const u32x2 ua = a[64 * j], ub = b[64 * j];
                v[j][0] += bflo(ua.x) + bflo(ub.x); v[j][1] += bfhi(ua.x) + bfhi(ub.x); v[j][2] += bflo(ua.y) + bflo(ub.y); v[j][3] += bfhi(ua.y) + bfhi(ub.y); }
        }
#pragma unroll
        for (int j = 0; j < 4; ++j) s += (v[j][0] * v[j][0] + v[j][1] * v[j][1]) + (v[j][2] * v[j][2] + v[j][3] * v[j][3]);
        const float rinv = 1.f / sqrtf(wave_sum(s) * (1.f / DM) + 1e-6f);
        if (mode == 2) {
            f32x4* o = (f32x4*)(F.out + (size_t)m * DM) + F.lane;
#pragma unroll
            for (int j = 0; j < 4; ++j) { const f32x4 g = *((const f32x4*)fg + F.lane + 64 * j); o[64 * j] = v[j] * rinv * g; }
        } else {
            if (mode == 1) { f32x4* o = (f32x4*)(F.out + (size_t)m * DM) + F.lane;
#pragma unroll
                for (int j = 0; j < 4; ++j) o[64 * j] = v[j]; }
            u32x2* o8 = (u32x2*)(xn + (size_t)m * DM) + F.lane;
#pragma unroll
            for (int j = 0; j < 4; ++j) { u32x2 w; w.x = pk2(v[j][0] * rinv, v[j][1] * rinv); w.y = pk2(v[j][2] * rinv, v[j][3] * rinv); o8[64 * j] = w; }
        }
    }
}

__device__ __forceinline__ void attn_item(Frame& F, int l, int item) {
    const int t0 = item * 128;
    const bf16_t* P = (const bf16_t*)(F.ws + WS_P);
    bf16_t* ycat = (bf16_t*)(F.ws + WS_ACT);
    ldsp Ks = F.lds, Vt = F.lds + 65536;
    for (int i = F.tid; i < 4096; i += NTHR) {
        const int ko = i >> 4, kvh = (i >> 3) & 1, c = i & 7; const int s = t0 - 128 + ko;
        u32x4 kv = (u32x4){0u, 0u, 0u, 0u}, vv = (u32x4){0u, 0u, 0u, 0u};
        if (s >= 0) { kv = *(const u32x4*)(P + (size_t)s * NINP + C_K + kvh * 64 + c * 8); vv = *(const u32x4*)(P + (size_t)s * NINP + C_V + kvh * 64 + c * 8); }
        *(LAS u32x4*)(Ks + kvh * 32768 + swz128(ko, c)) = kv;
        const int k32 = ko & 31, sg = ko >> 5, g = (k32 >> 2) & 3, j = ((k32 >> 4) << 2) | (k32 & 3), chunk = sg * 4 + g;
        const unsigned vw[4] = {vv.x, vv.y, vv.z, vv.w};
#pragma unroll
        for (int e = 0; e < 8; ++e) { const int d = c * 8 + e; const unsigned short val = (unsigned short)((e & 1) ? (vw[e >> 1] >> 16) : (vw[e >> 1] & 0xffffu));
            *(LAS unsigned short*)(Vt + kvh * 32768 + swz512(d, chunk) + j * 2) = val; }
    }
    __syncthreads();
    const int h = F.wave >> 1, half = F.wave & 1, kvh = h >> 1, fr = F.lane & 15, g = F.lane >> 4;
    const float slope = exp2f(-2.f * (float)(h + 1));
    const float sink = F.in[10][l * 4 + h];
    ldsp Kh = Ks + kvh * 32768, Vh = Vt + kvh * 32768;
#pragma unroll 1
    for (int qt = 0; qt < 4; ++qt) {
        const int q_lo = 64 * half + 16 * qt, qo = q_lo + fr, tile0 = (q_lo >> 5) << 1;
        bf16x8 qf[2];
#pragma unroll
        for (int ks = 0; ks < 2; ++ks) qf[ks] = *(const bf16x8*)(P + (size_t)(t0 + qo) * NINP + C_Q + h * 64 + ks * 32 + g * 8);
        f32x4 s[10];
#pragma unroll
        for (int kt = 0; kt < 10; ++kt) { s[kt] = (f32x4){0.f, 0.f, 0.f, 0.f};
#pragma unroll
            for (int ks = 0; ks < 2; ++ks) { const bf16x8 a = *(const LAS bf16x8*)(Kh + swz128((tile0 + kt) * 16 + fr, ks * 4 + g)); s[kt] = mfma16(a, qf[ks], s[kt]); } }
        float m = sink;
#pragma unroll
        for (int kt = 0; kt < 10; ++kt)
#pragma unroll
            for (int j = 0; j < 4; ++j) { const int ko = 16 * (tile0 + kt) + 4 * g + j; const int dist = qo + 128 - ko;
                const bool valid = (dist >= 0) && (dist < 128) && (t0 - 128 + ko >= 0);
                const float v = valid ? s[kt][j] * 0.125f - slope * (float)dist : -INFINITY; s[kt][j] = v; m = fmaxf(m, v); }
        m = fmaxf(m, __shfl_xor(m, 16)); m = fmaxf(m, __shfl_xor(m, 32));
        float sum = 0.f;
#pragma unroll
        for (int kt = 0; kt < 10; ++kt)
#pragma unroll
            for (int j = 0; j < 4; ++j) { const float p = __expf(s[kt][j] - m); s[kt][j] = p; sum += p; }
        sum += __shfl_xor(sum, 16); sum += __shfl_xor(sum, 32);
        const float inv = 1.f / (sum + __expf(sink - m));
        f32x4 o[4];
#pragma unroll
        for (int dt = 0; dt < 4; ++dt) o[dt] = (f32x4){0.f, 0.f, 0.f, 0.f};
#pragma unroll
        for (int ss = 0; ss < 5; ++ss) {
            u32x4 pw; pw.x = pk2(s[2 * ss][0], s[2 * ss][1]); pw.y = pk2(s[2 * ss][2], s[2 * ss][3]); pw.z = pk2(s[2 * ss + 1][0], s[2 * ss + 1][1]); pw.w = pk2(s[2 * ss + 1][2], s[2 * ss + 1][3]);
            const bf16x8 pb = __builtin_bit_cast(bf16x8, pw);
#pragma unroll
            for (int dt = 0; dt < 4; ++dt) { const bf16x8 a = *(const LAS bf16x8*)(Vh + swz512(dt * 16 + fr, ((tile0 >> 1) + ss) * 4 + g)); o[dt] = mfma16(a, pb, o[dt]); }
        }
#pragma unroll
        for (int dt = 0; dt < 4; ++dt) { u32x2 w; w.x = pk2(o[dt][0] * inv, o[dt][1] * inv); w.y = pk2(o[dt][2] * inv, o[dt][3] * inv);
            *(u32x2*)(ycat + (size_t)(t0 + qo) * DM + 256 + h * 64 + dt * 16 + 4 * g) = w; }
    }
    __syncthreads();
}

__device__ __forceinline__ void poolconv_item(Frame& F, int l, int item) {
    const int t0 = item * 128;
    const bf16_t* P = (const bf16_t*)(F.ws + WS_P);
    bf16_t* ycat = (bf16_t*)(F.ws + WS_ACT);
    ldsp U = F.lds;
    ldsp Dt = F.lds + 73728;
    for (int i = F.tid; i < 144 * 32; i += NTHR) { const int r = i >> 5, c = i & 31; const int s = t0 - 16 + r;
        u32x4 v = (u32x4){0u, 0u, 0u, 0u}; if (s >= 0) v = *(const u32x4*)(P + (size_t)s * NINP + c * 8);
        *(LAS u32x4*)(U + r * 512 + c * 16) = v; }
    __syncthreads();
    for (int i = F.tid; i < 128 * 32; i += NTHR) { const int tok = i >> 5, c8 = i & 31, j = c8 >> 3, w = 2 << j; const int t = t0 + tok;
        float acc[8];
#pragma unroll
        for (int e = 0; e < 8; ++e) acc[e] = 0.f;
        u32x4 cur = (u32x4){0u, 0u, 0u, 0u};
        for (int q = 0; q < w; ++q) { const u32x4 v = *(const LAS u32x4*)(U + (tok + 16 - q) * 512 + c8 * 16); if (q == 0) cur = v;
            acc[0] += bflo(v.x); acc[1] += bfhi(v.x); acc[2] += bflo(v.y); acc[3] += bfhi(v.y); acc[4] += bflo(v.z); acc[5] += bfhi(v.z); acc[6] += bflo(v.w); acc[7] += bfhi(v.w); }
        const float ic = 1.f / (float)((t + 1) < w ? (t + 1) : w);
        u32x4 o; o.x = pk2(acc[0] * ic - bflo(cur.x), acc[1] * ic - bfhi(cur.x)); o.y = pk2(acc[2] * ic - bflo(cur.y), acc[3] * ic - bfhi(cur.y));
        o.z = pk2(acc[4] * ic - bflo(cur.z), acc[5] * ic - bfhi(cur.z)); o.w = pk2(acc[6] * ic - bflo(cur.w), acc[7] * ic - bfhi(cur.w));
        *(LAS u32x4*)(Dt + j * 16384 + swz128(tok, c8 & 7)) = o; }
    __syncthreads();
    {
        const int j = F.wave >> 1, half = F.wave & 1, fr = F.lane & 15, g = F.lane >> 4;
        const bf16_t* pwt = (const bf16_t*)(F.ws + WS_PWT) + j * 4096;
        const float* psc = F.in[9] + l * 256 + j * 64;
        bf16x8 bfr[4][2];
#pragma unroll
        for (int n = 0; n < 4; ++n)
#pragma unroll
            for (int ks = 0; ks < 2; ++ks) bfr[n][ks] = *(const bf16x8*)(pwt + (16 * n + fr) * 64 + ks * 32 + g * 8);
#pragma unroll
        for (int m = 0; m < 4; ++m) {
            bf16x8 af[2];
#pragma unroll
            for (int ks = 0; ks < 2; ++ks) af[ks] = *(const LAS bf16x8*)(Dt + j * 16384 + swz128(64 * half + 16 * m + fr, ks * 4 + g));
#pragma unroll
            for (int n = 0; n < 4; ++n) { f32x4 acc = (f32x4){0.f, 0.f, 0.f, 0.f};
#pragma unroll
                for (int ks = 0; ks < 2; ++ks) acc = mfma16(bfr[n][ks], af[ks], acc);
                const f32x4 sc = *(const f32x4*)(psc + 16 * n + 4 * g);
                u32x2 w; w.x = pk2(acc[0] * sc[0], acc[1] * sc[1]); w.y = pk2(acc[2] * sc[2], acc[3] * sc[3]);
                *(u32x2*)(ycat + (size_t)(t0 + 64 * half + 16 * m + fr) * DM + j * 64 + 16 * n + 4 * g) = w; }
        }
    }
    const float* cw = F.in[11] + l * 3 * 256;
    for (int i = F.tid; i < 128 * 32; i += NTHR) { const int tok = i >> 5, c8 = i & 31; const int t = t0 + tok;
        float acc[8];
#pragma unroll
        for (int e = 0; e < 8; ++e) acc[e] = 0.f;
#pragma unroll
        for (int q = 0; q < 3; ++q) { const int s = t - 2 + q; if (s >= 0) {
                const u32x4 a = *(const u32x4*)(P + (size_t)s * NINP + C_CG + c8 * 8), b = *(const u32x4*)(P + (size_t)s * NINP + C_XIN + c8 * 8);
                const float* wq = cw + q * 256 + c8 * 8;
                acc[0] += wq[0] * bflo(a.x) * bflo(b.x); acc[1] += wq[1] * bfhi(a.x) * bfhi(b.x); acc[2] += wq[2] * bflo(a.y) * bflo(b.y); acc[3] += wq[3] * bfhi(a.y) * bfhi(b.y);
                acc[4] += wq[4] * bflo(a.z) * bflo(b.z); acc[5] += wq[5] * bfhi(a.z) * bfhi(b.z); acc[6] += wq[6] * bflo(a.w) * bflo(b.w); acc[7] += wq[7] * bfhi(a.w) * bfhi(b.w); } }
        const u32x4 bg = *(const u32x4*)(P + (size_t)t * NINP + C_BG + c8 * 8);
        u32x4 o; o.x = pk2(acc[0] * bflo(bg.x), acc[1] * bfhi(bg.x)); o.y = pk2(acc[2] * bflo(bg.y), acc[3] * bfhi(bg.y));
        o.z = pk2(acc[4] * bflo(bg.z), acc[5] * bfhi(bg.z)); o.w = pk2(acc[6] * bflo(bg.w), acc[7] * bfhi(bg.w));
        *(u32x4*)(ycat + (size_t)t * DM + 512 + c8 * 8) = o; }
    __syncthreads();
}

__device__ __forceinline__ f32x4 up4_(u32x2 w) { return (f32x4){bflo(w.x), bfhi(w.x), bflo(w.y), bfhi(w.y)}; }
__device__ __forceinline__ u32x2 pk4_(f32x4 v) { u32x2 w; w.x = pk2(v[0], v[1]); w.y = pk2(v[2], v[3]); return w; }
__device__ __forceinline__ u32x4 lerp8(u32x4 cur, u32x4 prv, const float* mu, int act) {
    const unsigned cw[4] = {cur.x, cur.y, cur.z, cur.w}, pw[4] = {prv.x, prv.y, prv.z, prv.w}; float z[8];
#pragma unroll
    for (int e = 0; e < 8; ++e) { const float c = (e & 1) ? bfhi(cw[e >> 1]) : bflo(cw[e >> 1]), p = (e & 1) ? bfhi(pw[e >> 1]) : bflo(pw[e >> 1]);
        float v = c + (p - c) * mu[e]; if (act == 1) v = tanhf(v); else if (act == 2) v = sigmoidf_(v); z[e] = v; }
    u32x4 o; o.x = pk2(z[0], z[1]); o.y = pk2(z[2], z[3]); o.z = pk2(z[4], z[5]); o.w = pk2(z[6], z[7]); return o;
}
__device__ __forceinline__ void rwkvprep_item(Frame& F, int l, int item) {
    const int t0 = item * 64;
    const bf16_t* P = (const bf16_t*)(F.ws + WS_P);
    const float* mu = F.in[12] + l * 896;
    ldsp Zw = F.lds, Za = F.lds + 4096, Zg = F.lds + 8192, Zv = F.lds + 16384, V1 = F.lds + 49152 + F.wave * 2048;
    const int nch = (l > 0) ? 48 : 16;
    for (int i = F.tid; i < 64 * nch; i += NTHR) { const int tok = i / nch, c = i % nch; const int t = t0 + tok;
        const int col = (c < 16) ? (768 + c * 8) : (512 + (c - 16) * 8);
        const u32x4 cur = *(const u32x4*)(P + (size_t)t * NINP + C_D + col);
        const u32x4 prv = (t > 0) ? *(const u32x4*)(P + (size_t)(t - 1) * NINP + C_D + col) : (u32x4){0u, 0u, 0u, 0u};
        const u32x4 z = lerp8(cur, prv, mu + col, c < 4 ? 1 : (c >= 8 && c < 16 ? 2 : 0));
        if (c < 4) *(LAS u32x4*)(Zw + tok * 64 + c * 16) = z;
        else if (c < 8) *(LAS u32x4*)(Za + tok * 64 + (c - 4) * 16) = z;
        else if (c < 16) *(LAS u32x4*)(Zg + swz128(tok, c - 8)) = z;
        else *(LAS u32x4*)(Zv + swz512(tok, c - 16)) = z; }
    __syncthreads();
    const int h = F.wave >> 1, half = F.wave & 1, fr = F.lane & 15, g = F.lane >> 4;
    const bf16_t* w2t = (const bf16_t*)(F.ws + WS_W2T); const bf16_t* a2t = (const bf16_t*)(F.ws + WS_A2T); const bf16_t* g2t = (const bf16_t*)(F.ws + WS_G2T);
    const bf16_t* v1t = (const bf16_t*)(F.ws + WS_V1T); const bf16_t* v2t = (const bf16_t*)(F.ws + WS_V2T);
    const float *w0 = F.in[13] + l * 256, *a0 = F.in[15] + l * 256, *kkp = F.in[18] + l * 256, *kap = F.in[19] + l * 256, *rkp = F.in[20] + l * 256;
    const float* v0 = (l > 0) ? F.in[23] + (l - 1) * 256 : nullptr;
    bf16_t *Rr = (bf16_t*)(F.ws + RW_R), *Rk = (bf16_t*)(F.ws + RW_K), *Rv = (bf16_t*)(F.ws + RW_V), *Rkap = (bf16_t*)(F.ws + RW_KAP), *Rb = (bf16_t*)(F.ws + RW_B), *Rg = (bf16_t*)(F.ws + RW_G);
    bf16_t* Rld = (bf16_t*)(F.ws + RW_LD); float* Rbon = (float*)(F.ws + RW_BONUS); bf16_t* VF = (bf16_t*)(F.ws + WS_VFIRST);
#pragma unroll 1
    for (int m = 0; m < 2; ++m) {
        asm volatile("" ::: "memory");
        const int row = 32 * half + 16 * m + fr;
        const bf16x8 aw = *(const LAS bf16x8*)(Zw + row * 64 + g * 16), aa = *(const LAS bf16x8*)(Za + row * 64 + g * 16);
        const bf16x8 ag0 = *(const LAS bf16x8*)(Zg + swz128(row, g)), ag1 = *(const LAS bf16x8*)(Zg + swz128(row, 4 + g));
        bf16x8 a1 = aw;
        if (l > 0) {
            f32x4 t1[2]; t1[0] = (f32x4){0.f, 0.f, 0.f, 0.f}; t1[1] = t1[0];
#pragma unroll
            for (int ks = 0; ks < 8; ++ks) { const bf16x8 av_ = *(const LAS bf16x8*)(Zv + swz512(row, ks * 4 + g));
#pragma unroll
                for (int n = 0; n < 2; ++n) t1[n] = mfma16(*(const bf16x8*)(v1t + (16 * n + fr) * 256 + ks * 32 + g * 8), av_, t1[n]); }
#pragma unroll
            for (int n = 0; n < 2; ++n) { u32x2 w; w.x = pk2(t1[n][0], t1[n][1]); w.y = pk2(t1[n][2], t1[n][3]); *(LAS u32x2*)(V1 + fr * 64 + (16 * n + 4 * g) * 2) = w; }
            LDS_WAIT();
            a1 = *(const LAS bf16x8*)(V1 + fr * 64 + g * 16);
            LDS_WAIT();
        }
        const int t = t0 + 32 * half + 16 * m + fr;
        float ss = 0.f, bon = 0.f;
#pragma unroll 1
        for (int n = 0; n < 4; ++n) { const int ch = 64 * h + 16 * n + 4 * g;
            const bf16_t* pc = P + (size_t)t * NINP + C_D + ch; const bf16_t* pp = pc - NINP;
            const u32x2 kc = *(const u32x2*)(pc + 256); u32x2 kp = (u32x2){0u, 0u}; if (t > 0) kp = *(const u32x2*)(pp + 256);
            const f32x4 kcv = up4_(kc), kpv = up4_(kp), muk = *(const f32x4*)(mu + 256 + ch), kkv = *(const f32x4*)(kkp + ch);
#pragma unroll
            for (int j = 0; j < 4; ++j) { const float kk = (kcv[j] + (kpv[j] - kcv[j]) * muk[j]) * kkv[j]; ss += kk * kk; } }
        ss += __shfl_xor(ss, 16); ss += __shfl_xor(ss, 32);
        const float inn = 1.f / fmaxf(sqrtf(ss), 1e-12f);
#pragma unroll 1
        for (int n = 0; n < 4; ++n) { const int ch = 64 * h + 16 * n + 4 * g;
            asm volatile("" ::: "memory");
            const int nr = 64 * h + 16 * n + fr; const f32x4 z0 = (f32x4){0.f, 0.f, 0.f, 0.f};
            const f32x4 wl = mfma16(*(const bf16x8*)(w2t + nr * 32 + g * 8), aw, z0);
            const f32x4 al = mfma16(*(const bf16x8*)(a2t + nr * 32 + g * 8), aa, z0);
            f32x4 gl = mfma16(*(const bf16x8*)(g2t + nr * 64 + g * 8), ag0, z0); gl = mfma16(*(const bf16x8*)(g2t + nr * 64 + 32 + g * 8), ag1, gl);
            f32x4 vl = z0; if (l > 0) vl = mfma16(*(const bf16x8*)(v2t + nr * 32 + g * 8), a1, z0);
            const bf16_t* pc = P + (size_t)t * NINP + C_D + ch; const bf16_t* pp = pc - NINP;
            const u32x2 rc = *(const u32x2*)(pc), kc = *(const u32x2*)(pc + 256), vc = *(const u32x2*)(pc + 512);
            u32x2 rp = (u32x2){0u, 0u}, kp = rp, vp = rp; if (t > 0) { rp = *(const u32x2*)(pp); kp = *(const u32x2*)(pp + 256); vp = *(const u32x2*)(pp + 512); }
            const f32x4 rcv = up4_(rc), rpv = up4_(rp), kcv = up4_(kc), kpv = up4_(kp), vcv = up4_(vc), vpv = up4_(vp);
            u32x2 vf = (u32x2){0u, 0u}; if (l > 0) vf = *(const u32x2*)(VF + (size_t)t * 256 + ch);
            const f32x4 vfv = up4_(vf);
            const f32x4 mur = *(const f32x4*)(mu + ch), muk = *(const f32x4*)(mu + 256 + ch), muv = *(const f32x4*)(mu + 512 + ch);
            const f32x4 w0v = *(const f32x4*)(w0 + ch), a0v = *(const f32x4*)(a0 + ch), kkv = *(const f32x4*)(kkp + ch), kav = *(const f32x4*)(kap + ch), rkv = *(const f32x4*)(rkp + ch);
            f32x4 v0v = z0; if (l > 0) v0v = *(const f32x4*)(v0 + ch);
            f32x4 vout, ldv, zr, kmod, kp_, b_;
#pragma unroll
            for (int j = 0; j < 4; ++j) {
                const float r_ = rcv[j] + (rpv[j] - rcv[j]) * mur[j], k_ = kcv[j] + (kpv[j] - kcv[j]) * muk[j], v_ = vcv[j] + (vpv[j] - vcv[j]) * muv[j];
                const float wpre = w0v[j] + wl[j]; const float y = -wpre; const float sp = fmaxf(y, 0.f) + log1pf(__expf(-fabsf(y)));
                const float w = -sp - 0.5f; ldv[j] = -__expf(w);
                const float a = sigmoidf_(a0v[j] + al[j]);
                float vv = v_; if (l > 0) vv = v_ + (vfv[j] - v_) * sigmoidf_(v0v[j] + vl[j]);
                vout[j] = vv; zr[j] = r_;
                kp_[j] = k_ * kkv[j] * inn; b_[j] = kp_[j] * a;
                const float km = k_ * (1.f + (a - 1.f) * kav[j]); kmod[j] = km; bon += r_ * km * rkv[j]; }
            const size_t o = (size_t)t * 256 + ch;
            *(u32x2*)(Rr + o) = pk4_(zr); *(u32x2*)(Rk + o) = pk4_(kmod);
            { const u32x2 w = pk4_(vout); *(u32x2*)(Rv + o) = w; if (l == 0) *(u32x2*)(VF + o) = w; }
            *(u32x2*)(Rg + o) = pk4_(gl); *(u32x2*)(Rld + o) = pk4_(ldv);
            *(u32x2*)(Rkap + o) = pk4_(kp_); *(u32x2*)(Rb + o) = pk4_(b_);
        }
        bon += __shfl_xor(bon, 16); bon += __shfl_xor(bon, 32);
        if (g == 0) Rbon[(size_t)t * 4 + h] = bon;
    }
    __syncthreads();
}

__device__ __forceinline__ void mm_n(ldsp X, ldsp Y, int rb, int cb, int fr, int g, f32x4 (&acc)[2]) {
#pragma unroll
    for (int ks = 0; ks < 2; ++ks) { const bf16x8 xf = *(const LAS bf16x8*)(X + swz128(16 * rb + fr, ks * 4 + g));
#pragma unroll
        for (int n = 0; n < 2; ++n) { const bf16x8 yf = *(const LAS bf16x8*)(Y + swz128(32 * cb + 16 * n + fr, ks * 4 + g)); acc[n] = mfma16(yf, xf, acc[n]); } }
}
__device__ __forceinline__ void mm_t(ldsp X, ldsp Y, int rb, int cb, int fr, int g, f32x4 (&acc)[2]) {
#pragma unroll
    for (int ks = 0; ks < 2; ++ks) { const bf16x8 xf = *(const LAS bf16x8*)(X + swz128(16 * rb + fr, ks * 4 + g));
#pragma unroll
        for (int n = 0; n < 2; ++n) { const bf16x8 yf = *(const LAS bf16x8*)(Y + swz128(32 * cb + 16 * n + fr, ks * 4 + g)); acc[n] = mfma16(xf, yf, acc[n]); } }
}
__device__ __forceinline__ int adr_n(int rb, int cb, int n, int fr, int g) { return swz128(16 * rb + fr, 4 * cb + 2 * n + (g >> 1)) + (g & 1) * 8; }
__device__ __forceinline__ int adr_t(int rb, int cb, int n, int fr, int g) { return swz128(32 * cb + 16 * n + fr, 2 * rb + (g >> 1)) + (g & 1) * 8; }
__device__ __forceinline__ u32x2 pk4(f32x4 v) { u32x2 w; w.x = pk2(v[0], v[1]); w.y = pk2(v[2], v[3]); return w; }
__device__ __forceinline__ f32x4 up4(u32x2 w) { return (f32x4){bflo(w.x), bfhi(w.x), bflo(w.y), bfhi(w.y)}; }

__device__ __forceinline__ void chunk_prefix(Frame& F, const bf16_t* Rld, int t0, int h, LAS float* Lc, LAS float* seg) {
    { const int t = F.tid >> 3, c8 = F.tid & 7; const u32x4 v = *(const u32x4*)(Rld + (size_t)(t0 + t) * 256 + h * 64 + c8 * 8);
      LAS float* d = Lc + t * 64 + c8 * 8; d[0] = bflo(v.x); d[1] = bfhi(v.x); d[2] = bflo(v.y); d[3] = bfhi(v.y); d[4] = bflo(v.z); d[5] = bfhi(v.z); d[6] = bflo(v.w); d[7] = bfhi(v.w); }
    __syncthreads();
    { float s = 0.f;
#pragma unroll
      for (int i = 0; i < 8; ++i) { s += Lc[(8 * F.wave + i) * 64 + F.lane]; Lc[(8 * F.wave + i) * 64 + F.lane] = s; }
      seg[F.wave * 64 + F.lane] = s; }
    __syncthreads();
    { float off = 0.f;
      for (int w = 0; w < F.wave; ++w) off += seg[w * 64 + F.lane];
#pragma unroll
      for (int i = 0; i < 8; ++i) Lc[(8 * F.wave + i) * 64 + F.lane] += off; }
    __syncthreads();
}
__device__ __forceinline__ void unpack8(u32x4 v, float (&o)[8]) { o[0] = bflo(v.x); o[1] = bfhi(v.x); o[2] = bflo(v.y); o[3] = bfhi(v.y); o[4] = bflo(v.z); o[5] = bfhi(v.z); o[6] = bflo(v.w); o[7] = bfhi(v.w); }
__device__ __forceinline__ u32x4 pack8(const float (&o)[8]) { u32x4 w; w.x = pk2(o[0], o[1]); w.y = pk2(o[2], o[3]); w.z = pk2(o[4], o[5]); w.w = pk2(o[6], o[7]); return w; }
__device__ __forceinline__ void st_tr8(ldsp tile, int t, int c8, const float (&o)[8]) {
#pragma unroll
    for (int e = 0; e < 8; ++e) *(LAS unsigned short*)(tile + swz128(c8 * 8 + e, t >> 3) + (t & 7) * 2) = (unsigned short)f2bf(o[e]);
}

constexpr int R1_LC = 0, R1_SEG = 16384, R1_GC = 18432, R1_KQ = 20480, R1_BK = 28672, R1_KK = 36864, R1_KABS = 45056, R1_KABST = 53248, R1_BHT = 61440, R1_KHT = 69632, R1_VT = 77824,
              R1_E = 86016  , R1_Q = 102400  , R1_QT = 118784  , R1_AAK = 135168, R1_AVT = R1_Q, R1_W1T = R1_Q + 8192, R1_U0T = R1_QT;
__device__ __forceinline__ void rwkv_r1_item(Frame& F, int item) {
    const int c = item >> 2, h = item & 3, t0 = c * 64;
    const bf16_t *Rk = (const bf16_t*)(F.ws + RW_K), *Rv = (const bf16_t*)(F.ws + RW_V), *Rkap = (const bf16_t*)(F.ws + RW_KAP), *Rb = (const bf16_t*)(F.ws + RW_B), *Rld = (const bf16_t*)(F.ws + RW_LD);
    bf16_t *GW1 = (bf16_t*)(F.ws + RW_W1) + (size_t)item * 4096, *GU0T = (bf16_t*)(F.ws + RW_U0T) + (size_t)item * 4096, *GM = (bf16_t*)(F.ws + RW_M) + (size_t)item * 4096, *GN = (bf16_t*)(F.ws + RW_N) + (size_t)item * 4096;
    ldsp lds = F.lds; LAS float* Lc = (LAS float*)(lds + R1_LC); LAS float* seg = (LAS float*)(lds + R1_SEG); LAS float* GC = (LAS float*)(lds + R1_GC);
    const int rb = F.wave >> 1, cb = F.wave & 1, fr = F.lane & 15, g = F.lane >> 4;
    chunk_prefix(F, Rld, t0, h, Lc, seg);
    {   const int t = F.tid >> 3, c8 = F.tid & 7; const size_t go = (size_t)(t0 + t) * 256 + h * 64 + c8 * 8;
        float kap[8], b[8], k[8], v[8], o1[8], o2[8];
        unpack8(*(const u32x4*)(Rkap + go), kap); unpack8(*(const u32x4*)(Rb + go), b); unpack8(*(const u32x4*)(Rk + go), k); unpack8(*(const u32x4*)(Rv + go), v);
        float L[8], Lp[8], Lm[8], LC[8];
#pragma unroll
        for (int e = 0; e < 8; ++e) { const int cc = c8 * 8 + e; L[e] = Lc[t * 64 + cc]; Lp[e] = (t > 0) ? Lc[(t - 1) * 64 + cc] : 0.f; Lm[e] = Lc[31 * 64 + cc]; LC[e] = Lc[63 * 64 + cc]; }
#pragma unroll
        for (int e = 0; e < 8; ++e) o1[e] = kap[e] * __expf(Lp[e] - Lm[e]);
        *(LAS u32x4*)(lds + R1_KQ + swz128(t, c8)) = pack8(o1);
#pragma unroll
        for (int e = 0; e < 8; ++e) o1[e] = kap[e] * __expf(Lp[e]);
        *(LAS u32x4*)(lds + R1_KABS + swz128(t, c8)) = pack8(o1); st_tr8(lds + R1_KABST, t, c8, o1);
#pragma unroll
        for (int e = 0; e < 8; ++e) { const float s = __expf(Lm[e] - L[e]); o1[e] = b[e] * s; o2[e] = k[e] * s; }
        *(LAS u32x4*)(lds + R1_BK + swz128(t, c8)) = pack8(o1); *(LAS u32x4*)(lds + R1_KK + swz128(t, c8)) = pack8(o2);
#pragma unroll
        for (int e = 0; e < 8; ++e) { const float s = __expf(LC[e] - L[e]); o1[e] = b[e] * s; o2[e] = k[e] * s; }
        st_tr8(lds + R1_BHT, t, c8, o1); st_tr8(lds + R1_KHT, t, c8, o2); st_tr8(lds + R1_VT, t, c8, v);
        if (t == 63) {
#pragma unroll
            for (int e = 0; e < 8; ++e) GC[c8 * 8 + e] = __expf(LC[e]); }
    }
    __syncthreads();
    {
        f32x4 a[2] = {(f32x4){0.f, 0.f, 0.f, 0.f}, (f32x4){0.f, 0.f, 0.f, 0.f}}, at[2] = {a[0], a[0]}, k2[2] = {a[0], a[0]};
        mm_n(lds + R1_KQ, lds + R1_BK, rb, cb, fr, g, a); mm_t(lds + R1_KQ, lds + R1_BK, rb, cb, fr, g, at); mm_n(lds + R1_KQ, lds + R1_KK, rb, cb, fr, g, k2);
#pragma unroll
        for (int n = 0; n < 2; ++n) {
            f32x4 m1, m2, m3;
#pragma unroll
            for (int j = 0; j < 4; ++j) { const int tn = 16 * rb + fr, sn = 32 * cb + 16 * n + 4 * g + j; m1[j] = (sn < tn) ? a[n][j] : 0.f; m3[j] = (sn < tn) ? k2[n][j] : 0.f;
                const int tt = 16 * rb + 4 * g + j, st = 32 * cb + 16 * n + fr; m2[j] = (st < tt) ? at[n][j] : 0.f; }
            *(LAS u32x2*)(lds + R1_Q + adr_n(rb, cb, n, fr, g)) = pk4(m1); *(LAS u32x2*)(lds + R1_E + adr_n(rb, cb, n, fr, g)) = pk4(-m1);
            *(LAS u32x2*)(lds + R1_QT + adr_t(rb, cb, n, fr, g)) = pk4(m2); *(LAS u32x2*)(lds + R1_AAK + adr_n(rb, cb, n, fr, g)) = pk4(m3); }
    }
    __syncthreads();
    {
        f32x4 a[2] = {(f32x4){0.f, 0.f, 0.f, 0.f}, (f32x4){0.f, 0.f, 0.f, 0.f}}, at[2] = {a[0], a[0]};
        mm_n(lds + R1_Q, lds + R1_QT, rb, cb, fr, g, a); mm_t(lds + R1_Q, lds + R1_QT, rb, cb, fr, g, at);
#pragma unroll
        for (int n = 0; n < 2; ++n) { *(LAS u32x2*)(lds + R1_Q + 8192 + adr_n(rb, cb, n, fr, g)) = pk4(a[n]); *(LAS u32x2*)(lds + R1_QT + 8192 + adr_t(rb, cb, n, fr, g)) = pk4(at[n]); }
    }
    __syncthreads();
#pragma unroll 1
    for (int it = 0; it < 5; ++it) {
        ldsp Ecur = lds + R1_E + (it & 1) * 8192, Enew = lds + R1_E + ((it + 1) & 1) * 8192;
        ldsp Qcur = lds + R1_Q + ((it + 1) & 1) * 8192, Qnew = lds + R1_Q + (it & 1) * 8192, QTcur = lds + R1_QT + ((it + 1) & 1) * 8192, QTnew = lds + R1_QT + (it & 1) * 8192;
        f32x4 e[2];
#pragma unroll
        for (int n = 0; n < 2; ++n) e[n] = up4(*(const LAS u32x2*)(Ecur + adr_n(rb, cb, n, fr, g))) + up4(*(const LAS u32x2*)(Qcur + adr_n(rb, cb, n, fr, g)));
        mm_n(Ecur, QTcur, rb, cb, fr, g, e);
#pragma unroll
        for (int n = 0; n < 2; ++n) *(LAS u32x2*)(Enew + adr_n(rb, cb, n, fr, g)) = pk4(e[n]);
        if (it < 4) {
            f32x4 a[2] = {(f32x4){0.f, 0.f, 0.f, 0.f}, (f32x4){0.f, 0.f, 0.f, 0.f}}, at[2] = {a[0], a[0]};
            mm_n(Qcur, QTcur, rb, cb, fr, g, a); mm_t(Qcur, QTcur, rb, cb, fr, g, at);
#pragma unroll
            for (int n = 0; n < 2; ++n) { *(LAS u32x2*)(Qnew + adr_n(rb, cb, n, fr, g)) = pk4(a[n]); *(LAS u32x2*)(QTnew + adr_t(rb, cb, n, fr, g)) = pk4(at[n]); }
        }
        __syncthreads();
    }
    ldsp Ef = lds + R1_E + 8192;
    f32x4 avn[2];
    {
        avn[0] = (f32x4){0.f, 0.f, 0.f, 0.f}; avn[1] = avn[0]; f32x4 avt[2] = {avn[0], avn[0]};
        mm_n(lds + R1_AAK, lds + R1_VT, rb, cb, fr, g, avn); mm_t(lds + R1_AAK, lds + R1_VT, rb, cb, fr, g, avt);
        f32x4 w[2], wt[2];
#pragma unroll
        for (int n = 0; n < 2; ++n) { w[n] = up4(*(const LAS u32x2*)(lds + R1_KABS + adr_n(rb, cb, n, fr, g))); wt[n] = up4(*(const LAS u32x2*)(lds + R1_KABST + adr_t(rb, cb, n, fr, g))); }
        mm_n(Ef, lds + R1_KABST, rb, cb, fr, g, w); mm_t(Ef, lds + R1_KABST, rb, cb, fr, g, wt);
#pragma unroll
        for (int n = 0; n < 2; ++n) { *(LAS u32x2*)(lds + R1_AVT + adr_t(rb, cb, n, fr, g)) = pk4(avt[n]); *(LAS u32x2*)(lds + R1_W1T + adr_t(rb, cb, n, fr, g)) = pk4(wt[n]);
            *(u32x2*)(GW1 + (16 * rb + fr) * 64 + 32 * cb + 16 * n + 4 * g) = pk4(w[n]); }
    }
    __syncthreads();
    {
        f32x4 ut[2];
#pragma unroll
        for (int n = 0; n < 2; ++n) ut[n] = up4(*(const LAS u32x2*)(lds + R1_AVT + adr_t(rb, cb, n, fr, g)));
        mm_t(Ef, lds + R1_AVT, rb, cb, fr, g, ut);
        (void)avn;
#pragma unroll
        for (int n = 0; n < 2; ++n) { *(LAS u32x2*)(lds + R1_U0T + adr_t(rb, cb, n, fr, g)) = pk4(ut[n]); *(u32x2*)(GU0T + (32 * cb + 16 * n + fr) * 64 + 16 * rb + 4 * g) = pk4(ut[n]); }
    }
    __syncthreads();
    {
        f32x4 m[2] = {(f32x4){0.f, 0.f, 0.f, 0.f}, (f32x4){0.f, 0.f, 0.f, 0.f}}, n1[2] = {m[0], m[0]}, n2[2] = {m[0], m[0]};
        mm_n(lds + R1_BHT, lds + R1_W1T, rb, cb, fr, g, m); mm_t(lds + R1_KHT, lds + R1_VT, rb, cb, fr, g, n1); mm_t(lds + R1_BHT, lds + R1_U0T, rb, cb, fr, g, n2);
        float mo[8];
#pragma unroll
        for (int n = 0; n < 2; ++n)
#pragma unroll
            for (int j = 0; j < 4; ++j) { const int cr = 16 * rb + fr, cc = 32 * cb + 16 * n + 4 * g + j; mo[n * 4 + j] = ((cr == cc) ? GC[cr] : 0.f) - m[n][j]; }
        *(u32x4*)(GM + ((rb * 2 + cb) * 64 + F.lane) * 8) = pack8(mo);
#pragma unroll
        for (int n = 0; n < 2; ++n) *(u32x2*)(GN + (((2 * cb + n) * 4 + rb) * 64 + F.lane) * 4) = pk4(n1[n] - n2[n]);
    }
    __syncthreads();
}

template <int MODE>
__device__ __forceinline__ void scan16(Frame& F, const bf16_t* GMsrc, const bf16_t* GNsrc, int i0, int h) {
    ldsp lds = F.lds;
    bf16_t* GMG = (bf16_t*)(F.ws + RW_MG); bf16_t* GNG = (bf16_t*)(F.ws + RW_NG); bf16_t* GSG = (bf16_t*)(F.ws + RW_SG); bf16_t* GS = (bf16_t*)(F.ws + RW_S0);
    {   u32x4 r[16];
#pragma unroll
        for (int s = 0; s < 16; ++s) r[s] = *(const u32x4*)(GMsrc + (size_t)((i0 + s) * 4 + h) * 4096 + F.tid * 8);
#pragma unroll
        for (int s = 0; s < 16; ++s) *(LAS u32x4*)(lds + s * 8192 + F.tid * 16) = r[s];
    }
    const int cb2 = F.wave & 3, fr = F.lane & 15, g = F.lane >> 4;
    const bool nchain = (MODE == 0) ? (F.wave >= 4) : true;
    const bool active = (MODE == 0) ? true : (F.wave < 4);
    u32x2 Nf[16][4];
#pragma unroll
    for (int s = 0; s < 16; ++s)
#pragma unroll
        for (int mt = 0; mt < 4; ++mt) Nf[s][mt] = (u32x2){0u, 0u};
    if (active && nchain) {
#pragma unroll
        for (int s = 0; s < 16; ++s)
#pragma unroll
            for (int mt = 0; mt < 4; ++mt) Nf[s][mt] = *(const u32x2*)(GNsrc + (size_t)((i0 + s) * 4 + h) * 4096 + ((cb2 * 4 + mt) * 64 + F.lane) * 4);
    }
    f32x4 S[4];
#pragma unroll
    for (int mt = 0; mt < 4; ++mt) S[mt] = (f32x4){0.f, 0.f, 0.f, 0.f};
    if (MODE == 0 && F.wave < 4) {
#pragma unroll
        for (int mt = 0; mt < 4; ++mt)
#pragma unroll
            for (int j = 0; j < 4; ++j) S[mt][j] = (16 * mt + 4 * g + j == 16 * cb2 + fr) ? 1.f : 0.f;
    }
    if (MODE == 2) {
#pragma unroll
        for (int mt = 0; mt < 4; ++mt) S[mt] = up4(*(const u32x2*)(GSG + (size_t)((i0 >> 4) * 4 + h) * 4096 + ((cb2 * 4 + mt) * 64 + F.lane) * 4));
    }
    __syncthreads();
    if (active) {
#pragma unroll
        for (int s = 0; s < 16; ++s) {
            u32x4 sw[2];
#pragma unroll
            for (int ks = 0; ks < 2; ++ks) { const u32x2 lo = pk4(S[2 * ks]), hi = pk4(S[2 * ks + 1]); sw[ks] = (u32x4){lo.x, lo.y, hi.x, hi.y}; }
            if (MODE == 1) {
#pragma unroll
                for (int mt = 0; mt < 4; ++mt) { const u32x2 w = (mt & 1) ? (u32x2){sw[mt >> 1].z, sw[mt >> 1].w} : (u32x2){sw[mt >> 1].x, sw[mt >> 1].y};
                    *(u32x2*)(GSG + (size_t)((i0 + s) * 4 + h) * 4096 + ((cb2 * 4 + mt) * 64 + F.lane) * 4) = w; }
            }
            if (MODE == 2) {
#pragma unroll
                for (int mt = 0; mt < 4; ++mt) { const u32x2 w = (mt & 1) ? (u32x2){sw[mt >> 1].z, sw[mt >> 1].w} : (u32x2){sw[mt >> 1].x, sw[mt >> 1].y};
                    *(u32x2*)(GS + (size_t)((i0 + s) * 4 + h) * 4096 + (16 * cb2 + fr) * 64 + 16 * mt + 4 * g) = w; }
            }
#pragma unroll
            for (int mt = 0; mt < 4; ++mt) { f32x4 a = up4(Nf[s][mt]);
#pragma unroll
                for (int ks = 0; ks < 2; ++ks) a = mfma16(*(const LAS bf16x8*)(lds + s * 8192 + ((mt * 2 + ks) * 64 + F.lane) * 16), __builtin_bit_cast(bf16x8, sw[ks]), a);
                S[mt] = a; }
        }
    }
    if (MODE == 0) {
        const int gi = i0 >> 4;
        if (F.wave >= 4) {
#pragma unroll
            for (int mt = 0; mt < 4; ++mt) *(u32x2*)(GNG + (size_t)(gi * 4 + h) * 4096 + ((cb2 * 4 + mt) * 64 + F.lane) * 4) = pk4(S[mt]);
        }
        __syncthreads();
        if (F.wave < 4) {
#pragma unroll
            for (int mt = 0; mt < 4; ++mt)
#pragma unroll
                for (int j = 0; j < 4; ++j) *(LAS unsigned short*)(lds + (16 * mt + 4 * g + j) * 128 + (16 * cb2 + fr) * 2) = (unsigned short)f2bf(S[mt][j]);
        }
        __syncthreads();
        {
            const int mtp = F.wave >> 1, ks = F.wave & 1;
            const u32x2 lo = *(const LAS u32x2*)(lds + (16 * mtp + fr) * 128 + (16 * (2 * ks) + 4 * g) * 2), hi = *(const LAS u32x2*)(lds + (16 * mtp + fr) * 128 + (16 * (2 * ks + 1) + 4 * g) * 2);
            *(u32x4*)(GMG + (size_t)(gi * 4 + h) * 4096 + ((mtp * 2 + ks) * 64 + F.lane) * 8) = (u32x4){lo.x, lo.y, hi.x, hi.y};
        }
    }
    __syncthreads();
}

constexpr int R3_RQ = 20480, R3_RABS = 28672, R3_BK = 36864, R3_KK = 45056, R3_VT = 53248, R3_S = 61440, R3_W1 = 69632, R3_UT = 77824, R3_ARB = 86016, R3_ARK = 94208, R3_ST = 102400;
__device__ __forceinline__ void rwkv_p3_item(Frame& F, int l, int item) {
    const int c = item >> 2, h = item & 3, t0 = c * 64;
    const bf16_t *Rr = (const bf16_t*)(F.ws + RW_R), *Rk = (const bf16_t*)(F.ws + RW_K), *Rv = (const bf16_t*)(F.ws + RW_V), *Rb = (const bf16_t*)(F.ws + RW_B), *Rg = (const bf16_t*)(F.ws + RW_G), *Rld = (const bf16_t*)(F.ws + RW_LD);
    const bf16_t *GW1 = (const bf16_t*)(F.ws + RW_W1) + (size_t)item * 4096, *GU0T = (const bf16_t*)(F.ws + RW_U0T) + (size_t)item * 4096, *GS = (const bf16_t*)(F.ws + RW_S0) + (size_t)item * 4096;
    const float* Rbon = (const float*)(F.ws + RW_BONUS); bf16_t* ycat = (bf16_t*)(F.ws + WS_ACT);
    ldsp lds = F.lds; LAS float* Lc = (LAS float*)(lds + R1_LC); LAS float* seg = (LAS float*)(lds + R1_SEG); LAS float* ST = (LAS float*)(lds + R3_ST);
    const int rb = F.wave >> 1, cb = F.wave & 1, fr = F.lane & 15, g = F.lane >> 4;
    chunk_prefix(F, Rld, t0, h, Lc, seg);
    {   const int t = F.tid >> 3, c8 = F.tid & 7; const size_t go = (size_t)(t0 + t) * 256 + h * 64 + c8 * 8;
        float r[8], b[8], k[8], v[8], o1[8], o2[8];
        unpack8(*(const u32x4*)(Rr + go), r); unpack8(*(const u32x4*)(Rb + go), b); unpack8(*(const u32x4*)(Rk + go), k); unpack8(*(const u32x4*)(Rv + go), v);
        float L[8], Lm[8];
#pragma unroll
        for (int e = 0; e < 8; ++e) { const int cc = c8 * 8 + e; L[e] = Lc[t * 64 + cc]; Lm[e] = Lc[31 * 64 + cc]; }
#pragma unroll
        for (int e = 0; e < 8; ++e) { o1[e] = r[e] * __expf(L[e] - Lm[e]); o2[e] = r[e] * __expf(L[e]); }
        *(LAS u32x4*)(lds + R3_RQ + swz128(t, c8)) = pack8(o1); *(LAS u32x4*)(lds + R3_RABS + swz128(t, c8)) = pack8(o2);
#pragma unroll
        for (int e = 0; e < 8; ++e) { const float s = __expf(Lm[e] - L[e]); o1[e] = b[e] * s; o2[e] = k[e] * s; }
        *(LAS u32x4*)(lds + R3_BK + swz128(t, c8)) = pack8(o1); *(LAS u32x4*)(lds + R3_KK + swz128(t, c8)) = pack8(o2);
        st_tr8(lds + R3_VT, t, c8, v);
        *(LAS u32x4*)(lds + R3_S + swz128(t, c8)) = *(const u32x4*)(GS + t * 64 + c8 * 8);
        *(LAS u32x4*)(lds + R3_W1 + swz128(t, c8)) = *(const u32x4*)(GW1 + t * 64 + c8 * 8);
    }
    __syncthreads();
    f32x4 y[2];
    {   f32x4 ut[2];
#pragma unroll
        for (int n = 0; n < 2; ++n) ut[n] = up4(*(const u32x2*)(GU0T + (32 * cb + 16 * n + fr) * 64 + 16 * rb + 4 * g));
        mm_t(lds + R3_W1, lds + R3_S, rb, cb, fr, g, ut);
        f32x4 ab[2] = {(f32x4){0.f, 0.f, 0.f, 0.f}, (f32x4){0.f, 0.f, 0.f, 0.f}}, ak[2] = {ab[0], ab[0]};
        mm_n(lds + R3_RQ, lds + R3_BK, rb, cb, fr, g, ab); mm_n(lds + R3_RQ, lds + R3_KK, rb, cb, fr, g, ak);
        y[0] = (f32x4){0.f, 0.f, 0.f, 0.f}; y[1] = y[0];
        mm_n(lds + R3_RABS, lds + R3_S, rb, cb, fr, g, y);
#pragma unroll
        for (int n = 0; n < 2; ++n) {
            f32x4 m1, m2;
#pragma unroll
            for (int j = 0; j < 4; ++j) { const int tn = 16 * rb + fr, sn = 32 * cb + 16 * n + 4 * g + j; m1[j] = (sn <= tn) ? ab[n][j] : 0.f; m2[j] = (sn <= tn) ? ak[n][j] : 0.f; }
            *(LAS u32x2*)(lds + R3_UT + adr_t(rb, cb, n, fr, g)) = pk4(ut[n]);
            *(LAS u32x2*)(lds + R3_ARB + adr_n(rb, cb, n, fr, g)) = pk4(m1); *(LAS u32x2*)(lds + R3_ARK + adr_n(rb, cb, n, fr, g)) = pk4(m2); }
    }
    __syncthreads();
    {   f32x4 z[2] = {(f32x4){0.f, 0.f, 0.f, 0.f}, (f32x4){0.f, 0.f, 0.f, 0.f}};
        mm_n(lds + R3_ARB, lds + R3_UT, rb, cb, fr, g, z); mm_n(lds + R3_ARK, lds + R3_VT, rb, cb, fr, g, y);
        y[0] -= z[0]; y[1] -= z[1];
        float s1 = 0.f, s2 = 0.f;
#pragma unroll
        for (int n = 0; n < 2; ++n)
#pragma unroll
            for (int j = 0; j < 4; ++j) { s1 += y[n][j]; s2 += y[n][j] * y[n][j]; }
        s1 += __shfl_xor(s1, 16); s1 += __shfl_xor(s1, 32); s2 += __shfl_xor(s2, 16); s2 += __shfl_xor(s2, 32);
        if (g == 0) { ST[((16 * rb + fr) * 2 + cb) * 2] = s1; ST[((16 * rb + fr) * 2 + cb) * 2 + 1] = s2; }
    }
    __syncthreads();
    {   const int tl = 16 * rb + fr; const int t = t0 + tl;
        const float s1 = ST[(tl * 2) * 2] + ST[(tl * 2 + 1) * 2], s2 = ST[(tl * 2) * 2 + 1] + ST[(tl * 2 + 1) * 2 + 1];
        const float mean = s1 * (1.f / 64.f), var = fmaxf(s2 * (1.f / 64.f) - mean * mean, 0.f), rstd = 1.f / sqrtf(var + 64e-5f);
        const float bon = Rbon[(size_t)t * 4 + h];
        const float *lng = F.in[21] + l * 256 + h * 64, *lnb = F.in[22] + l * 256 + h * 64;
#pragma unroll
        for (int n = 0; n < 2; ++n) { const int i0 = 32 * cb + 16 * n + 4 * g; const size_t go = (size_t)t * 256 + h * 64 + i0;
            const f32x4 vv = up4(*(const u32x2*)(Rv + go)), gg = up4(*(const u32x2*)(Rg + go)); const f32x4 lg = *(const f32x4*)(lng + i0), lb = *(const f32x4*)(lnb + i0);
            f32x4 o;
#pragma unroll
            for (int j = 0; j < 4; ++j) o[j] = ((y[n][j] - mean) * rstd * lg[j] + lb[j] + bon * vv[j]) * gg[j];
            *(u32x2*)(ycat + (size_t)t * DM + 768 + h * 64 + i0) = pk4(o); }
    }
    __syncthreads();
}

__device__ __forceinline__ void phase_router(Frame& F, int l, int alt = 0) {
    const float* X = F.out;
    const bf16_t* WH = (const bf16_t*)(F.ws + WS_WRH); const bf16_t* WL = (const bf16_t*)(F.ws + WS_WRL);
    const float* bias_r = (const float*)(F.ws + WS_BR);
    float* rinv2 = (float*)(F.ws + WS_RINV2);
    unsigned* cnt = (unsigned*)(F.ws + WS_CTL) + CNT_W0 + (alt * 2 + l) * 2048;
    unsigned* list = (unsigned*)(F.ws + (alt ? WS_P + (size_t)alt * 8 * MiB : WS_LIST)); float* wlist = (float*)(F.ws + (alt ? WS_P + (size_t)alt * 8 * MiB + 2 * MiB : WS_WLIST));
    LAS float* Lg = (LAS float*)(F.lds + (F.wave >> 1) * 4096);
    LAS float* Px = (LAS float*)(F.lds + 16384 + (F.wave >> 1) * 4096);
    const int fr = F.lane & 15, g = F.lane >> 4;
    const int kh = F.wave & 1;
    LAS unsigned* hist = (LAS unsigned*)(F.lds + 40960); LAS unsigned* hbase = hist + 32;
    if (F.tid < 32) hist[F.tid] = 0u;
    __syncthreads();
    for (int it0 = F.bid * 4; it0 < T_ / 16; it0 += F.G * 4) {
        const int it = it0 + (F.wave >> 1);
        const int t = it * 16 + fr;
        int E0 = -1, E1 = -1; unsigned r0 = 0u, r1 = 0u; float w0 = 0.f, w1 = 0.f;
        const float* xr = X + (size_t)t * DM + kh * 512 + g * 8;
        f32x4 acc[3]; acc[0] = (f32x4){0.f, 0.f, 0.f, 0.f}; acc[1] = acc[0]; acc[2] = acc[0];
        float ss = 0.f;
#pragma unroll 1
        for (int kb = 0; kb < 2; ++kb) {
            f32x4 xa[8], xb[8];
#pragma unroll
            for (int k8 = 0; k8 < 8; ++k8) { xa[k8] = *(const f32x4*)(xr + (kb * 8 + k8) * 32); xb[k8] = *(const f32x4*)(xr + (kb * 8 + k8) * 32 + 4); }
#pragma unroll
            for (int k8 = 0; k8 < 8; ++k8) {
                const int ks = kh * 16 + kb * 8 + k8;
                const f32x4 x0 = xa[k8], x1 = xb[k8];
                const float xv[8] = {x0[0], x0[1], x0[2], x0[3], x1[0], x1[1], x1[2], x1[3]};
                unsigned hh[8], ll[8];
#pragma unroll
                for (int e = 0; e < 8; ++e) { ss += xv[e] * xv[e]; hh[e] = f2bf(xv[e]); ll[e] = f2bf(xv[e] - bf2f(hh[e])); }
                u32x4 hw, lw; hw.x = hh[0] | (hh[1] << 16); hw.y = hh[2] | (hh[3] << 16); hw.z = hh[4] | (hh[5] << 16); hw.w = hh[6] | (hh[7] << 16);
                lw.x = ll[0] | (ll[1] << 16); lw.y = ll[2] | (ll[3] << 16); lw.z = ll[4] | (ll[5] << 16); lw.w = ll[6] | (ll[7] << 16);
                const bf16x8 xh = __builtin_bit_cast(bf16x8, hw), xl = __builtin_bit_cast(bf16x8, lw);
#pragma unroll
                for (int n = 0; n < 3; ++n) { const bf16x8 wh = *(const bf16x8*)(WH + (16 * n + fr) * DM + ks * 32 + g * 8), wl = *(const bf16x8*)(WL + (16 * n + fr) * DM + ks * 32 + g * 8);
                    acc[n] = mfma16(wh, xh, acc[n]); acc[n] = mfma16(wh, xl, acc[n]); acc[n] = mfma16(wl, xh, acc[n]); }
            }
        }
        if (kh == 1) {
#pragma unroll
            for (int n = 0; n < 3; ++n)
#pragma unroll
                for (int j = 0; j < 4; ++j) Px[(n * 4 + j) * 64 + F.lane] = acc[n][j];
            Px[12 * 64 + F.lane] = ss; }
        __syncthreads();
        if (kh == 0) {
#pragma unroll
            for (int n = 0; n < 3; ++n)
#pragma unroll
                for (int j = 0; j < 4; ++j) acc[n][j] += Px[(n * 4 + j) * 64 + F.lane];
            ss += Px[12 * 64 + F.lane]; }
        ss += __shfl_xor(ss, 16); ss += __shfl_xor(ss, 32);
        const float rinv = 1.f / sqrtf(ss * (1.f / DM) + 1e-6f);
        if (kh == 0) {
#pragma unroll
        for (int n = 0; n < 3; ++n)
#pragma unroll
            for (int j = 0; j < 4; ++j) { const int c = 16 * n + 4 * g + j; Lg[fr * 48 + c] = acc[n][j] * rinv + bias_r[c]; }
        LDS_WAIT();
        if (F.lane < 16) {
            const LAS float* lg = Lg + F.lane * 48; const int tt = it * 16 + F.lane;
            rinv2[tt] = rinv;
            int gi = 0; float gm = lg[0];
#pragma unroll
            for (int k = 1; k < 4; ++k) if (lg[k] > gm) { gm = lg[k]; gi = k; }
            float gs = 0.f;
#pragma unroll
            for (int k = 0; k < 4; ++k) gs += __expf(lg[k] - gm);
            const float gp = 1.f / gs;
            int e0 = 0; float v0 = lg[4 + gi * 8];
#pragma unroll
            for (int k = 1; k < 8; ++k) { const float v = lg[4 + gi * 8 + k]; if (v > v0) { v0 = v; e0 = k; } }
            int e1 = -1; float v1 = -INFINITY;
#pragma unroll
            for (int k = 0; k < 8; ++k) { const float v = lg[4 + gi * 8 + k]; if (k != e0 && v > v1) { v1 = v; e1 = k; } }
            const float ex = __expf(v1 - v0); const float w0_ = gp / (1.f + ex), w1_ = gp * ex / (1.f + ex);
            E0 = gi * 8 + e0; E1 = gi * 8 + e1; w0 = w0_; w1 = w1_;
            r0 = __hip_atomic_fetch_add(hist + E0, 1u, __ATOMIC_RELAXED, __HIP_MEMORY_SCOPE_WORKGROUP);
            r1 = __hip_atomic_fetch_add(hist + E1, 1u, __ATOMIC_RELAXED, __HIP_MEMORY_SCOPE_WORKGROUP);
        }
        }
        __syncthreads();
        if (F.tid < 32) { const unsigned n = hist[F.tid]; unsigned b = 0u; if (n) b = atomicAdd(&cnt[F.tid * 64], n); hbase[F.tid] = b; }
        __syncthreads();
        if (E0 >= 0) { const int tt = it * 16 + F.lane;
            const unsigned p0 = hbase[E0] + r0; list[(size_t)E0 * T_ + p0] = (unsigned)tt; wlist[(size_t)E0 * T_ + p0] = w0;
            const unsigned p1 = hbase[E1] + r1; list[(size_t)E1 * T_ + p1] = (unsigned)tt | 0x80000000u; wlist[(size_t)E1 * T_ + p1] = w1; }
        __syncthreads();
        if (F.tid < 32) hist[F.tid] = 0u;
    }
}

__device__ __forceinline__ void phase_moe(Frame& F, int l) {
    const bf16_t* XB = (const bf16_t*)(F.ws + WS_RW);
    const bf16_t* WGU = (const bf16_t*)(F.ws + WS_WGU); const bf16_t* WD = (const bf16_t*)(F.ws + WS_WD);
    const float* bias_gu = (const float*)(F.ws + WS_BGU); const float* rinv2 = (const float*)(F.ws + WS_RINV2);
    const unsigned* cnt = (const unsigned*)(F.ws + WS_CTL) + CNT_W0 + l * 2048;
    const unsigned* list = (const unsigned*)(F.ws + WS_LIST); const float* wlist = (const float*)(F.ws + WS_WLIST);
    bf16_t* ys = (bf16_t*)(F.ws + WS_P);
    ldsp At = F.lds, Bt = F.lds + 16384, Bd = F.lds, Act = F.lds + 65536;
    LAS unsigned* tokl = (LAS unsigned*)(F.lds + 98304); LAS float* wtl = (LAS float*)(F.lds + 98304 + 512); LAS float* rvl = (LAS float*)(F.lds + 98304 + 1024);
    const int wr = F.wave >> 2, wc = F.wave & 3, fr = F.lane & 15, g = F.lane >> 4;
    int total = 0;
    for (int e = 0; e < 32; ++e) total += ((int)cnt[e * 64] + 127) >> 7;
    for (int ti = F.bid; ti < total; ti += F.G) {
        int e = 0, acc_t = 0, m0 = 0, ne = 0;
        for (int k = 0; k < 32; ++k) { const int n = (int)cnt[k * 64]; const int nt = (n + 127) >> 7; if (ti >= acc_t && ti < acc_t + nt) { e = k; m0 = (ti - acc_t) * 128; ne = n; } acc_t += nt; }
        const int nrows = (ne - m0) < 128 ? (ne - m0) : 128;
        __syncthreads();
        if (F.tid < 128) { unsigned tk = 0u; float w = 0.f; if (F.tid < nrows) { tk = list[(size_t)e * T_ + m0 + F.tid]; w = wlist[(size_t)e * T_ + m0 + F.tid]; }
            tokl[F.tid] = tk; wtl[F.tid] = w; rvl[F.tid] = rinv2[tk & 0x7fffffffu]; }
        __syncthreads();
        f32x4 ag[4][2], au[4][2];
#pragma unroll
        for (int m = 0; m < 4; ++m)
#pragma unroll
            for (int n = 0; n < 2; ++n) { ag[m][n] = (f32x4){0.f, 0.f, 0.f, 0.f}; au[m][n] = ag[m][n]; }
        const bf16_t* wgu = WGU + (size_t)e * 256 * DM;
        for (int kt = 0; kt < 16; ++kt) {
            u32x4 ra[2], rb[4];
#pragma unroll
            for (int i = 0; i < 2; ++i) { const int idx = F.tid + i * NTHR, row = idx >> 3, c = idx & 7; const unsigned tk = tokl[row] & 0x7fffffffu; ra[i] = *(const u32x4*)(XB + (size_t)tk * DM + kt * 64 + c * 8); }
#pragma unroll
            for (int i = 0; i < 4; ++i) { const int idx = F.tid + i * NTHR, row = idx >> 3, c = idx & 7; rb[i] = *(const u32x4*)(wgu + (size_t)row * DM + kt * 64 + c * 8); }
            __syncthreads();
#pragma unroll
            for (int i = 0; i < 2; ++i) { const int idx = F.tid + i * NTHR, row = idx >> 3, c = idx & 7; *(LAS u32x4*)(At + swz128(row, c)) = ra[i]; }
#pragma unroll
            for (int i = 0; i < 4; ++i) { const int idx = F.tid + i * NTHR, row = idx >> 3, c = idx & 7; *(LAS u32x4*)(Bt + swz128(row, c)) = rb[i]; }
            __syncthreads();
#pragma unroll
            for (int ks = 0; ks < 2; ++ks) {
                bf16x8 af[4], bg_[2], bu_[2];
#pragma unroll
                for (int m = 0; m < 4; ++m) af[m] = *(const LAS bf16x8*)(At + swz128(64 * wr + 16 * m + fr, ks * 4 + g));
#pragma unroll
                for (int n = 0; n < 2; ++n) { bg_[n] = *(const LAS bf16x8*)(Bt + swz128(32 * wc + 16 * n + fr, ks * 4 + g)); bu_[n] = *(const LAS bf16x8*)(Bt + swz128(128 + 32 * wc + 16 * n + fr, ks * 4 + g)); }
#pragma unroll
                for (int m = 0; m < 4; ++m)
#pragma unroll
                    for (int n = 0; n < 2; ++n) { ag[m][n] = mfma16(bg_[n], af[m], ag[m][n]); au[m][n] = mfma16(bu_[n], af[m], au[m][n]); }
            }
        }
        const float* bge = bias_gu + e * 256;
#pragma unroll
        for (int m = 0; m < 4; ++m) { const int row = 64 * wr + 16 * m + fr; const float rv = rvl[row], wt = wtl[row];
#pragma unroll
            for (int n = 0; n < 2; ++n) { const int f0 = 32 * wc + 16 * n + 4 * g; float a_[4];
#pragma unroll
                for (int j = 0; j < 4; ++j) { const float gv = ag[m][n][j] * rv + bge[f0 + j], uv = au[m][n][j] * rv + bge[128 + f0 + j]; a_[j] = gv * sigmoidf_(gv) * uv * wt; }
                u32x2 w; w.x = pk2(a_[0], a_[1]); w.y = pk2(a_[2], a_[3]);
                *(LAS u32x2*)(Act + swz256(row, f0 >> 3) + (g & 1) * 8) = w; } }
        const bf16_t* wd = WD + (size_t)e * DM * 128;
#pragma unroll 1
        for (int nc = 0; nc < 4; ++nc) {
            __syncthreads();
#pragma unroll
            for (int i = 0; i < 8; ++i) { const int idx = F.tid + i * NTHR, row = idx >> 4, c = idx & 15; *(LAS u32x4*)(Bd + swz256(row, c)) = *(const u32x4*)(wd + (size_t)(nc * 256 + row) * 128 + c * 8); }
            __syncthreads();
            f32x4 ao[4][4];
#pragma unroll
            for (int m = 0; m < 4; ++m)
#pragma unroll
                for (int n = 0; n < 4; ++n) ao[m][n] = (f32x4){0.f, 0.f, 0.f, 0.f};
#pragma unroll
            for (int ks = 0; ks < 4; ++ks) {
                bf16x8 af[4], bf_[4];
#pragma unroll
                for (int m = 0; m < 4; ++m) af[m] = *(const LAS bf16x8*)(Act + swz256(64 * wr + 16 * m + fr, ks * 4 + g));
#pragma unroll
                for (int n = 0; n < 4; ++n) bf_[n] = *(const LAS bf16x8*)(Bd + swz256(64 * wc + 16 * n + fr, ks * 4 + g));
#pragma unroll
                for (int m = 0; m < 4; ++m)
#pragma unroll
                    for (int n = 0; n < 4; ++n) ao[m][n] = mfma16(bf_[n], af[m], ao[m][n]);
            }
#pragma unroll
            for (int m = 0; m < 4; ++m) { const int row = 64 * wr + 16 * m + fr;
                if (row < nrows) { const unsigned tk = tokl[row]; bf16_t* dst = ys + ((size_t)(tk >> 31) * T_ + (tk & 0x7fffffffu)) * DM + nc * 256 + 64 * wc + 4 * g;
#pragma unroll
                    for (int n = 0; n < 4; ++n) { u32x2 w; w.x = pk2(ao[m][n][0], ao[m][n][1]); w.y = pk2(ao[m][n][2], ao[m][n][3]); *(u32x2*)(dst + 16 * n) = w; } } }
        }
    }
    __syncthreads();
}

#define XB_TMO      128
#define XB_XCNT(j)  (256  + 64 * (j))
#define XB_XSUB(j)  (1280 + 64 * (j))
#define XB_XGEN(j)  (2304 + 64 * (j))
#define XB_TOP      3328
#define XB_TOPGEN   3392
#define XCD_BAR_WORDS 3456
#define XB_SPIN_CAP (1u << 18)
__device__ __forceinline__ unsigned xb_ld(unsigned* p)              { return __hip_atomic_load(p, __ATOMIC_RELAXED, __HIP_MEMORY_SCOPE_AGENT); }
__device__ __forceinline__ unsigned xb_add(unsigned* p, unsigned v) { return __hip_atomic_fetch_add(p, v, __ATOMIC_RELAXED, __HIP_MEMORY_SCOPE_AGENT); }
__device__ __forceinline__ unsigned xb_xcc_id() { return (unsigned)__builtin_amdgcn_s_getreg((3 << 11) | 20) & 0xFu; }
#define XB_SPIN(cond, bar) do { unsigned _sp = 0; while (cond) { __builtin_amdgcn_s_sleep(1); \
    if ((++_sp & 255u) == 0u) { if (xb_ld(&(bar)[XB_TMO])) break; if (_sp > XB_SPIN_CAP) { atomicAdd(&(bar)[XB_TMO], 1u); break; } } } } while (0)
struct XcdBarrier { unsigned* bar; unsigned x; volatile LAS unsigned* st; };
__device__ __forceinline__ XcdBarrier xcd_barrier_post(unsigned* bar, volatile LAS unsigned* st) {
    XcdBarrier b; b.bar = bar; b.x = xb_xcc_id(); b.st = st;
    if (threadIdx.x == 0) (void)xb_add(&bar[XB_XCNT(b.x)], 1u);
    return b;
}
__device__ __forceinline__ void xcd_barrier_complete(unsigned* bar, unsigned x, unsigned& nloc, unsigned& nx) {
    const unsigned G = gridDim.x * gridDim.y * gridDim.z;
    unsigned sum, cnt, mine, sp = 0u;
    for (;;) {
        sum = 0u; cnt = 0u; mine = 0u;
#pragma unroll
        for (unsigned j = 0; j < 16; ++j) { const unsigned c = xb_ld(&bar[XB_XCNT(j)]); sum += c; cnt += (c > 0u) ? 1u : 0u; mine = (j == x) ? c : mine; }
        if (sum == G) break;
        __builtin_amdgcn_s_sleep(1);
        if ((++sp & 255u) == 0u) { if (xb_ld(&bar[XB_TMO])) break; if (sp > XB_SPIN_CAP) { atomicAdd(&bar[XB_TMO], 1u); break; } }
    }
    nloc = mine > 0u ? mine : 1u; nx = cnt > 0u ? cnt : 1u;
}
__device__ __forceinline__ void xcd_barrier(const XcdBarrier& b) {
    asm volatile("s_waitcnt vmcnt(0)" ::: "memory");
    __syncthreads();
    if (threadIdx.x == 0) {
        unsigned* bar = b.bar;
        __builtin_amdgcn_s_waitcnt(0);
        unsigned nloc = b.st[0], nx = b.st[1];
        if (nloc == 0u) { xcd_barrier_complete(bar, b.x, nloc, nx); b.st[0] = nloc; b.st[1] = nx; }
        const unsigned old = xb_add(&bar[XB_XSUB(b.x)], 1u);
        const unsigned gen = old / nloc;
        if (old + 1u == (gen + 1u) * nloc) {
            __builtin_amdgcn_fence(__ATOMIC_RELEASE, "agent");
            asm volatile("s_waitcnt vmcnt(0)" ::: "memory");
            const unsigned og = xb_add(&bar[XB_TOP], 1u);
            const unsigned tg = og / nx;
            if (og + 1u == (tg + 1u) * nx) xb_add(&bar[XB_TOPGEN], 1u);
            else XB_SPIN(xb_ld(&bar[XB_TOPGEN]) == tg, bar);
            __builtin_amdgcn_fence(__ATOMIC_ACQUIRE, "agent");
            xb_add(&bar[XB_XGEN(b.x)], 1u);
            asm volatile("s_waitcnt vmcnt(0)" ::: "memory");
        } else {
            XB_SPIN(xb_ld(&bar[XB_XGEN(b.x)]) == gen, bar);
            __builtin_amdgcn_fence(__ATOMIC_ACQUIRE, "agent");
            asm volatile("s_waitcnt vmcnt(0)" ::: "memory");
        }
    }
    __syncthreads();
}

constexpr int NPHASE = 24;
__device__ __forceinline__ bool fresh(Frame& F) { int t = threadIdx.x; asm volatile("" : "+v"(t)); F.tid = t; F.lane = t & 63; F.wave = __builtin_amdgcn_readfirstlane(t >> 6); return true; }
template <int L> __device__ __forceinline__ void layer_phases(Frame& F, const XcdBarrier& bar, const int lo, const int hi) {
    constexpr int B = 1 + 11 * L;
#ifndef PROBE_PH
#define PROBE_PH -1
#endif
#define RP(k) for (int rep_ = 0; rep_ < (((k) == PROBE_PH) ? 3 : 1); ++rep_)
#define INR(k) (lo <= (k) && (k) < hi)
#define IN(k) (INR(k) && fresh(F))
#define SEAM(k) do { if (INR(k) && INR((k) + 1)) xcd_barrier(bar); } while (0)
    if (IN(B + 0)) RP(B + 0) { phase_prep(F, L); __syncthreads(); phase_rownorm(F, L == 0 ? 0 : 1); } SEAM(B + 0);
    if (IN(B + 1)) RP(B + 1) {
        pg8::Gemm gm{(const bf16_t*)(F.ws + WS_ACT), (const bf16_t*)(F.ws + WS_WIN), T_, NINP, DM, DM, DM};
        pg8::StaticOrder S; S.init(T_, NINP, F.G, F.bid);
        pg8::EpiBf16Bias E{(bf16_t*)(F.ws + WS_P), NINP, (const float*)(F.ws + WS_BIN)};
        pg8::gemm_phase<pg8::EpiBf16Bias, pg8::StaticOrder, true, true>(F.lds, gm, S, E);
    } SEAM(B + 1);
    if (IN(B + 2)) RP(B + 2) {
#pragma unroll 1
        for (int it = F.bid; it < 512; it += F.G) { asm volatile("" ::: "memory"); if (it < 128) attn_item(F, L, it); }
#pragma unroll 1
        for (int it = F.bid; it < 512; it += F.G) { asm volatile("" ::: "memory"); if (it >= 128 && it < 256) poolconv_item(F, L, it - 128); }
#pragma unroll 1
        for (int it = F.bid; it < 512; it += F.G) { asm volatile("" ::: "memory"); if (it >= 256) rwkvprep_item(F, L, it - 256); }
    } SEAM(B + 2);
    if (IN(B + 3)) RP(B + 3) {
#pragma unroll 1
        for (int it = F.bid; it < 1024; it += F.G) { asm volatile("" ::: "memory"); rwkv_r1_item(F, it); }
    } SEAM(B + 3);
    if (IN(B + 4)) RP(B + 4) {
#pragma unroll 1
        for (int u = F.bid; u < 64; u += F.G) { asm volatile("" ::: "memory"); scan16<0>(F, (const bf16_t*)(F.ws + RW_M), (const bf16_t*)(F.ws + RW_N), (u >> 2) * 16, u & 3); }
    } SEAM(B + 4);
    if (IN(B + 5)) RP(B + 5) {
#pragma unroll 1
        for (int u = F.bid; u < 4; u += F.G) { asm volatile("" ::: "memory"); scan16<1>(F, (const bf16_t*)(F.ws + RW_MG), (const bf16_t*)(F.ws + RW_NG), 0, u); }
    } SEAM(B + 5);
    if (IN(B + 6)) RP(B + 6) {
#pragma unroll 1
        for (int u = F.bid; u < 64; u += F.G) { asm volatile("" ::: "memory"); scan16<2>(F, (const bf16_t*)(F.ws + RW_M), (const bf16_t*)(F.ws + RW_N), (u >> 2) * 16, u & 3); }
    } SEAM(B + 6);
    if (IN(B + 7)) RP(B + 7) {
#pragma unroll 1
        for (int it = F.bid; it < 1024; it += F.G) { asm volatile("" ::: "memory"); rwkv_p3_item(F, L, it); }
    } SEAM(B + 7);
    if (IN(B + 8)) RP(B + 8) {
        pg8::Gemm gm{(const bf16_t*)(F.ws + WS_ACT), (const bf16_t*)(F.ws + WS_WOUT), T_, DM, DM, DM, DM};
        pg8::StaticOrder S; S.init(T_, DM, F.G, F.bid);
        pg8::EpiResF32 E{L == 0 ? F.in[0] : F.out, F.out, (bf16_t*)(F.ws + WS_RW), DM};
        pg8::gemm_phase<pg8::EpiResF32, pg8::StaticOrder, true, true>(F.lds, gm, S, E);
    } SEAM(B + 8);
    if (IN(B + 9)) RP(B + 9) phase_router(F, L, rep_); SEAM(B + 9);
    if (IN(B + 10)) RP(B + 10) phase_moe(F, L); SEAM(B + 10);
}

__global__ void __launch_bounds__(NTHR, 2) fwd_kernel(Args a) {
    extern __shared__ __attribute__((aligned(16))) unsigned char smem[];
    Frame F;
    F.lds = (ldsp)smem; F.tid = threadIdx.x; F.lane = F.tid & 63; F.wave = __builtin_amdgcn_readfirstlane(F.tid >> 6);
    F.G = gridDim.x; F.bid = blockIdx.x; F.in = a.in; F.out = a.out; F.ws = a.ws;
    const int lo = a.ph_lo, hi = a.ph_hi;
    volatile LAS unsigned* bst = (volatile LAS unsigned*)(F.lds + LDS_BYTES - 64);
    if (F.tid < 16) bst[F.tid] = 0u;
    __syncthreads();
    const XcdBarrier bar = xcd_barrier_post((unsigned*)(F.ws + WS_CTL) + 1024, bst);
    if (IN(0)) RP(0) phase_mod(F); SEAM(0);
    layer_phases<0>(F, bar, lo, hi);
    layer_phases<1>(F, bar, lo, hi);
    if (IN(23)) phase_rownorm(F, 2);
#undef IN
#undef INR
#undef SEAM
}

extern "C" void kernel_launch(void* const* d_in, const int* in_sizes, int n_in, void* d_out, int out_size, void* d_ws, size_t ws_size, hipStream_t stream) {
    static int grid = 0;
    if (grid == 0) {
        int dev = 0, cus = 0;
        if (n_in != 34 || out_size != T_ * DM || ws_size < WS_END) { fprintf(stderr, "kernel_launch: unexpected shapes n_in %d out %d ws %zu\n", n_in, out_size, ws_size); grid = -1; return; }
        if (hipGetDevice(&dev) != hipSuccess || hipDeviceGetAttribute(&cus, hipDeviceAttributeMultiprocessorCount, dev) != hipSuccess) { grid = -1; return; }
        if (hipFuncSetAttribute((const void*)fwd_kernel, hipFuncAttributeMaxDynamicSharedMemorySize, LDS_BYTES) != hipSuccess) { fprintf(stderr, "kernel_launch: hipFuncSetAttribute failed\n"); grid = -1; return; }
        int per_cu = 0;
        if (hipOccupancyMaxActiveBlocksPerMultiprocessor(&per_cu, (const void*)fwd_kernel, NTHR, LDS_BYTES) != hipSuccess || per_cu < 1) { fprintf(stderr, "kernel_launch: occupancy query failed (%d)\n", per_cu); per_cu = 1; }
        (void)hipGetLastError();
        grid = cus;
    }
    if (grid < 0) return;
    (void)hipMemsetAsync((char*)d_ws + WS_CTL, 0, CTL_BYTES, stream);
    Args a{};
    for (int i = 0; i < 34; ++i) a.in[i] = (const float*)d_in[i];
    a.out = (float*)d_out; a.ws = (unsigned char*)d_ws;
#ifdef MULTI_LAUNCH
    for (int ph = 0; ph < NPHASE; ++ph) { a.ph_lo = ph; a.ph_hi = ph + 1; hipLaunchKernelGGL(fwd_kernel, dim3(grid), dim3(NTHR), LDS_BYTES, stream, a); }
#else
    a.ph_lo = 0; a.ph_hi = NPHASE;
    hipLaunchKernelGGL(fwd_kernel, dim3(grid), dim3(NTHR), LDS_BYTES, stream, a);
#endif
}
```

```cpp
#define PROBE_PH -1
#include <hip/hip_runtime.h>
#include <hip/hip_cooperative_groups.h>
#include <cstdio>
#include <cstdint>
namespace cg = cooperative_groups;

#define LAS __attribute__((address_space(3)))
typedef unsigned short bf16_t;
typedef short bf16x8 __attribute__((ext_vector_type(8)));
typedef float f32x4 __attribute__((ext_vector_type(4)));
typedef float f32x2 __attribute__((ext_vector_type(2)));
typedef unsigned u32x4 __attribute__((ext_vector_type(4)));
typedef unsigned u32x2 __attribute__((ext_vector_type(2)));
typedef LAS unsigned char* ldsp;

namespace pg8 {
#define PG8_LAS __attribute__((address_space(3)))
constexpr int BM = 256, BK = 64, HALF = 128, HTB = HALF * BK * 2, STAGE_BYTES = 8 * HTB, NXCD = 8, WGM = 8;
__host__ __device__ __forceinline__ int lds_byte(int r, int c) { const int st = (r >> 4) * 2 + (c >> 5), rr = r & 15, cc = c & 31, ob = rr * 64 + cc * 2; return st * 1024 + (ob ^ (((ob >> 9) & 1) << 5)); }
__host__ __device__ __forceinline__ void stage_rc(int b, int& R, int& C) { const int st = b / 1024, sb = b % 1024, swz = sb ^ (((sb >> 9) & 1) << 5); R = (st >> 1) * 16 + swz / 64; C = (st & 1) * 32 + (swz % 64) / 2; }
__host__ __device__ __forceinline__ int perm32(int rho) { const int n = rho >> 4, i = rho & 15; return 8 * (i >> 2) + 4 * n + (i & 3); }
struct Unit { int pm, pn; };
struct Gemm { const bf16_t* A; const bf16_t* Bt; int M, N, K, lda, ldb; };
struct StaticOrder {
    int nM, nN, nwg, G, c;
    __host__ __device__ void init(int M, int N, int G_, int c_) { nM = M / BM; nN = N / BM; nwg = nM * nN; G = G_; c = c_; }
    __host__ __device__ bool next(int i, Unit& u) const {
        const long L = (long)i * G + c; if (L >= nwg) return false;
        int wgid = (int)L; { const int q = nwg / NXCD, r = nwg % NXCD, xcd = wgid % NXCD, off = wgid / NXCD; wgid = (xcd < r ? xcd * (q + 1) : r * (q + 1) + (xcd - r) * q) + off; }
        const int nig = WGM * nN, gid = wgid / nig, fm = gid * WGM, gsz = (nM - fm) < WGM ? (nM - fm) : WGM;
        u.pm = fm + ((wgid % nig) % gsz); u.pn = (wgid % nig) / gsz; return true;
    }
    __device__ __forceinline__ void a_ready(const Unit&) const {}
    __device__ __forceinline__ void done(const Unit&) const {}
};
__device__ __forceinline__ unsigned cvt_pk_bf16(float lo, float hi) { unsigned r; asm volatile("v_cvt_pk_bf16_f32 %0, %1, %2" : "=v"(r) : "v"(lo), "v"(hi)); return r; }
struct EpiBf16Bias {
    static constexpr bool PERM = true, AFTER_DRAIN = false;
    bf16_t* O; int ldc; const float* bias;
    __device__ __forceinline__ void operator()(const f32x4 (&acc)[2][2][4][2], const Unit& u, int wr, int wc, int fr, int fq) const {
        const int row0 = u.pm * BM + wr * 64 + fr; const int col0 = u.pn * BM + wc * 32 + 8 * fq;
        f32x4 bv[2][2];
#pragma unroll
        for (int bj = 0; bj < 2; ++bj)
#pragma unroll
            for (int n = 0; n < 2; ++n) bv[bj][n] = *(const f32x4*)(bias + col0 + bj * HALF + 4 * n);
#pragma unroll
        for (int ai = 0; ai < 2; ++ai)
#pragma unroll
            for (int m = 0; m < 4; ++m) { bf16_t* rowp = O + (size_t)(row0 + ai * HALF + m * 16) * ldc + col0;
#pragma unroll
                for (int bj = 0; bj < 2; ++bj) { f32x4 v0 = acc[ai][bj][m][0] + bv[bj][0], v1 = acc[ai][bj][m][1] + bv[bj][1];
                    u32x4 w; w.x = cvt_pk_bf16(v0[0], v0[1]); w.y = cvt_pk_bf16(v0[2], v0[3]); w.z = cvt_pk_bf16(v1[0], v1[1]); w.w = cvt_pk_bf16(v1[2], v1[3]);
                    *(u32x4*)(rowp + bj * HALF) = w; } }
    }
};
struct EpiResF32 {
    static constexpr bool PERM = false, AFTER_DRAIN = false;
    const float* base; float* out; bf16_t* ob; int ldc;
    __device__ __forceinline__ void operator()(const f32x4 (&acc)[2][2][4][2], const Unit& u, int wr, int wc, int fr, int fq) const {
        const int row0 = u.pm * BM + wr * 64 + fr, col0 = u.pn * BM + wc * 32 + 4 * fq;
#pragma unroll
        for (int ai = 0; ai < 2; ++ai)
#pragma unroll
            for (int m = 0; m < 4; ++m) { const size_t off = (size_t)(row0 + ai * HALF + m * 16) * ldc + col0;
#pragma unroll
                for (int bj = 0; bj < 2; ++bj)
#pragma unroll
                    for (int n = 0; n < 2; ++n) { const f32x4 bs = *(const f32x4*)(base + off + bj * HALF + n * 16); const f32x4 o = bs + acc[ai][bj][m][n];
                        *(f32x4*)(out + off + bj * HALF + n * 16) = o;
                        u32x2 w; w.x = cvt_pk_bf16(o[0], o[1]); w.y = cvt_pk_bf16(o[2], o[3]); *(u32x2*)(ob + off + bj * HALF + n * 16) = w; }
                asm volatile("" ::: "memory"); }
    }
};
template <class Epi, class Sched, bool ALIGN_EPI = false, bool SP2 = false>
__device__ __forceinline__ void gemm_phase(PG8_LAS unsigned char* lds, const Gemm g, const Sched& S, const Epi& E) {
    const int tid = threadIdx.x, wid = __builtin_amdgcn_readfirstlane(tid >> 6), lane = tid & 63, wr = wid >> 2, wc = wid & 3, fr = lane & 15, fq = lane >> 4;
    const int K = g.K, nt = K / BK;
    unsigned voffA[2], voffB[2];
#pragma unroll
    for (int i = 0; i < 2; ++i) { int R, C; stage_rc(tid * 16 + i * 8192, R, C); const int Rb = Epi::PERM ? ((R & ~31) + perm32(R & 31)) : R;
        voffA[i] = (unsigned)(R * g.lda + C) * 2u; voffB[i] = (unsigned)(Rb * g.ldb + C) * 2u; }
    const size_t kstep = (size_t)(BK * 2);
    const size_t hstepA = (size_t)HALF * g.lda * 2, hstepB = (size_t)HALF * g.ldb * 2;
    const size_t tstepA = 2 * hstepA, tstepB = 2 * hstepB;
    const unsigned ldsw = (unsigned)wid * 1024u;
    const int aoff = lds_byte(wr * 64 + fr, fq * 8), boff = lds_byte(wc * 32 + fr, fq * 8);
#define PG8_SA(b, h) (((b) * 2 + (h)) * HTB)
#define PG8_SB(b, h) ((4 + (b) * 2 + (h)) * HTB)
#define PG8_STAGE(bufoff, gbase, voff) do { _Pragma("unroll") for (int _i = 0; _i < 2; ++_i) \
        __builtin_amdgcn_global_load_lds((const unsigned*)((const char*)(gbase) + (voff)[_i]), (PG8_LAS unsigned*)(lds + (bufoff) + ldsw + _i * 8192), 16, 0, 0); } while (0)
#define PG8_LDA(dst, b, h) do { _Pragma("unroll") for (int m = 0; m < 4; ++m) _Pragma("unroll") for (int k = 0; k < 2; ++k) dst[m][k] = *(const PG8_LAS bf16x8*)(lds + PG8_SA(b, h) + aoff + m * 2048 + k * 1024); } while (0)
#define PG8_LDB(dst, b, h) do { _Pragma("unroll") for (int n = 0; n < 2; ++n) _Pragma("unroll") for (int k = 0; k < 2; ++k) dst[n][k] = *(const PG8_LAS bf16x8*)(lds + PG8_SB(b, h) + boff + n * 2048 + k * 1024); } while (0)
#define PG8_MMA(ai, bj, At, Bt) do { __builtin_amdgcn_s_setprio(1); _Pragma("unroll") for (int m = 0; m < 4; ++m) _Pragma("unroll") for (int n = 0; n < 2; ++n) _Pragma("unroll") for (int k = 0; k < 2; ++k) \
        acc[ai][bj][m][n] = __builtin_amdgcn_mfma_f32_16x16x32_bf16(Bt[n][k], At[m][k], acc[ai][bj][m][n], 0, 0, 0); __builtin_amdgcn_s_setprio(0); } while (0)
#define PG8_WAIT_V(n) asm volatile("s_waitcnt vmcnt(" #n ")" ::: "memory")
#define PG8_WAIT_L(n) asm volatile("s_waitcnt lgkmcnt(" #n ")" ::: "memory")
#define PG8_BAR __builtin_amdgcn_s_barrier()
#define PG8_SCHED __builtin_amdgcn_sched_barrier(0)
    Unit cur, nxt; int ui = 0;
    if (!S.next(0, cur)) return;
    f32x4 acc[2][2][4][2];
#pragma unroll
    for (int a = 0; a < 2; ++a)
#pragma unroll
        for (int b = 0; b < 2; ++b)
#pragma unroll
            for (int m = 0; m < 4; ++m)
#pragma unroll
                for (int n = 0; n < 2; ++n) acc[a][b][m][n] = (f32x4){0.f, 0.f, 0.f, 0.f};
    bf16x8 At[4][2], B0[2][2], B1[2][2];
    const char* cA = (const char*)g.A + (size_t)cur.pm * tstepA; const char* cB = (const char*)g.Bt + (size_t)cur.pn * tstepB;
    S.a_ready(cur);
    if constexpr (SP2) {
        PG8_STAGE(PG8_SB(0, 0), cB, voffB); PG8_STAGE(PG8_SB(0, 1), cB + hstepB, voffB); PG8_STAGE(PG8_SA(0, 0), cA, voffA); PG8_STAGE(PG8_SA(0, 1), cA + hstepA, voffA);
        if (wr == 1) PG8_BAR;
        PG8_WAIT_V(2); PG8_BAR;
        PG8_STAGE(PG8_SB(1, 0), cB + kstep, voffB); PG8_STAGE(PG8_SA(1, 0), cA + kstep, voffA); PG8_STAGE(PG8_SB(1, 1), cB + hstepB + kstep, voffB);
        PG8_WAIT_V(6); PG8_BAR;
    } else {
        PG8_STAGE(PG8_SB(0, 0), cB, voffB); PG8_STAGE(PG8_SA(0, 0), cA, voffA); PG8_STAGE(PG8_SB(0, 1), cB + hstepB, voffB); PG8_STAGE(PG8_SA(0, 1), cA + hstepA, voffA);
        if (wr == 1) PG8_BAR;
        PG8_WAIT_V(4); PG8_BAR;
        PG8_STAGE(PG8_SB(1, 0), cB + kstep, voffB); PG8_STAGE(PG8_SA(1, 0), cA + kstep, voffA); PG8_STAGE(PG8_SB(1, 1), cB + hstepB + kstep, voffB);
        PG8_WAIT_V(6); PG8_BAR;
    }
    for (;;) {
        const bool has_next = S.next(ui + 1, nxt);
        const char* nA = has_next ? (const char*)g.A + (size_t)nxt.pm * tstepA : cA; const char* nB = has_next ? (const char*)g.Bt + (size_t)nxt.pn * tstepB : cB;
        for (int t = 0; t < nt; t += 2) {
            const bool last = (t == nt - 2);
            const char* a1 = cA + (size_t)(t + 1) * kstep;
            const char* a2 = last ? nA : cA + (size_t)(t + 2) * kstep; const char* b2 = last ? nB : cB + (size_t)(t + 2) * kstep;
            const char* a3 = a2 + kstep; const char* b3 = b2 + kstep;
            if (last && has_next) S.a_ready(nxt);
            if constexpr (SP2) {
            PG8_LDB(B0, 0, 0); PG8_LDB(B1, 0, 1); PG8_SCHED; PG8_LDA(At, 0, 0); PG8_STAGE(PG8_SA(1, 1), a1 + hstepA, voffA);
            PG8_WAIT_V(8); PG8_WAIT_L(0); PG8_BAR; PG8_MMA(0, 0, At, B0); PG8_MMA(0, 1, At, B1); PG8_BAR; PG8_SCHED;
            PG8_LDA(At, 0, 1); PG8_STAGE(PG8_SB(0, 0), b2, voffB); PG8_STAGE(PG8_SB(0, 1), b2 + hstepB, voffB); PG8_STAGE(PG8_SA(0, 0), a2, voffA);
            PG8_WAIT_V(8); PG8_WAIT_L(0); PG8_BAR; PG8_MMA(1, 0, At, B0); PG8_MMA(1, 1, At, B1); PG8_BAR; PG8_SCHED;
            PG8_LDB(B0, 1, 0); PG8_LDB(B1, 1, 1); PG8_SCHED; PG8_LDA(At, 1, 0); PG8_STAGE(PG8_SA(0, 1), a2 + hstepA, voffA);
            PG8_WAIT_V(8); PG8_WAIT_L(0); PG8_BAR; PG8_MMA(0, 0, At, B0); PG8_MMA(0, 1, At, B1); PG8_BAR; PG8_SCHED;
            PG8_LDA(At, 1, 1); PG8_STAGE(PG8_SB(1, 0), b3, voffB); PG8_STAGE(PG8_SB(1, 1), b3 + hstepB, voffB); PG8_STAGE(PG8_SA(1, 0), a3, voffA);
            PG8_WAIT_V(8); PG8_WAIT_L(0); PG8_BAR; PG8_MMA(1, 0, At, B0); PG8_MMA(1, 1, At, B1); PG8_BAR; PG8_SCHED;
            } else {
            PG8_LDB(B0, 0, 0); PG8_SCHED; PG8_LDA(At, 0, 0); PG8_STAGE(PG8_SA(1, 1), a1 + hstepA, voffA);
            PG8_WAIT_L(8); PG8_BAR; PG8_WAIT_L(0); PG8_MMA(0, 0, At, B0); PG8_BAR; PG8_SCHED;
            PG8_LDB(B1, 0, 1); PG8_STAGE(PG8_SB(0, 0), b2, voffB);
            PG8_BAR; PG8_WAIT_L(0); PG8_MMA(0, 1, At, B1); PG8_BAR;
            PG8_LDA(At, 0, 1); PG8_STAGE(PG8_SA(0, 0), a2, voffA);
            PG8_BAR; PG8_WAIT_L(0); PG8_MMA(1, 0, At, B0); PG8_BAR; PG8_SCHED;
            PG8_STAGE(PG8_SB(0, 1), b2 + hstepB, voffB);
            PG8_WAIT_V(6); PG8_BAR; PG8_MMA(1, 1, At, B1); PG8_BAR;
            PG8_LDB(B0, 1, 0); PG8_SCHED; PG8_LDA(At, 1, 0); PG8_STAGE(PG8_SA(0, 1), a2 + hstepA, voffA);
            PG8_WAIT_L(8); PG8_BAR; PG8_WAIT_L(0); PG8_MMA(0, 0, At, B0); PG8_BAR; PG8_SCHED;
            PG8_LDB(B1, 1, 1); PG8_STAGE(PG8_SB(1, 0), b3, voffB);
            PG8_BAR; PG8_WAIT_L(0); PG8_MMA(0, 1, At, B1); PG8_BAR;
            PG8_LDA(At, 1, 1); PG8_STAGE(PG8_SA(1, 0), a3, voffA);
            PG8_BAR; PG8_WAIT_L(0); PG8_MMA(1, 0, At, B0); PG8_BAR; PG8_SCHED;
            PG8_STAGE(PG8_SB(1, 1), b3 + hstepB, voffB);
            PG8_WAIT_V(6); PG8_BAR; PG8_MMA(1, 1, At, B1); PG8_BAR;
            }
        }
        if constexpr (ALIGN_EPI) { if (wr == 0) PG8_BAR; }
        if constexpr (!Epi::AFTER_DRAIN) { E(acc, cur, wr, wc, fr, fq); S.done(cur); }
        if (!has_next) break;
#pragma unroll
        for (int a = 0; a < 2; ++a)
#pragma unroll
            for (int b = 0; b < 2; ++b)
#pragma unroll
                for (int m = 0; m < 4; ++m)
#pragma unroll
                    for (int n = 0; n < 2; ++n) acc[a][b][m][n] = (f32x4){0.f, 0.f, 0.f, 0.f};
        cur = nxt; cA = nA; cB = nB; ++ui;
        if constexpr (ALIGN_EPI) { if (wr == 1) PG8_BAR; }
    }
    PG8_WAIT_V(0);
    if constexpr (!ALIGN_EPI) { if (wr == 0) PG8_BAR; }
    PG8_BAR;
    if constexpr (Epi::AFTER_DRAIN) { E.fused(acc, cur, wr, wc, fr, fq, lds, wid, lane); S.done(cur); }
#undef PG8_SA
#undef PG8_SB
#undef PG8_STAGE
#undef PG8_LDA
#undef PG8_LDB
#undef PG8_MMA
#undef PG8_WAIT_V
#undef PG8_WAIT_L
#undef PG8_BAR
#undef PG8_SCHED
}
}

constexpr int T_ = 16384, DM = 1024, NIN = 2432, NINP = 2560;
constexpr int C_Q = 256, C_K = 512, C_V = 640, C_BG = 768, C_CG = 1024, C_XIN = 1280, C_D = 1536;
constexpr int NWAVES = 8, NTHR = 512;
constexpr int LDS_BYTES = 163840;
constexpr size_t MiB = 1u << 20;
constexpr size_t WS_CTL = 0;
constexpr size_t CTL_BYTES = 131072;
constexpr int CNT_W0 = 8192;
constexpr size_t WS_MOD = 1 * MiB;
constexpr size_t WS_BIN = WS_MOD + 65536;
constexpr size_t WS_BGU = WS_BIN + 16384;
constexpr size_t WS_BR  = WS_BGU + 32768;
constexpr size_t WS_WRH = WS_BR + 1024;
constexpr size_t WS_WRL = WS_WRH + 98304;
constexpr size_t WS_W2T = WS_WRL + 98304;
constexpr size_t WS_A2T = WS_W2T + 16384;
constexpr size_t WS_G2T = WS_A2T + 16384;
constexpr size_t WS_V1T = WS_G2T + 32768;
constexpr size_t WS_V2T = WS_V1T + 16384;
constexpr size_t WS_PWT = WS_V2T + 16384;
constexpr size_t WS_RINV2 = WS_PWT + 32768;
static_assert(WS_RINV2 + 65536 <= 2 * MiB, "small region");
constexpr size_t WS_WIN = 2 * MiB;
constexpr size_t WS_WOUT = 7 * MiB;
constexpr size_t WS_WGU = 9 * MiB;
constexpr size_t WS_WD = 25 * MiB;
constexpr size_t WS_LIST = 33 * MiB;
constexpr size_t WS_WLIST = 35 * MiB;
constexpr size_t WS_VFIRST = 37 * MiB;
constexpr size_t WS_ACT = 45 * MiB;
constexpr size_t WS_P = 77 * MiB;
constexpr size_t WS_RW = 157 * MiB;
constexpr size_t RW_R = WS_RW, RW_K = WS_RW + 8 * MiB, RW_V = WS_RW + 16 * MiB, RW_KAP = WS_RW + 24 * MiB, RW_B = WS_RW + 32 * MiB, RW_G = WS_RW + 40 * MiB;
constexpr size_t RW_LD = WS_RW + 48 * MiB;
constexpr size_t RW_W1 = WS_RW + 56 * MiB, RW_U0T = WS_RW + 64 * MiB, RW_M = WS_RW + 72 * MiB, RW_N = WS_RW + 80 * MiB, RW_S0 = WS_RW + 88 * MiB;
constexpr size_t RW_BONUS = WS_RW + 96 * MiB;
constexpr size_t RW_MG = RW_BONUS + 256 * 1024, RW_NG = RW_MG + 512 * 1024, RW_SG = RW_NG + 512 * 1024;
constexpr size_t WS_END = WS_RW + 98 * MiB;
static_assert(WS_END <= 256 * MiB, "workspace");

struct Args { const float* in[34]; float* out; unsigned char* ws; int ph_lo, ph_hi; };

__device__ __forceinline__ unsigned f2bf(float f) { unsigned u = __builtin_bit_cast(unsigned, f); return (u + 0x7fffu + ((u >> 16) & 1u)) >> 16; }
__device__ __forceinline__ float bf2f(unsigned h) { return __builtin_bit_cast(float, h << 16); }
__device__ __forceinline__ unsigned pk2(float lo, float hi) { return f2bf(lo) | (f2bf(hi) << 16); }
__device__ __forceinline__ float bflo(unsigned w) { return __builtin_bit_cast(float, w << 16); }
__device__ __forceinline__ float bfhi(unsigned w) { return __builtin_bit_cast(float, w & 0xffff0000u); }
__device__ __forceinline__ float sigmoidf_(float x) { return 1.f / (1.f + __expf(-x)); }
__device__ __forceinline__ float wave_sum(float v) {
#pragma unroll
    for (int o = 1; o < 64; o <<= 1) v += __shfl_xor(v, o);
    return v;
}
#define LDS_WAIT() asm volatile("s_waitcnt lgkmcnt(0)" ::: "memory")
__device__ __forceinline__ int swz128(int r, int c) { return r * 128 + ((c ^ ((r >> 1) & 7)) << 4); }
__device__ __forceinline__ int swz256(int r, int c) { return r * 256 + ((c ^ (r & 15)) << 4); }
__device__ __forceinline__ int swz512(int r, int c) { return r * 512 + ((c ^ (r & 15)) << 4); }
__device__ __forceinline__ f32x4 mfma16(bf16x8 a, bf16x8 b, f32x4 c) { return __builtin_amdgcn_mfma_f32_16x16x32_bf16(a, b, c, 0, 0, 0); }

struct Frame {
    ldsp lds; int tid, lane, wave, G, bid;
    const float* const* in; float* out; unsigned char* ws;
};

__device__ __forceinline__ bool fresh(Frame& F) { int t = (int)__builtin_amdgcn_mbcnt_hi(~0u, __builtin_amdgcn_mbcnt_lo(~0u, 0u)) + 64 * F.wave; asm volatile("" : "+v"(t)); F.tid = t; F.lane = t & 63; return true; }
__device__ __forceinline__ void phase_mod(Frame& F) {
    const float* c = F.in[1]; const float* w_ada = F.in[2]; const float* b_ada = F.in[3];
    float* mod = (float*)(F.ws + WS_MOD);
    LAS float* red = (LAS float*)F.lds;
    for (int it = F.bid; it < 192; it += F.G) {
        const int l = it / 96, n0 = (it % 96) * 64;
        const float* W = w_ada + (size_t)l * DM * 6144 + n0 + F.lane;
        const int k0 = F.wave * 128;
        float acc = 0.f;
#pragma unroll 8
        for (int k = 0; k < 128; ++k) { const float cv = c[k0 + k]; const float s = cv / (1.f + __expf(-cv)); acc += s * W[(size_t)(k0 + k) * 6144]; }
        red[F.wave * 64 + F.lane] = acc;
        __syncthreads();
        if (F.wave == 0) { float s = b_ada[l * 6144 + n0 + F.lane];
#pragma unroll
            for (int w = 0; w < 8; ++w) s += red[w * 64 + F.lane];
            mod[l * 6144 + n0 + F.lane] = s; }
        __syncthreads();
    }
}

__device__ __forceinline__ float transpose_strip(const float* W, int N, int K, int kb, int kn, int n0, const float* rs_a, const float* rs_b, const float* cs, const float* sh,
                                                 bf16_t* dst, int dst_row0, LAS float* scr, int lane) {
    const int col = lane & 31, kp = lane >> 5;
    const float csv = cs ? cs[n0 + col] : 1.f;
    LAS float* scl = scr + 64 * 33;
    float bacc = 0.f;
#pragma unroll 1
    for (int k0 = kb; k0 < kb + kn; k0 += 64) {
        float wv[32];
#pragma unroll
        for (int i = 0; i < 32; ++i) wv[i] = W[(size_t)(k0 + 2 * i + kp) * N + n0 + col];
        scl[lane] = rs_a ? rs_a[k0 + lane] * (1.f + rs_b[k0 + lane]) : 1.f;
        scl[64 + lane] = sh ? sh[k0 + lane] : 0.f;
        LDS_WAIT();
#pragma unroll
        for (int i = 0; i < 32; ++i) { const int kk = 2 * i + kp; bacc += scl[64 + kk] * wv[i]; scr[kk * 33 + col] = wv[i] * csv * scl[kk]; }
        LDS_WAIT();
        const int c = lane & 7;
#pragma unroll
        for (int j = 0; j < 4; ++j) { const int n = (lane >> 3) + 8 * j; const LAS float* s = scr + (8 * c) * 33 + n;
            u32x4 o; o.x = pk2(s[0 * 33], s[1 * 33]); o.y = pk2(s[2 * 33], s[3 * 33]); o.z = pk2(s[4 * 33], s[5 * 33]); o.w = pk2(s[6 * 33], s[7 * 33]);
            *(u32x4*)(dst + (size_t)(dst_row0 + n) * K + k0 + 8 * c) = o; }
        LDS_WAIT();
    }
    bacc += __shfl_xor(bacc, 32);
    return bacc;
}
__device__ __forceinline__ void phase_prep(Frame& F, int l) {
    fresh(F);
    LAS float* scr = (LAS float*)(F.lds + F.wave * 16384);
    LAS float* red = (LAS float*)(F.lds + 131072);
    const float* mod = (const float*)(F.ws + WS_MOD) + l * 6144;
    const float *sh1 = mod, *sc1 = mod + 1024, *gt1 = mod + 2048, *sh2 = mod + 3072, *sc2 = mod + 4096, *gt2 = mod + 5120;
    const float* n1g = F.in[4] + l * DM; const float* n2g = F.in[5] + l * DM;
    const float* w_in = F.in[6] + (size_t)l * DM * NIN; const float* w_out = F.in[7] + (size_t)l * DM * DM;
    const float* wg = F.in[30] + (size_t)l * 32 * DM * 128; const float* wu = F.in[31] + (size_t)l * 32 * DM * 128; const float* wd = F.in[32] + (size_t)l * 32 * 128 * DM;
    bf16_t* WIN = (bf16_t*)(F.ws + WS_WIN); bf16_t* WOUT = (bf16_t*)(F.ws + WS_WOUT); bf16_t* WGU = (bf16_t*)(F.ws + WS_WGU); bf16_t* WD = (bf16_t*)(F.ws + WS_WD);
    float* bias_in = (float*)(F.ws + WS_BIN); float* bias_gu = (float*)(F.ws + WS_BGU); float* bias_r = (float*)(F.ws + WS_BR);
    constexpr int nA = 76, nB = 32, nC = 128, nD = 128, NFULL = nA + nB + nC + nD;
#pragma unroll 1
    for (int p = F.bid; p < NFULL / 2; p += F.G) {
        int r = 2 * p + (F.wave >> 2); const int q = F.wave & 3;
        const float* W; int N, n0, drow; const float *rsa = nullptr, *rsb = nullptr, *cs = nullptr, *sh = nullptr; float* bo = nullptr; bf16_t* dst;
        if (r < nA) { W = w_in; N = NIN; n0 = r * 32; rsa = n1g; rsb = sc1; sh = sh1; bo = bias_in + n0; dst = WIN; drow = n0; }
        else if (r < nA + nB) { r -= nA; W = w_out; N = DM; n0 = r * 32; cs = gt1; dst = WOUT; drow = n0; }
        else { r -= nA + nB; const int up = r >= nC ? 1 : 0; r -= up * nC; const int e = r >> 2, s = r & 3;
            W = (up ? wu : wg) + (size_t)e * DM * 128; N = 128; n0 = s * 32; rsa = n2g; rsb = sc2; sh = sh2; bo = bias_gu + e * 256 + up * 128 + s * 32; dst = WGU + (size_t)e * 256 * DM; drow = up * 128 + s * 32; }
        const float b = transpose_strip(W, N, DM, q * 256, 256, n0, rsa, rsb, cs, sh, dst, drow, scr, F.lane);
        if (F.lane < 32) red[F.wave * 32 + F.lane] = b;
        __syncthreads();
        if (q == 0 && F.lane < 32 && bo) bo[F.lane] = (red[F.wave * 32 + F.lane] + red[(F.wave + 1) * 32 + F.lane]) + (red[(F.wave + 2) * 32 + F.lane] + red[(F.wave + 3) * 32 + F.lane]);
        __syncthreads();
    }
    const int gw = F.bid * NWAVES + F.wave, NGW = F.G * NWAVES;
    constexpr int nE = 1024, nZ = 4, nF = 48, nG = 6, NIT = nE + nZ + nF + nG;
#pragma unroll 1
    for (int it = gw; it < NIT; it += NGW) {
        int r = it;
        if (r < nE) { const int e = r >> 5, s = r & 31; (void)transpose_strip(wd + (size_t)e * 128 * DM, DM, 128, 0, 128, s * 32, nullptr, nullptr, gt2, nullptr, WD + (size_t)e * DM * 128, s * 32, scr, F.lane); continue; } r -= nE;
        if (r < nZ) { const int rr = 76 + r; for (int i = F.lane; i < 32 * 128; i += 64) { const int n = i >> 7, c = i & 127; *(u32x4*)(WIN + (size_t)(rr * 32 + n) * DM + c * 8) = (u32x4){0u, 0u, 0u, 0u}; }
                      if (F.lane < 32) bias_in[rr * 32 + F.lane] = 0.f; continue; } r -= nZ;
        if (r < nF) {
            bf16_t* wh = (bf16_t*)(F.ws + WS_WRH) + r * DM; bf16_t* wl = (bf16_t*)(F.ws + WS_WRL) + r * DM;
            float bacc = 0.f;
            for (int k = F.lane; k < DM; k += 64) {
                float wv = 0.f;
                if (r < 4) wv = F.in[26][(size_t)l * DM * 4 + k * 4 + r]; else if (r < 36) wv = F.in[28][(size_t)l * DM * 32 + k * 32 + (r - 4)];
                bacc += sh2[k] * wv;
                const float v = wv * n2g[k] * (1.f + sc2[k]);
                const unsigned h = f2bf(v); const unsigned lo = f2bf(v - bf2f(h));
                wh[k] = (bf16_t)h; wl[k] = (bf16_t)lo; }
            bacc = wave_sum(bacc);
            if (F.lane == 0) { float b = 0.f; if (r < 4) b = F.in[27][l * 4 + r]; else if (r < 36) b = F.in[29][l * 32 + r - 4]; bias_r[r] = bacc + b; }
            continue; } r -= nF;
        if (r == 0) { const float* s = F.in[14] + l * 32 * 256; bf16_t* d = (bf16_t*)(F.ws + WS_W2T); for (int i = F.lane; i < 8192; i += 64) { const int n = i >> 5, k = i & 31; d[i] = (bf16_t)f2bf(s[k * 256 + n]); } }
        else if (r == 1) { const float* s = F.in[16] + l * 32 * 256; bf16_t* d = (bf16_t*)(F.ws + WS_A2T); for (int i = F.lane; i < 8192; i += 64) { const int n = i >> 5, k = i & 31; d[i] = (bf16_t)f2bf(s[k * 256 + n]); } }
        else if (r == 2) { const float* s = F.in[17] + l * 64 * 256; bf16_t* d = (bf16_t*)(F.ws + WS_G2T); for (int i = F.lane; i < 16384; i += 64) { const int n = i >> 6, k = i & 63; d[i] = (bf16_t)f2bf(s[k * 256 + n]); } }
        else if (r == 3) { if (l > 0) { const float* s = F.in[24] + (l - 1) * 256 * 32; bf16_t* d = (bf16_t*)(F.ws + WS_V1T); for (int i = F.lane; i < 8192; i += 64) { const int n = i >> 8, k = i & 255; d[i] = (bf16_t)f2bf(s[k * 32 + n]); } } }
        else if (r == 4) { if (l > 0) { const float* s = F.in[25] + (l - 1) * 32 * 256; bf16_t* d = (bf16_t*)(F.ws + WS_V2T); for (int i = F.lane; i < 8192; i += 64) { const int n = i >> 5, k = i & 31; d[i] = (bf16_t)f2bf(s[k * 256 + n]); } } }
        else { const float* s = F.in[8] + l * 4 * 64 * 64; bf16_t* d = (bf16_t*)(F.ws + WS_PWT); for (int i = F.lane; i < 16384; i += 64) { const int j = i >> 12, e = (i >> 6) & 63, c = i & 63; d[i] = (bf16_t)f2bf(s[(j * 64 + c) * 64 + e]); } }
    }
}

__device__ __forceinline__ void phase_rownorm(Frame& F, int mode) {
    const float* xin = (mode == 0) ? F.in[0] : F.out;
    const bf16_t* ys0 = (const bf16_t*)(F.ws + WS_P); const bf16_t* ys1 = ys0 + (size_t)T_ * DM;
    bf16_t* xn = (bf16_t*)(F.ws + WS_ACT);
    const float* fg = F.in[33];
    const int gw = F.bid * NWAVES + F.wave, NGW = F.G * NWAVES;
    for (int m = gw; m < T_; m += NGW) {
        const f32x4* xr = (const f32x4*)(xin + (size_t)m * DM) + F.lane;
        f32x4 v[4]; float s = 0.f;
#pragma unroll
        for (int j = 0; j < 4; ++j) v[j] = xr[64 * j];
        if (mode != 0) {
            const u32x2* a = (const u32x2*)(ys0 + (size_t)m * DM) + F.lane; const u32x2* b = (const u32x2*)(ys1 + (size_t)m * DM) + F.lane;
#pragma unroll
            for (int j = 0; j < 4; ++j) { const u32x2 ua = a[64 * j], ub = b[64 * j];
                v[j][0] += bflo(ua.x) + bflo(ub.x); v[j][1] += bfhi(ua.x) + bfhi(ub.x); v[j][2] += bflo(ua.y) + bflo(ub.y); v[j][3] += bfhi(ua.y) + bfhi(ub.y); }
        }
#pragma unroll
        for (int j = 0; j < 4; ++j) s += (v[j][0] * v[j][0] + v[j][1] * v[j][1]) + (v[j][2] * v[j][2] + v[j][3] * v[j][3]);
        const float rinv = 1.f / sqrtf(wave_sum(s) * (1.f / DM) + 1e-6f);
        if (mode == 2) {
            f32x4* o = (f32x4*)(F.out + (size_t)m * DM) + F.lane;
#pragma unroll
            for (int j = 0; j < 4; ++j) { const f32x4 g = *((const f32x4*)fg + F.lane + 64 * j); o[64 * j] = v[j] * rinv * g; }
        } else {
            if (mode == 1) { f32x4* o = (f32x4*)(F.out + (size_t)m * DM) + F.lane;
#pragma unroll
                for (int j = 0; j < 4; ++j) o[64 * j] = v[j]; }
            u32x2* o8 = (u32x2*)(xn + (size_t)m * DM) + F.lane;
#pragma unroll
            for (int j = 0; j < 4; ++j) { u32x2 w; w.x = pk2(v[j][0] * rinv, v[j][1] * rinv); w.y = pk2(v[j][2] * rinv, v[j][3] * rinv); o8[64 * j] = w; }
        }
    }
}

__device__ __forceinline__ void attn_item(Frame& F, int l, int item) {
    const int t0 = item * 128;
    const bf16_t* P = (const bf16_t*)(F.ws + WS_P);
    bf16_t* ycat = (bf16_t*)(F.ws + WS_ACT);
    ldsp Ks = F.lds, Vt = F.lds + 65536;
#pragma unroll 1
    for (int b = 0; b < 2; ++b) {
        u32x4 kq[4], vq[4];
#pragma unroll
        for (int q = 0; q < 4; ++q) { const int i = F.tid + (b * 4 + q) * NTHR; const int ko = i >> 4, kvh = (i >> 3) & 1, c = i & 7; const int s = t0 - 128 + ko; const int sc = s < 0 ? 0 : s;
            kq[q] = *(const u32x4*)(P + (size_t)sc * NINP + C_K + kvh * 64 + c * 8); vq[q] = *(const u32x4*)(P + (size_t)sc * NINP + C_V + kvh * 64 + c * 8); }
#pragma unroll
        for (int q = 0; q < 4; ++q) { const int i = F.tid + (b * 4 + q) * NTHR; const int ko = i >> 4, kvh = (i >> 3) & 1, c = i & 7; const int s = t0 - 128 + ko;
            const u32x4 z4 = (u32x4){0u, 0u, 0u, 0u}; const u32x4 kv = (s >= 0) ? kq[q] : z4, vv = (s >= 0) ? vq[q] : z4;
            *(LAS u32x4*)(Ks + kvh * 32768 + swz128(ko, c)) = kv;
            const int k32 = ko & 31, sg = ko >> 5, g = (k32 >> 2) & 3, j = ((k32 >> 4) << 2) | (k32 & 3), chunk = sg * 4 + g;
            const unsigned vw[4] = {vv.x, vv.y, vv.z, vv.w};
#pragma unroll
            for (int e = 0; e < 8; ++e) { const int d = c * 8 + e; const unsigned short val = (unsigned short)((e & 1) ? (vw[e >> 1] >> 16) : (vw[e >> 1] & 0xffffu));
                *(LAS unsigned short*)(Vt + kvh * 32768 + swz512(d, chunk) + j * 2) = val; } }
    }
    __syncthreads();
    const int h = F.wave >> 1, half = F.wave & 1, kvh = h >> 1, fr = F.lane & 15, g = F.lane >> 4;
    const float slope = exp2f(-2.f * (float)(h + 1));
    const float sink = F.in[10][l * 4 + h];
    ldsp Kh = Ks + kvh * 32768, Vh = Vt + kvh * 32768;
#pragma unroll 1
    for (int qt = 0; qt < 4; ++qt) {
        const int q_lo = 64 * half + 16 * qt, qo = q_lo + fr, tile0 = (q_lo >> 5) << 1;
        bf16x8 qf[2];
#pragma unroll
        for (int ks = 0; ks < 2; ++ks) qf[ks] = *(const bf16x8*)(P + (size_t)(t0 + qo) * NINP + C_Q + h * 64 + ks * 32 + g * 8);
        f32x4 s[10];
#pragma unroll
        for (int kt = 0; kt < 10; ++kt) { s[kt] = (f32x4){0.f, 0.f, 0.f, 0.f};
#pragma unroll
            for (int ks = 0; ks < 2; ++ks) { const bf16x8 a = *(const LAS bf16x8*)(Kh + swz128((tile0 + kt) * 16 + fr, ks * 4 + g)); s[kt] = mfma16(a, qf[ks], s[kt]); } }
        float m = sink;
#pragma unroll
        for (int kt = 0; kt < 10; ++kt)
#pragma unroll
            for (int j = 0; j < 4; ++j) { const int ko = 16 * (tile0 + kt) + 4 * g + j; const int dist = qo + 128 - ko;
                const bool valid = (dist >= 0) && (dist < 128) && (t0 - 128 + ko >= 0);
                const float v = valid ? s[kt][j] * 0.125f - slope * (float)dist : -INFINITY; s[kt][j] = v; m = fmaxf(m, v); }
        m = fmaxf(m, __shfl_xor(m, 16)); m = fmaxf(m, __shfl_xor(m, 32));
        float sum = 0.f;
#pragma unroll
        for (int kt = 0; kt < 10; ++kt)
#pragma unroll
            for (int j = 0; j < 4; ++j) { const float p = __expf(s[kt][j] - m); s[kt][j] = p; sum += p; }
        sum += __shfl_xor(sum, 16); sum += __shfl_xor(sum, 32);
        const float inv = 1.f / (sum + __expf(sink - m));
        f32x4 o[4];
#pragma unroll
        for (int dt = 0; dt < 4; ++dt) o[dt] = (f32x4){0.f, 0.f, 0.f, 0.f};
#pragma unroll
        for (int ss = 0; ss < 5; ++ss) {
            u32x4 pw; pw.x = pk2(s[2 * ss][0], s[2 * ss][1]); pw.y = pk2(s[2 * ss][2], s[2 * ss][3]); pw.z = pk2(s[2 * ss + 1][0], s[2 * ss + 1][1]); pw.w = pk2(s[2 * ss + 1][2], s[2 * ss + 1][3]);
            const bf16x8 pb = __builtin_bit_cast(bf16x8, pw);
#pragma unroll
            for (int dt = 0; dt < 4; ++dt) { const bf16x8 a = *(const LAS bf16x8*)(Vh + swz512(dt * 16 + fr, ((tile0 >> 1) + ss) * 4 + g)); o[dt] = mfma16(a, pb, o[dt]); }
        }
#pragma unroll
        for (int dt = 0; dt < 4; ++dt) { u32x2 w; w.x = pk2(o[dt][0] * inv, o[dt][1] * inv); w.y = pk2(o[dt][2] * inv, o[dt][3] * inv);
            *(u32x2*)(ycat + (size_t)(t0 + qo) * DM + 256 + h * 64 + dt * 16 + 4 * g) = w; }
    }
    __syncthreads();
}

__device__ __forceinline__ void poolconv_item(Frame& F, int l, int item) {
    const int t0 = item * 128;
    const bf16_t* P = (const bf16_t*)(F.ws + WS_P);
    bf16_t* ycat = (bf16_t*)(F.ws + WS_ACT);
    ldsp U = F.lds;
    ldsp Dt = F.lds + 73728;
    {   u32x4 uv[9];
#pragma unroll
        for (int q = 0; q < 9; ++q) { const int i = F.tid + q * NTHR; const int r = i >> 5, c = i & 31; const int s = t0 - 16 + r; uv[q] = *(const u32x4*)(P + (size_t)(s < 0 ? 0 : s) * NINP + c * 8); }
#pragma unroll
        for (int q = 0; q < 9; ++q) { const int i = F.tid + q * NTHR; const int r = i >> 5, c = i & 31; const int s = t0 - 16 + r;
            *(LAS u32x4*)(U + r * 512 + c * 16) = (s >= 0) ? uv[q] : (u32x4){0u, 0u, 0u, 0u}; } }
    __syncthreads();
    for (int i = F.tid; i < 128 * 32; i += NTHR) { const int tok = i >> 5, c8 = i & 31, j = c8 >> 3, w = 2 << j; const int t = t0 + tok;
        float acc[8];
#pragma unroll
        for (int e = 0; e < 8; ++e) acc[e] = 0.f;
        u32x4 cur = (u32x4){0u, 0u, 0u, 0u};
        for (int q = 0; q < w; ++q) { const u32x4 v = *(const LAS u32x4*)(U + (tok + 16 - q) * 512 + c8 * 16); if (q == 0) cur = v;
            acc[0] += bflo(v.x); acc[1] += bfhi(v.x); acc[2] += bflo(v.y); acc[3] += bfhi(v.y); acc[4] += bflo(v.z); acc[5] += bfhi(v.z); acc[6] += bflo(v.w); acc[7] += bfhi(v.w); }
        const float ic = 1.f / (float)((t + 1) < w ? (t + 1) : w);
        u32x4 o; o.x = pk2(acc[0] * ic - bflo(cur.x), acc[1] * ic - bfhi(cur.x)); o.y = pk2(acc[2] * ic - bflo(cur.y), acc[3] * ic - bfhi(cur.y));
        o.z = pk2(acc[4] * ic - bflo(cur.z), acc[5] * ic - bfhi(cur.z)); o.w = pk2(acc[6] * ic - bflo(cur.w), acc[7] * ic - bfhi(cur.w));
        *(LAS u32x4*)(Dt + j * 16384 + swz128(tok, c8 & 7)) = o; }
    __syncthreads();
    {
        const int j = F.wave >> 1, half = F.wave & 1, fr = F.lane & 15, g = F.lane >> 4;
        const bf16_t* pwt = (const bf16_t*)(F.ws + WS_PWT) + j * 4096;
        const float* psc = F.in[9] + l * 256 + j * 64;
        bf16x8 bfr[4][2];
#pragma unroll
        for (int n = 0; n < 4; ++n)
#pragma unroll
            for (int ks = 0; ks < 2; ++ks) bfr[n][ks] = *(const bf16x8*)(pwt + (16 * n + fr) * 64 + ks * 32 + g * 8);
#pragma unroll
        for (int m = 0; m < 4; ++m) {
            bf16x8 af[2];
#pragma unroll
            for (int ks = 0; ks < 2; ++ks) af[ks] = *(const LAS bf16x8*)(Dt + j * 16384 + swz128(64 * half + 16 * m + fr, ks * 4 + g));
#pragma unroll
            for (int n = 0; n < 4; ++n) { f32x4 acc = (f32x4){0.f, 0.f, 0.f, 0.f};
#pragma unroll
                for (int ks = 0; ks < 2; ++ks) acc = mfma16(bfr[n][ks], af[ks], acc);
                const f32x4 sc = *(const f32x4*)(psc + 16 * n + 4 * g);
                u32x2 w; w.x = pk2(acc[0] * sc[0], acc[1] * sc[1]); w.y = pk2(acc[2] * sc[2], acc[3] * sc[3]);
                *(u32x2*)(ycat + (size_t)(t0 + 64 * half + 16 * m + fr) * DM + j * 64 + 16 * n + 4 * g) = w; }
        }
    }
    const float* cw = F.in[11] + l * 3 * 256;
#pragma unroll 2
    for (int i = F.tid; i < 128 * 32; i += NTHR) { const int tok = i >> 5, c8 = i & 31; const int t = t0 + tok;
        u32x4 a[3], b[3];
#pragma unroll
        for (int q = 0; q < 3; ++q) { const int s = t - 2 + q; const int sc = s < 0 ? 0 : s; a[q] = *(const u32x4*)(P + (size_t)sc * NINP + C_CG + c8 * 8); b[q] = *(const u32x4*)(P + (size_t)sc * NINP + C_XIN + c8 * 8); }
        const u32x4 bg = *(const u32x4*)(P + (size_t)t * NINP + C_BG + c8 * 8);
        float acc[8];
#pragma unroll
        for (int e = 0; e < 8; ++e) acc[e] = 0.f;
#pragma unroll
        for (int q = 0; q < 3; ++q) { const int s = t - 2 + q; const float m = (s >= 0) ? 1.f : 0.f;
            const f32x4 w0 = *(const f32x4*)(cw + q * 256 + c8 * 8) * m, w1 = *(const f32x4*)(cw + q * 256 + c8 * 8 + 4) * m;
            acc[0] += w0[0] * bflo(a[q].x) * bflo(b[q].x); acc[1] += w0[1] * bfhi(a[q].x) * bfhi(b[q].x); acc[2] += w0[2] * bflo(a[q].y) * bflo(b[q].y); acc[3] += w0[3] * bfhi(a[q].y) * bfhi(b[q].y);
            acc[4] += w1[0] * bflo(a[q].z) * bflo(b[q].z); acc[5] += w1[1] * bfhi(a[q].z) * bfhi(b[q].z); acc[6] += w1[2] * bflo(a[q].w) * bflo(b[q].w); acc[7] += w1[3] * bfhi(a[q].w) * bfhi(b[q].w); }
        u32x4 o; o.x = pk2(acc[0] * bflo(bg.x), acc[1] * bfhi(bg.x)); o.y = pk2(acc[2] * bflo(bg.y), acc[3] * bfhi(bg.y));
        o.z = pk2(acc[4] * bflo(bg.z), acc[5] * bfhi(bg.z)); o.w = pk2(acc[6] * bflo(bg.w), acc[7] * bfhi(bg.w));
        *(u32x4*)(ycat + (size_t)t * DM + 512 + c8 * 8) = o; }
    __syncthreads();
}

__device__ __forceinline__ f32x4 up4_(u32x2 w) { return (f32x4){bflo(w.x), bfhi(w.x), bflo(w.y), bfhi(w.y)}; }
__device__ __forceinline__ u32x2 pk4_(f32x4 v) { u32x2 w; w.x = pk2(v[0], v[1]); w.y = pk2(v[2], v[3]); return w; }
__device__ __forceinline__ u32x4 lerp8(u32x4 cur, u32x4 prv, const float* mu, int act) {
    const unsigned cw[4] = {cur.x, cur.y, cur.z, cur.w}, pw[4] = {prv.x, prv.y, prv.z, prv.w}; float z[8];
#pragma unroll
    for (int e = 0; e < 8; ++e) { const float c = (e & 1) ? bfhi(cw[e >> 1]) : bflo(cw[e >> 1]), p = (e & 1) ? bfhi(pw[e >> 1]) : bflo(pw[e >> 1]);
        float v = c + (p - c) * mu[e]; if (act == 1) v = tanhf(v); else if (act == 2) v = sigmoidf_(v); z[e] = v; }
    u32x4 o; o.x = pk2(z[0], z[1]); o.y = pk2(z[2], z[3]); o.z = pk2(z[4], z[5]); o.w = pk2(z[6], z[7]); return o;
}
__device__ __forceinline__ void rwkvprep_item(Frame& F, int l, int item) {
    const int t0 = item * 64;
    const bf16_t* P = (const bf16_t*)(F.ws + WS_P);
    const float* mu = F.in[12] + l * 896;
    ldsp Zw = F.lds, Za = F.lds + 4096, Zg = F.lds + 8192, Zr = F.lds + 16384, Zk = F.lds + 49152, Zv = F.lds + 81920, V1 = F.lds + 114688 + F.wave * 1024;
#pragma unroll 1
    for (int b = 0; b < 2; ++b) {
        u32x4 cu[6], pv[6];
#pragma unroll
        for (int q = 0; q < 6; ++q) { const int i = F.tid + (b * 6 + q) * NTHR; const int tok = i / 96, c = i - tok * 96; const int t = t0 + tok;
            cu[q] = *(const u32x4*)(P + (size_t)t * NINP + C_D + c * 8); pv[q] = *(const u32x4*)(P + (size_t)(t > 0 ? t - 1 : 0) * NINP + C_D + c * 8); }
#pragma unroll
        for (int q = 0; q < 6; ++q) { const int i = F.tid + (b * 6 + q) * NTHR; const int tok = i / 96, c = i - tok * 96; const int t = t0 + tok;
            const u32x4 prv = (t > 0) ? pv[q] : (u32x4){0u, 0u, 0u, 0u};
            const u32x4 z = lerp8(cu[q], prv, mu + c * 8, 0);
            *(LAS u32x4*)(F.lds + 16384 + (c >> 5) * 32768 + swz512(tok, c & 31)) = z; }
    }
    {   u32x4 cu[2], pv[2];
#pragma unroll
        for (int q = 0; q < 2; ++q) { const int i = F.tid + q * NTHR; const int tok = i >> 4, c = i & 15; const int t = t0 + tok;
            cu[q] = *(const u32x4*)(P + (size_t)t * NINP + C_D + 768 + c * 8); pv[q] = *(const u32x4*)(P + (size_t)(t > 0 ? t - 1 : 0) * NINP + C_D + 768 + c * 8); }
#pragma unroll
        for (int q = 0; q < 2; ++q) { const int i = F.tid + q * NTHR; const int tok = i >> 4, c = i & 15; const int t = t0 + tok;
            const u32x4 prv = (t > 0) ? pv[q] : (u32x4){0u, 0u, 0u, 0u};
            if (c < 4) *(LAS u32x4*)(Zw + tok * 64 + c * 16) = lerp8(cu[q], prv, mu + 768 + c * 8, 1);
            else if (c < 8) *(LAS u32x4*)(Za + tok * 64 + (c - 4) * 16) = lerp8(cu[q], prv, mu + 768 + c * 8, 0);
            else *(LAS u32x4*)(Zg + swz128(tok, c - 8)) = lerp8(cu[q], prv, mu + 768 + c * 8, 2); }
    }
    __syncthreads();
    const int h = F.wave >> 1, half = F.wave & 1, fr = F.lane & 15, g = F.lane >> 4;
    const bf16_t* w2t = (const bf16_t*)(F.ws + WS_W2T); const bf16_t* a2t = (const bf16_t*)(F.ws + WS_A2T); const bf16_t* g2t = (const bf16_t*)(F.ws + WS_G2T);
    const bf16_t* v1t = (const bf16_t*)(F.ws + WS_V1T); const bf16_t* v2t = (const bf16_t*)(F.ws + WS_V2T);
    const float *w0 = F.in[13] + l * 256, *a0 = F.in[15] + l * 256, *kkp = F.in[18] + l * 256, *kap = F.in[19] + l * 256, *rkp = F.in[20] + l * 256;
    const float* v0 = (l > 0) ? F.in[23] + (l - 1) * 256 : nullptr;
    bf16_t *Rr = (bf16_t*)(F.ws + RW_R), *Rk = (bf16_t*)(F.ws + RW_K), *Rv = (bf16_t*)(F.ws + RW_V), *Rkap = (bf16_t*)(F.ws + RW_KAP), *Rb = (bf16_t*)(F.ws + RW_B), *Rg = (bf16_t*)(F.ws + RW_G);
    bf16_t* Rld = (bf16_t*)(F.ws + RW_LD); float* Rbon = (float*)(F.ws + RW_BONUS); bf16_t* VF = (bf16_t*)(F.ws + WS_VFIRST);
#pragma unroll 1
    for (int m = 0; m < 2; ++m) {
        asm volatile("" ::: "memory");
        const int row = 32 * half + 16 * m + fr;
        const bf16x8 aw = *(const LAS bf16x8*)(Zw + row * 64 + g * 16), aa = *(const LAS bf16x8*)(Za + row * 64 + g * 16);
        const bf16x8 ag0 = *(const LAS bf16x8*)(Zg + swz128(row, g)), ag1 = *(const LAS bf16x8*)(Zg + swz128(row, 4 + g));
        bf16x8 a1 = aw;
        if (l > 0) {
            f32x4 t1[2]; t1[0] = (f32x4){0.f, 0.f, 0.f, 0.f}; t1[1] = t1[0];
#pragma unroll
            for (int ks = 0; ks < 8; ++ks) { const bf16x8 av_ = *(const LAS bf16x8*)(Zv + swz512(row, ks * 4 + g));
#pragma unroll
                for (int n = 0; n < 2; ++n) t1[n] = mfma16(*(const bf16x8*)(v1t + (16 * n + fr) * 256 + ks * 32 + g * 8), av_, t1[n]); }
#pragma unroll
            for (int n = 0; n < 2; ++n) { u32x2 w; w.x = pk2(t1[n][0], t1[n][1]); w.y = pk2(t1[n][2], t1[n][3]); *(LAS u32x2*)(V1 + fr * 64 + (16 * n + 4 * g) * 2) = w; }
            LDS_WAIT();
            a1 = *(const LAS bf16x8*)(V1 + fr * 64 + g * 16);
            LDS_WAIT();
        }
        const int t = t0 + row;
        float ss = 0.f;
#pragma unroll
        for (int n = 0; n < 4; ++n) { const int ch = 64 * h + 16 * n + 4 * g;
            const f32x4 kz = up4_(*(const LAS u32x2*)(Zk + swz512(row, ch >> 3) + (g & 1) * 8)), kkv = *(const f32x4*)(kkp + ch);
#pragma unroll
            for (int j = 0; j < 4; ++j) { const float kk = kz[j] * kkv[j]; ss += kk * kk; } }
        ss += __shfl_xor(ss, 16); ss += __shfl_xor(ss, 32);
        const float inn = 1.f / fmaxf(sqrtf(ss), 1e-12f);
        float bon = 0.f;
#pragma unroll 2
        for (int n = 0; n < 4; ++n) { const int ch = 64 * h + 16 * n + 4 * g;
            const int nr = 64 * h + 16 * n + fr; const f32x4 z0 = (f32x4){0.f, 0.f, 0.f, 0.f};
            const f32x4 wl = mfma16(*(const bf16x8*)(w2t + nr * 32 + g * 8), aw, z0);
            const f32x4 al = mfma16(*(const bf16x8*)(a2t + nr * 32 + g * 8), aa, z0);
            f32x4 gl = mfma16(*(const bf16x8*)(g2t + nr * 64 + g * 8), ag0, z0); gl = mfma16(*(const bf16x8*)(g2t + nr * 64 + 32 + g * 8), ag1, gl);
            f32x4 vl = z0; if (l > 0) vl = mfma16(*(const bf16x8*)(v2t + nr * 32 + g * 8), a1, z0);
            const int zo = swz512(row, ch >> 3) + (g & 1) * 8;
            const f32x4 rz = up4_(*(const LAS u32x2*)(Zr + zo)), kz = up4_(*(const LAS u32x2*)(Zk + zo)), vz = up4_(*(const LAS u32x2*)(Zv + zo));
            u32x2 vf = (u32x2){0u, 0u}; if (l > 0) vf = *(const u32x2*)(VF + (size_t)t * 256 + ch);
            const f32x4 vfv = up4_(vf);
            const f32x4 w0v = *(const f32x4*)(w0 + ch), a0v = *(const f32x4*)(a0 + ch), kkv = *(const f32x4*)(kkp + ch), kav = *(const f32x4*)(kap + ch), rkv = *(const f32x4*)(rkp + ch);
            f32x4 v0v = z0; if (l > 0) v0v = *(const f32x4*)(v0 + ch);
            f32x4 vout, ldv, kmod, kp_, b_;
#pragma unroll
            for (int j = 0; j < 4; ++j) {
                const float r_ = rz[j], k_ = kz[j], v_ = vz[j];
                const float wpre = w0v[j] + wl[j]; const float y = -wpre; const float sp = fmaxf(y, 0.f) + log1pf(__expf(-fabsf(y)));
                const float w = -sp - 0.5f; ldv[j] = -__expf(w);
                const float a = sigmoidf_(a0v[j] + al[j]);
                float vv = v_; if (l > 0) vv = v_ + (vfv[j] - v_) * sigmoidf_(v0v[j] + vl[j]);
                vout[j] = vv;
                kp_[j] = k_ * kkv[j] * inn; b_[j] = kp_[j] * a;
                const float km = k_ * (1.f + (a - 1.f) * kav[j]); kmod[j] = km; bon += r_ * km * rkv[j]; }
            const size_t o = (size_t)t * 256 + ch;
            *(u32x2*)(Rr + o) = *(const LAS u32x2*)(Zr + zo); *(u32x2*)(Rk + o) = pk4_(kmod);
            { const u32x2 w = pk4_(vout); *(u32x2*)(Rv + o) = w; if (l == 0) *(u32x2*)(VF + o) = w; }
            *(u32x2*)(Rg + o) = pk4_(gl); *(u32x2*)(Rld + o) = pk4_(ldv);
            *(u32x2*)(Rkap + o) = pk4_(kp_); *(u32x2*)(Rb + o) = pk4_(b_);
        }
        bon += __shfl_xor(bon, 16); bon += __shfl_xor(bon, 32);
        if (g == 0) Rbon[(size_t)t * 4 + h] = bon;
    }
    __syncthreads();
}

__device__ __forceinline__ void mm_n(ldsp X, ldsp Y, int rb, int cb, int fr, int g, f32x4 (&acc)[2]) {
#pragma unroll
    for (int ks = 0; ks < 2; ++ks) { const bf16x8 xf = *(const LAS bf16x8*)(X + swz128(16 * rb + fr, ks * 4 + g));
#pragma unroll
        for (int n = 0; n < 2; ++n) { const bf16x8 yf = *(const LAS bf16x8*)(Y + swz128(32 * cb + 16 * n + fr, ks * 4 + g)); acc[n] = mfma16(yf, xf, acc[n]); } }
}
__device__ __forceinline__ void mm_t(ldsp X, ldsp Y, int rb, int cb, int fr, int g, f32x4 (&acc)[2]) {
#pragma unroll
    for (int ks = 0; ks < 2; ++ks) { const bf16x8 xf = *(const LAS bf16x8*)(X + swz128(16 * rb + fr, ks * 4 + g));
#pragma unroll
        for (int n = 0; n < 2; ++n) { const bf16x8 yf = *(const LAS bf16x8*)(Y + swz128(32 * cb + 16 * n + fr, ks * 4 + g)); acc[n] = mfma16(xf, yf, acc[n]); } }
}
__device__ __forceinline__ int adr_n(int rb, int cb, int n, int fr, int g) { return swz128(16 * rb + fr, 4 * cb + 2 * n + (g >> 1)) + (g & 1) * 8; }
__device__ __forceinline__ int adr_t(int rb, int cb, int n, int fr, int g) { return swz128(32 * cb + 16 * n + fr, 2 * rb + (g >> 1)) + (g & 1) * 8; }
__device__ __forceinline__ u32x2 pk4(f32x4 v) { u32x2 w; w.x = pk2(v[0], v[1]); w.y = pk2(v[2], v[3]); return w; }
__device__ __forceinline__ f32x4 up4(u32x2 w) { return (f32x4){bflo(w.x), bfhi(w.x), bflo(w.y), bfhi(w.y)}; }

__device__ __forceinline__ void chunk_prefix(Frame& F, const bf16_t* Rld, int t0, int h, LAS float* Lc, LAS float* seg) {
    { const int t = F.tid >> 3, c8 = F.tid & 7; const u32x4 v = *(const u32x4*)(Rld + (size_t)(t0 + t) * 256 + h * 64 + c8 * 8);
      LAS float* d = Lc + t * 64 + c8 * 8; d[0] = bflo(v.x); d[1] = bfhi(v.x); d[2] = bflo(v.y); d[3] = bfhi(v.y); d[4] = bflo(v.z); d[5] = bfhi(v.z); d[6] = bflo(v.w); d[7] = bfhi(v.w); }
    __syncthreads();
    { float s = 0.f;
#pragma unroll
      for (int i = 0; i < 8; ++i) { s += Lc[(8 * F.wave + i) * 64 + F.lane]; Lc[(8 * F.wave + i) * 64 + F.lane] = s; }
      seg[F.wave * 64 + F.lane] = s; }
    __syncthreads();
    { float off = 0.f;
      for (int w = 0; w < F.wave; ++w) off += seg[w * 64 + F.lane];
#pragma unroll
      for (int i = 0; i < 8; ++i) Lc[(8 * F.wave + i) * 64 + F.lane] += off; }
    __syncthreads();
}
__device__ __forceinline__ void unpack8(u32x4 v, float (&o)[8]) { o[0] = bflo(v.x); o[1] = bfhi(v.x); o[2] = bflo(v.y); o[3] = bfhi(v.y); o[4] = bflo(v.z); o[5] = bfhi(v.z); o[6] = bflo(v.w); o[7] = bfhi(v.w); }
__device__ __forceinline__ u32x4 pack8(const float (&o)[8]) { u32x4 w; w.x = pk2(o[0], o[1]); w.y = pk2(o[2], o[3]); w.z = pk2(o[4], o[5]); w.w = pk2(o[6], o[7]); return w; }
__device__ __forceinline__ void st_tr8(ldsp tile, int t, int c8, const float (&o)[8]) {
#pragma unroll
    for (int e = 0; e < 8; ++e) *(LAS unsigned short*)(tile + swz128(c8 * 8 + e, t >> 3) + (t & 7) * 2) = (unsigned short)f2bf(o[e]);
}

constexpr int R1_LC = 0, R1_SEG = 16384, R1_GC = 18432, R1_KQ = 20480, R1_BK = 28672, R1_KK = 36864, R1_KABS = 45056, R1_KABST = 53248, R1_BHT = 61440, R1_KHT = 69632, R1_VT = 77824,
              R1_E = 86016  , R1_Q = 102400  , R1_QT = 118784  , R1_AAK = 135168, R1_AVT = R1_Q, R1_W1T = R1_Q + 8192, R1_U0T = R1_QT;
__device__ __forceinline__ void rwkv_r1_item(Frame& F, int item) {
    const int c = item >> 2, h = item & 3, t0 = c * 64;
    const bf16_t *Rk = (const bf16_t*)(F.ws + RW_K), *Rv = (const bf16_t*)(F.ws + RW_V), *Rkap = (const bf16_t*)(F.ws + RW_KAP), *Rb = (const bf16_t*)(F.ws + RW_B), *Rld = (const bf16_t*)(F.ws + RW_LD);
    bf16_t *GW1 = (bf16_t*)(F.ws + RW_W1) + (size_t)item * 4096, *GU0T = (bf16_t*)(F.ws + RW_U0T) + (size_t)item * 4096, *GM = (bf16_t*)(F.ws + RW_M) + (size_t)item * 4096, *GN = (bf16_t*)(F.ws + RW_N) + (size_t)item * 4096;
    ldsp lds = F.lds; LAS float* Lc = (LAS float*)(lds + R1_LC); LAS float* seg = (LAS float*)(lds + R1_SEG); LAS float* GC = (LAS float*)(lds + R1_GC);
    const int rb = F.wave >> 1, cb = F.wave & 1, fr = F.lane & 15, g = F.lane >> 4;
    chunk_prefix(F, Rld, t0, h, Lc, seg);
    {   const int t = F.tid >> 3, c8 = F.tid & 7; const size_t go = (size_t)(t0 + t) * 256 + h * 64 + c8 * 8;
        float kap[8], b[8], k[8], v[8], o1[8], o2[8];
        unpack8(*(const u32x4*)(Rkap + go), kap); unpack8(*(const u32x4*)(Rb + go), b); unpack8(*(const u32x4*)(Rk + go), k); unpack8(*(const u32x4*)(Rv + go), v);
        float L[8], Lp[8], Lm[8], LC[8];
#pragma unroll
        for (int e = 0; e < 8; ++e) { const int cc = c8 * 8 + e; L[e] = Lc[t * 64 + cc]; Lp[e] = (t > 0) ? Lc[(t - 1) * 64 + cc] : 0.f; Lm[e] = Lc[31 * 64 + cc]; LC[e] = Lc[63 * 64 + cc]; }
#pragma unroll
        for (int e = 0; e < 8; ++e) o1[e] = kap[e] * __expf(Lp[e] - Lm[e]);
        *(LAS u32x4*)(lds + R1_KQ + swz128(t, c8)) = pack8(o1);
#pragma unroll
        for (int e = 0; e < 8; ++e) o1[e] = kap[e] * __expf(Lp[e]);
        *(LAS u32x4*)(lds + R1_KABS + swz128(t, c8)) = pack8(o1); st_tr8(lds + R1_KABST, t, c8, o1);
#pragma unroll
        for (int e = 0; e < 8; ++e) { const float s = __expf(Lm[e] - L[e]); o1[e] = b[e] * s; o2[e] = k[e] * s; }
        *(LAS u32x4*)(lds + R1_BK + swz128(t, c8)) = pack8(o1); *(LAS u32x4*)(lds + R1_KK + swz128(t, c8)) = pack8(o2);
#pragma unroll
        for (int e = 0; e < 8; ++e) { const float s = __expf(LC[e] - L[e]); o1[e] = b[e] * s; o2[e] = k[e] * s; }
        st_tr8(lds + R1_BHT, t, c8, o1); st_tr8(lds + R1_KHT, t, c8, o2); st_tr8(lds + R1_VT, t, c8, v);
        if (t == 63) {
#pragma unroll
            for (int e = 0; e < 8; ++e) GC[c8 * 8 + e] = __expf(LC[e]); }
    }
    __syncthreads();
    {
        f32x4 a[2] = {(f32x4){0.f, 0.f, 0.f, 0.f}, (f32x4){0.f, 0.f, 0.f, 0.f}}, at[2] = {a[0], a[0]}, k2[2] = {a[0], a[0]};
        mm_n(lds + R1_KQ, lds + R1_BK, rb, cb, fr, g, a); mm_t(lds + R1_KQ, lds + R1_BK, rb, cb, fr, g, at); mm_n(lds + R1_KQ, lds + R1_KK, rb, cb, fr, g, k2);
#pragma unroll
        for (int n = 0; n < 2; ++n) {
            f32x4 m1, m2, m3;
#pragma unroll
            for (int j = 0; j < 4; ++j) { const int tn = 16 * rb + fr, sn = 32 * cb + 16 * n + 4 * g + j; m1[j] = (sn < tn) ? a[n][j] : 0.f; m3[j] = (sn < tn) ? k2[n][j] : 0.f;
                const int tt = 16 * rb + 4 * g + j, st = 32 * cb + 16 * n + fr; m2[j] = (st < tt) ? at[n][j] : 0.f; }
            *(LAS u32x2*)(lds + R1_Q + adr_n(rb, cb, n, fr, g)) = pk4(m1); *(LAS u32x2*)(lds + R1_E + adr_n(rb, cb, n, fr, g)) = pk4(-m1);
            *(LAS u32x2*)(lds + R1_QT + adr_t(rb, cb, n, fr, g)) = pk4(m2); *(LAS u32x2*)(lds + R1_AAK + adr_n(rb, cb, n, fr, g)) = pk4(m3); }
    }
    __syncthreads();
    {
        f32x4 a[2] = {(f32x4){0.f, 0.f, 0.f, 0.f}, (f32x4){0.f, 0.f, 0.f, 0.f}}, at[2] = {a[0], a[0]};
        mm_n(lds + R1_Q, lds + R1_QT, rb, cb, fr, g, a); mm_t(lds + R1_Q, lds + R1_QT, rb, cb, fr, g, at);
#pragma unroll
        for (int n = 0; n < 2; ++n) { *(LAS u32x2*)(lds + R1_Q + 8192 + adr_n(rb, cb, n, fr, g)) = pk4(a[n]); *(LAS u32x2*)(lds + R1_QT + 8192 + adr_t(rb, cb, n, fr, g)) = pk4(at[n]); }
    }
    __syncthreads();
#pragma unroll 1
    for (int it = 0; it < 5; ++it) {
        ldsp Ecur = lds + R1_E + (it & 1) * 8192, Enew = lds + R1_E + ((it + 1) & 1) * 8192;
        ldsp Qcur = lds + R1_Q + ((it + 1) & 1) * 8192, Qnew = lds + R1_Q + (it & 1) * 8192, QTcur = lds + R1_QT + ((it + 1) & 1) * 8192, QTnew = lds + R1_QT + (it & 1) * 8192;
        f32x4 e[2];
#pragma unroll
        for (int n = 0; n < 2; ++n) e[n] = up4(*(const LAS u32x2*)(Ecur + adr_n(rb, cb, n, fr, g))) + up4(*(const LAS u32x2*)(Qcur + adr_n(rb, cb, n, fr, g)));
        mm_n(Ecur, QTcur, rb, cb, fr, g, e);
#pragma unroll
        for (int n = 0; n < 2; ++n) *(LAS u32x2*)(Enew + adr_n(rb, cb, n, fr, g)) = pk4(e[n]);
        if (it < 4) {
            f32x4 a[2] = {(f32x4){0.f, 0.f, 0.f, 0.f}, (f32x4){0.f, 0.f, 0.f, 0.f}}, at[2] = {a[0], a[0]};
            mm_n(Qcur, QTcur, rb, cb, fr, g, a); mm_t(Qcur, QTcur, rb, cb, fr, g, at);
#pragma unroll
            for (int n = 0; n < 2; ++n) { *(LAS u32x2*)(Qnew + adr_n(rb, cb, n, fr, g)) = pk4(a[n]); *(LAS u32x2*)(QTnew + adr_t(rb, cb, n, fr, g)) = pk4(at[n]); }
        }
        __syncthreads();
    }
    ldsp Ef = lds + R1_E + 8192;
    f32x4 avn[2];
    {
        avn[0] = (f32x4){0.f, 0.f, 0.f, 0.f}; avn[1] = avn[0]; f32x4 avt[2] = {avn[0], avn[0]};
        mm_n(lds + R1_AAK, lds + R1_VT, rb, cb, fr, g, avn); mm_t(lds + R1_AAK, lds + R1_VT, rb, cb, fr, g, avt);
        f32x4 w[2], wt[2];
#pragma unroll
        for (int n = 0; n < 2; ++n) { w[n] = up4(*(const LAS u32x2*)(lds + R1_KABS + adr_n(rb, cb, n, fr, g))); wt[n] = up4(*(const LAS u32x2*)(lds + R1_KABST + adr_t(rb, cb, n, fr, g))); }
        mm_n(Ef, lds + R1_KABST, rb, cb, fr, g, w); mm_t(Ef, lds + R1_KABST, rb, cb, fr, g, wt);
#pragma unroll
        for (int n = 0; n < 2; ++n) { *(LAS u32x2*)(lds + R1_AVT + adr_t(rb, cb, n, fr, g)) = pk4(avt[n]); *(LAS u32x2*)(lds + R1_W1T + adr_t(rb, cb, n, fr, g)) = pk4(wt[n]);
            *(u32x2*)(GW1 + (16 * rb + fr) * 64 + 32 * cb + 16 * n + 4 * g) = pk4(w[n]); }
    }
    __syncthreads();
    {
        f32x4 ut[2];
#pragma unroll
        for (int n = 0; n < 2; ++n) ut[n] = up4(*(const LAS u32x2*)(lds + R1_AVT + adr_t(rb, cb, n, fr, g)));
        mm_t(Ef, lds + R1_AVT, rb, cb, fr, g, ut);
        (void)avn;
#pragma unroll
        for (int n = 0; n < 2; ++n) { *(LAS u32x2*)(lds + R1_U0T + adr_t(rb, cb, n, fr, g)) = pk4(ut[n]); *(u32x2*)(GU0T + (32 * cb + 16 * n + fr) * 64 + 16 * rb + 4 * g) = pk4(ut[n]); }
    }
    __syncthreads();
    {
        f32x4 m[2] = {(f32x4){0.f, 0.f, 0.f, 0.f}, (f32x4){0.f, 0.f, 0.f, 0.f}}, n1[2] = {m[0], m[0]}, n2[2] = {m[0], m[0]};
        mm_n(lds + R1_BHT, lds + R1_W1T, rb, cb, fr, g, m); mm_t(lds + R1_KHT, lds + R1_VT, rb, cb, fr, g, n1); mm_t(lds + R1_BHT, lds + R1_U0T, rb, cb, fr, g, n2);
        float mo[8];
#pragma unroll
        for (int n = 0; n < 2; ++n)
#pragma unroll
            for (int j = 0; j < 4; ++j) { const int cr = 16 * rb + fr, cc = 32 * cb + 16 * n + 4 * g + j; mo[n * 4 + j] = ((cr == cc) ? GC[cr] : 0.f) - m[n][j]; }
        *(u32x4*)(GM + ((rb * 2 + cb) * 64 + F.lane) * 8) = pack8(mo);
#pragma unroll
        for (int n = 0; n < 2; ++n) *(u32x2*)(GN + (((2 * cb + n) * 4 + rb) * 64 + F.lane) * 4) = pk4(n1[n] - n2[n]);
    }
    __syncthreads();
}

template <int MODE>
__device__ __forceinline__ void scan16(Frame& F, const bf16_t* GMsrc, const bf16_t* GNsrc, int i0, int h) {
    ldsp lds = F.lds;
    bf16_t* GMG = (bf16_t*)(F.ws + RW_MG); bf16_t* GNG = (bf16_t*)(F.ws + RW_NG); bf16_t* GSG = (bf16_t*)(F.ws + RW_SG); bf16_t* GS = (bf16_t*)(F.ws + RW_S0);
    {   u32x4 r[16];
#pragma unroll
        for (int s = 0; s < 16; ++s) r[s] = *(const u32x4*)(GMsrc + (size_t)((i0 + s) * 4 + h) * 4096 + F.tid * 8);
#pragma unroll
        for (int s = 0; s < 16; ++s) *(LAS u32x4*)(lds + s * 8192 + F.tid * 16) = r[s];
    }
    const int cb2 = F.wave & 3, fr = F.lane & 15, g = F.lane >> 4;
    const bool nchain = (MODE == 0) ? (F.wave >= 4) : true;
    const bool active = (MODE == 0) ? true : (F.wave < 4);
    u32x2 Nf[16][4];
#pragma unroll
    for (int s = 0; s < 16; ++s)
#pragma unroll
        for (int mt = 0; mt < 4; ++mt) Nf[s][mt] = (u32x2){0u, 0u};
    if (active && nchain) {
#pragma unroll
        for (int s = 0; s < 16; ++s)
#pragma unroll
            for (int mt = 0; mt < 4; ++mt) Nf[s][mt] = *(const u32x2*)(GNsrc + (size_t)((i0 + s) * 4 + h) * 4096 + ((cb2 * 4 + mt) * 64 + F.lane) * 4);
    }
    f32x4 S[4];
#pragma unroll
    for (int mt = 0; mt < 4; ++mt) S[mt] = (f32x4){0.f, 0.f, 0.f, 0.f};
    if (MODE == 0 && F.wave < 4) {
#pragma unroll
        for (int mt = 0; mt < 4; ++mt)
#pragma unroll
            for (int j = 0; j < 4; ++j) S[mt][j] = (16 * mt + 4 * g + j == 16 * cb2 + fr) ? 1.f : 0.f;
    }
    if (MODE == 2) {
#pragma unroll
        for (int mt = 0; mt < 4; ++mt) S[mt] = up4(*(const u32x2*)(GSG + (size_t)((i0 >> 4) * 4 + h) * 4096 + ((cb2 * 4 + mt) * 64 + F.lane) * 4));
    }
    __syncthreads();
    if (active) {
#pragma unroll
        for (int s = 0; s < 16; ++s) {
            u32x4 sw[2];
#pragma unroll
            for (int ks = 0; ks < 2; ++ks) { const u32x2 lo = pk4(S[2 * ks]), hi = pk4(S[2 * ks + 1]); sw[ks] = (u32x4){lo.x, lo.y, hi.x, hi.y}; }
            if (MODE == 1) {
#pragma unroll
                for (int mt = 0; mt < 4; ++mt) { const u32x2 w = (mt & 1) ? (u32x2){sw[mt >> 1].z, sw[mt >> 1].w} : (u32x2){sw[mt >> 1].x, sw[mt >> 1].y};
                    *(u32x2*)(GSG + (size_t)((i0 + s) * 4 + h) * 4096 + ((cb2 * 4 + mt) * 64 + F.lane) * 4) = w; }
            }
            if (MODE == 2) {
#pragma unroll
                for (int mt = 0; mt < 4; ++mt) { const u32x2 w = (mt & 1) ? (u32x2){sw[mt >> 1].z, sw[mt >> 1].w} : (u32x2){sw[mt >> 1].x, sw[mt >> 1].y};
                    *(u32x2*)(GS + (size_t)((i0 + s) * 4 + h) * 4096 + (16 * cb2 + fr) * 64 + 16 * mt + 4 * g) = w; }
            }
#pragma unroll
            for (int mt = 0; mt < 4; ++mt) { f32x4 a = up4(Nf[s][mt]);
#pragma unroll
                for (int ks = 0; ks < 2; ++ks) a = mfma16(*(const LAS bf16x8*)(lds + s * 8192 + ((mt * 2 + ks) * 64 + F.lane) * 16), __builtin_bit_cast(bf16x8, sw[ks]), a);
                S[mt] = a; }
        }
    }
    if (MODE == 0) {
        const int gi = i0 >> 4;
        if (F.wave >= 4) {
#pragma unroll
            for (int mt = 0; mt < 4; ++mt) *(u32x2*)(GNG + (size_t)(gi * 4 + h) * 4096 + ((cb2 * 4 + mt) * 64 + F.lane) * 4) = pk4(S[mt]);
        }
        __syncthreads();
        if (F.wave < 4) {
#pragma unroll
            for (int mt = 0; mt < 4; ++mt)
#pragma unroll
                for (int j = 0; j < 4; ++j) *(LAS unsigned short*)(lds + (16 * mt + 4 * g + j) * 128 + (16 * cb2 + fr) * 2) = (unsigned short)f2bf(S[mt][j]);
        }
        __syncthreads();
        {
            const int mtp = F.wave >> 1, ks = F.wave & 1;
            const u32x2 lo = *(const LAS u32x2*)(lds + (16 * mtp + fr) * 128 + (16 * (2 * ks) + 4 * g) * 2), hi = *(const LAS u32x2*)(lds + (16 * mtp + fr) * 128 + (16 * (2 * ks + 1) + 4 * g) * 2);
            *(u32x4*)(GMG + (size_t)(gi * 4 + h) * 4096 + ((mtp * 2 + ks) * 64 + F.lane) * 8) = (u32x4){lo.x, lo.y, hi.x, hi.y};
        }
    }
    __syncthreads();
}

constexpr int R3_RQ = 20480, R3_RABS = 28672, R3_BK = 36864, R3_KK = 45056, R3_VT = 53248, R3_S = 61440, R3_W1 = 69632, R3_UT = 77824, R3_ARB = 86016, R3_ARK = 94208, R3_ST = 102400;
__device__ __forceinline__ void rwkv_p3_item(Frame& F, int l, int item) {
    const int c = item >> 2, h = item & 3, t0 = c * 64;
    const bf16_t *Rr = (const bf16_t*)(F.ws + RW_R), *Rk = (const bf16_t*)(F.ws + RW_K), *Rv = (const bf16_t*)(F.ws + RW_V), *Rb = (const bf16_t*)(F.ws + RW_B), *Rg = (const bf16_t*)(F.ws + RW_G), *Rld = (const bf16_t*)(F.ws + RW_LD);
    const bf16_t *GW1 = (const bf16_t*)(F.ws + RW_W1) + (size_t)item * 4096, *GU0T = (const bf16_t*)(F.ws + RW_U0T) + (size_t)item * 4096, *GS = (const bf16_t*)(F.ws + RW_S0) + (size_t)item * 4096;
    const float* Rbon = (const float*)(F.ws + RW_BONUS); bf16_t* ycat = (bf16_t*)(F.ws + WS_ACT);
    ldsp lds = F.lds; LAS float* Lc = (LAS float*)(lds + R1_LC); LAS float* seg = (LAS float*)(lds + R1_SEG); LAS float* ST = (LAS float*)(lds + R3_ST);
    const int rb = F.wave >> 1, cb = F.wave & 1, fr = F.lane & 15, g = F.lane >> 4;
    chunk_prefix(F, Rld, t0, h, Lc, seg);
    {   const int t = F.tid >> 3, c8 = F.tid & 7; const size_t go = (size_t)(t0 + t) * 256 + h * 64 + c8 * 8;
        float r[8], b[8], k[8], v[8], o1[8], o2[8];
        unpack8(*(const u32x4*)(Rr + go), r); unpack8(*(const u32x4*)(Rb + go), b); unpack8(*(const u32x4*)(Rk + go), k); unpack8(*(const u32x4*)(Rv + go), v);
        float L[8], Lm[8];
#pragma unroll
        for (int e = 0; e < 8; ++e) { const int cc = c8 * 8 + e; L[e] = Lc[t * 64 + cc]; Lm[e] = Lc[31 * 64 + cc]; }
#pragma unroll
        for (int e = 0; e < 8; ++e) { o1[e] = r[e] * __expf(L[e] - Lm[e]); o2[e] = r[e] * __expf(L[e]); }
        *(LAS u32x4*)(lds + R3_RQ + swz128(t, c8)) = pack8(o1); *(LAS u32x4*)(lds + R3_RABS + swz128(t, c8)) = pack8(o2);
#pragma unroll
        for (int e = 0; e < 8; ++e) { const float s = __expf(Lm[e] - L[e]); o1[e] = b[e] * s; o2[e] = k[e] * s; }
        *(LAS u32x4*)(lds + R3_BK + swz128(t, c8)) = pack8(o1); *(LAS u32x4*)(lds + R3_KK + swz128(t, c8)) = pack8(o2);
        st_tr8(lds + R3_VT, t, c8, v);
        *(LAS u32x4*)(lds + R3_S + swz128(t, c8)) = *(const u32x4*)(GS + t * 64 + c8 * 8);
        *(LAS u32x4*)(lds + R3_W1 + swz128(t, c8)) = *(const u32x4*)(GW1 + t * 64 + c8 * 8);
    }
    __syncthreads();
    f32x4 y[2];
    {   f32x4 ut[2];
#pragma unroll
        for (int n = 0; n < 2; ++n) ut[n] = up4(*(const u32x2*)(GU0T + (32 * cb + 16 * n + fr) * 64 + 16 * rb + 4 * g));
        mm_t(lds + R3_W1, lds + R3_S, rb, cb, fr, g, ut);
        f32x4 ab[2] = {(f32x4){0.f, 0.f, 0.f, 0.f}, (f32x4){0.f, 0.f, 0.f, 0.f}}, ak[2] = {ab[0], ab[0]};
        mm_n(lds + R3_RQ, lds + R3_BK, rb, cb, fr, g, ab); mm_n(lds + R3_RQ, lds + R3_KK, rb, cb, fr, g, ak);
        y[0] = (f32x4){0.f, 0.f, 0.f, 0.f}; y[1] = y[0];
        mm_n(lds + R3_RABS, lds + R3_S, rb, cb, fr, g, y);
#pragma unroll
        for (int n = 0; n < 2; ++n) {
            f32x4 m1, m2;
#pragma unroll
            for (int j = 0; j < 4; ++j) { const int tn = 16 * rb + fr, sn = 32 * cb + 16 * n + 4 * g + j; m1[j] = (sn <= tn) ? ab[n][j] : 0.f; m2[j] = (sn <= tn) ? ak[n][j] : 0.f; }
            *(LAS u32x2*)(lds + R3_UT + adr_t(rb, cb, n, fr, g)) = pk4(ut[n]);
            *(LAS u32x2*)(lds + R3_ARB + adr_n(rb, cb, n, fr, g)) = pk4(m1); *(LAS u32x2*)(lds + R3_ARK + adr_n(rb, cb, n, fr, g)) = pk4(m2); }
    }
    __syncthreads();
    {   f32x4 z[2] = {(f32x4){0.f, 0.f, 0.f, 0.f}, (f32x4){0.f, 0.f, 0.f, 0.f}};
        mm_n(lds + R3_ARB, lds + R3_UT, rb, cb, fr, g, z); mm_n(lds + R3_ARK, lds + R3_VT, rb, cb, fr, g, y);
        y[0] -= z[0]; y[1] -= z[1];
        float s1 = 0.f, s2 = 0.f;
#pragma unroll
        for (int n = 0; n < 2; ++n)
#pragma unroll
            for (int j = 0; j < 4; ++j) { s1 += y[n][j]; s2 += y[n][j] * y[n][j]; }
        s1 += __shfl_xor(s1, 16); s1 += __shfl_xor(s1, 32); s2 += __shfl_xor(s2, 16); s2 += __shfl_xor(s2, 32);
        if (g == 0) { ST[((16 * rb + fr) * 2 + cb) * 2] = s1; ST[((16 * rb + fr) * 2 + cb) * 2 + 1] = s2; }
    }
    __syncthreads();
    {   const int tl = 16 * rb + fr; const int t = t0 + tl;
        const float s1 = ST[(tl * 2) * 2] + ST[(tl * 2 + 1) * 2], s2 = ST[(tl * 2) * 2 + 1] + ST[(tl * 2 + 1) * 2 + 1];
        const float mean = s1 * (1.f / 64.f), var = fmaxf(s2 * (1.f / 64.f) - mean * mean, 0.f), rstd = 1.f / sqrtf(var + 64e-5f);
        const float bon = Rbon[(size_t)t * 4 + h];
        const float *lng = F.in[21] + l * 256 + h * 64, *lnb = F.in[22] + l * 256 + h * 64;
#pragma unroll
        for (int n = 0; n < 2; ++n) { const int i0 = 32 * cb + 16 * n + 4 * g; const size_t go = (size_t)t * 256 + h * 64 + i0;
            const f32x4 vv = up4(*(const u32x2*)(Rv + go)), gg = up4(*(const u32x2*)(Rg + go)); const f32x4 lg = *(const f32x4*)(lng + i0), lb = *(const f32x4*)(lnb + i0);
            f32x4 o;
#pragma unroll
            for (int j = 0; j < 4; ++j) o[j] = ((y[n][j] - mean) * rstd * lg[j] + lb[j] + bon * vv[j]) * gg[j];
            *(u32x2*)(ycat + (size_t)t * DM + 768 + h * 64 + i0) = pk4(o); }
    }
    __syncthreads();
}

__device__ __forceinline__ void phase_router(Frame& F, int l, int alt = 0) {
    const float* X = F.out;
    const bf16_t* WH = (const bf16_t*)(F.ws + WS_WRH); const bf16_t* WL = (const bf16_t*)(F.ws + WS_WRL);
    const float* bias_r = (const float*)(F.ws + WS_BR);
    float* rinv2 = (float*)(F.ws + WS_RINV2);
    unsigned* cnt = (unsigned*)(F.ws + WS_CTL) + CNT_W0 + (alt * 2 + l) * 2048;
    unsigned* list = (unsigned*)(F.ws + (alt ? WS_P + (size_t)alt * 8 * MiB : WS_LIST)); float* wlist = (float*)(F.ws + (alt ? WS_P + (size_t)alt * 8 * MiB + 2 * MiB : WS_WLIST));
    LAS float* Lg = (LAS float*)(F.lds + (F.wave >> 1) * 4096);
    LAS float* Px = (LAS float*)(F.lds + 16384 + (F.wave >> 1) * 4096);
    const int fr = F.lane & 15, g = F.lane >> 4;
    const int kh = F.wave & 1;
    LAS unsigned* hist = (LAS unsigned*)(F.lds + 40960); LAS unsigned* hbase = hist + 32;
    if (F.tid < 32) hist[F.tid] = 0u;
    __syncthreads();
    for (int it0 = F.bid * 4; it0 < T_ / 16; it0 += F.G * 4) {
        const int it = it0 + (F.wave >> 1);
        const int t = it * 16 + fr;
        int E0 = -1, E1 = -1; unsigned r0 = 0u, r1 = 0u; float w0 = 0.f, w1 = 0.f;
        const float* xr = X + (size_t)t * DM + kh * 512 + g * 8;
        f32x4 acc[3]; acc[0] = (f32x4){0.f, 0.f, 0.f, 0.f}; acc[1] = acc[0]; acc[2] = acc[0];
        float ss = 0.f;
#pragma unroll 1
        for (int kb = 0; kb < 2; ++kb) {
            f32x4 xa[8], xb[8];
#pragma unroll
            for (int k8 = 0; k8 < 8; ++k8) { xa[k8] = *(const f32x4*)(xr + (kb * 8 + k8) * 32); xb[k8] = *(const f32x4*)(xr + (kb * 8 + k8) * 32 + 4); }
#pragma unroll
            for (int k8 = 0; k8 < 8; ++k8) {
                const int ks = kh * 16 + kb * 8 + k8;
                const f32x4 x0 = xa[k8], x1 = xb[k8];
                const float xv[8] = {x0[0], x0[1], x0[2], x0[3], x1[0], x1[1], x1[2], x1[3]};
                unsigned hh[8], ll[8];
#pragma unroll
                for (int e = 0; e < 8; ++e) { ss += xv[e] * xv[e]; hh[e] = f2bf(xv[e]); ll[e] = f2bf(xv[e] - bf2f(hh[e])); }
                u32x4 hw, lw; hw.x = hh[0] | (hh[1] << 16); hw.y = hh[2] | (hh[3] << 16); hw.z = hh[4] | (hh[5] << 16); hw.w = hh[6] | (hh[7] << 16);
                lw.x = ll[0] | (ll[1] << 16); lw.y = ll[2] | (ll[3] << 16); lw.z = ll[4] | (ll[5] << 16); lw.w = ll[6] | (ll[7] << 16);
                const bf16x8 xh = __builtin_bit_cast(bf16x8, hw), xl = __builtin_bit_cast(bf16x8, lw);
#pragma unroll
                for (int n = 0; n < 3; ++n) { const bf16x8 wh = *(const bf16x8*)(WH + (16 * n + fr) * DM + ks * 32 + g * 8), wl = *(const bf16x8*)(WL + (16 * n + fr) * DM + ks * 32 + g * 8);
                    acc[n] = mfma16(wh, xh, acc[n]); acc[n] = mfma16(wh, xl, acc[n]); acc[n] = mfma16(wl, xh, acc[n]); }
            }
        }
        if (kh == 1) {
#pragma unroll
            for (int n = 0; n < 3; ++n)
#pragma unroll
                for (int j = 0; j < 4; ++j) Px[(n * 4 + j) * 64 + F.lane] = acc[n][j];
            Px[12 * 64 + F.lane] = ss; }
        __syncthreads();
        if (kh == 0) {
#pragma unroll
            for (int n = 0; n < 3; ++n)
#pragma unroll
                for (int j = 0; j < 4; ++j) acc[n][j] += Px[(n * 4 + j) * 64 + F.lane];
            ss += Px[12 * 64 + F.lane]; }
        ss += __shfl_xor(ss, 16); ss += __shfl_xor(ss, 32);
        const float rinv = 1.f / sqrtf(ss * (1.f / DM) + 1e-6f);
        if (kh == 0) {
#pragma unroll
        for (int n = 0; n < 3; ++n)
#pragma unroll
            for (int j = 0; j < 4; ++j) { const int c = 16 * n + 4 * g + j; Lg[fr * 48 + c] = acc[n][j] * rinv + bias_r[c]; }
        LDS_WAIT();
        if (F.lane < 16) {
            const LAS float* lg = Lg + F.lane * 48; const int tt = it * 16 + F.lane;
            rinv2[tt] = rinv;
            int gi = 0; float gm = lg[0];
#pragma unroll
            for (int k = 1; k < 4; ++k) if (lg[k] > gm) { gm = lg[k]; gi = k; }
            float gs = 0.f;
#pragma unroll
            for (int k = 0; k < 4; ++k) gs += __expf(lg[k] - gm);
            const float gp = 1.f / gs;
            int e0 = 0; float v0 = lg[4 + gi * 8];
#pragma unroll
            for (int k = 1; k < 8; ++k) { const float v = lg[4 + gi * 8 + k]; if (v > v0) { v0 = v; e0 = k; } }
            int e1 = -1; float v1 = -INFINITY;
#pragma unroll
            for (int k = 0; k < 8; ++k) { const float v = lg[4 + gi * 8 + k]; if (k != e0 && v > v1) { v1 = v; e1 = k; } }
            const float ex = __expf(v1 - v0); const float w0_ = gp / (1.f + ex), w1_ = gp * ex / (1.f + ex);
            E0 = gi * 8 + e0; E1 = gi * 8 + e1; w0 = w0_; w1 = w1_;
            r0 = __hip_atomic_fetch_add(hist + E0, 1u, __ATOMIC_RELAXED, __HIP_MEMORY_SCOPE_WORKGROUP);
            r1 = __hip_atomic_fetch_add(hist + E1, 1u, __ATOMIC_RELAXED, __HIP_MEMORY_SCOPE_WORKGROUP);
        }
        }
        __syncthreads();
        if (F.tid < 32) { const unsigned n = hist[F.tid]; unsigned b = 0u; if (n) b = atomicAdd(&cnt[F.tid * 64], n); hbase[F.tid] = b; }
        __syncthreads();
        if (E0 >= 0) { const int tt = it * 16 + F.lane;
            const unsigned p0 = hbase[E0] + r0; list[(size_t)E0 * T_ + p0] = (unsigned)tt; wlist[(size_t)E0 * T_ + p0] = w0;
            const unsigned p1 = hbase[E1] + r1; list[(size_t)E1 * T_ + p1] = (unsigned)tt | 0x80000000u; wlist[(size_t)E1 * T_ + p1] = w1; }
        __syncthreads();
        if (F.tid < 32) hist[F.tid] = 0u;
    }
}

constexpr int MOE_R = 160, MOE_SLOT = 53248  , MOE_TAB = 3 * MOE_SLOT;
__device__ __forceinline__ int h4(int q) { return (0x78 >> (2 * q)) & 3; }
__device__ __forceinline__ int off64(int row, int c) { return row * 64 + ((c ^ h4((row >> 2) & 3)) << 4); }
#define MOE_GLDS(gp, lp) __builtin_amdgcn_global_load_lds((const unsigned*)(gp), (LAS unsigned*)(lp), 16, 0, 0)
__device__ __forceinline__ void phase_moe(Frame& F, int l, int var = 0) {
    const char* wsb = (const char*)F.ws;
    const float* bias_gu = (const float*)(F.ws + WS_BGU); const float* rinv2 = (const float*)(F.ws + WS_RINV2);
    const unsigned* cnt = (const unsigned*)(F.ws + WS_CTL) + CNT_W0 + l * 2048;
    const unsigned* list = (const unsigned*)(F.ws + WS_LIST); const float* wlist = (const float*)(F.ws + WS_WLIST);
    bf16_t* ys = (bf16_t*)(F.ws + WS_P);
    ldsp lds = F.lds;
    LAS unsigned* tokl = (LAS unsigned*)(lds + MOE_TAB); LAS float* wtl = (LAS float*)(lds + MOE_TAB + 640); LAS float* rvl = (LAS float*)(lds + MOE_TAB + 1280);
    int total = 0;
    for (int e = 0; e < 32; ++e) { const int n = (int)cnt[e * 64]; const int nt = (n + MOE_R - 1) / MOE_R; total += nt > 8 ? nt : 8; }
    total = __builtin_amdgcn_readfirstlane(total);
    const int vcu = (F.G % 8 == 0) ? (F.bid % 8) * (F.G / 8) + F.bid / 8 : F.bid;
#pragma unroll 1
    for (int ti = vcu; ti < total; ti += F.G) {
        int e = 0, acc_t = 0, m0 = 0, nrows = 0;
        for (int k = 0; k < 32; ++k) { const int n = (int)cnt[k * 64]; int nt = (n + MOE_R - 1) / MOE_R; nt = nt > 8 ? nt : 8;
            if (ti >= acc_t && ti < acc_t + nt) { e = k; const int rows = (n + nt - 1) / nt; m0 = (ti - acc_t) * rows; nrows = n - m0; nrows = nrows < 0 ? 0 : (nrows > rows ? rows : nrows); }
            acc_t += nt; }
        e = __builtin_amdgcn_readfirstlane(e); m0 = __builtin_amdgcn_readfirstlane(m0); nrows = __builtin_amdgcn_readfirstlane(nrows);
        const int e_w = (var & 16) ? 0 : e;
        __syncthreads();
        int tid_ = (int)__builtin_amdgcn_mbcnt_hi(~0u, __builtin_amdgcn_mbcnt_lo(~0u, 0u)) + 64 * F.wave; asm volatile("" : "+v"(tid_));
        if (tid_ < MOE_R) { unsigned tk = 0u; float w = 0.f; if (tid_ < nrows) { tk = list[(size_t)e * T_ + m0 + tid_]; w = wlist[(size_t)e * T_ + m0 + tid_]; }
            if (var & 8) tk = (unsigned)((ti * 160 + tid_) & (T_ - 1));
            tokl[tid_] = tk; wtl[tid_] = w; rvl[tid_] = rinv2[tk & 0x7fffffffu]; }
        asm volatile("s_waitcnt vmcnt(0)" ::: "memory");
        __syncthreads();
        if (nrows > 0) {
        const int lane = tid_ & 63, wv = __builtin_amdgcn_readfirstlane(tid_ >> 6), fr = lane & 15, g = lane >> 4;
        constexpr int WDR = 40960;
        if (wv >= 4) {
            const int lw = wv - 4;
            unsigned soff[13]; int ldst[13];
#pragma unroll
            for (int r = 0; r < 13; ++r) { const int q = lw + 4 * r; const int lrow = lane >> 3, pc = lane & 7;
                if (q < 20) { const int row = 8 * q + lrow; const int c = pc ^ ((row >> 1) & 7); soff[r] = (unsigned)WS_RW + (tokl[row] & 0x7fffffffu) * 2048u + c * 16; ldst[r] = q * 1024; }
                else { const int qb = q - 20; const int row = 8 * qb + lrow; const int c = pc ^ ((row >> 1) & 7);
                       soff[r] = (unsigned)WS_WGU + (unsigned)e_w * 524288u + row * 2048u + c * 16; ldst[r] = 20480 + qb * 1024; } }
            if (!(var & 2)) {
#pragma unroll
            for (int p = 0; p < 2; ++p)
#pragma unroll
                for (int r = 0; r < 13; ++r) MOE_GLDS(wsb + (soff[r] + p * 128u), lds + p * MOE_SLOT + ldst[r]);
            }
#pragma unroll 1
            for (int kt = 0; kt < ((var & 2) ? 0 : 16); ++kt) {
                if (kt < 15) asm volatile("s_waitcnt vmcnt(13)" ::: "memory"); else asm volatile("s_waitcnt vmcnt(0)" ::: "memory");
                __builtin_amdgcn_s_barrier();
                asm volatile("" ::: "memory");
                if (kt + 2 < 16 && !(var & 64)) { const unsigned ko = (unsigned)(kt + 2) * 128u; ldsp sl = lds + ((kt + 2) % 3) * MOE_SLOT;
#pragma unroll
                    for (int r = 0; r < 13; ++r) MOE_GLDS(wsb + (soff[r] + ko), sl + ldst[r]); }
            }
            __builtin_amdgcn_s_barrier();
            asm volatile("" ::: "memory");
            unsigned doff[8];
#pragma unroll
            for (int r = 0; r < 8; ++r) { const int q = lw + 4 * r; const int rho = 4 * q + (lane >> 4), pc = lane & 15; const int col = (rho & ~31) + pg8::perm32(rho & 31); const int c = pc ^ (rho & 15);
                doff[r] = (unsigned)WS_WD + (unsigned)e_w * 262144u + col * 256u + c * 16; }
#pragma unroll
            for (int r = 0; r < 8; ++r) MOE_GLDS(wsb + doff[r], lds + WDR + (lw + 4 * r) * 1024);
#pragma unroll 1
            for (int hc = 0; hc < ((var & 4) ? 0 : 8); ++hc) {
                asm volatile("s_waitcnt vmcnt(0)" ::: "memory");
                __builtin_amdgcn_s_barrier();
                asm volatile("" ::: "memory");
                if (hc + 1 < 8) { ldsp sl = lds + WDR + ((hc + 1) & 1) * 32768;
#pragma unroll
                    for (int r = 0; r < 8; ++r) MOE_GLDS(wsb + (doff[r] + (unsigned)(hc + 1) * 32768u), sl + (lw + 4 * r) * 1024); }
            }
            asm volatile("s_waitcnt vmcnt(0)" ::: "memory");
        } else {
            const int wr = wv >> 1, wc = wv & 1;
            f32x4 ag[5][4], au[5][4];
#pragma unroll
            for (int m = 0; m < 5; ++m)
#pragma unroll
                for (int n = 0; n < 4; ++n) { ag[m][n] = (f32x4){0.f, 0.f, 0.f, 0.f}; au[m][n] = ag[m][n]; }
            const int aof0 = swz128(80 * wr + fr, g);
            const int bgo0 = 20480 + swz128(64 * wc + fr, g);
#pragma unroll 1
            for (int kt = 0; kt < ((var & 2) ? 0 : 16); ++kt) {
                __builtin_amdgcn_s_barrier();
                asm volatile("" ::: "memory");
                ldsp cur = lds + (kt % 3) * MOE_SLOT;
                if (var & 32) continue;
#pragma unroll
                for (int ks = 0; ks < 2; ++ks) {
                    bf16x8 af[5], bg_[4], bu_[4];
#pragma unroll
                    for (int m = 0; m < 5; ++m) af[m] = *(const LAS bf16x8*)(cur + ((aof0 + m * 2048) ^ (ks * 64)));
#pragma unroll
                    for (int n = 0; n < 4; ++n) { bg_[n] = *(const LAS bf16x8*)(cur + ((bgo0 + n * 2048) ^ (ks * 64))); bu_[n] = *(const LAS bf16x8*)(cur + ((bgo0 + n * 2048 + 16384) ^ (ks * 64))); }
                    asm volatile("s_waitcnt lgkmcnt(0)" ::: "memory");
                    __builtin_amdgcn_sched_barrier(0);
                    __builtin_amdgcn_s_setprio(1);
#pragma unroll
                    for (int n = 0; n < 4; ++n)
#pragma unroll
                        for (int m = 0; m < 5; ++m) { ag[m][n] = mfma16(bg_[n], af[m], ag[m][n]); au[m][n] = mfma16(bu_[n], af[m], au[m][n]); }
                    __builtin_amdgcn_s_setprio(0);
                }
            }
            __builtin_amdgcn_s_barrier();
            asm volatile("" ::: "memory");
            {   const float* bge = bias_gu + e * 256;
#pragma unroll
                for (int n = 0; n < 4; ++n) { const int f0 = 64 * wc + 16 * n + 4 * g;
                    asm volatile("" ::: "memory");
                    const f32x4 bgv = *(const f32x4*)(bge + f0), buv = *(const f32x4*)(bge + 128 + f0);
#pragma unroll
                    for (int m = 0; m < 5; ++m) { const int row = 80 * wr + 16 * m + fr; const float rv = rvl[row], wt = wtl[row]; float a_[4];
#pragma unroll
                        for (int j = 0; j < 4; ++j) { const float gv = ag[m][n][j] * rv + bgv[j], uv = au[m][n][j] * rv + buv[j]; a_[j] = gv * sigmoidf_(gv) * uv * wt; }
                        u32x2 w; w.x = pk2(a_[0], a_[1]); w.y = pk2(a_[2], a_[3]);
                        *(LAS u32x2*)(lds + swz256(row, f0 >> 3) + (g & 1) * 8) = w; } }
            }
            const int aof30 = (80 * wr + fr) * 256;
#pragma unroll 1
            for (int hc = 0; hc < ((var & 4) ? 0 : 8); ++hc) {
                asm volatile("s_waitcnt vmcnt(0) lgkmcnt(0)" ::: "memory");
                __builtin_amdgcn_s_barrier();
                asm volatile("" ::: "memory");
                ldsp cur = lds + WDR + (hc & 1) * 32768;
                f32x4 ao[5][4];
#pragma unroll
                for (int m = 0; m < 5; ++m)
#pragma unroll
                    for (int n = 0; n < 4; ++n) ao[m][n] = (f32x4){0.f, 0.f, 0.f, 0.f};
#pragma unroll
                for (int ks = 0; ks < 4; ++ks) {
                    bf16x8 af[5];
#pragma unroll
                    for (int m = 0; m < 5; ++m) af[m] = *(const LAS bf16x8*)(lds + aof30 + m * 4096 + (((ks * 4 + g) ^ fr) << 4));
#pragma unroll
                    for (int n = 0; n < 4; ++n) { const bf16x8 bf_ = *(const LAS bf16x8*)(cur + (64 * wc + 16 * n + fr) * 256 + (((ks * 4 + g) ^ fr) << 4));
#pragma unroll
                        for (int m = 0; m < 5; ++m) ao[m][n] = mfma16(bf_, af[m], ao[m][n]); }
                }
                if (!(var & 1)) {
#pragma unroll
                for (int m = 0; m < 5; ++m) { const int row = 80 * wr + 16 * m + fr;
                    if (row < nrows) { const unsigned tk = tokl[row]; bf16_t* dst = ys + ((size_t)(tk >> 31) * T_ + (tk & 0x7fffffffu)) * DM + hc * 128 + 64 * wc + 8 * g;
#pragma unroll
                        for (int n2 = 0; n2 < 2; ++n2) { u32x4 w; w.x = pk2(ao[m][2 * n2][0], ao[m][2 * n2][1]); w.y = pk2(ao[m][2 * n2][2], ao[m][2 * n2][3]); w.z = pk2(ao[m][2 * n2 + 1][0], ao[m][2 * n2 + 1][1]); w.w = pk2(ao[m][2 * n2 + 1][2], ao[m][2 * n2 + 1][3]);
                            *(u32x4*)(dst + 32 * n2) = w; } } }
                }
            }
            asm volatile("s_waitcnt vmcnt(0)" ::: "memory");
        }
        }
    }
    __syncthreads();
}

#define XB_TMO      128
#define XB_XCNT(j)  (256  + 64 * (j))
#define XB_XSUB(j)  (1280 + 64 * (j))
#define XB_XGEN(j)  (2304 + 64 * (j))
#define XB_TOP      3328
#define XB_TOPGEN   3392
#define XCD_BAR_WORDS 3456
#define XB_SPIN_CAP (1u << 18)
__device__ __forceinline__ unsigned xb_ld(unsigned* p)              { return __hip_atomic_load(p, __ATOMIC_RELAXED, __HIP_MEMORY_SCOPE_AGENT); }
__device__ __forceinline__ unsigned xb_add(unsigned* p, unsigned v) { return __hip_atomic_fetch_add(p, v, __ATOMIC_RELAXED, __HIP_MEMORY_SCOPE_AGENT); }
__device__ __forceinline__ unsigned xb_xcc_id() { return (unsigned)__builtin_amdgcn_s_getreg((3 << 11) | 20) & 0xFu; }
#define XB_SPIN(cond, bar) do { unsigned _sp = 0; while (cond) { __builtin_amdgcn_s_sleep(1); \
    if ((++_sp & 255u) == 0u) { if (xb_ld(&(bar)[XB_TMO])) break; if (_sp > XB_SPIN_CAP) { atomicAdd(&(bar)[XB_TMO], 1u); break; } } } } while (0)
struct XcdBarrier { unsigned* bar; unsigned x; volatile LAS unsigned* st; };
__device__ __forceinline__ XcdBarrier xcd_barrier_post(unsigned* bar, volatile LAS unsigned* st) {
    XcdBarrier b; b.bar = bar; b.x = xb_xcc_id(); b.st = st;
    if (threadIdx.x == 0) (void)xb_add(&bar[XB_XCNT(b.x)], 1u);
    return b;
}
__device__ __forceinline__ void xcd_barrier_complete(unsigned* bar, unsigned x, unsigned& nloc, unsigned& nx) {
    const unsigned G = gridDim.x * gridDim.y * gridDim.z;
    unsigned sum, cnt, mine, sp = 0u;
    for (;;) {
        sum = 0u; cnt = 0u; mine = 0u;
#pragma unroll
        for (unsigned j = 0; j < 16; ++j) { const unsigned c = xb_ld(&bar[XB_XCNT(j)]); sum += c; cnt += (c > 0u) ? 1u : 0u; mine = (j == x) ? c : mine; }
        if (sum == G) break;
        __builtin_amdgcn_s_sleep(1);
        if ((++sp & 255u) == 0u) { if (xb_ld(&bar[XB_TMO])) break; if (sp > XB_SPIN_CAP) { atomicAdd(&bar[XB_TMO], 1u); break; } }
    }
    nloc = mine > 0u ? mine : 1u; nx = cnt > 0u ? cnt : 1u;
}
__device__ __forceinline__ void xcd_barrier(const XcdBarrier& b) {
    asm volatile("s_waitcnt vmcnt(0)" ::: "memory");
    __syncthreads();
    if (threadIdx.x == 0) {
        unsigned* bar = b.bar;
        __builtin_amdgcn_s_waitcnt(0);
        unsigned nloc = b.st[0], nx = b.st[1];
        if (nloc == 0u) { xcd_barrier_complete(bar, b.x, nloc, nx); b.st[0] = nloc; b.st[1] = nx; }
        const unsigned old = xb_add(&bar[XB_XSUB(b.x)], 1u);
        const unsigned gen = old / nloc;
        if (old + 1u == (gen + 1u) * nloc) {
            __builtin_amdgcn_fence(__ATOMIC_RELEASE, "agent");
            asm volatile("s_waitcnt vmcnt(0)" ::: "memory");
            const unsigned og = xb_add(&bar[XB_TOP], 1u);
            const unsigned tg = og / nx;
            if (og + 1u == (tg + 1u) * nx) xb_add(&bar[XB_TOPGEN], 1u);
            else XB_SPIN(xb_ld(&bar[XB_TOPGEN]) == tg, bar);
            __builtin_amdgcn_fence(__ATOMIC_ACQUIRE, "agent");
            xb_add(&bar[XB_XGEN(b.x)], 1u);
            asm volatile("s_waitcnt vmcnt(0)" ::: "memory");
        } else {
            XB_SPIN(xb_ld(&bar[XB_XGEN(b.x)]) == gen, bar);
            __builtin_amdgcn_fence(__ATOMIC_ACQUIRE, "agent");
            asm volatile("s_waitcnt vmcnt(0)" ::: "memory");
        }
    }
    __syncthreads();
}

constexpr int NPHASE = 24;
template <int L> __device__ __forceinline__ void layer_phases(Frame& F, const XcdBarrier& bar, const int lo, const int hi) {
    constexpr int B = 1 + 11 * L;
#ifndef PROBE_PH
#define PROBE_PH -1
#endif
#define RP(k) for (int rep_ = 0; rep_ < (((k) == PROBE_PH) ? 3 : 1); ++rep_)
#define INR(k) (lo <= (k) && (k) < hi)
#define IN(k) (INR(k) && fresh(F))
#define SEAM(k) do { if (INR(k) && INR((k) + 1)) xcd_barrier(bar); } while (0)
    if (IN(B + 0)) RP(B + 0) { phase_prep(F, L); __syncthreads(); phase_rownorm(F, L == 0 ? 0 : 1); } SEAM(B + 0);
    if (IN(B + 1)) RP(B + 1) {
        pg8::Gemm gm{(const bf16_t*)(F.ws + WS_ACT), (const bf16_t*)(F.ws + WS_WIN), T_, NINP, DM, DM, DM};
        pg8::StaticOrder S; S.init(T_, NINP, F.G, F.bid);
        pg8::EpiBf16Bias E{(bf16_t*)(F.ws + WS_P), NINP, (const float*)(F.ws + WS_BIN)};
        pg8::gemm_phase<pg8::EpiBf16Bias, pg8::StaticOrder, true, true>(F.lds, gm, S, E);
    } SEAM(B + 1);
    if (IN(B + 2)) RP(B + 2) {
#ifndef PROBE_ITEM
#define PROBE_ITEM -1
#endif
        for (int rp = 0; rp < ((PROBE_ITEM == 0 && L == 0) ? 3 : 1); ++rp) {
#pragma unroll 1
        for (int it = F.bid; it < 512; it += F.G) { asm volatile("" ::: "memory"); if (it < 128) attn_item(F, L, it); } }
        for (int rp = 0; rp < ((PROBE_ITEM == 1 && L == 0) ? 3 : 1); ++rp) {
#pragma unroll 1
        for (int it = F.bid; it < 512; it += F.G) { asm volatile("" ::: "memory"); if (it >= 128 && it < 256) poolconv_item(F, L, it - 128); } }
        for (int rp = 0; rp < ((PROBE_ITEM == 2 && L == 0) ? 3 : 1); ++rp) {
#pragma unroll 1
        for (int it = F.bid; it < 512; it += F.G) { asm volatile("" ::: "memory"); if (it >= 256) rwkvprep_item(F, L, it - 256); } }
    } SEAM(B + 2);
    if (IN(B + 3)) RP(B + 3) {
#pragma unroll 1
        for (int it = F.bid; it < 1024; it += F.G) { asm volatile("" ::: "memory"); rwkv_r1_item(F, it); }
    } SEAM(B + 3);
    if (IN(B + 4)) RP(B + 4) {
#pragma unroll 1
        for (int u = F.bid; u < 64; u += F.G) { asm volatile("" ::: "memory"); scan16<0>(F, (const bf16_t*)(F.ws + RW_M), (const bf16_t*)(F.ws + RW_N), (u >> 2) * 16, u & 3); }
    } SEAM(B + 4);
    if (IN(B + 5)) RP(B + 5) {
#pragma unroll 1
        for (int u = F.bid; u < 4; u += F.G) { asm volatile("" ::: "memory"); scan16<1>(F, (const bf16_t*)(F.ws + RW_MG), (const bf16_t*)(F.ws + RW_NG), 0, u); }
    } SEAM(B + 5);
    if (IN(B + 6)) RP(B + 6) {
#pragma unroll 1
        for (int u = F.bid; u < 64; u += F.G) { asm volatile("" ::: "memory"); scan16<2>(F, (const bf16_t*)(F.ws + RW_M), (const bf16_t*)(F.ws + RW_N), (u >> 2) * 16, u & 3); }
    } SEAM(B + 6);
    if (IN(B + 7)) RP(B + 7) {
#pragma unroll 1
        for (int it = F.bid; it < 1024; it += F.G) { asm volatile("" ::: "memory"); rwkv_p3_item(F, L, it); }
    } SEAM(B + 7);
    if (IN(B + 8)) RP(B + 8) {
        pg8::Gemm gm{(const bf16_t*)(F.ws + WS_ACT), (const bf16_t*)(F.ws + WS_WOUT), T_, DM, DM, DM, DM};
        pg8::StaticOrder S; S.init(T_, DM, F.G, F.bid);
        pg8::EpiResF32 E{L == 0 ? F.in[0] : F.out, F.out, (bf16_t*)(F.ws + WS_RW), DM};
        pg8::gemm_phase<pg8::EpiResF32, pg8::StaticOrder, true, true>(F.lds, gm, S, E);
    } SEAM(B + 8);
    if (IN(B + 9)) RP(B + 9) phase_router(F, L, rep_); SEAM(B + 9);
    #ifndef PROBE_VAR
#define PROBE_VAR 0
#endif
    if (IN(B + 10)) RP(B + 10) phase_moe(F, L, rep_ > 0 ? PROBE_VAR : 0); SEAM(B + 10);
}

__global__ void __launch_bounds__(NTHR, 2) fwd_kernel(Args a) {
    extern __shared__ __attribute__((aligned(16))) unsigned char smem[];
    Frame F;
    F.lds = (ldsp)smem; F.tid = threadIdx.x; F.lane = F.tid & 63; F.wave = __builtin_amdgcn_readfirstlane(F.tid >> 6);
    F.G = gridDim.x; F.bid = blockIdx.x; F.in = a.in; F.out = a.out; F.ws = a.ws;
    const int lo = a.ph_lo, hi = a.ph_hi;
    volatile LAS unsigned* bst = (volatile LAS unsigned*)(F.lds + LDS_BYTES - 64);
    if (F.tid < 16) bst[F.tid] = 0u;
    __syncthreads();
    const XcdBarrier bar = xcd_barrier_post((unsigned*)(F.ws + WS_CTL) + 1024, bst);
    if (IN(0)) RP(0) phase_mod(F); SEAM(0);
    layer_phases<0>(F, bar, lo, hi);
    layer_phases<1>(F, bar, lo, hi);
#ifdef PROBE_XBAR
    if (hi == NPHASE) { for (int i = 0; i < PROBE_XBAR; ++i) xcd_barrier(bar); }
#endif
    if (IN(23)) phase_rownorm(F, 2);
#undef IN
#undef INR
#undef SEAM
}

extern "C" void kernel_launch(void* const* d_in, const int* in_sizes, int n_in, void* d_out, int out_size, void* d_ws, size_t ws_size, hipStream_t stream) {
    static int grid = 0;
    if (grid == 0) {
        int dev = 0, cus = 0;
        if (n_in != 34 || out_size != T_ * DM || ws_size < WS_END) { fprintf(stderr, "kernel_launch: unexpected shapes n_in %d out %d ws %zu\n", n_in, out_size, ws_size); grid = -1; return; }
        if (hipGetDevice(&dev) != hipSuccess || hipDeviceGetAttribute(&cus, hipDeviceAttributeMultiprocessorCount, dev) != hipSuccess) { grid = -1; return; }
        if (hipFuncSetAttribute((const void*)fwd_kernel, hipFuncAttributeMaxDynamicSharedMemorySize, LDS_BYTES) != hipSuccess) { fprintf(stderr, "kernel_launch: hipFuncSetAttribute failed\n"); grid = -1; return; }
        int per_cu = 0;
        if (hipOccupancyMaxActiveBlocksPerMultiprocessor(&per_cu, (const void*)fwd_kernel, NTHR, LDS_BYTES) != hipSuccess || per_cu < 1) { fprintf(stderr, "kernel_launch: occupancy query failed (%d)\n", per_cu); per_cu = 1; }
        (void)hipGetLastError();
        grid = cus;
    }
    if (grid < 0) return;
    (void)hipMemsetAsync((char*)d_ws + WS_CTL, 0, CTL_BYTES, stream);
    Args a{};
    for (int i = 0; i < 34; ++i) a.in[i] = (const float*)d_in[i];
    a.out = (float*)d_out; a.ws = (unsigned char*)d_ws;
#ifdef MULTI_LAUNCH
    for (int ph = 0; ph < NPHASE; ++ph) { a.ph_lo = ph; a.ph_hi = ph + 1; hipLaunchKernelGGL(fwd_kernel, dim3(grid), dim3(NTHR), LDS_BYTES, stream, a); }
#else
    a.ph_lo = 0; a.ph_hi = NPHASE;
    hipLaunchKernelGGL(fwd_kernel, dim3(grid), dim3(NTHR), LDS_BYTES, stream, a);
#endif
}
```

```cpp
#define PROBE_PH -1
#include <hip/hip_runtime.h>
#include <hip/hip_cooperative_groups.h>
#include <cstdio>
#include <cstdint>
namespace cg = cooperative_groups;

#define LAS __attribute__((address_space(3)))
typedef unsigned short bf16_t;
typedef short bf16x8 __attribute__((ext_vector_type(8)));
typedef float f32x4 __attribute__((ext_vector_type(4)));
typedef float f32x2 __attribute__((ext_vector_type(2)));
typedef unsigned u32x4 __attribute__((ext_vector_type(4)));
typedef unsigned u32x2 __attribute__((ext_vector_type(2)));
typedef LAS unsigned char* ldsp;

namespace pg8 {
#define PG8_LAS __attribute__((address_space(3)))
constexpr int BM = 256, BK = 64, HALF = 128, HTB = HALF * BK * 2, STAGE_BYTES = 8 * HTB, NXCD = 8, WGM = 8;
__host__ __device__ __forceinline__ int lds_byte(int r, int c) { const int st = (r >> 4) * 2 + (c >> 5), rr = r & 15, cc = c & 31, ob = rr * 64 + cc * 2; return st * 1024 + (ob ^ (((ob >> 9) & 1) << 5)); }
__host__ __device__ __forceinline__ void stage_rc(int b, int& R, int& C) { const int st = b / 1024, sb = b % 1024, swz = sb ^ (((sb >> 9) & 1) << 5); R = (st >> 1) * 16 + swz / 64; C = (st & 1) * 32 + (swz % 64) / 2; }
__host__ __device__ __forceinline__ int perm32(int rho) { const int n = rho >> 4, i = rho & 15; return 8 * (i >> 2) + 4 * n + (i & 3); }
struct Unit { int pm, pn; };
struct Gemm { const bf16_t* A; const bf16_t* Bt; int M, N, K, lda, ldb; };
struct StaticOrder {
    int nM, nN, nwg, G, c;
    __host__ __device__ void init(int M, int N, int G_, int c_) { nM = M / BM; nN = N / BM; nwg = nM * nN; G = G_; c = c_; }
    __host__ __device__ bool next(int i, Unit& u) const {
        const long L = (long)i * G + c; if (L >= nwg) return false;
        int wgid = (int)L; { const int q = nwg / NXCD, r = nwg % NXCD, xcd = wgid % NXCD, off = wgid / NXCD; wgid = (xcd < r ? xcd * (q + 1) : r * (q + 1) + (xcd - r) * q) + off; }
        const int nig = WGM * nN, gid = wgid / nig, fm = gid * WGM, gsz = (nM - fm) < WGM ? (nM - fm) : WGM;
        u.pm = fm + ((wgid % nig) % gsz); u.pn = (wgid % nig) / gsz; return true;
    }
    __device__ __forceinline__ void a_ready(const Unit&) const {}
    __device__ __forceinline__ void done(const Unit&) const {}
};
__device__ __forceinline__ unsigned cvt_pk_bf16(float lo, float hi) { unsigned r; asm volatile("v_cvt_pk_bf16_f32 %0, %1, %2" : "=v"(r) : "v"(lo), "v"(hi)); return r; }
struct EpiBf16Bias {
    static constexpr bool PERM = true, AFTER_DRAIN = false;
    bf16_t* O; int ldc; const float* bias;
    __device__ __forceinline__ void operator()(const f32x4 (&acc)[2][2][4][2], const Unit& u, int wr, int wc, int fr, int fq) const {
        const int row0 = u.pm * BM + wr * 64 + fr; const int col0 = u.pn * BM + wc * 32 + 8 * fq;
        f32x4 bv[2][2];
#pragma unroll
        for (int bj = 0; bj < 2; ++bj)
#pragma unroll
            for (int n = 0; n < 2; ++n) bv[bj][n] = *(const f32x4*)(bias + col0 + bj * HALF + 4 * n);
#pragma unroll
        for (int ai = 0; ai < 2; ++ai)
#pragma unroll
            for (int m = 0; m < 4; ++m) { bf16_t* rowp = O + (size_t)(row0 + ai * HALF + m * 16) * ldc + col0;
#pragma unroll
                for (int bj = 0; bj < 2; ++bj) { f32x4 v0 = acc[ai][bj][m][0] + bv[bj][0], v1 = acc[ai][bj][m][1] + bv[bj][1];
                    u32x4 w; w.x = cvt_pk_bf16(v0[0], v0[1]); w.y = cvt_pk_bf16(v0[2], v0[3]); w.z = cvt_pk_bf16(v1[0], v1[1]); w.w = cvt_pk_bf16(v1[2], v1[3]);
                    *(u32x4*)(rowp + bj * HALF) = w; } }
    }
};
struct EpiResF32 {
    static constexpr bool PERM = false, AFTER_DRAIN = false;
    const float* base; float* out; bf16_t* ob; int ldc;
    __device__ __forceinline__ void operator()(const f32x4 (&acc)[2][2][4][2], const Unit& u, int wr, int wc, int fr, int fq) const {
        const int row0 = u.pm * BM + wr * 64 + fr, col0 = u.pn * BM + wc * 32 + 4 * fq;
#pragma unroll
        for (int ai = 0; ai < 2; ++ai)
#pragma unroll
            for (int m = 0; m < 4; ++m) { const size_t off = (size_t)(row0 + ai * HALF + m * 16) * ldc + col0;
#pragma unroll
                for (int bj = 0; bj < 2; ++bj)
#pragma unroll
                    for (int n = 0; n < 2; ++n) { const f32x4 bs = *(const f32x4*)(base + off + bj * HALF + n * 16); const f32x4 o = bs + acc[ai][bj][m][n];
                        *(f32x4*)(out + off + bj * HALF + n * 16) = o;
                        u32x2 w; w.x = cvt_pk_bf16(o[0], o[1]); w.y = cvt_pk_bf16(o[2], o[3]); *(u32x2*)(ob + off + bj * HALF + n * 16) = w; }
                asm volatile("" ::: "memory"); }
    }
};
template <class Epi, class Sched, bool ALIGN_EPI = false, bool SP2 = false>
__device__ __forceinline__ void gemm_phase(PG8_LAS unsigned char* lds, const Gemm g, const Sched& S, const Epi& E) {
    const int tid = threadIdx.x, wid = __builtin_amdgcn_readfirstlane(tid >> 6), lane = tid & 63, wr = wid >> 2, wc = wid & 3, fr = lane & 15, fq = lane >> 4;
    const int K = g.K, nt = K / BK;
    unsigned voffA[2], voffB[2];
#pragma unroll
    for (int i = 0; i < 2; ++i) { int R, C; stage_rc(tid * 16 + i * 8192, R, C); const int Rb = Epi::PERM ? ((R & ~31) + perm32(R & 31)) : R;
        voffA[i] = (unsigned)(R * g.lda + C) * 2u; voffB[i] = (unsigned)(Rb * g.ldb + C) * 2u; }
    const size_t kstep = (size_t)(BK * 2);
    const size_t hstepA = (size_t)HALF * g.lda * 2, hstepB = (size_t)HALF * g.ldb * 2;
    const size_t tstepA = 2 * hstepA, tstepB = 2 * hstepB;
    const unsigned ldsw = (unsigned)wid * 1024u;
    const int aoff = lds_byte(wr * 64 + fr, fq * 8), boff = lds_byte(wc * 32 + fr, fq * 8);
#define PG8_SA(b, h) (((b) * 2 + (h)) * HTB)
#define PG8_SB(b, h) ((4 + (b) * 2 + (h)) * HTB)
#define PG8_STAGE(bufoff, gbase, voff) do { _Pragma("unroll") for (int _i = 0; _i < 2; ++_i) \
        __builtin_amdgcn_global_load_lds((const unsigned*)((const char*)(gbase) + (voff)[_i]), (PG8_LAS unsigned*)(lds + (bufoff) + ldsw + _i * 8192), 16, 0, 0); } while (0)
#define PG8_LDA(dst, b, h) do { _Pragma("unroll") for (int m = 0; m < 4; ++m) _Pragma("unroll") for (int k = 0; k < 2; ++k) dst[m][k] = *(const PG8_LAS bf16x8*)(lds + PG8_SA(b, h) + aoff + m * 2048 + k * 1024); } while (0)
#define PG8_LDB(dst, b, h) do { _Pragma("unroll") for (int n = 0; n < 2; ++n) _Pragma("unroll") for (int k = 0; k < 2; ++k) dst[n][k] = *(const PG8_LAS bf16x8*)(lds + PG8_SB(b, h) + boff + n * 2048 + k * 1024); } while (0)
#define PG8_MMA(ai, bj, At, Bt) do { __builtin_amdgcn_s_setprio(1); _Pragma("unroll") for (int m = 0; m < 4; ++m) _Pragma("unroll") for (int n = 0; n < 2; ++n) _Pragma("unroll") for (int k = 0; k < 2; ++k) \
        acc[ai][bj][m][n] = __builtin_amdgcn_mfma_f32_16x16x32_bf16(Bt[n][k], At[m][k], acc[ai][bj][m][n], 0, 0, 0); __builtin_amdgcn_s_setprio(0); } while (0)
#define PG8_WAIT_V(n) asm volatile("s_waitcnt vmcnt(" #n ")" ::: "memory")
#define PG8_WAIT_L(n) asm volatile("s_waitcnt lgkmcnt(" #n ")" ::: "memory")
#define PG8_BAR __builtin_amdgcn_s_barrier()
#define PG8_SCHED __builtin_amdgcn_sched_barrier(0)
    Unit cur, nxt; int ui = 0;
    if (!S.next(0, cur)) return;
    f32x4 acc[2][2][4][2];
#pragma unroll
    for (int a = 0; a < 2; ++a)
#pragma unroll
        for (int b = 0; b < 2; ++b)
#pragma unroll
            for (int m = 0; m < 4; ++m)
#pragma unroll
                for (int n = 0; n < 2; ++n) acc[a][b][m][n] = (f32x4){0.f, 0.f, 0.f, 0.f};
    bf16x8 At[4][2], B0[2][2], B1[2][2];
    const char* cA = (const char*)g.A + (size_t)cur.pm * tstepA; const char* cB = (const char*)g.Bt + (size_t)cur.pn * tstepB;
    S.a_ready(cur);
    if constexpr (SP2) {
        PG8_STAGE(PG8_SB(0, 0), cB, voffB); PG8_STAGE(PG8_SB(0, 1), cB + hstepB, voffB); PG8_STAGE(PG8_SA(0, 0), cA, voffA); PG8_STAGE(PG8_SA(0, 1), cA + hstepA, voffA);
        if (wr == 1) PG8_BAR;
        PG8_WAIT_V(2); PG8_BAR;
        PG8_STAGE(PG8_SB(1, 0), cB + kstep, voffB); PG8_STAGE(PG8_SA(1, 0), cA + kstep, voffA); PG8_STAGE(PG8_SB(1, 1), cB + hstepB + kstep, voffB);
        PG8_WAIT_V(6); PG8_BAR;
    } else {
        PG8_STAGE(PG8_SB(0, 0), cB, voffB); PG8_STAGE(PG8_SA(0, 0), cA, voffA); PG8_STAGE(PG8_SB(0, 1), cB + hstepB, voffB); PG8_STAGE(PG8_SA(0, 1), cA + hstepA, voffA);
        if (wr == 1) PG8_BAR;
        PG8_WAIT_V(4); PG8_BAR;
        PG8_STAGE(PG8_SB(1, 0), cB + kstep, voffB); PG8_STAGE(PG8_SA(1, 0), cA + kstep, voffA); PG8_STAGE(PG8_SB(1, 1), cB + hstepB + kstep, voffB);
        PG8_WAIT_V(6); PG8_BAR;
    }
    for (;;) {
        const bool has_next = S.next(ui + 1, nxt);
        const char* nA = has_next ? (const char*)g.A + (size_t)nxt.pm * tstepA : cA; const char* nB = has_next ? (const char*)g.Bt + (size_t)nxt.pn * tstepB : cB;
        for (int t = 0; t < nt; t += 2) {
            const bool last = (t == nt - 2);
            const char* a1 = cA + (size_t)(t + 1) * kstep;
            const char* a2 = last ? nA : cA + (size_t)(t + 2) * kstep; const char* b2 = last ? nB : cB + (size_t)(t + 2) * kstep;
            const char* a3 = a2 + kstep; const char* b3 = b2 + kstep;
            if (last && has_next) S.a_ready(nxt);
            if constexpr (SP2) {
            PG8_LDB(B0, 0, 0); PG8_LDB(B1, 0, 1); PG8_SCHED; PG8_LDA(At, 0, 0); PG8_STAGE(PG8_SA(1, 1), a1 + hstepA, voffA);
            PG8_WAIT_V(8); PG8_WAIT_L(0); PG8_BAR; PG8_MMA(0, 0, At, B0); PG8_MMA(0, 1, At, B1); PG8_BAR; PG8_SCHED;
            PG8_LDA(At, 0, 1); PG8_STAGE(PG8_SB(0, 0), b2, voffB); PG8_STAGE(PG8_SB(0, 1), b2 + hstepB, voffB); PG8_STAGE(PG8_SA(0, 0), a2, voffA);
            PG8_WAIT_V(8); PG8_WAIT_L(0); PG8_BAR; PG8_MMA(1, 0, At, B0); PG8_MMA(1, 1, At, B1); PG8_BAR; PG8_SCHED;
            PG8_LDB(B0, 1, 0); PG8_LDB(B1, 1, 1); PG8_SCHED; PG8_LDA(At, 1, 0); PG8_STAGE(PG8_SA(0, 1), a2 + hstepA, voffA);
            PG8_WAIT_V(8); PG8_WAIT_L(0); PG8_BAR; PG8_MMA(0, 0, At, B0); PG8_MMA(0, 1, At, B1); PG8_BAR; PG8_SCHED;
            PG8_LDA(At, 1, 1); PG8_STAGE(PG8_SB(1, 0), b3, voffB); PG8_STAGE(PG8_SB(1, 1), b3 + hstepB, voffB); PG8_STAGE(PG8_SA(1, 0), a3, voffA);
            PG8_WAIT_V(8); PG8_WAIT_L(0); PG8_BAR; PG8_MMA(1, 0, At, B0); PG8_MMA(1, 1, At, B1); PG8_BAR; PG8_SCHED;
            } else {
            PG8_LDB(B0, 0, 0); PG8_SCHED; PG8_LDA(At, 0, 0); PG8_STAGE(PG8_SA(1, 1), a1 + hstepA, voffA);
            PG8_WAIT_L(8); PG8_BAR; PG8_WAIT_L(0); PG8_MMA(0, 0, At, B0); PG8_BAR; PG8_SCHED;
            PG8_LDB(B1, 0, 1); PG8_STAGE(PG8_SB(0, 0), b2, voffB);
            PG8_BAR; PG8_WAIT_L(0); PG8_MMA(0, 1, At, B1); PG8_BAR;
            PG8_LDA(At, 0, 1); PG8_STAGE(PG8_SA(0, 0), a2, voffA);
            PG8_BAR; PG8_WAIT_L(0); PG8_MMA(1, 0, At, B0); PG8_BAR; PG8_SCHED;
            PG8_STAGE(PG8_SB(0, 1), b2 + hstepB, voffB);
            PG8_WAIT_V(6); PG8_BAR; PG8_MMA(1, 1, At, B1); PG8_BAR;
            PG8_LDB(B0, 1, 0); PG8_SCHED; PG8_LDA(At, 1, 0); PG8_STAGE(PG8_SA(0, 1), a2 + hstepA, voffA);
            PG8_WAIT_L(8); PG8_BAR; PG8_WAIT_L(0); PG8_MMA(0, 0, At, B0); PG8_BAR; PG8_SCHED;
            PG8_LDB(B1, 1, 1); PG8_STAGE(PG8_SB(1, 0), b3, voffB);
            PG8_BAR; PG8_WAIT_L(0); PG8_MMA(0, 1, At, B1); PG8_BAR;
            PG8_LDA(At, 1, 1); PG8_STAGE(PG8_SA(1, 0), a3, voffA);
            PG8_BAR; PG8_WAIT_L(0); PG8_MMA(1, 0, At, B0); PG8_BAR; PG8_SCHED;
            PG8_STAGE(PG8_SB(1, 1), b3 + hstepB, voffB);
            PG8_WAIT_V(6); PG8_BAR; PG8_MMA(1, 1, At, B1); PG8_BAR;
            }
        }
        if constexpr (ALIGN_EPI) { if (wr == 0) PG8_BAR; }
        if constexpr (!Epi::AFTER_DRAIN) { E(acc, cur, wr, wc, fr, fq); S.done(cur); }
        if (!has_next) break;
#pragma unroll
        for (int a = 0; a < 2; ++a)
#pragma unroll
            for (int b = 0; b < 2; ++b)
#pragma unroll
                for (int m = 0; m < 4; ++m)
#pragma unroll
                    for (int n = 0; n < 2; ++n) acc[a][b][m][n] = (f32x4){0.f, 0.f, 0.f, 0.f};
        cur = nxt; cA = nA; cB = nB; ++ui;
        if constexpr (ALIGN_EPI) { if (wr == 1) PG8_BAR; }
    }
    PG8_WAIT_V(0);
    if constexpr (!ALIGN_EPI) { if (wr == 0) PG8_BAR; }
    PG8_BAR;
    if constexpr (Epi::AFTER_DRAIN) { E.fused(acc, cur, wr, wc, fr, fq, lds, wid, lane); S.done(cur); }
#undef PG8_SA
#undef PG8_SB
#undef PG8_STAGE
#undef PG8_LDA
#undef PG8_LDB
#undef PG8_MMA
#undef PG8_WAIT_V
#undef PG8_WAIT_L
#undef PG8_BAR
#undef PG8_SCHED
}
}

constexpr int T_ = 16384, DM = 1024, NIN = 2432, NINP = 2560;
constexpr int C_Q = 256, C_K = 512, C_V = 640, C_BG = 768, C_CG = 1024, C_XIN = 1280, C_D = 1536;
constexpr int NWAVES = 8, NTHR = 512;
constexpr int LDS_BYTES = 163840;
constexpr size_t MiB = 1u << 20;
constexpr size_t WS_CTL = 0;
constexpr size_t CTL_BYTES = 262144;
constexpr int FLG_W0 = 24576;
constexpr int CNT_W0 = 8192;
constexpr size_t WS_MOD = 1 * MiB;
constexpr size_t WS_BIN = WS_MOD + 65536;
constexpr size_t WS_BGU = WS_BIN + 16384;
constexpr size_t WS_BR  = WS_BGU + 32768;
constexpr size_t WS_WRH = WS_BR + 1024;
constexpr size_t WS_WRL = WS_WRH + 98304;
constexpr size_t WS_W2T = WS_WRL + 98304;
constexpr size_t WS_A2T = WS_W2T + 16384;
constexpr size_t WS_G2T = WS_A2T + 16384;
constexpr size_t WS_V1T = WS_G2T + 32768;
constexpr size_t WS_V2T = WS_V1T + 16384;
constexpr size_t WS_PWT = WS_V2T + 16384;
constexpr size_t WS_RINV2 = WS_PWT + 32768;
static_assert(WS_RINV2 + 65536 <= 2 * MiB, "small region");
constexpr size_t WS_WIN = 2 * MiB;
constexpr size_t WS_WOUT = 7 * MiB;
constexpr size_t WS_WGU = 9 * MiB;
constexpr size_t WS_WD = 25 * MiB;
constexpr size_t WS_LIST = 33 * MiB;
constexpr size_t WS_WLIST = 35 * MiB;
constexpr size_t WS_VFIRST = 37 * MiB;
constexpr size_t WS_ACT = 45 * MiB;
constexpr size_t WS_P = 77 * MiB;
constexpr size_t WS_RW = 157 * MiB;
constexpr size_t RW_R = WS_RW, RW_K = WS_RW + 8 * MiB, RW_V = WS_RW + 16 * MiB, RW_KAP = WS_RW + 24 * MiB, RW_B = WS_RW + 32 * MiB, RW_G = WS_RW + 40 * MiB;
constexpr size_t RW_LD = WS_RW + 48 * MiB;
constexpr size_t RW_W1 = WS_RW + 56 * MiB, RW_U0T = WS_RW + 64 * MiB, RW_M = WS_RW + 72 * MiB, RW_N = WS_RW + 80 * MiB, RW_S0 = WS_RW + 88 * MiB;
constexpr size_t RW_BONUS = WS_RW + 96 * MiB;
constexpr size_t RW_MG = RW_BONUS + 256 * 1024, RW_NG = RW_MG + 512 * 1024, RW_SG = RW_NG + 512 * 1024;
constexpr size_t WS_END = WS_RW + 98 * MiB;
static_assert(WS_END <= 256 * MiB, "workspace");

struct Args { const float* in[34]; float* out; unsigned char* ws; int ph_lo, ph_hi; };

__device__ __forceinline__ unsigned f2bf(float f) { unsigned u = __builtin_bit_cast(unsigned, f); return (u + 0x7fffu + ((u >> 16) & 1u)) >> 16; }
__device__ __forceinline__ float bf2f(unsigned h) { return __builtin_bit_cast(float, h << 16); }
__device__ __forceinline__ unsigned pk2(float lo, float hi) { return f2bf(lo) | (f2bf(hi) << 16); }
__device__ __forceinline__ float bflo(unsigned w) { return __builtin_bit_cast(float, w << 16); }
__device__ __forceinline__ float bfhi(unsigned w) { return __builtin_bit_cast(float, w & 0xffff0000u); }
__device__ __forceinline__ float sigmoidf_(float x) { return 1.f / (1.f + __expf(-x)); }
__device__ __forceinline__ float wave_sum(float v) {
#pragma unroll
    for (int o = 1; o < 64; o <<= 1) v += __shfl_xor(v, o);
    return v;
}
#define LDS_WAIT() asm volatile("s_waitcnt lgkmcnt(0)" ::: "memory")
__device__ __forceinline__ int swz128(int r, int c) { return r * 128 + ((c ^ ((r >> 1) & 7)) << 4); }
__device__ __forceinline__ int swz256(int r, int c) { return r * 256 + ((c ^ (r & 15)) << 4); }
__device__ __forceinline__ int swz512(int r, int c) { return r * 512 + ((c ^ (r & 15)) << 4); }
__device__ __forceinline__ f32x4 mfma16(bf16x8 a, bf16x8 b, f32x4 c) { return __builtin_amdgcn_mfma_f32_16x16x32_bf16(a, b, c, 0, 0, 0); }

struct Frame {
    ldsp lds; int tid, lane, wave, G, bid;
    const float* const* in; float* out; unsigned char* ws;
};

__device__ __forceinline__ bool fresh(Frame& F) { int t = (int)__builtin_amdgcn_mbcnt_hi(~0u, __builtin_amdgcn_mbcnt_lo(~0u, 0u)) + 64 * F.wave; asm volatile("" : "+v"(t)); F.tid = t; F.lane = t & 63; return true; }
typedef __attribute__((address_space(1))) unsigned long long gu64_t;
typedef __attribute__((address_space(1))) unsigned gu32_t;
__device__ __forceinline__ void st8_wt(void* p, u32x2 v) { __hip_atomic_store((gu64_t*)p, ((unsigned long long)v.y << 32) | (unsigned long long)v.x, __ATOMIC_RELAXED, __HIP_MEMORY_SCOPE_AGENT); }
__device__ __forceinline__ void st16_wt(void* p, u32x4 v) { st8_wt(p, (u32x2){v.x, v.y}); st8_wt((char*)p + 8, (u32x2){v.z, v.w}); }
__device__ __forceinline__ void flag_signal(Frame& F, unsigned* flag) {
    asm volatile("s_waitcnt vmcnt(0)" ::: "memory");
    __syncthreads();
    if (F.tid == 0) (void)__hip_atomic_fetch_add((gu32_t*)flag, 1u, __ATOMIC_RELAXED, __HIP_MEMORY_SCOPE_AGENT);
}
__device__ __forceinline__ void flag_poll(unsigned* flag, unsigned need) {
    unsigned sp = 0u;
    while (__hip_atomic_load((gu32_t*)flag, __ATOMIC_RELAXED, __HIP_MEMORY_SCOPE_AGENT) < need) { __builtin_amdgcn_s_sleep(2); if (++sp > (1u << 22)) break; }
}
__device__ __forceinline__ void flag_acquire(Frame& F) {
    if (F.tid == 0) { __builtin_amdgcn_fence(__ATOMIC_ACQUIRE, "agent"); asm volatile("s_waitcnt vmcnt(0)" ::: "memory"); }
    __syncthreads();
}
__device__ __forceinline__ void phase_mod(Frame& F) {
    const float* c = F.in[1]; const float* w_ada = F.in[2]; const float* b_ada = F.in[3];
    float* mod = (float*)(F.ws + WS_MOD);
    LAS float* red = (LAS float*)F.lds;
    for (int it = F.bid; it < 192; it += F.G) {
        const int l = it / 96, n0 = (it % 96) * 64;
        const float* W = w_ada + (size_t)l * DM * 6144 + n0 + F.lane;
        const int k0 = F.wave * 128;
        float acc = 0.f;
#pragma unroll 8
        for (int k = 0; k < 128; ++k) { const float cv = c[k0 + k]; const float s = cv / (1.f + __expf(-cv)); acc += s * W[(size_t)(k0 + k) * 6144]; }
        red[F.wave * 64 + F.lane] = acc;
        __syncthreads();
        if (F.wave == 0) { float s = b_ada[l * 6144 + n0 + F.lane];
#pragma unroll
            for (int w = 0; w < 8; ++w) s += red[w * 64 + F.lane];
            mod[l * 6144 + n0 + F.lane] = s; }
        __syncthreads();
    }
}

__device__ __forceinline__ float transpose_strip(const float* W, int N, int K, int kb, int kn, int n0, const float* rs_a, const float* rs_b, const float* cs, const float* sh,
                                                 bf16_t* dst, int dst_row0, LAS float* scr, int lane) {
    const int col = lane & 31, kp = lane >> 5;
    const float csv = cs ? cs[n0 + col] : 1.f;
    LAS float* scl = scr + 64 * 33;
    float bacc = 0.f;
#pragma unroll 1
    for (int k0 = kb; k0 < kb + kn; k0 += 64) {
        float wv[32];
#pragma unroll
        for (int i = 0; i < 32; ++i) wv[i] = W[(size_t)(k0 + 2 * i + kp) * N + n0 + col];
        scl[lane] = rs_a ? rs_a[k0 + lane] * (1.f + rs_b[k0 + lane]) : 1.f;
        scl[64 + lane] = sh ? sh[k0 + lane] : 0.f;
        LDS_WAIT();
#pragma unroll
        for (int i = 0; i < 32; ++i) { const int kk = 2 * i + kp; bacc += scl[64 + kk] * wv[i]; scr[kk * 33 + col] = wv[i] * csv * scl[kk]; }
        LDS_WAIT();
        const int c = lane & 7;
#pragma unroll
        for (int j = 0; j < 4; ++j) { const int n = (lane >> 3) + 8 * j; const LAS float* s = scr + (8 * c) * 33 + n;
            u32x4 o; o.x = pk2(s[0 * 33], s[1 * 33]); o.y = pk2(s[2 * 33], s[3 * 33]); o.z = pk2(s[4 * 33], s[5 * 33]); o.w = pk2(s[6 * 33], s[7 * 33]);
            *(u32x4*)(dst + (size_t)(dst_row0 + n) * K + k0 + 8 * c) = o; }
        LDS_WAIT();
    }
    bacc += __shfl_xor(bacc, 32);
    return bacc;
}
__device__ __forceinline__ void phase_prep(Frame& F, int l) {
    fresh(F);
    LAS float* scr = (LAS float*)(F.lds + F.wave * 16384);
    LAS float* red = (LAS float*)(F.lds + 131072);
    const float* mod = (const float*)(F.ws + WS_MOD) + l * 6144;
    const float *sh1 = mod, *sc1 = mod + 1024, *gt1 = mod + 2048, *sh2 = mod + 3072, *sc2 = mod + 4096, *gt2 = mod + 5120;
    const float* n1g = F.in[4] + l * DM; const float* n2g = F.in[5] + l * DM;
    const float* w_in = F.in[6] + (size_t)l * DM * NIN; const float* w_out = F.in[7] + (size_t)l * DM * DM;
    const float* wg = F.in[30] + (size_t)l * 32 * DM * 128; const float* wu = F.in[31] + (size_t)l * 32 * DM * 128; const float* wd = F.in[32] + (size_t)l * 32 * 128 * DM;
    bf16_t* WIN = (bf16_t*)(F.ws + WS_WIN); bf16_t* WOUT = (bf16_t*)(F.ws + WS_WOUT); bf16_t* WGU = (bf16_t*)(F.ws + WS_WGU); bf16_t* WD = (bf16_t*)(F.ws + WS_WD);
    float* bias_in = (float*)(F.ws + WS_BIN); float* bias_gu = (float*)(F.ws + WS_BGU); float* bias_r = (float*)(F.ws + WS_BR);
    constexpr int nA = 76, nB = 32, nC = 128, nD = 128, NFULL = nA + nB + nC + nD;
#pragma unroll 1
    for (int p = F.bid; p < NFULL / 2; p += F.G) {
        int r = 2 * p + (F.wave >> 2); const int q = F.wave & 3;
        const float* W; int N, n0, drow; const float *rsa = nullptr, *rsb = nullptr, *cs = nullptr, *sh = nullptr; float* bo = nullptr; bf16_t* dst;
        if (r < nA) { W = w_in; N = NIN; n0 = r * 32; rsa = n1g; rsb = sc1; sh = sh1; bo = bias_in + n0; dst = WIN; drow = n0; }
        else if (r < nA + nB) { r -= nA; W = w_out; N = DM; n0 = r * 32; cs = gt1; dst = WOUT; drow = n0; }
        else { r -= nA + nB; const int up = r >= nC ? 1 : 0; r -= up * nC; const int e = r >> 2, s = r & 3;
            W = (up ? wu : wg) + (size_t)e * DM * 128; N = 128; n0 = s * 32; rsa = n2g; rsb = sc2; sh = sh2; bo = bias_gu + e * 256 + up * 128 + s * 32; dst = WGU + (size_t)e * 256 * DM; drow = up * 128 + s * 32; }
        const float b = transpose_strip(W, N, DM, q * 256, 256, n0, rsa, rsb, cs, sh, dst, drow, scr, F.lane);
        if (F.lane < 32) red[F.wave * 32 + F.lane] = b;
        __syncthreads();
        if (q == 0 && F.lane < 32 && bo) bo[F.lane] = (red[F.wave * 32 + F.lane] + red[(F.wave + 1) * 32 + F.lane]) + (red[(F.wave + 2) * 32 + F.lane] + red[(F.wave + 3) * 32 + F.lane]);
        __syncthreads();
    }
    const int gw = F.bid * NWAVES + F.wave, NGW = F.G * NWAVES;
    constexpr int nE = 1024, nZ = 4, nF = 48, nG = 6, NIT = nE + nZ + nF + nG;
#pragma unroll 1
    for (int it = gw; it < NIT; it += NGW) {
        int r = it;
        if (r < nE) { const int e = r >> 5, s = r & 31; (void)transpose_strip(wd + (size_t)e * 128 * DM, DM, 128, 0, 128, s * 32, nullptr, nullptr, gt2, nullptr, WD + (size_t)e * DM * 128, s * 32, scr, F.lane); continue; } r -= nE;
        if (r < nZ) { const int rr = 76 + r; for (int i = F.lane; i < 32 * 128; i += 64) { const int n = i >> 7, c = i & 127; *(u32x4*)(WIN + (size_t)(rr * 32 + n) * DM + c * 8) = (u32x4){0u, 0u, 0u, 0u}; }
                      if (F.lane < 32) bias_in[rr * 32 + F.lane] = 0.f; continue; } r -= nZ;
        if (r < nF) {
            bf16_t* wh = (bf16_t*)(F.ws + WS_WRH) + r * DM; bf16_t* wl = (bf16_t*)(F.ws + WS_WRL) + r * DM;
            float bacc = 0.f;
            for (int k = F.lane; k < DM; k += 64) {
                float wv = 0.f;
                if (r < 4) wv = F.in[26][(size_t)l * DM * 4 + k * 4 + r]; else if (r < 36) wv = F.in[28][(size_t)l * DM * 32 + k * 32 + (r - 4)];
                bacc += sh2[k] * wv;
                const float v = wv * n2g[k] * (1.f + sc2[k]);
                const unsigned h = f2bf(v); const unsigned lo = f2bf(v - bf2f(h));
                wh[k] = (bf16_t)h; wl[k] = (bf16_t)lo; }
            bacc = wave_sum(bacc);
            if (F.lane == 0) { float b = 0.f; if (r < 4) b = F.in[27][l * 4 + r]; else if (r < 36) b = F.in[29][l * 32 + r - 4]; bias_r[r] = bacc + b; }
            continue; } r -= nF;
        if (r == 0) { const float* s = F.in[14] + l * 32 * 256; bf16_t* d = (bf16_t*)(F.ws + WS_W2T); for (int i = F.lane; i < 8192; i += 64) { const int n = i >> 5, k = i & 31; d[i] = (bf16_t)f2bf(s[k * 256 + n]); } }
        else if (r == 1) { const float* s = F.in[16] + l * 32 * 256; bf16_t* d = (bf16_t*)(F.ws + WS_A2T); for (int i = F.lane; i < 8192; i += 64) { const int n = i >> 5, k = i & 31; d[i] = (bf16_t)f2bf(s[k * 256 + n]); } }
        else if (r == 2) { const float* s = F.in[17] + l * 64 * 256; bf16_t* d = (bf16_t*)(F.ws + WS_G2T); for (int i = F.lane; i < 16384; i += 64) { const int n = i >> 6, k = i & 63; d[i] = (bf16_t)f2bf(s[k * 256 + n]); } }
        else if (r == 3) { if (l > 0) { const float* s = F.in[24] + (l - 1) * 256 * 32; bf16_t* d = (bf16_t*)(F.ws + WS_V1T); for (int i = F.lane; i < 8192; i += 64) { const int n = i >> 8, k = i & 255; d[i] = (bf16_t)f2bf(s[k * 32 + n]); } } }
        else if (r == 4) { if (l > 0) { const float* s = F.in[25] + (l - 1) * 32 * 256; bf16_t* d = (bf16_t*)(F.ws + WS_V2T); for (int i = F.lane; i < 8192; i += 64) { const int n = i >> 5, k = i & 31; d[i] = (bf16_t)f2bf(s[k * 256 + n]); } } }
        else { const float* s = F.in[8] + l * 4 * 64 * 64; bf16_t* d = (bf16_t*)(F.ws + WS_PWT); for (int i = F.lane; i < 16384; i += 64) { const int j = i >> 12, e = (i >> 6) & 63, c = i & 63; d[i] = (bf16_t)f2bf(s[(j * 64 + c) * 64 + e]); } }
    }
}

__device__ __forceinline__ void phase_rownorm(Frame& F, int mode) {
    const float* xin = (mode == 0) ? F.in[0] : F.out;
    const bf16_t* ys0 = (const bf16_t*)(F.ws + WS_P); const bf16_t* ys1 = ys0 + (size_t)T_ * DM;
    bf16_t* xn = (bf16_t*)(F.ws + WS_ACT);
    const float* fg = F.in[33];
    const int gw = F.bid * NWAVES + F.wave, NGW = F.G * NWAVES;
#pragma unroll 1
    for (int m0 = gw; m0 < T_; m0 += 2 * NGW) {
        f32x4 v[2][4]; u32x2 ya[2][4], yb[2][4];
#pragma unroll
        for (int r = 0; r < 2; ++r) { const int m = (m0 + r * NGW < T_) ? m0 + r * NGW : m0;
            const f32x4* xr = (const f32x4*)(xin + (size_t)m * DM) + F.lane;
#pragma unroll
            for (int j = 0; j < 4; ++j) v[r][j] = xr[64 * j];
            if (mode != 0) { const u32x2* a = (const u32x2*)(ys0 + (size_t)m * DM) + F.lane; const u32x2* b = (const u32x2*)(ys1 + (size_t)m * DM) + F.lane;
#pragma unroll
                for (int j = 0; j < 4; ++j) { ya[r][j] = a[64 * j]; yb[r][j] = b[64 * j]; } } }
#pragma unroll
        for (int r = 0; r < 2; ++r) { const int m = m0 + r * NGW; if (m < T_) {
            float s = 0.f;
            if (mode != 0) {
#pragma unroll
                for (int j = 0; j < 4; ++j) { const u32x2 ua = ya[r][j], ub = yb[r][j];
                    v[r][j][0] += bflo(ua.x) + bflo(ub.x); v[r][j][1] += bfhi(ua.x) + bfhi(ub.x); v[r][j][2] += bflo(ua.y) + bflo(ub.y); v[r][j][3] += bfhi(ua.y) + bfhi(ub.y); } }
#pragma unroll
            for (int j = 0; j < 4; ++j) s += (v[r][j][0] * v[r][j][0] + v[r][j][1] * v[r][j][1]) + (v[r][j][2] * v[r][j][2] + v[r][j][3] * v[r][j][3]);
            const float rinv = 1.f / sqrtf(wave_sum(s) * (1.f / DM) + 1e-6f);
            if (mode == 2) {
                f32x4* o = (f32x4*)(F.out + (size_t)m * DM) + F.lane;
#pragma unroll
                for (int j = 0; j < 4; ++j) { const f32x4 g = *((const f32x4*)fg + F.lane + 64 * j); o[64 * j] = v[r][j] * rinv * g; }
            } else {
                if (mode == 1) { f32x4* o = (f32x4*)(F.out + (size_t)m * DM) + F.lane;
#pragma unroll
                    for (int j = 0; j < 4; ++j) o[64 * j] = v[r][j]; }
                u32x2* o8 = (u32x2*)(xn + (size_t)m * DM) + F.lane;
#pragma unroll
                for (int j = 0; j < 4; ++j) { u32x2 w; w.x = pk2(v[r][j][0] * rinv, v[r][j][1] * rinv); w.y = pk2(v[r][j][2] * rinv, v[r][j][3] * rinv); o8[64 * j] = w; }
            } } }
    }
}

__device__ __forceinline__ void attn_item(Frame& F, int l, int item) {
    const int t0 = item * 128;
    const bf16_t* P = (const bf16_t*)(F.ws + WS_P);
    bf16_t* ycat = (bf16_t*)(F.ws + WS_ACT);
    ldsp Ks = F.lds, Vt = F.lds + 65536;
#pragma unroll 1
    for (int b = 0; b < 2; ++b) {
        u32x4 kq[4], vq[4];
#pragma unroll
        for (int q = 0; q < 4; ++q) { const int i = F.tid + (b * 4 + q) * NTHR; const int ko = i >> 4, kvh = (i >> 3) & 1, c = i & 7; const int s = t0 - 128 + ko; const int sc = s < 0 ? 0 : s;
            kq[q] = *(const u32x4*)(P + (size_t)sc * NINP + C_K + kvh * 64 + c * 8); vq[q] = *(const u32x4*)(P + (size_t)sc * NINP + C_V + kvh * 64 + c * 8); }
#pragma unroll
        for (int q = 0; q < 4; ++q) { const int i = F.tid + (b * 4 + q) * NTHR; const int ko = i >> 4, kvh = (i >> 3) & 1, c = i & 7; const int s = t0 - 128 + ko;
            const u32x4 z4 = (u32x4){0u, 0u, 0u, 0u}; const u32x4 kv = (s >= 0) ? kq[q] : z4, vv = (s >= 0) ? vq[q] : z4;
            *(LAS u32x4*)(Ks + kvh * 32768 + swz128(ko, c)) = kv;
            const int k32 = ko & 31, sg = ko >> 5, g = (k32 >> 2) & 3, j = ((k32 >> 4) << 2) | (k32 & 3), chunk = sg * 4 + g;
            const unsigned vw[4] = {vv.x, vv.y, vv.z, vv.w};
#pragma unroll
            for (int e = 0; e < 8; ++e) { const int d = c * 8 + e; const unsigned short val = (unsigned short)((e & 1) ? (vw[e >> 1] >> 16) : (vw[e >> 1] & 0xffffu));
                *(LAS unsigned short*)(Vt + kvh * 32768 + swz512(d, chunk) + j * 2) = val; } }
    }
    __syncthreads();
    const int h = F.wave >> 1, half = F.wave & 1, kvh = h >> 1, fr = F.lane & 15, g = F.lane >> 4;
    const float slope = exp2f(-2.f * (float)(h + 1));
    const float sink = F.in[10][l * 4 + h];
    ldsp Kh = Ks + kvh * 32768, Vh = Vt + kvh * 32768;
#pragma unroll 1
    for (int qt = 0; qt < 4; ++qt) {
        const int q_lo = 64 * half + 16 * qt, qo = q_lo + fr, tile0 = (q_lo >> 5) << 1;
        bf16x8 qf[2];
#pragma unroll
        for (int ks = 0; ks < 2; ++ks) qf[ks] = *(const bf16x8*)(P + (size_t)(t0 + qo) * NINP + C_Q + h * 64 + ks * 32 + g * 8);
        f32x4 s[10];
#pragma unroll
        for (int kt = 0; kt < 10; ++kt) { s[kt] = (f32x4){0.f, 0.f, 0.f, 0.f};
#pragma unroll
            for (int ks = 0; ks < 2; ++ks) { const bf16x8 a = *(const LAS bf16x8*)(Kh + swz128((tile0 + kt) * 16 + fr, ks * 4 + g)); s[kt] = mfma16(a, qf[ks], s[kt]); } }
        float m = sink;
#pragma unroll
        for (int kt = 0; kt < 10; ++kt)
#pragma unroll
            for (int j = 0; j < 4; ++j) { const int ko = 16 * (tile0 + kt) + 4 * g + j; const int dist = qo + 128 - ko;
                const bool valid = (dist >= 0) && (dist < 128) && (t0 - 128 + ko >= 0);
                const float v = valid ? s[kt][j] * 0.125f - slope * (float)dist : -INFINITY; s[kt][j] = v; m = fmaxf(m, v); }
        m = fmaxf(m, __shfl_xor(m, 16)); m = fmaxf(m, __shfl_xor(m, 32));
        float sum = 0.f;
#pragma unroll
        for (int kt = 0; kt < 10; ++kt)
#pragma unroll
            for (int j = 0; j < 4; ++j) { const float p = __expf(s[kt][j] - m); s[kt][j] = p; sum += p; }
        sum += __shfl_xor(sum, 16); sum += __shfl_xor(sum, 32);
        const float inv = 1.f / (sum + __expf(sink - m));
        f32x4 o[4];
#pragma unroll
        for (int dt = 0; dt < 4; ++dt) o[dt] = (f32x4){0.f, 0.f, 0.f, 0.f};
#pragma unroll
        for (int ss = 0; ss < 5; ++ss) {
            u32x4 pw; pw.x = pk2(s[2 * ss][0], s[2 * ss][1]); pw.y = pk2(s[2 * ss][2], s[2 * ss][3]); pw.z = pk2(s[2 * ss + 1][0], s[2 * ss + 1][1]); pw.w = pk2(s[2 * ss + 1][2], s[2 * ss + 1][3]);
            const bf16x8 pb = __builtin_bit_cast(bf16x8, pw);
#pragma unroll
            for (int dt = 0; dt < 4; ++dt) { const bf16x8 a = *(const LAS bf16x8*)(Vh + swz512(dt * 16 + fr, ((tile0 >> 1) + ss) * 4 + g)); o[dt] = mfma16(a, pb, o[dt]); }
        }
#pragma unroll
        for (int dt = 0; dt < 4; ++dt) { u32x2 w; w.x = pk2(o[dt][0] * inv, o[dt][1] * inv); w.y = pk2(o[dt][2] * inv, o[dt][3] * inv);
            *(u32x2*)(ycat + (size_t)(t0 + qo) * DM + 256 + h * 64 + dt * 16 + 4 * g) = w; }
    }
    __syncthreads();
}

__device__ __forceinline__ void poolconv_item(Frame& F, int l, int item) {
    const int t0 = item * 128;
    const bf16_t* P = (const bf16_t*)(F.ws + WS_P);
    bf16_t* ycat = (bf16_t*)(F.ws + WS_ACT);
    ldsp U = F.lds;
    ldsp Dt = F.lds + 73728;
    {   u32x4 uv[9];
#pragma unroll
        for (int q = 0; q < 9; ++q) { const int i = F.tid + q * NTHR; const int r = i >> 5, c = i & 31; const int s = t0 - 16 + r; uv[q] = *(const u32x4*)(P + (size_t)(s < 0 ? 0 : s) * NINP + c * 8); }
#pragma unroll
        for (int q = 0; q < 9; ++q) { const int i = F.tid + q * NTHR; const int r = i >> 5, c = i & 31; const int s = t0 - 16 + r;
            *(LAS u32x4*)(U + r * 512 + c * 16) = (s >= 0) ? uv[q] : (u32x4){0u, 0u, 0u, 0u}; } }
    __syncthreads();
    for (int i = F.tid; i < 128 * 32; i += NTHR) { const int tok = i >> 5, c8 = i & 31, j = c8 >> 3, w = 2 << j; const int t = t0 + tok;
        float acc[8];
#pragma unroll
        for (int e = 0; e < 8; ++e) acc[e] = 0.f;
        u32x4 cur = (u32x4){0u, 0u, 0u, 0u};
        for (int q = 0; q < w; ++q) { const u32x4 v = *(const LAS u32x4*)(U + (tok + 16 - q) * 512 + c8 * 16); if (q == 0) cur = v;
            acc[0] += bflo(v.x); acc[1] += bfhi(v.x); acc[2] += bflo(v.y); acc[3] += bfhi(v.y); acc[4] += bflo(v.z); acc[5] += bfhi(v.z); acc[6] += bflo(v.w); acc[7] += bfhi(v.w); }
        const float ic = 1.f / (float)((t + 1) < w ? (t + 1) : w);
        u32x4 o; o.x = pk2(acc[0] * ic - bflo(cur.x), acc[1] * ic - bfhi(cur.x)); o.y = pk2(acc[2] * ic - bflo(cur.y), acc[3] * ic - bfhi(cur.y));
        o.z = pk2(acc[4] * ic - bflo(cur.z), acc[5] * ic - bfhi(cur.z)); o.w = pk2(acc[6] * ic - bflo(cur.w), acc[7] * ic - bfhi(cur.w));
        *(LAS u32x4*)(Dt + j * 16384 + swz128(tok, c8 & 7)) = o; }
    __syncthreads();
    {
        const int j = F.wave >> 1, half = F.wave & 1, fr = F.lane & 15, g = F.lane >> 4;
        const bf16_t* pwt = (const bf16_t*)(F.ws + WS_PWT) + j * 4096;
        const float* psc = F.in[9] + l * 256 + j * 64;
        bf16x8 bfr[4][2];
#pragma unroll
        for (int n = 0; n < 4; ++n)
#pragma unroll
            for (int ks = 0; ks < 2; ++ks) bfr[n][ks] = *(const bf16x8*)(pwt + (16 * n + fr) * 64 + ks * 32 + g * 8);
#pragma unroll
        for (int m = 0; m < 4; ++m) {
            bf16x8 af[2];
#pragma unroll
            for (int ks = 0; ks < 2; ++ks) af[ks] = *(const LAS bf16x8*)(Dt + j * 16384 + swz128(64 * half + 16 * m + fr, ks * 4 + g));
#pragma unroll
            for (int n = 0; n < 4; ++n) { f32x4 acc = (f32x4){0.f, 0.f, 0.f, 0.f};
#pragma unroll
                for (int ks = 0; ks < 2; ++ks) acc = mfma16(bfr[n][ks], af[ks], acc);
                const f32x4 sc = *(const f32x4*)(psc + 16 * n + 4 * g);
                u32x2 w; w.x = pk2(acc[0] * sc[0], acc[1] * sc[1]); w.y = pk2(acc[2] * sc[2], acc[3] * sc[3]);
                *(u32x2*)(ycat + (size_t)(t0 + 64 * half + 16 * m + fr) * DM + j * 64 + 16 * n + 4 * g) = w; }
        }
    }
    const float* cw = F.in[11] + l * 3 * 256;
#pragma unroll 2
    for (int i = F.tid; i < 128 * 32; i += NTHR) { const int tok = i >> 5, c8 = i & 31; const int t = t0 + tok;
        u32x4 a[3], b[3];
#pragma unroll
        for (int q = 0; q < 3; ++q) { const int s = t - 2 + q; const int sc = s < 0 ? 0 : s; a[q] = *(const u32x4*)(P + (size_t)sc * NINP + C_CG + c8 * 8); b[q] = *(const u32x4*)(P + (size_t)sc * NINP + C_XIN + c8 * 8); }
        const u32x4 bg = *(const u32x4*)(P + (size_t)t * NINP + C_BG + c8 * 8);
        float acc[8];
#pragma unroll
        for (int e = 0; e < 8; ++e) acc[e] = 0.f;
#pragma unroll
        for (int q = 0; q < 3; ++q) { const int s = t - 2 + q; const float m = (s >= 0) ? 1.f : 0.f;
            const f32x4 w0 = *(const f32x4*)(cw + q * 256 + c8 * 8) * m, w1 = *(const f32x4*)(cw + q * 256 + c8 * 8 + 4) * m;
            acc[0] += w0[0] * bflo(a[q].x) * bflo(b[q].x); acc[1] += w0[1] * bfhi(a[q].x) * bfhi(b[q].x); acc[2] += w0[2] * bflo(a[q].y) * bflo(b[q].y); acc[3] += w0[3] * bfhi(a[q].y) * bfhi(b[q].y);
            acc[4] += w1[0] * bflo(a[q].z) * bflo(b[q].z); acc[5] += w1[1] * bfhi(a[q].z) * bfhi(b[q].z); acc[6] += w1[2] * bflo(a[q].w) * bflo(b[q].w); acc[7] += w1[3] * bfhi(a[q].w) * bfhi(b[q].w); }
        u32x4 o; o.x = pk2(acc[0] * bflo(bg.x), acc[1] * bfhi(bg.x)); o.y = pk2(acc[2] * bflo(bg.y), acc[3] * bfhi(bg.y));
        o.z = pk2(acc[4] * bflo(bg.z), acc[5] * bfhi(bg.z)); o.w = pk2(acc[6] * bflo(bg.w), acc[7] * bfhi(bg.w));
        *(u32x4*)(ycat + (size_t)t * DM + 512 + c8 * 8) = o; }
    __syncthreads();
}

__device__ __forceinline__ f32x4 up4_(u32x2 w) { return (f32x4){bflo(w.x), bfhi(w.x), bflo(w.y), bfhi(w.y)}; }
__device__ __forceinline__ u32x2 pk4_(f32x4 v) { u32x2 w; w.x = pk2(v[0], v[1]); w.y = pk2(v[2], v[3]); return w; }
__device__ __forceinline__ u32x4 lerp8(u32x4 cur, u32x4 prv, const float* mu, int act) {
    const unsigned cw[4] = {cur.x, cur.y, cur.z, cur.w}, pw[4] = {prv.x, prv.y, prv.z, prv.w}; float z[8];
#pragma unroll
    for (int e = 0; e < 8; ++e) { const float c = (e & 1) ? bfhi(cw[e >> 1]) : bflo(cw[e >> 1]), p = (e & 1) ? bfhi(pw[e >> 1]) : bflo(pw[e >> 1]);
        float v = c + (p - c) * mu[e]; if (act == 1) v = tanhf(v); else if (act == 2) v = sigmoidf_(v); z[e] = v; }
    u32x4 o; o.x = pk2(z[0], z[1]); o.y = pk2(z[2], z[3]); o.z = pk2(z[4], z[5]); o.w = pk2(z[6], z[7]); return o;
}
__device__ __forceinline__ void rwkvprep_item(Frame& F, int l, int item) {
    const int t0 = item * 64;
    const bf16_t* P = (const bf16_t*)(F.ws + WS_P);
    const float* mu = F.in[12] + l * 896;
    ldsp Zw = F.lds, Za = F.lds + 4096, Zg = F.lds + 8192, Zr = F.lds + 16384, Zk = F.lds + 49152, Zv = F.lds + 81920, V1 = F.lds + 114688 + F.wave * 1024;
    LAS float* Pm = (LAS float*)(F.lds + 122880); ldsp VFt = F.lds + 129024;
    {   const float* srcs[6] = {F.in[13] + l * 256, F.in[15] + l * 256, F.in[18] + l * 256, F.in[19] + l * 256, F.in[20] + l * 256, (l > 0) ? F.in[23] + (l - 1) * 256 : F.in[13] + l * 256};
#pragma unroll
        for (int q = 0; q < 3; ++q) { const int i = F.tid + q * NTHR; Pm[i] = srcs[i >> 8][i & 255]; }
        if (l > 0) { const bf16_t* VFg = (const bf16_t*)(F.ws + WS_VFIRST); u32x4 vq[4];
#pragma unroll
            for (int q = 0; q < 4; ++q) { const int i = F.tid + q * NTHR; vq[q] = *(const u32x4*)(VFg + (size_t)(t0 + (i >> 5)) * 256 + (i & 31) * 8); }
#pragma unroll
            for (int q = 0; q < 4; ++q) { const int i = F.tid + q * NTHR; *(LAS u32x4*)(VFt + swz512(i >> 5, i & 31)) = vq[q]; } }
    }
#pragma unroll 1
    for (int b = 0; b < 2; ++b) {
        u32x4 cu[6], pv[6];
#pragma unroll
        for (int q = 0; q < 6; ++q) { const int i = F.tid + (b * 6 + q) * NTHR; const int tok = i / 96, c = i - tok * 96; const int t = t0 + tok;
            cu[q] = *(const u32x4*)(P + (size_t)t * NINP + C_D + c * 8); pv[q] = *(const u32x4*)(P + (size_t)(t > 0 ? t - 1 : 0) * NINP + C_D + c * 8); }
#pragma unroll
        for (int q = 0; q < 6; ++q) { const int i = F.tid + (b * 6 + q) * NTHR; const int tok = i / 96, c = i - tok * 96; const int t = t0 + tok;
            const u32x4 prv = (t > 0) ? pv[q] : (u32x4){0u, 0u, 0u, 0u};
            const u32x4 z = lerp8(cu[q], prv, mu + c * 8, 0);
            *(LAS u32x4*)(F.lds + 16384 + (c >> 5) * 32768 + swz512(tok, c & 31)) = z; }
    }
    {   u32x4 cu[2], pv[2];
#pragma unroll
        for (int q = 0; q < 2; ++q) { const int i = F.tid + q * NTHR; const int tok = i >> 4, c = i & 15; const int t = t0 + tok;
            cu[q] = *(const u32x4*)(P + (size_t)t * NINP + C_D + 768 + c * 8); pv[q] = *(const u32x4*)(P + (size_t)(t > 0 ? t - 1 : 0) * NINP + C_D + 768 + c * 8); }
#pragma unroll
        for (int q = 0; q < 2; ++q) { const int i = F.tid + q * NTHR; const int tok = i >> 4, c = i & 15; const int t = t0 + tok;
            const u32x4 prv = (t > 0) ? pv[q] : (u32x4){0u, 0u, 0u, 0u};
            if (c < 4) *(LAS u32x4*)(Zw + tok * 64 + c * 16) = lerp8(cu[q], prv, mu + 768 + c * 8, 1);
            else if (c < 8) *(LAS u32x4*)(Za + tok * 64 + (c - 4) * 16) = lerp8(cu[q], prv, mu + 768 + c * 8, 0);
            else *(LAS u32x4*)(Zg + swz128(tok, c - 8)) = lerp8(cu[q], prv, mu + 768 + c * 8, 2); }
    }
    __syncthreads();
    const int h = F.wave >> 1, half = F.wave & 1, fr = F.lane & 15, g = F.lane >> 4;
    const bf16_t* w2t = (const bf16_t*)(F.ws + WS_W2T); const bf16_t* a2t = (const bf16_t*)(F.ws + WS_A2T); const bf16_t* g2t = (const bf16_t*)(F.ws + WS_G2T);
    const bf16_t* v1t = (const bf16_t*)(F.ws + WS_V1T); const bf16_t* v2t = (const bf16_t*)(F.ws + WS_V2T);
    const float *w0 = F.in[13] + l * 256, *a0 = F.in[15] + l * 256, *kkp = F.in[18] + l * 256, *kap = F.in[19] + l * 256, *rkp = F.in[20] + l * 256;
    const float* v0 = (l > 0) ? F.in[23] + (l - 1) * 256 : nullptr;
    bf16_t *Rr = (bf16_t*)(F.ws + RW_R), *Rk = (bf16_t*)(F.ws + RW_K), *Rv = (bf16_t*)(F.ws + RW_V), *Rkap = (bf16_t*)(F.ws + RW_KAP), *Rb = (bf16_t*)(F.ws + RW_B), *Rg = (bf16_t*)(F.ws + RW_G);
    bf16_t* Rld = (bf16_t*)(F.ws + RW_LD); float* Rbon = (float*)(F.ws + RW_BONUS); bf16_t* VF = (bf16_t*)(F.ws + WS_VFIRST);
#pragma unroll 1
    for (int m = 0; m < 2; ++m) {
        asm volatile("" ::: "memory");
        const int row = 32 * half + 16 * m + fr;
        const bf16x8 aw = *(const LAS bf16x8*)(Zw + row * 64 + g * 16), aa = *(const LAS bf16x8*)(Za + row * 64 + g * 16);
        const bf16x8 ag0 = *(const LAS bf16x8*)(Zg + swz128(row, g)), ag1 = *(const LAS bf16x8*)(Zg + swz128(row, 4 + g));
        bf16x8 a1 = aw;
        if (l > 0) {
            f32x4 t1[2]; t1[0] = (f32x4){0.f, 0.f, 0.f, 0.f}; t1[1] = t1[0];
#pragma unroll
            for (int ks = 0; ks < 8; ++ks) { const bf16x8 av_ = *(const LAS bf16x8*)(Zv + swz512(row, ks * 4 + g));
#pragma unroll
                for (int n = 0; n < 2; ++n) t1[n] = mfma16(*(const bf16x8*)(v1t + (16 * n + fr) * 256 + ks * 32 + g * 8), av_, t1[n]); }
#pragma unroll
            for (int n = 0; n < 2; ++n) { u32x2 w; w.x = pk2(t1[n][0], t1[n][1]); w.y = pk2(t1[n][2], t1[n][3]); *(LAS u32x2*)(V1 + fr * 64 + (16 * n + 4 * g) * 2) = w; }
            LDS_WAIT();
            a1 = *(const LAS bf16x8*)(V1 + fr * 64 + g * 16);
            LDS_WAIT();
        }
        const int t = t0 + row;
        float ss = 0.f;
#pragma unroll
        for (int n = 0; n < 4; ++n) { const int ch = 64 * h + 16 * n + 4 * g;
            const f32x4 kz = up4_(*(const LAS u32x2*)(Zk + swz512(row, ch >> 3) + (g & 1) * 8)), kkv = *(const LAS f32x4*)(Pm + 512 + ch);
#pragma unroll
            for (int j = 0; j < 4; ++j) { const float kk = kz[j] * kkv[j]; ss += kk * kk; } }
        ss += __shfl_xor(ss, 16); ss += __shfl_xor(ss, 32);
        const float inn = 1.f / fmaxf(sqrtf(ss), 1e-12f);
        float bon = 0.f;
#pragma unroll
        for (int n = 0; n < 4; ++n) { const int ch = 64 * h + 16 * n + 4 * g;
            const int nr = 64 * h + 16 * n + fr; const f32x4 z0 = (f32x4){0.f, 0.f, 0.f, 0.f};
            const f32x4 wl = mfma16(*(const bf16x8*)(w2t + nr * 32 + g * 8), aw, z0);
            const f32x4 al = mfma16(*(const bf16x8*)(a2t + nr * 32 + g * 8), aa, z0);
            f32x4 gl = mfma16(*(const bf16x8*)(g2t + nr * 64 + g * 8), ag0, z0); gl = mfma16(*(const bf16x8*)(g2t + nr * 64 + 32 + g * 8), ag1, gl);
            f32x4 vl = z0; if (l > 0) vl = mfma16(*(const bf16x8*)(v2t + nr * 32 + g * 8), a1, z0);
            const int zo = swz512(row, ch >> 3) + (g & 1) * 8;
            const f32x4 rz = up4_(*(const LAS u32x2*)(Zr + zo)), kz = up4_(*(const LAS u32x2*)(Zk + zo)), vz = up4_(*(const LAS u32x2*)(Zv + zo));
            u32x2 vf = (u32x2){0u, 0u}; if (l > 0) vf = *(const LAS u32x2*)(VFt + zo);
            const f32x4 vfv = up4_(vf);
            const f32x4 w0v = *(const LAS f32x4*)(Pm + ch), a0v = *(const LAS f32x4*)(Pm + 256 + ch), kkv = *(const LAS f32x4*)(Pm + 512 + ch), kav = *(const LAS f32x4*)(Pm + 768 + ch), rkv = *(const LAS f32x4*)(Pm + 1024 + ch);
            const f32x4 v0v = *(const LAS f32x4*)(Pm + 1280 + ch);
            f32x4 vout, ldv, kmod, kp_, b_;
#pragma unroll
            for (int j = 0; j < 4; ++j) {
                const float r_ = rz[j], k_ = kz[j], v_ = vz[j];
                const float wpre = w0v[j] + wl[j]; const float y = -wpre; const float sp = fmaxf(y, 0.f) + log1pf(__expf(-fabsf(y)));
                const float w = -sp - 0.5f; ldv[j] = -__expf(w);
                const float a = sigmoidf_(a0v[j] + al[j]);
                float vv = v_; if (l > 0) vv = v_ + (vfv[j] - v_) * sigmoidf_(v0v[j] + vl[j]);
                vout[j] = vv;
                kp_[j] = k_ * kkv[j] * inn; b_[j] = kp_[j] * a;
                const float km = k_ * (1.f + (a - 1.f) * kav[j]); kmod[j] = km; bon += r_ * km * rkv[j]; }
            const size_t o = (size_t)t * 256 + ch;
            *(u32x2*)(Rr + o) = *(const LAS u32x2*)(Zr + zo); *(u32x2*)(Rk + o) = pk4_(kmod);
            { const u32x2 w = pk4_(vout); *(u32x2*)(Rv + o) = w; if (l == 0) *(u32x2*)(VF + o) = w; }
            *(u32x2*)(Rg + o) = pk4_(gl); *(u32x2*)(Rld + o) = pk4_(ldv);
            *(u32x2*)(Rkap + o) = pk4_(kp_); *(u32x2*)(Rb + o) = pk4_(b_);
        }
        bon += __shfl_xor(bon, 16); bon += __shfl_xor(bon, 32);
        if (g == 0) Rbon[(size_t)t * 4 + h] = bon;
    }
    __syncthreads();
}

__device__ __forceinline__ void mm_n(ldsp X, ldsp Y, int rb, int cb, int fr, int g, f32x4 (&acc)[2]) {
#pragma unroll
    for (int ks = 0; ks < 2; ++ks) { const bf16x8 xf = *(const LAS bf16x8*)(X + swz128(16 * rb + fr, ks * 4 + g));
#pragma unroll
        for (int n = 0; n < 2; ++n) { const bf16x8 yf = *(const LAS bf16x8*)(Y + swz128(32 * cb + 16 * n + fr, ks * 4 + g)); acc[n] = mfma16(yf, xf, acc[n]); } }
}
__device__ __forceinline__ void mm_t(ldsp X, ldsp Y, int rb, int cb, int fr, int g, f32x4 (&acc)[2]) {
#pragma unroll
    for (int ks = 0; ks < 2; ++ks) { const bf16x8 xf = *(const LAS bf16x8*)(X + swz128(16 * rb + fr, ks * 4 + g));
#pragma unroll
        for (int n = 0; n < 2; ++n) { const bf16x8 yf = *(const LAS bf16x8*)(Y + swz128(32 * cb + 16 * n + fr, ks * 4 + g)); acc[n] = mfma16(xf, yf, acc[n]); } }
}
__device__ __forceinline__ int adr_n(int rb, int cb, int n, int fr, int g) { return swz128(16 * rb + fr, 4 * cb + 2 * n + (g >> 1)) + (g & 1) * 8; }
__device__ __forceinline__ int adr_t(int rb, int cb, int n, int fr, int g) { return swz128(32 * cb + 16 * n + fr, 2 * rb + (g >> 1)) + (g & 1) * 8; }
__device__ __forceinline__ u32x2 pk4(f32x4 v) { u32x2 w; w.x = pk2(v[0], v[1]); w.y = pk2(v[2], v[3]); return w; }
__device__ __forceinline__ f32x4 up4(u32x2 w) { return (f32x4){bflo(w.x), bfhi(w.x), bflo(w.y), bfhi(w.y)}; }

__device__ __forceinline__ void chunk_prefix(Frame& F, const bf16_t* Rld, int t0, int h, LAS float* Lc, LAS float* seg) {
    { const int t = F.tid >> 3, c8 = F.tid & 7; const u32x4 v = *(const u32x4*)(Rld + (size_t)(t0 + t) * 256 + h * 64 + c8 * 8);
      LAS float* d = Lc + t * 64 + c8 * 8; d[0] = bflo(v.x); d[1] = bfhi(v.x); d[2] = bflo(v.y); d[3] = bfhi(v.y); d[4] = bflo(v.z); d[5] = bfhi(v.z); d[6] = bflo(v.w); d[7] = bfhi(v.w); }
    __syncthreads();
    { float s = 0.f;
#pragma unroll
      for (int i = 0; i < 8; ++i) { s += Lc[(8 * F.wave + i) * 64 + F.lane]; Lc[(8 * F.wave + i) * 64 + F.lane] = s; }
      seg[F.wave * 64 + F.lane] = s; }
    __syncthreads();
    { float off = 0.f;
      for (int w = 0; w < F.wave; ++w) off += seg[w * 64 + F.lane];
#pragma unroll
      for (int i = 0; i < 8; ++i) Lc[(8 * F.wave + i) * 64 + F.lane] += off; }
    __syncthreads();
}
__device__ __forceinline__ void unpack8(u32x4 v, float (&o)[8]) { o[0] = bflo(v.x); o[1] = bfhi(v.x); o[2] = bflo(v.y); o[3] = bfhi(v.y); o[4] = bflo(v.z); o[5] = bfhi(v.z); o[6] = bflo(v.w); o[7] = bfhi(v.w); }
__device__ __forceinline__ u32x4 pack8(const float (&o)[8]) { u32x4 w; w.x = pk2(o[0], o[1]); w.y = pk2(o[2], o[3]); w.z = pk2(o[4], o[5]); w.w = pk2(o[6], o[7]); return w; }
__device__ __forceinline__ void st_tr8(ldsp tile, int t, int c8, const float (&o)[8]) {
#pragma unroll
    for (int e = 0; e < 8; ++e) *(LAS unsigned short*)(tile + swz128(c8 * 8 + e, t >> 3) + (t & 7) * 2) = (unsigned short)f2bf(o[e]);
}

constexpr int R1_LC = 0, R1_SEG = 16384, R1_GC = 18432, R1_KQ = 20480, R1_BK = 28672, R1_KK = 36864, R1_KABS = 45056, R1_KABST = 53248, R1_BHT = 61440, R1_KHT = 69632, R1_VT = 77824,
              R1_E = 86016  , R1_Q = 102400  , R1_QT = 118784  , R1_AAK = 135168, R1_AVT = R1_Q, R1_W1T = R1_Q + 8192, R1_U0T = R1_QT;
__device__ __forceinline__ void rwkv_r1_item(Frame& F, int item) {
    const int c = item >> 2, h = item & 3, t0 = c * 64;
    const bf16_t *Rk = (const bf16_t*)(F.ws + RW_K), *Rv = (const bf16_t*)(F.ws + RW_V), *Rkap = (const bf16_t*)(F.ws + RW_KAP), *Rb = (const bf16_t*)(F.ws + RW_B), *Rld = (const bf16_t*)(F.ws + RW_LD);
    bf16_t *GW1 = (bf16_t*)(F.ws + RW_W1) + (size_t)item * 4096, *GU0T = (bf16_t*)(F.ws + RW_U0T) + (size_t)item * 4096, *GM = (bf16_t*)(F.ws + RW_M) + (size_t)item * 4096, *GN = (bf16_t*)(F.ws + RW_N) + (size_t)item * 4096;
    ldsp lds = F.lds; LAS float* Lc = (LAS float*)(lds + R1_LC); LAS float* seg = (LAS float*)(lds + R1_SEG); LAS float* GC = (LAS float*)(lds + R1_GC);
    const int rb = F.wave >> 1, cb = F.wave & 1, fr = F.lane & 15, g = F.lane >> 4;
    chunk_prefix(F, Rld, t0, h, Lc, seg);
    {   const int t = F.tid >> 3, c8 = F.tid & 7; const size_t go = (size_t)(t0 + t) * 256 + h * 64 + c8 * 8;
        float kap[8], b[8], k[8], v[8], o1[8], o2[8];
        unpack8(*(const u32x4*)(Rkap + go), kap); unpack8(*(const u32x4*)(Rb + go), b); unpack8(*(const u32x4*)(Rk + go), k); unpack8(*(const u32x4*)(Rv + go), v);
        float L[8], Lp[8], Lm[8], LC[8];
#pragma unroll
        for (int e = 0; e < 8; ++e) { const int cc = c8 * 8 + e; L[e] = Lc[t * 64 + cc]; Lp[e] = (t > 0) ? Lc[(t - 1) * 64 + cc] : 0.f; Lm[e] = Lc[31 * 64 + cc]; LC[e] = Lc[63 * 64 + cc]; }
#pragma unroll
        for (int e = 0; e < 8; ++e) o1[e] = kap[e] * __expf(Lp[e] - Lm[e]);
        *(LAS u32x4*)(lds + R1_KQ + swz128(t, c8)) = pack8(o1);
#pragma unroll
        for (int e = 0; e < 8; ++e) o1[e] = kap[e] * __expf(Lp[e]);
        *(LAS u32x4*)(lds + R1_KABS + swz128(t, c8)) = pack8(o1); st_tr8(lds + R1_KABST, t, c8, o1);
#pragma unroll
        for (int e = 0; e < 8; ++e) { const float s = __expf(Lm[e] - L[e]); o1[e] = b[e] * s; o2[e] = k[e] * s; }
        *(LAS u32x4*)(lds + R1_BK + swz128(t, c8)) = pack8(o1); *(LAS u32x4*)(lds + R1_KK + swz128(t, c8)) = pack8(o2);
#pragma unroll
        for (int e = 0; e < 8; ++e) { const float s = __expf(LC[e] - L[e]); o1[e] = b[e] * s; o2[e] = k[e] * s; }
        st_tr8(lds + R1_BHT, t, c8, o1); st_tr8(lds + R1_KHT, t, c8, o2); st_tr8(lds + R1_VT, t, c8, v);
        if (t == 63) {
#pragma unroll
            for (int e = 0; e < 8; ++e) GC[c8 * 8 + e] = __expf(LC[e]); }
    }
    __syncthreads();
    {
        f32x4 a[2] = {(f32x4){0.f, 0.f, 0.f, 0.f}, (f32x4){0.f, 0.f, 0.f, 0.f}}, at[2] = {a[0], a[0]}, k2[2] = {a[0], a[0]};
        mm_n(lds + R1_KQ, lds + R1_BK, rb, cb, fr, g, a); mm_t(lds + R1_KQ, lds + R1_BK, rb, cb, fr, g, at); mm_n(lds + R1_KQ, lds + R1_KK, rb, cb, fr, g, k2);
#pragma unroll
        for (int n = 0; n < 2; ++n) {
            f32x4 m1, m2, m3;
#pragma unroll
            for (int j = 0; j < 4; ++j) { const int tn = 16 * rb + fr, sn = 32 * cb + 16 * n + 4 * g + j; m1[j] = (sn < tn) ? a[n][j] : 0.f; m3[j] = (sn < tn) ? k2[n][j] : 0.f;
                const int tt = 16 * rb + 4 * g + j, st = 32 * cb + 16 * n + fr; m2[j] = (st < tt) ? at[n][j] : 0.f; }
            *(LAS u32x2*)(lds + R1_Q + adr_n(rb, cb, n, fr, g)) = pk4(m1); *(LAS u32x2*)(lds + R1_E + adr_n(rb, cb, n, fr, g)) = pk4(-m1);
            *(LAS u32x2*)(lds + R1_QT + adr_t(rb, cb, n, fr, g)) = pk4(m2); *(LAS u32x2*)(lds + R1_AAK + adr_n(rb, cb, n, fr, g)) = pk4(m3); }
    }
    __syncthreads();
    {
        f32x4 a[2] = {(f32x4){0.f, 0.f, 0.f, 0.f}, (f32x4){0.f, 0.f, 0.f, 0.f}}, at[2] = {a[0], a[0]};
        mm_n(lds + R1_Q, lds + R1_QT, rb, cb, fr, g, a); mm_t(lds + R1_Q, lds + R1_QT, rb, cb, fr, g, at);
#pragma unroll
        for (int n = 0; n < 2; ++n) { *(LAS u32x2*)(lds + R1_Q + 8192 + adr_n(rb, cb, n, fr, g)) = pk4(a[n]); *(LAS u32x2*)(lds + R1_QT + 8192 + adr_t(rb, cb, n, fr, g)) = pk4(at[n]); }
    }
    __syncthreads();
#pragma unroll 1
    for (int it = 0; it < 5; ++it) {
        ldsp Ecur = lds + R1_E + (it & 1) * 8192, Enew = lds + R1_E + ((it + 1) & 1) * 8192;
        ldsp Qcur = lds + R1_Q + ((it + 1) & 1) * 8192, Qnew = lds + R1_Q + (it & 1) * 8192, QTcur = lds + R1_QT + ((it + 1) & 1) * 8192, QTnew = lds + R1_QT + (it & 1) * 8192;
        f32x4 e[2];
#pragma unroll
        for (int n = 0; n < 2; ++n) e[n] = up4(*(const LAS u32x2*)(Ecur + adr_n(rb, cb, n, fr, g))) + up4(*(const LAS u32x2*)(Qcur + adr_n(rb, cb, n, fr, g)));
        mm_n(Ecur, QTcur, rb, cb, fr, g, e);
#pragma unroll
        for (int n = 0; n < 2; ++n) *(LAS u32x2*)(Enew + adr_n(rb, cb, n, fr, g)) = pk4(e[n]);
        if (it < 4) {
            f32x4 a[2] = {(f32x4){0.f, 0.f, 0.f, 0.f}, (f32x4){0.f, 0.f, 0.f, 0.f}}, at[2] = {a[0], a[0]};
            mm_n(Qcur, QTcur, rb, cb, fr, g, a); mm_t(Qcur, QTcur, rb, cb, fr, g, at);
#pragma unroll
            for (int n = 0; n < 2; ++n) { *(LAS u32x2*)(Qnew + adr_n(rb, cb, n, fr, g)) = pk4(a[n]); *(LAS u32x2*)(QTnew + adr_t(rb, cb, n, fr, g)) = pk4(at[n]); }
        }
        __syncthreads();
    }
    ldsp Ef = lds + R1_E + 8192;
    f32x4 avn[2];
    {
        avn[0] = (f32x4){0.f, 0.f, 0.f, 0.f}; avn[1] = avn[0]; f32x4 avt[2] = {avn[0], avn[0]};
        mm_n(lds + R1_AAK, lds + R1_VT, rb, cb, fr, g, avn); mm_t(lds + R1_AAK, lds + R1_VT, rb, cb, fr, g, avt);
        f32x4 w[2], wt[2];
#pragma unroll
        for (int n = 0; n < 2; ++n) { w[n] = up4(*(const LAS u32x2*)(lds + R1_KABS + adr_n(rb, cb, n, fr, g))); wt[n] = up4(*(const LAS u32x2*)(lds + R1_KABST + adr_t(rb, cb, n, fr, g))); }
        mm_n(Ef, lds + R1_KABST, rb, cb, fr, g, w); mm_t(Ef, lds + R1_KABST, rb, cb, fr, g, wt);
#pragma unroll
        for (int n = 0; n < 2; ++n) { *(LAS u32x2*)(lds + R1_AVT + adr_t(rb, cb, n, fr, g)) = pk4(avt[n]); *(LAS u32x2*)(lds + R1_W1T + adr_t(rb, cb, n, fr, g)) = pk4(wt[n]);
            st8_wt(GW1 + (16 * rb + fr) * 64 + 32 * cb + 16 * n + 4 * g, pk4(w[n])); }
    }
    __syncthreads();
    {
        f32x4 ut[2];
#pragma unroll
        for (int n = 0; n < 2; ++n) ut[n] = up4(*(const LAS u32x2*)(lds + R1_AVT + adr_t(rb, cb, n, fr, g)));
        mm_t(Ef, lds + R1_AVT, rb, cb, fr, g, ut);
        (void)avn;
#pragma unroll
        for (int n = 0; n < 2; ++n) { *(LAS u32x2*)(lds + R1_U0T + adr_t(rb, cb, n, fr, g)) = pk4(ut[n]); st8_wt(GU0T + (32 * cb + 16 * n + fr) * 64 + 16 * rb + 4 * g, pk4(ut[n])); }
    }
    __syncthreads();
    {
        f32x4 m[2] = {(f32x4){0.f, 0.f, 0.f, 0.f}, (f32x4){0.f, 0.f, 0.f, 0.f}}, n1[2] = {m[0], m[0]}, n2[2] = {m[0], m[0]};
        mm_n(lds + R1_BHT, lds + R1_W1T, rb, cb, fr, g, m); mm_t(lds + R1_KHT, lds + R1_VT, rb, cb, fr, g, n1); mm_t(lds + R1_BHT, lds + R1_U0T, rb, cb, fr, g, n2);
        float mo[8];
#pragma unroll
        for (int n = 0; n < 2; ++n)
#pragma unroll
            for (int j = 0; j < 4; ++j) { const int cr = 16 * rb + fr, cc = 32 * cb + 16 * n + 4 * g + j; mo[n * 4 + j] = ((cr == cc) ? GC[cr] : 0.f) - m[n][j]; }
        st16_wt(GM + ((rb * 2 + cb) * 64 + F.lane) * 8, pack8(mo));
#pragma unroll
        for (int n = 0; n < 2; ++n) st8_wt(GN + (((2 * cb + n) * 4 + rb) * 64 + F.lane) * 4, pk4(n1[n] - n2[n]));
    }
    __syncthreads();
}

template <int MODE>
__device__ __forceinline__ void scan16(Frame& F, const bf16_t* GMsrc, const bf16_t* GNsrc, int i0, int h) {
    ldsp lds = F.lds;
    bf16_t* GMG = (bf16_t*)(F.ws + RW_MG); bf16_t* GNG = (bf16_t*)(F.ws + RW_NG); bf16_t* GSG = (bf16_t*)(F.ws + RW_SG); bf16_t* GS = (bf16_t*)(F.ws + RW_S0);
    {   u32x4 r[16];
#pragma unroll
        for (int s = 0; s < 16; ++s) r[s] = *(const u32x4*)(GMsrc + (size_t)((i0 + s) * 4 + h) * 4096 + F.tid * 8);
#pragma unroll
        for (int s = 0; s < 16; ++s) *(LAS u32x4*)(lds + s * 8192 + F.tid * 16) = r[s];
    }
    const int cb2 = F.wave & 3, fr = F.lane & 15, g = F.lane >> 4;
    const bool nchain = (MODE == 0) ? (F.wave >= 4) : true;
    const bool active = (MODE == 0) ? true : (F.wave < 4);
    u32x2 Nf[16][4];
#pragma unroll
    for (int s = 0; s < 16; ++s)
#pragma unroll
        for (int mt = 0; mt < 4; ++mt) Nf[s][mt] = (u32x2){0u, 0u};
    if (active && nchain) {
#pragma unroll
        for (int s = 0; s < 16; ++s)
#pragma unroll
            for (int mt = 0; mt < 4; ++mt) Nf[s][mt] = *(const u32x2*)(GNsrc + (size_t)((i0 + s) * 4 + h) * 4096 + ((cb2 * 4 + mt) * 64 + F.lane) * 4);
    }
    f32x4 S[4];
#pragma unroll
    for (int mt = 0; mt < 4; ++mt) S[mt] = (f32x4){0.f, 0.f, 0.f, 0.f};
    if (MODE == 0 && F.wave < 4) {
#pragma unroll
        for (int mt = 0; mt < 4; ++mt)
#pragma unroll
            for (int j = 0; j < 4; ++j) S[mt][j] = (16 * mt + 4 * g + j == 16 * cb2 + fr) ? 1.f : 0.f;
    }
    if (MODE == 2) {
#pragma unroll
        for (int mt = 0; mt < 4; ++mt) S[mt] = up4(*(const u32x2*)(GSG + (size_t)((i0 >> 4) * 4 + h) * 4096 + ((cb2 * 4 + mt) * 64 + F.lane) * 4));
    }
    __syncthreads();
    if (active) {
#pragma unroll
        for (int s = 0; s < 16; ++s) {
            u32x4 sw[2];
#pragma unroll
            for (int ks = 0; ks < 2; ++ks) { const u32x2 lo = pk4(S[2 * ks]), hi = pk4(S[2 * ks + 1]); sw[ks] = (u32x4){lo.x, lo.y, hi.x, hi.y}; }
            if (MODE == 1) {
#pragma unroll
                for (int mt = 0; mt < 4; ++mt) { const u32x2 w = (mt & 1) ? (u32x2){sw[mt >> 1].z, sw[mt >> 1].w} : (u32x2){sw[mt >> 1].x, sw[mt >> 1].y};
                    st8_wt(GSG + (size_t)((i0 + s) * 4 + h) * 4096 + ((cb2 * 4 + mt) * 64 + F.lane) * 4, w); }
            }
            if (MODE == 2) {
#pragma unroll
                for (int mt = 0; mt < 4; ++mt) { const u32x2 w = (mt & 1) ? (u32x2){sw[mt >> 1].z, sw[mt >> 1].w} : (u32x2){sw[mt >> 1].x, sw[mt >> 1].y};
                    st8_wt(GS + (size_t)((i0 + s) * 4 + h) * 4096 + (16 * cb2 + fr) * 64 + 16 * mt + 4 * g, w); }
            }
#pragma unroll
            for (int mt = 0; mt < 4; ++mt) { f32x4 a = up4(Nf[s][mt]);
#pragma unroll
                for (int ks = 0; ks < 2; ++ks) a = mfma16(*(const LAS bf16x8*)(lds + s * 8192 + ((mt * 2 + ks) * 64 + F.lane) * 16), __builtin_bit_cast(bf16x8, sw[ks]), a);
                S[mt] = a; }
        }
    }
    if (MODE == 0) {
        const int gi = i0 >> 4;
        if (F.wave >= 4) {
#pragma unroll
            for (int mt = 0; mt < 4; ++mt) st8_wt(GNG + (size_t)(gi * 4 + h) * 4096 + ((cb2 * 4 + mt) * 64 + F.lane) * 4, pk4(S[mt]));
        }
        __syncthreads();
        if (F.wave < 4) {
#pragma unroll
            for (int mt = 0; mt < 4; ++mt)
#pragma unroll
                for (int j = 0; j < 4; ++j) *(LAS unsigned short*)(lds + (16 * mt + 4 * g + j) * 128 + (16 * cb2 + fr) * 2) = (unsigned short)f2bf(S[mt][j]);
        }
        __syncthreads();
        {
            const int mtp = F.wave >> 1, ks = F.wave & 1;
            const u32x2 lo = *(const LAS u32x2*)(lds + (16 * mtp + fr) * 128 + (16 * (2 * ks) + 4 * g) * 2), hi = *(const LAS u32x2*)(lds + (16 * mtp + fr) * 128 + (16 * (2 * ks + 1) + 4 * g) * 2);
            st16_wt(GMG + (size_t)(gi * 4 + h) * 4096 + ((mtp * 2 + ks) * 64 + F.lane) * 8, (u32x4){lo.x, lo.y, hi.x, hi.y});
        }
    }
    __syncthreads();
}

constexpr int R3_RQ = 20480, R3_RABS = 28672, R3_BK = 36864, R3_KK = 45056, R3_VT = 53248, R3_S = 61440, R3_W1 = 69632, R3_UT = 77824, R3_ARB = 86016, R3_ARK = 94208, R3_ST = 102400;
__device__ __forceinline__ void rwkv_p3_item(Frame& F, int l, int item) {
    const int c = item >> 2, h = item & 3, t0 = c * 64;
    const bf16_t *Rr = (const bf16_t*)(F.ws + RW_R), *Rk = (const bf16_t*)(F.ws + RW_K), *Rv = (const bf16_t*)(F.ws + RW_V), *Rb = (const bf16_t*)(F.ws + RW_B), *Rg = (const bf16_t*)(F.ws + RW_G), *Rld = (const bf16_t*)(F.ws + RW_LD);
    const bf16_t *GW1 = (const bf16_t*)(F.ws + RW_W1) + (size_t)item * 4096, *GU0T = (const bf16_t*)(F.ws + RW_U0T) + (size_t)item * 4096, *GS = (const bf16_t*)(F.ws + RW_S0) + (size_t)item * 4096;
    const float* Rbon = (const float*)(F.ws + RW_BONUS); bf16_t* ycat = (bf16_t*)(F.ws + WS_ACT);
    ldsp lds = F.lds; LAS float* Lc = (LAS float*)(lds + R1_LC); LAS float* seg = (LAS float*)(lds + R1_SEG); LAS float* ST = (LAS float*)(lds + R3_ST);
    const int rb = F.wave >> 1, cb = F.wave & 1, fr = F.lane & 15, g = F.lane >> 4;
    chunk_prefix(F, Rld, t0, h, Lc, seg);
    {   const int t = F.tid >> 3, c8 = F.tid & 7; const size_t go = (size_t)(t0 + t) * 256 + h * 64 + c8 * 8;
        float r[8], b[8], k[8], v[8], o1[8], o2[8];
        unpack8(*(const u32x4*)(Rr + go), r); unpack8(*(const u32x4*)(Rb + go), b); unpack8(*(const u32x4*)(Rk + go), k); unpack8(*(const u32x4*)(Rv + go), v);
        float L[8], Lm[8];
#pragma unroll
        for (int e = 0; e < 8; ++e) { const int cc = c8 * 8 + e; L[e] = Lc[t * 64 + cc]; Lm[e] = Lc[31 * 64 + cc]; }
#pragma unroll
        for (int e = 0; e < 8; ++e) { o1[e] = r[e] * __expf(L[e] - Lm[e]); o2[e] = r[e] * __expf(L[e]); }
        *(LAS u32x4*)(lds + R3_RQ + swz128(t, c8)) = pack8(o1); *(LAS u32x4*)(lds + R3_RABS + swz128(t, c8)) = pack8(o2);
#pragma unroll
        for (int e = 0; e < 8; ++e) { const float s = __expf(Lm[e] - L[e]); o1[e] = b[e] * s; o2[e] = k[e] * s; }
        *(LAS u32x4*)(lds + R3_BK + swz128(t, c8)) = pack8(o1); *(LAS u32x4*)(lds + R3_KK + swz128(t, c8)) = pack8(o2);
        st_tr8(lds + R3_VT, t, c8, v);
        *(LAS u32x4*)(lds + R3_S + swz128(t, c8)) = *(const u32x4*)(GS + t * 64 + c8 * 8);
        *(LAS u32x4*)(lds + R3_W1 + swz128(t, c8)) = *(const u32x4*)(GW1 + t * 64 + c8 * 8);
    }
    __syncthreads();
    f32x4 y[2];
    {   f32x4 ut[2];
#pragma unroll
        for (int n = 0; n < 2; ++n) ut[n] = up4(*(const u32x2*)(GU0T + (32 * cb + 16 * n + fr) * 64 + 16 * rb + 4 * g));
        mm_t(lds + R3_W1, lds + R3_S, rb, cb, fr, g, ut);
        f32x4 ab[2] = {(f32x4){0.f, 0.f, 0.f, 0.f}, (f32x4){0.f, 0.f, 0.f, 0.f}}, ak[2] = {ab[0], ab[0]};
        mm_n(lds + R3_RQ, lds + R3_BK, rb, cb, fr, g, ab); mm_n(lds + R3_RQ, lds + R3_KK, rb, cb, fr, g, ak);
        y[0] = (f32x4){0.f, 0.f, 0.f, 0.f}; y[1] = y[0];
        mm_n(lds + R3_RABS, lds + R3_S, rb, cb, fr, g, y);
#pragma unroll
        for (int n = 0; n < 2; ++n) {
            f32x4 m1, m2;
#pragma unroll
            for (int j = 0; j < 4; ++j) { const int tn = 16 * rb + fr, sn = 32 * cb + 16 * n + 4 * g + j; m1[j] = (sn <= tn) ? ab[n][j] : 0.f; m2[j] = (sn <= tn) ? ak[n][j] : 0.f; }
            *(LAS u32x2*)(lds + R3_UT + adr_t(rb, cb, n, fr, g)) = pk4(ut[n]);
            *(LAS u32x2*)(lds + R3_ARB + adr_n(rb, cb, n, fr, g)) = pk4(m1); *(LAS u32x2*)(lds + R3_ARK + adr_n(rb, cb, n, fr, g)) = pk4(m2); }
    }
    __syncthreads();
    {   f32x4 z[2] = {(f32x4){0.f, 0.f, 0.f, 0.f}, (f32x4){0.f, 0.f, 0.f, 0.f}};
        mm_n(lds + R3_ARB, lds + R3_UT, rb, cb, fr, g, z); mm_n(lds + R3_ARK, lds + R3_VT, rb, cb, fr, g, y);
        y[0] -= z[0]; y[1] -= z[1];
        float s1 = 0.f, s2 = 0.f;
#pragma unroll
        for (int n = 0; n < 2; ++n)
#pragma unroll
            for (int j = 0; j < 4; ++j) { s1 += y[n][j]; s2 += y[n][j] * y[n][j]; }
        s1 += __shfl_xor(s1, 16); s1 += __shfl_xor(s1, 32); s2 += __shfl_xor(s2, 16); s2 += __shfl_xor(s2, 32);
        if (g == 0) { ST[((16 * rb + fr) * 2 + cb) * 2] = s1; ST[((16 * rb + fr) * 2 + cb) * 2 + 1] = s2; }
    }
    __syncthreads();
    {   const int tl = 16 * rb + fr; const int t = t0 + tl;
        const float s1 = ST[(tl * 2) * 2] + ST[(tl * 2 + 1) * 2], s2 = ST[(tl * 2) * 2 + 1] + ST[(tl * 2 + 1) * 2 + 1];
        const float mean = s1 * (1.f / 64.f), var = fmaxf(s2 * (1.f / 64.f) - mean * mean, 0.f), rstd = 1.f / sqrtf(var + 64e-5f);
        const float bon = Rbon[(size_t)t * 4 + h];
        const float *lng = F.in[21] + l * 256 + h * 64, *lnb = F.in[22] + l * 256 + h * 64;
#pragma unroll
        for (int n = 0; n < 2; ++n) { const int i0 = 32 * cb + 16 * n + 4 * g; const size_t go = (size_t)t * 256 + h * 64 + i0;
            const f32x4 vv = up4(*(const u32x2*)(Rv + go)), gg = up4(*(const u32x2*)(Rg + go)); const f32x4 lg = *(const f32x4*)(lng + i0), lb = *(const f32x4*)(lnb + i0);
            f32x4 o;
#pragma unroll
            for (int j = 0; j < 4; ++j) o[j] = ((y[n][j] - mean) * rstd * lg[j] + lb[j] + bon * vv[j]) * gg[j];
            *(u32x2*)(ycat + (size_t)t * DM + 768 + h * 64 + i0) = pk4(o); }
    }
    __syncthreads();
}

typedef _Float16 f16x2_ __attribute__((ext_vector_type(2)));
__device__ __forceinline__ unsigned pkh(float a, float b) { const f16x2_ h = {(_Float16)a, (_Float16)b}; return __builtin_bit_cast(unsigned, h); }
__device__ __forceinline__ float h_lo(unsigned w) { const f16x2_ h = __builtin_bit_cast(f16x2_, w); return (float)h[0]; }
__device__ __forceinline__ float h_hi(unsigned w) { const f16x2_ h = __builtin_bit_cast(f16x2_, w); return (float)h[1]; }
__device__ __forceinline__ void phase_router(Frame& F, int l, int alt = 0) {
    const float* X = F.out;
    const bf16_t* WH = (const bf16_t*)(F.ws + WS_WRH); const bf16_t* WL = (const bf16_t*)(F.ws + WS_WRL);
    const float* bias_r = (const float*)(F.ws + WS_BR);
    unsigned* cnt = (unsigned*)(F.ws + WS_CTL) + CNT_W0 + (alt * 2 + l) * 2048;
    u32x2* list = (u32x2*)(F.ws + (alt ? WS_P + (size_t)alt * 8 * MiB : WS_LIST));
    LAS float* Lg = (LAS float*)(F.lds + (F.wave & 3) * 4096);
    LAS float* Px = (LAS float*)(F.lds + 16384);
    const int fr = F.lane & 15, g = F.lane >> 4;
    const int kh = (F.wave < 4) ? 0 : 1;
    LAS unsigned* hist = (LAS unsigned*)(F.lds + 16384 + 106496); LAS unsigned* hbase = hist + 32;
    if (F.tid < 32) hist[F.tid] = 0u;
    __syncthreads();
    for (int it0 = F.bid * 4; it0 < T_ / 16; it0 += F.G * 4) {
        const int it = it0 + (F.wave & 3);
        int E0 = -1, E1 = -1; unsigned r0 = 0u, r1 = 0u; float w0 = 0.f, w1 = 0.f;
        f32x4 acc[4][3]; float ssq[4];
#pragma unroll
        for (int q = 0; q < 4; ++q) { ssq[q] = 0.f;
#pragma unroll
            for (int n = 0; n < 3; ++n) acc[q][n] = (f32x4){0.f, 0.f, 0.f, 0.f}; }
        const float* xr = X + (size_t)(it0 * 16 + fr) * DM + F.wave * 128 + g * 8;
        f32x4 xa[4][4], xb[4][4];
#pragma unroll
        for (int q = 0; q < 4; ++q)
#pragma unroll
            for (int k4 = 0; k4 < 4; ++k4) { xa[q][k4] = *(const f32x4*)(xr + (size_t)q * 16 * DM + k4 * 32); xb[q][k4] = *(const f32x4*)(xr + (size_t)q * 16 * DM + k4 * 32 + 4); }
#pragma unroll
        for (int k4 = 0; k4 < 4; ++k4) {
            const int ks = F.wave * 4 + k4;
            bf16x8 wh[3], wl[3];
#pragma unroll
            for (int n = 0; n < 3; ++n) { wh[n] = *(const bf16x8*)(WH + (16 * n + fr) * DM + ks * 32 + g * 8); wl[n] = *(const bf16x8*)(WL + (16 * n + fr) * DM + ks * 32 + g * 8); }
#pragma unroll
            for (int q = 0; q < 4; ++q) {
                const f32x4 x0 = xa[q][k4], x1 = xb[q][k4];
                const float xv[8] = {x0[0], x0[1], x0[2], x0[3], x1[0], x1[1], x1[2], x1[3]};
                unsigned hh[8], ll[8];
#pragma unroll
                for (int e = 0; e < 8; ++e) { ssq[q] += xv[e] * xv[e]; hh[e] = f2bf(xv[e]); ll[e] = f2bf(xv[e] - bf2f(hh[e])); }
                u32x4 hw, lw; hw.x = hh[0] | (hh[1] << 16); hw.y = hh[2] | (hh[3] << 16); hw.z = hh[4] | (hh[5] << 16); hw.w = hh[6] | (hh[7] << 16);
                lw.x = ll[0] | (ll[1] << 16); lw.y = ll[2] | (ll[3] << 16); lw.z = ll[4] | (ll[5] << 16); lw.w = ll[6] | (ll[7] << 16);
                const bf16x8 xh = __builtin_bit_cast(bf16x8, hw), xl = __builtin_bit_cast(bf16x8, lw);
#pragma unroll
                for (int n = 0; n < 3; ++n) { acc[q][n] = mfma16(wh[n], xh, acc[q][n]); acc[q][n] = mfma16(wh[n], xl, acc[q][n]); acc[q][n] = mfma16(wl[n], xh, acc[q][n]); }
            }
        }
#pragma unroll
        for (int q = 0; q < 4; ++q) { LAS float* pw = Px + ((F.wave * 4 + q) * 13) * 64 + F.lane;
#pragma unroll
            for (int n = 0; n < 3; ++n)
#pragma unroll
                for (int j = 0; j < 4; ++j) pw[(n * 4 + j) * 64] = acc[q][n][j];
            pw[12 * 64] = ssq[q]; }
        __syncthreads();
        f32x4 accf[3]; float ss = 0.f;
        accf[0] = (f32x4){0.f, 0.f, 0.f, 0.f}; accf[1] = accf[0]; accf[2] = accf[0];
        if (kh == 0) {
#pragma unroll
            for (int w = 0; w < 8; ++w) { const LAS float* pw = Px + ((w * 4 + F.wave) * 13) * 64 + F.lane;
#pragma unroll
                for (int n = 0; n < 3; ++n)
#pragma unroll
                    for (int j = 0; j < 4; ++j) accf[n][j] += pw[(n * 4 + j) * 64];
                ss += pw[12 * 64]; } }
        ss += __shfl_xor(ss, 16); ss += __shfl_xor(ss, 32);
        const float rinv = 1.f / sqrtf(ss * (1.f / DM) + 1e-6f);
        if (kh == 0) {
#pragma unroll
        for (int n = 0; n < 3; ++n)
#pragma unroll
            for (int j = 0; j < 4; ++j) { const int c = 16 * n + 4 * g + j; Lg[fr * 48 + c] = accf[n][j] * rinv + bias_r[c]; }
        LDS_WAIT();
        if (F.lane < 16) {
            const LAS float* lg = Lg + F.lane * 48; const int tt = it * 16 + F.lane;
            int gi = 0; float gm = lg[0];
#pragma unroll
            for (int k = 1; k < 4; ++k) if (lg[k] > gm) { gm = lg[k]; gi = k; }
            float gs = 0.f;
#pragma unroll
            for (int k = 0; k < 4; ++k) gs += __expf(lg[k] - gm);
            const float gp = 1.f / gs;
            int e0 = 0; float v0 = lg[4 + gi * 8];
#pragma unroll
            for (int k = 1; k < 8; ++k) { const float v = lg[4 + gi * 8 + k]; if (v > v0) { v0 = v; e0 = k; } }
            int e1 = -1; float v1 = -INFINITY;
#pragma unroll
            for (int k = 0; k < 8; ++k) { const float v = lg[4 + gi * 8 + k]; if (k != e0 && v > v1) { v1 = v; e1 = k; } }
            const float ex = __expf(v1 - v0); const float w0_ = gp / (1.f + ex), w1_ = gp * ex / (1.f + ex);
            E0 = gi * 8 + e0; E1 = gi * 8 + e1; w0 = w0_; w1 = w1_;
            r0 = __hip_atomic_fetch_add(hist + E0, 1u, __ATOMIC_RELAXED, __HIP_MEMORY_SCOPE_WORKGROUP);
            r1 = __hip_atomic_fetch_add(hist + E1, 1u, __ATOMIC_RELAXED, __HIP_MEMORY_SCOPE_WORKGROUP);
        }
        }
        __syncthreads();
        if (F.tid < 32) { const unsigned n = hist[F.tid]; unsigned b = 0u; if (n) b = atomicAdd(&cnt[F.tid * 64], n); hbase[F.tid] = b; }
        __syncthreads();
        if (E0 >= 0) { const int tt = it * 16 + F.lane;
            const unsigned p0 = hbase[E0] + r0; list[(size_t)E0 * T_ + p0] = (u32x2){(unsigned)tt, pkh(w0, rinv)};
            const unsigned p1 = hbase[E1] + r1; list[(size_t)E1 * T_ + p1] = (u32x2){(unsigned)tt | 0x80000000u, pkh(w1, rinv)}; }
        __syncthreads();
        if (F.tid < 32) hist[F.tid] = 0u;
    }
}

constexpr int MOE_R = 160, MOE_SLOT = 53248  , MOE_TAB = 3 * MOE_SLOT;
__device__ __forceinline__ int h4(int q) { return (0x78 >> (2 * q)) & 3; }
__device__ __forceinline__ int off64(int row, int c) { return row * 64 + ((c ^ h4((row >> 2) & 3)) << 4); }
#define MOE_GLDS(gp, lp) __builtin_amdgcn_global_load_lds((const unsigned*)(gp), (LAS unsigned*)(lp), 16, 0, 0)
__device__ __forceinline__ void phase_moe(Frame& F, int l, int var = 0) {
    const char* wsb = (const char*)F.ws;
    const float* bias_gu = (const float*)(F.ws + WS_BGU);
    const unsigned* cnt = (const unsigned*)(F.ws + WS_CTL) + CNT_W0 + l * 2048;
    const u32x2* list = (const u32x2*)(F.ws + WS_LIST);
    bf16_t* ys = (bf16_t*)(F.ws + WS_P);
    ldsp lds = F.lds;
    LAS unsigned* tokl = (LAS unsigned*)(lds + MOE_TAB); LAS float* wtl = (LAS float*)(lds + MOE_TAB + 640); LAS float* rvl = (LAS float*)(lds + MOE_TAB + 1280);
    const int vcu = (F.G % 8 == 0) ? (F.bid % 8) * (F.G / 8) + F.bid / 8 : F.bid;
    int total = 0; int fits_i = (F.G == 256) ? 1 : 0;
#pragma unroll
    for (int e = 0; e < 32; ++e) { const int n = (int)cnt[e * 64]; const int nt = (n + MOE_R - 1) / MOE_R; total += nt > 8 ? nt : 8; fits_i &= (n <= 8 * MOE_R) ? 1 : 0; }
    total = __builtin_amdgcn_readfirstlane(total); const bool fits = __builtin_amdgcn_readfirstlane(fits_i) != 0;
#pragma unroll 1
    for (int ti = vcu; ti < total; ti += F.G) {
        int e = 0, m0 = 0, nrows = 0;
        if (fits) { e = ti >> 3; const int n = (int)cnt[e * 64];
            const int rows = (n + 7) >> 3; m0 = (ti & 7) * rows; nrows = n - m0; nrows = nrows < 0 ? 0 : (nrows > rows ? rows : nrows); }
        else { int acc_t = 0;
#pragma unroll 1
            for (int k = 0; k < 32; ++k) { const int n = (int)cnt[k * 64]; int nt = (n + MOE_R - 1) / MOE_R; nt = nt > 8 ? nt : 8;
                if (ti >= acc_t && ti < acc_t + nt) { e = k; const int rows = (n + nt - 1) / nt; m0 = (ti - acc_t) * rows; nrows = n - m0; nrows = nrows < 0 ? 0 : (nrows > rows ? rows : nrows); }
                acc_t += nt; } }
        e = __builtin_amdgcn_readfirstlane(e); m0 = __builtin_amdgcn_readfirstlane(m0); nrows = __builtin_amdgcn_readfirstlane(nrows);
        const int e_w = (var & 16) ? 0 : e;
        __syncthreads();
        int tid_ = (int)__builtin_amdgcn_mbcnt_hi(~0u, __builtin_amdgcn_mbcnt_lo(~0u, 0u)) + 64 * F.wave; asm volatile("" : "+v"(tid_));
        if (tid_ < MOE_R) { u32x2 le = (u32x2){0u, 0u}; if (tid_ < nrows) le = list[(size_t)e * T_ + m0 + tid_];
            if (var & 8) le.x = (unsigned)((ti * 160 + tid_) & (T_ - 1));
            tokl[tid_] = le.x; wtl[tid_] = h_lo(le.y); rvl[tid_] = h_hi(le.y); }
        asm volatile("s_waitcnt vmcnt(0)" ::: "memory");
        __syncthreads();
        if (nrows > 0) {
        const int lane = tid_ & 63, wv = __builtin_amdgcn_readfirstlane(tid_ >> 6), wr = wv >> 2, wc = wv & 3, fr = lane & 15, g = lane >> 4;
        constexpr int WDR = 40960;
        unsigned soffA[3], soffB; int ldst[7];
#pragma unroll
        for (int r = 0; r < 4; ++r) { const int q = wv + 8 * r; const int lrow = lane >> 3, pc = lane & 7; unsigned so;
            if (q < 20) { const int row = 8 * q + lrow; const int c = pc ^ ((row >> 1) & 7); so = (unsigned)WS_RW + (tokl[row] & 0x7fffffffu) * 2048u + c * 16; }
            else { const int row = 8 * (q - 20) + lrow; const int c = pc ^ ((row >> 1) & 7); so = (unsigned)WS_WGU + (unsigned)e_w * 524288u + row * 2048u + c * 16; }
            if (r < 3) soffA[r] = so; else soffB = so; }
#pragma unroll
        for (int r = 0; r < 7; ++r) { const int q = wv + 8 * r; ldst[r] = (q < 20) ? q * 1024 : 20480 + (q - 20) * 1024; }
        const int npc = (wv < 4) ? 7 : 6;
#define SOFF(r) ((r) < 3 ? soffA[(r) < 3 ? (r) : 0] : soffB + (unsigned)((r) - 3) * 131072u)
        u32x4 R0[7], R1[7];
        const int ldw = lane * 16;
#pragma unroll
        for (int r = 0; r < 7; ++r) if (r < npc) { R0[r] = *(const u32x4*)(wsb + SOFF(r)); R1[r] = *(const u32x4*)(wsb + (SOFF(r) + 128u)); }
        f32x4 ag[5][2], au[5][2];
#pragma unroll
        for (int m = 0; m < 5; ++m)
#pragma unroll
            for (int n = 0; n < 2; ++n) { ag[m][n] = (f32x4){0.f, 0.f, 0.f, 0.f}; au[m][n] = ag[m][n]; }
        const int aof0 = swz128(80 * wr + fr, g);
        const int bgo0 = 20480 + swz128(32 * wc + fr, g);
#pragma unroll
        for (int r = 0; r < 7; ++r) if (r < npc) *(LAS u32x4*)(lds + ldst[r] + ldw) = R0[r];
#pragma unroll
        for (int r = 0; r < 7; ++r) if (r < npc) R0[r] = *(const u32x4*)(wsb + (SOFF(r) + 256u));
        asm volatile("s_waitcnt lgkmcnt(0)" ::: "memory");
        __builtin_amdgcn_s_barrier();
        asm volatile("" ::: "memory");
        if (wr == 1) __builtin_amdgcn_s_barrier();
#define MOE_L(KT, RR) do { \
            if ((KT) + 1 < 16) { ldsp sl_ = lds + (((KT) + 1) % 3) * MOE_SLOT; _Pragma("unroll") for (int r = 0; r < 7; ++r) if (r < npc) *(LAS u32x4*)(sl_ + ldst[r] + ldw) = RR[r]; } \
            if ((KT) + 3 < 16) { const unsigned ko_ = (unsigned)((KT) + 3) * 128u; _Pragma("unroll") for (int r = 0; r < 7; ++r) if (r < npc) RR[r] = *(const u32x4*)(wsb + (SOFF(r) + ko_)); } \
            ldsp cur_ = lds + ((KT) % 3) * MOE_SLOT; \
            _Pragma("unroll") for (int ks = 0; ks < 2; ++ks) { \
                _Pragma("unroll") for (int m = 0; m < 5; ++m) af[ks][m] = *(const LAS bf16x8*)(cur_ + ((aof0 + m * 2048) ^ (ks * 64))); \
                _Pragma("unroll") for (int n = 0; n < 2; ++n) { bg_[ks][n] = *(const LAS bf16x8*)(cur_ + ((bgo0 + n * 2048) ^ (ks * 64))); bu_[ks][n] = *(const LAS bf16x8*)(cur_ + ((bgo0 + n * 2048 + 16384) ^ (ks * 64))); } } \
            asm volatile("s_waitcnt lgkmcnt(0)" ::: "memory"); \
            __builtin_amdgcn_s_barrier(); \
            __builtin_amdgcn_sched_barrier(0); \
            __builtin_amdgcn_s_setprio(1); \
            _Pragma("unroll") for (int ks = 0; ks < 2; ++ks) _Pragma("unroll") for (int n = 0; n < 2; ++n) _Pragma("unroll") for (int m = 0; m < 5; ++m) { \
                ag[m][n] = mfma16(bg_[ks][n], af[ks][m], ag[m][n]); au[m][n] = mfma16(bu_[ks][n], af[ks][m], au[m][n]); } \
            __builtin_amdgcn_s_setprio(0); \
            __builtin_amdgcn_s_barrier(); \
            __builtin_amdgcn_sched_barrier(0); } while (0)
#pragma unroll 1
        for (int kt = 0; kt < 16; kt += 2) {
            bf16x8 af[2][5], bg_[2][2], bu_[2][2];
            MOE_L(kt, R1);
            MOE_L(kt + 1, R0);
        }
#undef MOE_L
#undef SOFF
        if (wr == 0) __builtin_amdgcn_s_barrier();
        __builtin_amdgcn_s_barrier();
        asm volatile("" ::: "memory");
        unsigned doff[4];
#pragma unroll
        for (int r = 0; r < 4; ++r) { const int q = wv + 8 * r; const int rho = 4 * q + (lane >> 4), pc = lane & 15; const int col = (rho & ~31) + pg8::perm32(rho & 31); const int c = pc ^ (rho & 15);
            doff[r] = (unsigned)WS_WD + (unsigned)e_w * 262144u + col * 256u + c * 16; }
#pragma unroll
        for (int r = 0; r < 4; ++r) MOE_GLDS(wsb + doff[r], lds + WDR + (wv + 8 * r) * 1024);
        {   const float* bge = bias_gu + e * 256;
#pragma unroll
            for (int n = 0; n < 2; ++n) { const int f0 = 32 * wc + 16 * n + 4 * g;
                const f32x4 bgv = *(const f32x4*)(bge + f0), buv = *(const f32x4*)(bge + 128 + f0);
#pragma unroll
                for (int m = 0; m < 5; ++m) { const int row = 80 * wr + 16 * m + fr; const float rv = rvl[row], wt = wtl[row]; float a_[4];
#pragma unroll
                    for (int j = 0; j < 4; ++j) { const float gv = ag[m][n][j] * rv + bgv[j], uv = au[m][n][j] * rv + buv[j]; a_[j] = gv * sigmoidf_(gv) * uv * wt; }
                    u32x2 w; w.x = pk2(a_[0], a_[1]); w.y = pk2(a_[2], a_[3]);
                    *(LAS u32x2*)(lds + swz256(row, f0 >> 3) + (g & 1) * 8) = w; } }
        }
        const int aof30 = (80 * wr + fr) * 256;
#pragma unroll 1
        for (int hc = 0; hc < 8; ++hc) {
            asm volatile("s_waitcnt vmcnt(0) lgkmcnt(0)" ::: "memory");
            __builtin_amdgcn_s_barrier();
            asm volatile("" ::: "memory");
            if (hc + 1 < 8) { ldsp sl = lds + WDR + ((hc + 1) & 1) * 32768;
#pragma unroll
                for (int r = 0; r < 4; ++r) MOE_GLDS(wsb + (doff[r] + (unsigned)(hc + 1) * 32768u), sl + (wv + 8 * r) * 1024); }
            ldsp cur = lds + WDR + (hc & 1) * 32768;
            f32x4 ao[5][2];
#pragma unroll
            for (int m = 0; m < 5; ++m) { ao[m][0] = (f32x4){0.f, 0.f, 0.f, 0.f}; ao[m][1] = ao[m][0]; }
#pragma unroll
            for (int ks = 0; ks < 4; ++ks) {
                bf16x8 af[5], bf_[2];
#pragma unroll
                for (int m = 0; m < 5; ++m) af[m] = *(const LAS bf16x8*)(lds + aof30 + m * 4096 + (((ks * 4 + g) ^ fr) << 4));
#pragma unroll
                for (int n = 0; n < 2; ++n) bf_[n] = *(const LAS bf16x8*)(cur + (32 * wc + 16 * n + fr) * 256 + (((ks * 4 + g) ^ fr) << 4));
#pragma unroll
                for (int m = 0; m < 5; ++m)
#pragma unroll
                    for (int n = 0; n < 2; ++n) ao[m][n] = mfma16(bf_[n], af[m], ao[m][n]);
            }
            if (!(var & 1)) {
#pragma unroll
            for (int m = 0; m < 5; ++m) { const int row = 80 * wr + 16 * m + fr;
                if (row < nrows) { const unsigned tk = tokl[row]; bf16_t* dst = ys + ((size_t)(tk >> 31) * T_ + (tk & 0x7fffffffu)) * DM + hc * 128 + 32 * wc + 8 * g;
                    u32x4 w; w.x = pk2(ao[m][0][0], ao[m][0][1]); w.y = pk2(ao[m][0][2], ao[m][0][3]); w.z = pk2(ao[m][1][0], ao[m][1][1]); w.w = pk2(ao[m][1][2], ao[m][1][3]);
                    *(u32x4*)dst = w; } }
            }
        }
        asm volatile("s_waitcnt vmcnt(0)" ::: "memory");
        }
    }
    __syncthreads();
}

#define XB_TMO      128
#define XB_XCNT(j)  (256  + 64 * (j))
#define XB_XSUB(j)  (1280 + 64 * (j))
#define XB_XGEN(j)  (2304 + 64 * (j))
#define XB_TOP      3328
#define XB_TOPGEN   3392
#define XCD_BAR_WORDS 3456
#define XB_SPIN_CAP (1u << 18)
__device__ __forceinline__ unsigned xb_ld(unsigned* p)              { return __hip_atomic_load(p, __ATOMIC_RELAXED, __HIP_MEMORY_SCOPE_AGENT); }
__device__ __forceinline__ unsigned xb_add(unsigned* p, unsigned v) { return __hip_atomic_fetch_add(p, v, __ATOMIC_RELAXED, __HIP_MEMORY_SCOPE_AGENT); }
__device__ __forceinline__ unsigned xb_xcc_id() { return (unsigned)__builtin_amdgcn_s_getreg((3 << 11) | 20) & 0xFu; }
#define XB_SPIN(cond, bar) do { unsigned _sp = 0; while (cond) { __builtin_amdgcn_s_sleep(1); \
    if ((++_sp & 255u) == 0u) { if (xb_ld(&(bar)[XB_TMO])) break; if (_sp > XB_SPIN_CAP) { atomicAdd(&(bar)[XB_TMO], 1u); break; } } } } while (0)
struct XcdBarrier { unsigned* bar; unsigned x; volatile LAS unsigned* st; };
__device__ __forceinline__ XcdBarrier xcd_barrier_post(unsigned* bar, volatile LAS unsigned* st) {
    XcdBarrier b; b.bar = bar; b.x = xb_xcc_id(); b.st = st;
    if (threadIdx.x == 0) (void)xb_add(&bar[XB_XCNT(b.x)], 1u);
    return b;
}
__device__ __forceinline__ void xcd_barrier_complete(unsigned* bar, unsigned x, unsigned& nloc, unsigned& nx) {
    const unsigned G = gridDim.x * gridDim.y * gridDim.z;
    unsigned sum, cnt, mine, sp = 0u;
    for (;;) {
        sum = 0u; cnt = 0u; mine = 0u;
#pragma unroll
        for (unsigned j = 0; j < 16; ++j) { const unsigned c = xb_ld(&bar[XB_XCNT(j)]); sum += c; cnt += (c > 0u) ? 1u : 0u; mine = (j == x) ? c : mine; }
        if (sum == G) break;
        __builtin_amdgcn_s_sleep(1);
        if ((++sp & 255u) == 0u) { if (xb_ld(&bar[XB_TMO])) break; if (sp > XB_SPIN_CAP) { atomicAdd(&bar[XB_TMO], 1u); break; } }
    }
    nloc = mine > 0u ? mine : 1u; nx = cnt > 0u ? cnt : 1u;
}
__device__ __forceinline__ void xcd_barrier(const XcdBarrier& b) {
    asm volatile("s_waitcnt vmcnt(0)" ::: "memory");
    __syncthreads();
    if (threadIdx.x == 0) {
        unsigned* bar = b.bar;
        __builtin_amdgcn_s_waitcnt(0);
        unsigned nloc = b.st[0], nx = b.st[1];
        if (nloc == 0u) { xcd_barrier_complete(bar, b.x, nloc, nx); b.st[0] = nloc; b.st[1] = nx; }
        const unsigned old = xb_add(&bar[XB_XSUB(b.x)], 1u);
        const unsigned gen = old / nloc;
        if (old + 1u == (gen + 1u) * nloc) {
            __builtin_amdgcn_fence(__ATOMIC_RELEASE, "agent");
            asm volatile("s_waitcnt vmcnt(0)" ::: "memory");
            const unsigned og = xb_add(&bar[XB_TOP], 1u);
            const unsigned tg = og / nx;
            if (og + 1u == (tg + 1u) * nx) xb_add(&bar[XB_TOPGEN], 1u);
            else XB_SPIN(xb_ld(&bar[XB_TOPGEN]) == tg, bar);
            __builtin_amdgcn_fence(__ATOMIC_ACQUIRE, "agent");
            xb_add(&bar[XB_XGEN(b.x)], 1u);
            asm volatile("s_waitcnt vmcnt(0)" ::: "memory");
        } else {
            XB_SPIN(xb_ld(&bar[XB_XGEN(b.x)]) == gen, bar);
            __builtin_amdgcn_fence(__ATOMIC_ACQUIRE, "agent");
            asm volatile("s_waitcnt vmcnt(0)" ::: "memory");
        }
    }
    __syncthreads();
}

constexpr int NPHASE = 16;
template <int L> __device__ __forceinline__ void layer_phases(Frame& F, const XcdBarrier& bar, const int lo, const int hi) {
    constexpr int B = 1 + 7 * L;
#ifndef PROBE_PH
#define PROBE_PH -1
#endif
#define RP(k) for (int rep_ = 0; rep_ < (((k) == PROBE_PH) ? 3 : 1); ++rep_)
#define INR(k) (lo <= (k) && (k) < hi)
#define IN(k) (INR(k) && fresh(F))
#define SEAM(k) do { if (INR(k) && INR((k) + 1)) xcd_barrier(bar); } while (0)
    if (IN(B + 0)) RP(B + 0) { phase_prep(F, L); __syncthreads(); phase_rownorm(F, L == 0 ? 0 : 1); } SEAM(B + 0);
    if (IN(B + 1)) RP(B + 1) {
        pg8::Gemm gm{(const bf16_t*)(F.ws + WS_ACT), (const bf16_t*)(F.ws + WS_WIN), T_, NINP, DM, DM, DM};
        pg8::StaticOrder S; S.init(T_, NINP, F.G, F.bid);
        pg8::EpiBf16Bias E{(bf16_t*)(F.ws + WS_P), NINP, (const float*)(F.ws + WS_BIN)};
        pg8::gemm_phase<pg8::EpiBf16Bias, pg8::StaticOrder, true, true>(F.lds, gm, S, E);
    } SEAM(B + 1);
    if (IN(B + 2)) RP(B + 2) {
#ifndef PROBE_ITEM
#define PROBE_ITEM -1
#endif
        for (int rp = 0; rp < ((PROBE_ITEM == 0 && L == 0) ? 3 : 1); ++rp) {
#pragma unroll 1
        for (int it = F.bid; it < 512; it += F.G) { asm volatile("" ::: "memory"); if (it < 128) attn_item(F, L, it); } }
        for (int rp = 0; rp < ((PROBE_ITEM == 1 && L == 0) ? 3 : 1); ++rp) {
#pragma unroll 1
        for (int it = F.bid; it < 512; it += F.G) { asm volatile("" ::: "memory"); if (it >= 128 && it < 256) poolconv_item(F, L, it - 128); } }
        for (int rp = 0; rp < ((PROBE_ITEM == 2 && L == 0) ? 3 : 1); ++rp) {
#pragma unroll 1
        for (int it = F.bid; it < 512; it += F.G) { asm volatile("" ::: "memory"); if (it >= 256) rwkvprep_item(F, L, it - 256); } }
    } SEAM(B + 2);
    if (IN(B + 3)) RP(B + 3) {
        unsigned* fl = (unsigned*)(F.ws + WS_CTL) + FLG_W0 + L * 8192 + rep_ * 2304;
#define FLA(u) (fl + (u) * 16)
#define FLB(h) (fl + (64 + (h)) * 16)
#define FLC(h) (fl + (68 + (h)) * 16)
#define FLP(u) (fl + (72 + (u)) * 16)
#pragma unroll 1
        for (int it = F.bid; it < 1024; it += F.G) { asm volatile("" ::: "memory"); rwkv_r1_item(F, it); flag_signal(F, FLA(((it >> 2) >> 4) * 4 + (it & 3))); }
#pragma unroll 1
        for (int u = F.bid; u < 64; u += F.G) { asm volatile("" ::: "memory"); if (F.tid == 0) flag_poll(FLA(u), 16u); flag_acquire(F);
            scan16<0>(F, (const bf16_t*)(F.ws + RW_M), (const bf16_t*)(F.ws + RW_N), (u >> 2) * 16, u & 3); flag_signal(F, FLB(u & 3)); }
#pragma unroll 1
        for (int u = F.bid; u < 4; u += F.G) { asm volatile("" ::: "memory"); if (F.tid == 0) flag_poll(FLB(u), 16u); flag_acquire(F);
            scan16<1>(F, (const bf16_t*)(F.ws + RW_MG), (const bf16_t*)(F.ws + RW_NG), 0, u); flag_signal(F, FLC(u)); }
#pragma unroll 1
        for (int u = F.bid; u < 64; u += F.G) { asm volatile("" ::: "memory"); if (F.tid == 0) flag_poll(FLC(u & 3), 1u); flag_acquire(F);
            scan16<2>(F, (const bf16_t*)(F.ws + RW_M), (const bf16_t*)(F.ws + RW_N), (u >> 2) * 16, u & 3); flag_signal(F, FLP(u)); }
        if (F.tid == 0) { for (int it = F.bid; it < 1024; it += F.G) flag_poll(FLP(((it >> 2) >> 4) * 4 + (it & 3)), 1u); }
        flag_acquire(F);
#pragma unroll 1
        for (int it = F.bid; it < 1024; it += F.G) { asm volatile("" ::: "memory"); rwkv_p3_item(F, L, it); }
#undef FLA
#undef FLB
#undef FLC
#undef FLP
    } SEAM(B + 3);
    if (IN(B + 4)) RP(B + 4) {
        pg8::Gemm gm{(const bf16_t*)(F.ws + WS_ACT), (const bf16_t*)(F.ws + WS_WOUT), T_, DM, DM, DM, DM};
        pg8::StaticOrder S; S.init(T_, DM, F.G, F.bid);
        pg8::EpiResF32 E{L == 0 ? F.in[0] : F.out, F.out, (bf16_t*)(F.ws + WS_RW), DM};
        pg8::gemm_phase<pg8::EpiResF32, pg8::StaticOrder, true, true>(F.lds, gm, S, E);
    } SEAM(B + 4);
    if (IN(B + 5)) RP(B + 5) phase_router(F, L, rep_); SEAM(B + 5);
    #ifndef PROBE_VAR
#define PROBE_VAR 0
#endif
    if (IN(B + 6)) RP(B + 6) phase_moe(F, L, rep_ > 0 ? PROBE_VAR : 0); SEAM(B + 6);
}

__global__ void __launch_bounds__(NTHR, 2) fwd_kernel(Args a) {
    extern __shared__ __attribute__((aligned(16))) unsigned char smem[];
    Frame F;
    F.lds = (ldsp)smem; F.tid = threadIdx.x; F.lane = F.tid & 63; F.wave = __builtin_amdgcn_readfirstlane(F.tid >> 6);
    F.G = gridDim.x; F.bid = blockIdx.x; F.in = a.in; F.out = a.out; F.ws = a.ws;
    const int lo = a.ph_lo, hi = a.ph_hi;
    volatile LAS unsigned* bst = (volatile LAS unsigned*)(F.lds + LDS_BYTES - 64);
    if (F.tid < 16) bst[F.tid] = 0u;
    __syncthreads();
    const XcdBarrier bar = xcd_barrier_post((unsigned*)(F.ws + WS_CTL) + 1024, bst);
    if (IN(0)) RP(0) phase_mod(F); SEAM(0);
    layer_phases<0>(F, bar, lo, hi);
    layer_phases<1>(F, bar, lo, hi);
#ifdef PROBE_XBAR
    if (hi == NPHASE) { for (int i = 0; i < PROBE_XBAR; ++i) xcd_barrier(bar); }
#endif
    if (IN(15)) phase_rownorm(F, 2);
#undef IN
#undef INR
#undef SEAM
}

extern "C" void kernel_launch(void* const* d_in, const int* in_sizes, int n_in, void* d_out, int out_size, void* d_ws, size_t ws_size, hipStream_t stream) {
    static int grid = 0;
    if (grid == 0) {
        int dev = 0, cus = 0;
        if (n_in != 34 || out_size != T_ * DM || ws_size < WS_END) { fprintf(stderr, "kernel_launch: unexpected shapes n_in %d out %d ws %zu\n", n_in, out_size, ws_size); grid = -1; return; }
        if (hipGetDevice(&dev) != hipSuccess || hipDeviceGetAttribute(&cus, hipDeviceAttributeMultiprocessorCount, dev) != hipSuccess) { grid = -1; return; }
        if (hipFuncSetAttribute((const void*)fwd_kernel, hipFuncAttributeMaxDynamicSharedMemorySize, LDS_BYTES) != hipSuccess) { fprintf(stderr, "kernel_launch: hipFuncSetAttribute failed\n"); grid = -1; return; }
        int per_cu = 0;
        if (hipOccupancyMaxActiveBlocksPerMultiprocessor(&per_cu, (const void*)fwd_kernel, NTHR, LDS_BYTES) != hipSuccess || per_cu < 1) { fprintf(stderr, "kernel_launch: occupancy query failed (%d)\n", per_cu); per_cu = 1; }
        (void)hipGetLastError();
        grid = cus;
    }
    if (grid < 0) return;
    (void)hipMemsetAsync((char*)d_ws + WS_CTL, 0, CTL_BYTES, stream);
    Args a{};
    for (int i = 0; i < 34; ++i) a.in[i] = (const float*)d_in[i];
    a.out = (float*)d_out; a.ws = (unsigned char*)d_ws;
#ifdef MULTI_LAUNCH
    for (int ph = 0; ph < NPHASE; ++ph) { a.ph_lo = ph; a.ph_hi = ph + 1; hipLaunchKernelGGL(fwd_kernel, dim3(grid), dim3(NTHR), LDS_BYTES, stream, a); }
#else
    a.ph_lo = 0; a.ph_hi = NPHASE;
    hipLaunchKernelGGL(fwd_kernel, dim3(grid), dim3(NTHR), LDS_BYTES, stream, a);
#endif
}
```
